# Optimizing an MI355X kernel written in HIP

```python
import math
import jax, jax.numpy as jnp
from jax import lax
import numpy as np

D_MODEL = 1024
BATCH = 16
SEQ = 2048
DEPTH = 1

N_MEM = 256
MEM_HEADS = 4
MEM_HEAD_DIM = D_MODEL // MEM_HEADS
D_MIX = D_MODEL
D_LRU = D_MIX // 2
LRU_BLOCKS = 8
LRU_BLOCK_DIM = D_LRU // LRU_BLOCKS
CONV_WIDTH = 4
LRU_C = 8.0
MLA_HEADS = 4
QK_NOPE_DIM = 128
QK_ROPE_DIM = 64
V_HEAD_DIM = 128
Q_LORA_RANK = 384
KV_LORA_RANK = 256
D_MLA_OUT = MLA_HEADS * V_HEAD_DIM
ROPE_THETA = 10000.0
Q_BLOCK = 128
OFF_LRU_X = 0
OFF_LRU_GATE = OFF_LRU_X + D_LRU
OFF_CQ = OFF_LRU_GATE + D_LRU
OFF_CKV = OFF_CQ + Q_LORA_RANK
OFF_KPE = OFF_CKV + KV_LORA_RANK
D_IN = OFF_KPE + QK_ROPE_DIM
D_FF = -(-8 * D_MODEL // (3 * 256)) * 256
RMS_EPS = 1e-6
NEG_INF = -1e30

kernel_name = "hymba_rglru_mla_memory_layer"


def rmsnorm(x, g):
    xf = x.astype(jnp.float32)
    y = xf * lax.rsqrt(jnp.mean(xf * xf, axis=-1, keepdims=True) + RMS_EPS)
    return (y * g.astype(jnp.float32)).astype(x.dtype)


def causal_depthwise_conv(x, w, b):
    s = x.shape[1]
    xp = jnp.pad(x, ((0, 0), (CONV_WIDTH - 1, 0), (0, 0)))
    y = b
    for k in range(CONV_WIDTH):
        y = y + w[k] * xp[:, k:k + s]
    return y


def rg_lru(x, w_a, b_a, w_x, b_x, lam):
    bsz, s, _ = x.shape
    xb = x.reshape(bsz, s, LRU_BLOCKS, LRU_BLOCK_DIM)
    r = jax.nn.sigmoid(jnp.einsum('bshi,hij->bshj', xb, w_a).reshape(bsz, s, D_LRU) + b_a)
    i = jax.nn.sigmoid(jnp.einsum('bshi,hij->bshj', xb, w_x).reshape(bsz, s, D_LRU) + b_x)
    log_a = -LRU_C * r.astype(jnp.float32) * jax.nn.softplus(-lam.astype(jnp.float32))
    a = jnp.exp(log_a)
    u = jnp.sqrt(-jnp.expm1(2.0 * log_a)) * (i * x).astype(jnp.float32)

    def combine(c1, c2):
        a1, b1 = c1
        a2, b2 = c2
        return a1 * a2, a2 * b1 + b2

    _, h = lax.associative_scan(combine, (a, u), axis=1)
    return h.astype(x.dtype)


def apply_rope(x, cos, sin):
    half = x.shape[-1] // 2
    x1, x2 = x[..., :half], x[..., half:]
    return jnp.concatenate([x1 * cos - x2 * sin, x2 * cos + x1 * sin], axis=-1)


def causal_block_attention(q, k, v, scale):
    s = q.shape[1]
    outs = []
    for blk in range(s // Q_BLOCK):
        q0 = blk * Q_BLOCK
        kv_len = q0 + Q_BLOCK
        qb = q[:, q0:kv_len]
        kb = k[:, :kv_len]
        vb = v[:, :kv_len]
        sc = jnp.einsum('bqhd,bkhd->bhqk', qb, kb).astype(jnp.float32) * scale
        mask = (q0 + jnp.arange(Q_BLOCK))[:, None] >= jnp.arange(kv_len)[None, :]
        sc = jnp.where(mask[None, None], sc, NEG_INF)
        p = jax.nn.softmax(sc, axis=-1).astype(vb.dtype)
        outs.append(jnp.einsum('bhqk,bkhd->bqhd', p, vb))
    return jnp.concatenate(outs, axis=1)


def setup_inputs(seed: int = 0) -> dict:
    key = jax.random.key(seed)
    ks = iter(jax.random.split(key, 48))

    def w(shape, fan_in):
        return jax.random.normal(next(ks), shape, jnp.float32) * fan_in ** -0.5

    def gain(n):
        return 1.0 + 0.05 * jax.random.normal(next(ks), (DEPTH, n), jnp.float32)

    def bias(n, s=0.02):
        return s * jax.random.normal(next(ks), (DEPTH, n), jnp.float32)

    x = jax.random.normal(next(ks), (BATCH, SEQ, D_MODEL), jnp.float32)
    mem = jax.random.normal(next(ks), (BATCH, N_MEM, D_MODEL), jnp.float32)
    start = jax.random.randint(next(ks), (BATCH, 1), 0, 4096, dtype=jnp.int32)
    positions = (start + jnp.arange(SEQ, dtype=jnp.int32)[None, :]).astype(jnp.int32)
    a0 = jax.random.uniform(next(ks), (DEPTH, D_LRU), jnp.float32, minval=0.9, maxval=0.999)
    lru_lambda = jnp.log(a0) - jnp.log1p(-a0)

    return {
        "x": x,
        "mem": mem,
        "positions": positions,
        "g_pre_mix": gain(D_MODEL),
        "w_in": w((DEPTH, D_MODEL, D_IN), D_MODEL),
        "conv_w": w((DEPTH, CONV_WIDTH, D_LRU), CONV_WIDTH),
        "conv_b": bias(D_LRU),
        "lru_wa": w((DEPTH, LRU_BLOCKS, LRU_BLOCK_DIM, LRU_BLOCK_DIM), LRU_BLOCK_DIM),
        "lru_ba": bias(D_LRU, 0.1),
        "lru_wx": w((DEPTH, LRU_BLOCKS, LRU_BLOCK_DIM, LRU_BLOCK_DIM), LRU_BLOCK_DIM),
        "lru_bx": bias(D_LRU, 0.1),
        "lru_lambda": lru_lambda,
        "g_q_lat": gain(Q_LORA_RANK),
        "w_uq": w((DEPTH, Q_LORA_RANK, MLA_HEADS * (QK_NOPE_DIM + QK_ROPE_DIM)), Q_LORA_RANK),
        "g_kv_lat": gain(KV_LORA_RANK),
        "w_ukv": w((DEPTH, KV_LORA_RANK, MLA_HEADS * (QK_NOPE_DIM + V_HEAD_DIM)), KV_LORA_RANK),
        "g_lru_out": gain(D_LRU),
        "g_mla_out": gain(D_MLA_OUT),
        "w_out": w((DEPTH, D_MIX, D_MODEL), D_MIX),
        "g_post_mix": gain(D_MODEL),
        "g_pre_mem": gain(D_MODEL),
        "g_mem_kv": gain(D_MODEL),
        "w_mq": w((DEPTH, D_MODEL, D_MODEL), D_MODEL),
        "w_mk": w((DEPTH, D_MODEL, D_MODEL), D_MODEL),
        "w_mv": w((DEPTH, D_MODEL, D_MODEL), D_MODEL),
        "w_mo": w((DEPTH, D_MODEL, D_MODEL), D_MODEL),
        "g_post_mem": gain(D_MODEL),
        "g_pre_ffn": gain(D_MODEL),
        "w_gate": w((DEPTH, D_MODEL, D_FF), D_MODEL),
        "w_up": w((DEPTH, D_MODEL, D_FF), D_MODEL),
        "w_down": w((DEPTH, D_FF, D_MODEL), D_FF),
        "g_post_ffn": gain(D_MODEL),
    }


def reference(x, mem, positions, g_pre_mix, w_in, conv_w, conv_b, lru_wa, lru_ba, lru_wx,
              lru_bx, lru_lambda, g_q_lat, w_uq, g_kv_lat, w_ukv, g_lru_out, g_mla_out, w_out,
              g_post_mix, g_pre_mem, g_mem_kv, w_mq, w_mk, w_mv, w_mo, g_post_mem, g_pre_ffn,
              w_gate, w_up, w_down, g_post_ffn):
    bsz, s, _ = x.shape
    n_mem = mem.shape[1]
    mla_scale = 1.0 / math.sqrt(QK_NOPE_DIM + QK_ROPE_DIM)
    mem_scale = 1.0 / math.sqrt(MEM_HEAD_DIM)

    inv_freq = ROPE_THETA ** (-jnp.arange(0, QK_ROPE_DIM, 2, dtype=jnp.float32) / QK_ROPE_DIM)
    ang = positions.astype(jnp.float32)[..., None] * inv_freq
    cos = jnp.cos(ang)[:, :, None, :].astype(x.dtype)
    sin = jnp.sin(ang)[:, :, None, :].astype(x.dtype)

    h = x
    for l in range(DEPTH):
        xn = rmsnorm(h, g_pre_mix[l])
        z = xn @ w_in[l]
        lru_x = z[..., OFF_LRU_X:OFF_LRU_GATE]
        lru_gate = z[..., OFF_LRU_GATE:OFF_CQ]
        c_q = z[..., OFF_CQ:OFF_CKV]
        c_kv = z[..., OFF_CKV:OFF_KPE]
        k_pe = z[..., OFF_KPE:D_IN]

        u = causal_depthwise_conv(lru_x, conv_w[l], conv_b[l])
        hl = rg_lru(u, lru_wa[l], lru_ba[l], lru_wx[l], lru_bx[l], lru_lambda[l])
        y_lru = hl * jax.nn.gelu(lru_gate, approximate=True)

        q = (rmsnorm(c_q, g_q_lat[l]) @ w_uq[l]).reshape(bsz, s, MLA_HEADS, QK_NOPE_DIM + QK_ROPE_DIM)
        kv = (rmsnorm(c_kv, g_kv_lat[l]) @ w_ukv[l]).reshape(bsz, s, MLA_HEADS, QK_NOPE_DIM + V_HEAD_DIM)
        q_nope, q_pe = q[..., :QK_NOPE_DIM], q[..., QK_NOPE_DIM:]
        k_nope, v = kv[..., :QK_NOPE_DIM], kv[..., QK_NOPE_DIM:]
        q_pe = apply_rope(q_pe, cos, sin)
        k_pe_r = apply_rope(k_pe[:, :, None, :], cos, sin)
        q_full = jnp.concatenate([q_nope, q_pe], axis=-1)
        k_full = jnp.concatenate(
            [k_nope, jnp.broadcast_to(k_pe_r, (bsz, s, MLA_HEADS, QK_ROPE_DIM))], axis=-1)
        y_mla = causal_block_attention(q_full, k_full, v, mla_scale).reshape(bsz, s, D_MLA_OUT)

        y = jnp.concatenate([rmsnorm(y_lru, g_lru_out[l]), rmsnorm(y_mla, g_mla_out[l])], axis=-1)
        h = h + rmsnorm(y @ w_out[l], g_post_mix[l])

        xn = rmsnorm(h, g_pre_mem[l])
        mn = rmsnorm(mem, g_mem_kv[l])
        mq = (xn @ w_mq[l]).reshape(bsz, s, MEM_HEADS, MEM_HEAD_DIM)
        mk = (mn @ w_mk[l]).reshape(bsz, n_mem, MEM_HEADS, MEM_HEAD_DIM)
        mv = (mn @ w_mv[l]).reshape(bsz, n_mem, MEM_HEADS, MEM_HEAD_DIM)
        sc = jnp.einsum('bshd,bnhd->bhsn', mq, mk).astype(jnp.float32) * mem_scale
        p = jax.nn.softmax(sc, axis=-1).astype(mv.dtype)
        o = jnp.einsum('bhsn,bnhd->bshd', p, mv).reshape(bsz, s, D_MODEL)
        h = h + rmsnorm(o @ w_mo[l], g_post_mem[l])

        xn = rmsnorm(h, g_pre_ffn[l])
        f = (jax.nn.silu(xn @ w_gate[l]) * (xn @ w_up[l])) @ w_down[l]
        h = h + rmsnorm(f, g_post_ffn[l])
    return h
```

```cpp
#include <hip/hip_runtime.h>
#include <hip/hip_bf16.h>
#include <cstdio>
#include <cstdint>

#define LAS __attribute__((address_space(3)))
#define GAS __attribute__((address_space(1)))
typedef unsigned short bf16_t;
typedef short bf16x8 __attribute__((ext_vector_type(8)));
typedef short s16x4 __attribute__((ext_vector_type(4)));
typedef float f32x4 __attribute__((ext_vector_type(4)));
typedef float f32x2 __attribute__((ext_vector_type(2)));
typedef float f32x16 __attribute__((ext_vector_type(16)));
typedef unsigned u32x4 __attribute__((ext_vector_type(4)));
typedef unsigned u32x2 __attribute__((ext_vector_type(2)));

constexpr int BATCH = 16, SEQ = 2048, DM = 1024, T = BATCH * SEQ;
constexpr int NMEM = 256, TM = BATCH * NMEM;
constexpr int DLRU = 512, DINP = 1792, QLR = 384, KVLR = 256, DFF = 2816;
constexpr int OFF_GATE = 512, OFF_CQ = 1024, OFF_CKV = 1408, OFF_KPE = 1664;
constexpr float EPS = 1e-6f;
constexpr float LOG2E = 1.4426950408889634f;
constexpr float QSCALE = 0.07216878364870322f * LOG2E;
constexpr float MSCALE = 0.0625f * LOG2E;

constexpr size_t MiB = 1u << 20;
constexpr size_t WS_CTL = 0, CTL_ZERO_BYTES = 2 * MiB;
constexpr size_t WS_SSQ = 1 * MiB;
constexpr size_t WS_SLOTS = 2 * MiB;
constexpr int CW_SEAM = 16384, SEAM_BANK = 8192;
constexpr size_t WS_ROPE = 4 * MiB;
constexpr size_t WS_WIN = 12 * MiB, WS_WUQ = 16 * MiB, WS_WUKV = 17 * MiB, WS_WOUT = 18 * MiB, WS_WMQ = 20 * MiB, WS_WMKV = 22 * MiB,
                 WS_WMO = 26 * MiB, WS_WGU = 28 * MiB, WS_WDOWN = 39 * MiB;
constexpr size_t WS_MN = 46 * MiB, WS_MKV = 54 * MiB, WS_WQK = 70 * MiB, WS_WVO = 102 * MiB, WS_XN = 134 * MiB, WS_KPE = 198 * MiB;
constexpr size_t WS_Z = 202 * MiB, WS_Q = 314 * MiB, WS_KV = 362 * MiB, WS_Y = 426 * MiB;
constexpr size_t WS_PRE = 202 * MiB, WS_P = 330 * MiB, WS_F = 330 * MiB, WS_END = 506 * MiB;
constexpr int CW_BAR = 4096;

constexpr int RING_BYTES = 131072, EPI_OFF = RING_BYTES, EPI_BYTES = 16384, MISC_OFF = EPI_OFF + EPI_BYTES, LDS_BYTES = MISC_OFF + 1024;

__device__ __forceinline__ unsigned cvt_pk_bf16(float lo, float hi) { unsigned r; asm volatile("v_cvt_pk_bf16_f32 %0, %1, %2" : "=v"(r) : "v"(lo), "v"(hi)); return r; }
__device__ __forceinline__ float bf2f(unsigned short v) { return __uint_as_float((unsigned)v << 16); }
__device__ __forceinline__ float bflo(unsigned w) { return __uint_as_float(w << 16); }
__device__ __forceinline__ float bfhi(unsigned w) { return __uint_as_float(w & 0xffff0000u); }
__device__ __forceinline__ float wave_sum(float v) {
#pragma unroll
    for (int o = 1; o < 64; o <<= 1) v += __shfl_xor(v, o);
    return v;
}
__device__ __forceinline__ int lane_id() { int l; asm volatile("v_mbcnt_lo_u32_b32 %0, -1, 0\n\tv_mbcnt_hi_u32_b32 %0, -1, %0" : "=v"(l)); return l; }
#define LDS_WAIT() asm volatile("s_waitcnt lgkmcnt(0)" ::: "memory")
#define VM_WAIT() asm volatile("s_waitcnt vmcnt(0)" ::: "memory")

namespace pg8 {
constexpr int BM = 256, BK = 64, HALF = 128, HTB = HALF * BK * 2, STAGE_BYTES = 8 * HTB, NXCD = 8, WGM = 8;
__host__ __device__ __forceinline__ int lds_byte(int r, int c) { const int st = (r >> 4) * 2 + (c >> 5), rr = r & 15, cc = c & 31, ob = rr * 64 + cc * 2; return st * 1024 + (ob ^ (((ob >> 9) & 1) << 5)); }
__host__ __device__ __forceinline__ void stage_rc(int b, int& R, int& C) { const int st = b / 1024, sb = b % 1024, swz = sb ^ (((sb >> 9) & 1) << 5); R = (st >> 1) * 16 + swz / 64; C = (st & 1) * 32 + (swz % 64) / 2; }
__host__ __device__ __forceinline__ int perm32(int rho) { const int n = rho >> 4, i = rho & 15; return 8 * (i >> 2) + 4 * n + (i & 3); }

struct Unit { int pm, pn; const char* A; const char* B; long cofs; };

struct TileOrder {
    int nM, nN, nwg, G, c; const char* A; const char* B; size_t tA, tB, bB;
    __device__ void init(int M, int N, int G_, int c_, const void* A_, int lda, const void* B_, int ldb, size_t batchB_bytes = 0) {
        nM = M / BM; nN = N / BM; nwg = nM * nN; G = G_; c = c_; A = (const char*)A_; B = (const char*)B_; tA = (size_t)BM * lda * 2; tB = (size_t)BM * ldb * 2; bB = batchB_bytes; }
    __device__ bool next(int i, Unit& u) const {
        const long L = (long)i * G + c; if (L >= nwg) return false;
        int wgid = (int)L; { const int q = nwg / NXCD, r = nwg % NXCD, xcd = wgid % NXCD, off = wgid / NXCD; wgid = (xcd < r ? xcd * (q + 1) : r * (q + 1) + (xcd - r) * q) + off; }
        const int nig = WGM * nN, gid = wgid / nig, fm = gid * WGM, gsz = (nM - fm) < WGM ? (nM - fm) : WGM;
        u.pm = fm + ((wgid % nig) % gsz); u.pn = (wgid % nig) / gsz; u.A = A + (size_t)u.pm * tA; u.B = B + (size_t)u.pn * tB + (size_t)(u.pm >> 3) * bB; u.cofs = 0; return true;
    }
};

template <class Epi, class Sched, bool ALIGN_EPI = true, bool SP2 = true>
__device__ __forceinline__ void gemm_phase(LAS unsigned char* lds, const int lda, const int ldb, const int K, const Sched& S, const Epi& E, const int wv) {
    int lane = lane_id(); asm volatile("" : "+v"(lane));
    const int wid = wv, tid = wv * 64 + lane, wr = wid >> 2, wc = wid & 3, fr = lane & 15, fq = lane >> 4;
    const int nt = K / BK;
    unsigned voffA[2], voffB[2];
#pragma unroll
    for (int i = 0; i < 2; ++i) { int R, C; stage_rc(tid * 16 + i * 8192, R, C); const int Rb = Epi::PERM ? ((R & ~31) + perm32(R & 31)) : R;
        voffA[i] = (unsigned)(R * lda + C) * 2u; voffB[i] = (unsigned)(Rb * ldb + C) * 2u; }
    const size_t kstep = (size_t)(BK * 2);
    const size_t hstepA = (size_t)HALF * lda * 2, hstepB = (size_t)HALF * ldb * 2;
    const unsigned ldsw = (unsigned)wid * 1024u;
    const int aoff = lds_byte(wr * 64 + fr, fq * 8), boff = lds_byte(wc * 32 + fr, fq * 8);
#define PG8_SA(b, h) (((b) * 2 + (h)) * HTB)
#define PG8_SB(b, h) ((4 + (b) * 2 + (h)) * HTB)
#define PG8_STAGE(bufoff, gbase, voff) do { _Pragma("unroll") for (int _i = 0; _i < 2; ++_i) \
        __builtin_amdgcn_global_load_lds((const unsigned*)((const char*)(gbase) + (voff)[_i]), (LAS unsigned*)(lds + (bufoff) + ldsw + _i * 8192), 16, 0, 0); } while (0)
#define PG8_LDA(dst, b, h) do { _Pragma("unroll") for (int m = 0; m < 4; ++m) _Pragma("unroll") for (int k = 0; k < 2; ++k) dst[m][k] = *(const LAS bf16x8*)(lds + PG8_SA(b, h) + aoff + m * 2048 + k * 1024); } while (0)
#define PG8_LDB(dst, b, h) do { _Pragma("unroll") for (int n = 0; n < 2; ++n) _Pragma("unroll") for (int k = 0; k < 2; ++k) dst[n][k] = *(const LAS bf16x8*)(lds + PG8_SB(b, h) + boff + n * 2048 + k * 1024); } while (0)
#define PG8_MMA(ai, bj, At, Bt) do { __builtin_amdgcn_s_setprio(1); _Pragma("unroll") for (int m = 0; m < 4; ++m) _Pragma("unroll") for (int n = 0; n < 2; ++n) _Pragma("unroll") for (int k = 0; k < 2; ++k) \
        acc[ai][bj][m][n] = __builtin_amdgcn_mfma_f32_16x16x32_bf16(Bt[n][k], At[m][k], acc[ai][bj][m][n], 0, 0, 0); __builtin_amdgcn_s_setprio(0); } while (0)
#define PG8_WAIT_V(n) asm volatile("s_waitcnt vmcnt(" #n ")" ::: "memory")
#define PG8_WAIT_L(n) asm volatile("s_waitcnt lgkmcnt(" #n ")" ::: "memory")
#define PG8_BAR __builtin_amdgcn_s_barrier()
#define PG8_SCHED __builtin_amdgcn_sched_barrier(0)
    Unit cur, nxt; int ui = 0;
    if (!S.next(0, cur)) return;
    if constexpr (Epi::MIDK) E.prep(cur, lds, wid, 0);
    f32x4 acc[2][2][4][2];
#pragma unroll
    for (int a = 0; a < 2; ++a)
#pragma unroll
        for (int b = 0; b < 2; ++b)
#pragma unroll
            for (int m = 0; m < 4; ++m)
#pragma unroll
                for (int n = 0; n < 2; ++n) acc[a][b][m][n] = (f32x4){0.f, 0.f, 0.f, 0.f};
    bf16x8 At[4][2], B0[2][2], B1[2][2];
    const char* cA = cur.A; const char* cB = cur.B;
    static_assert(SP2, "only the SP2 loop is kept");
    PG8_STAGE(PG8_SB(0, 0), cB, voffB); PG8_STAGE(PG8_SB(0, 1), cB + hstepB, voffB); PG8_STAGE(PG8_SA(0, 0), cA, voffA); PG8_STAGE(PG8_SA(0, 1), cA + hstepA, voffA);
    if (wr == 1) PG8_BAR;
    PG8_WAIT_V(2); PG8_BAR;
    PG8_STAGE(PG8_SB(1, 0), cB + kstep, voffB); PG8_STAGE(PG8_SA(1, 0), cA + kstep, voffA); PG8_STAGE(PG8_SB(1, 1), cB + hstepB + kstep, voffB);
    PG8_WAIT_V(6); PG8_BAR;
    for (;;) {
        const bool has_next = S.next(ui + 1, nxt);
        const char* nA = has_next ? nxt.A : cA; const char* nB = has_next ? nxt.B : cB;
        for (int t = 0; t < nt; t += 2) {
            if constexpr (Epi::MIDK) { if (t == Epi::TSPLIT) E.midk(acc, lds, ui & 1, wr); }
            const bool last = (t == nt - 2);
            const char* a1 = cA + (size_t)(t + 1) * kstep;
            const char* a2 = last ? nA : cA + (size_t)(t + 2) * kstep; const char* b2 = last ? nB : cB + (size_t)(t + 2) * kstep;
            const char* a3 = a2 + kstep; const char* b3 = b2 + kstep;
            PG8_LDB(B0, 0, 0); PG8_LDB(B1, 0, 1); PG8_SCHED; PG8_LDA(At, 0, 0); PG8_STAGE(PG8_SA(1, 1), a1 + hstepA, voffA);
            PG8_WAIT_V(8); PG8_WAIT_L(0); PG8_BAR; PG8_MMA(0, 0, At, B0); PG8_MMA(0, 1, At, B1); PG8_BAR; PG8_SCHED;
            PG8_LDA(At, 0, 1); PG8_STAGE(PG8_SB(0, 0), b2, voffB); PG8_STAGE(PG8_SB(0, 1), b2 + hstepB, voffB); PG8_STAGE(PG8_SA(0, 0), a2, voffA);
            PG8_WAIT_V(8); PG8_WAIT_L(0); PG8_BAR; PG8_MMA(1, 0, At, B0); PG8_MMA(1, 1, At, B1); PG8_BAR; PG8_SCHED;
            PG8_LDB(B0, 1, 0); PG8_LDB(B1, 1, 1); PG8_SCHED; PG8_LDA(At, 1, 0); PG8_STAGE(PG8_SA(0, 1), a2 + hstepA, voffA);
            PG8_WAIT_V(8); PG8_WAIT_L(0); PG8_BAR; PG8_MMA(0, 0, At, B0); PG8_MMA(0, 1, At, B1); PG8_BAR; PG8_SCHED;
            PG8_LDA(At, 1, 1); PG8_STAGE(PG8_SB(1, 0), b3, voffB); PG8_STAGE(PG8_SB(1, 1), b3 + hstepB, voffB); PG8_STAGE(PG8_SA(1, 0), a3, voffA);
            PG8_WAIT_V(8); PG8_WAIT_L(0); PG8_BAR; PG8_MMA(1, 0, At, B0); PG8_MMA(1, 1, At, B1); PG8_BAR; PG8_SCHED;
        }
        if constexpr (ALIGN_EPI) { if (wr == 0) PG8_BAR; }
        E(acc, cur, wr, wc, fr, fq, lds, wid, ui & 1);
        if (!has_next) break;
        if constexpr (Epi::MIDK) E.prep(nxt, lds, wid, (ui + 1) & 1);
#pragma unroll
        for (int a = 0; a < 2; ++a)
#pragma unroll
            for (int b = 0; b < 2; ++b)
#pragma unroll
                for (int m = 0; m < 4; ++m)
#pragma unroll
                    for (int n = 0; n < 2; ++n) acc[a][b][m][n] = (f32x4){0.f, 0.f, 0.f, 0.f};
        cur = nxt; cA = nA; cB = nB; ++ui;
        if constexpr (ALIGN_EPI) { if (wr == 1) PG8_BAR; }
    }
    PG8_WAIT_V(0);
    if constexpr (!ALIGN_EPI) { if (wr == 0) PG8_BAR; }
    PG8_BAR;
#undef PG8_SA
#undef PG8_SB
#undef PG8_STAGE
#undef PG8_LDA
#undef PG8_LDB
#undef PG8_MMA
#undef PG8_WAIT_V
#undef PG8_WAIT_L
#undef PG8_BAR
#undef PG8_SCHED
}
}

typedef f32x4 Acc[2][2][4][2];
__device__ __forceinline__ void ssq_rows_atomic(const Acc& acc, float* ssq, int row_base  , int bjmask, int fq, int lane) {
#pragma unroll
    for (int ai = 0; ai < 2; ++ai) {
        float s[4];
#pragma unroll
        for (int m = 0; m < 4; ++m) { float q = 0.f;
#pragma unroll
            for (int bj = 0; bj < 2; ++bj) if (bjmask & (1 << bj))
#pragma unroll
                for (int n = 0; n < 2; ++n) { const f32x4 x = acc[ai][bj][m][n]; q += (x[0] * x[0] + x[1] * x[1]) + (x[2] * x[2] + x[3] * x[3]); }
            q += __shfl_xor(q, 16); q += __shfl_xor(q, 32); s[m] = q; }
        const float v = fq == 0 ? s[0] : fq == 1 ? s[1] : fq == 2 ? s[2] : s[3];
        atomicAdd(ssq + row_base + ai * 128 + lane, v);
    }
}
struct EpiBf16 {
    static constexpr bool PERM = true, MIDK = false;
    bf16_t* O; int ldc; float scale; const float* ssq; float rdim_inv;
    __device__ __forceinline__ void operator()(const Acc& acc, const pg8::Unit& u, int wr, int wc, int fr, int fq, LAS unsigned char*, int, int) const {
        { const int ln_ = lane_id(); fr = ln_ & 15; fq = ln_ >> 4; }
        const int row0 = u.pm * 256 + wr * 64 + fr, col0 = u.pn * 256 + wc * 32 + 8 * fq;
#pragma unroll
        for (int ai = 0; ai < 2; ++ai)
#pragma unroll
            for (int m = 0; m < 4; ++m) { const int row = row0 + ai * 128 + m * 16; float sc = scale;
                if (ssq) sc *= __builtin_amdgcn_rsqf(ssq[row] * rdim_inv + EPS);
                bf16_t* rowp = O + u.cofs + (size_t)row * ldc + col0;
#pragma unroll
                for (int bj = 0; bj < 2; ++bj) { const f32x4 v0 = acc[ai][bj][m][0] * sc, v1 = acc[ai][bj][m][1] * sc;
                    u32x4 w; w.x = cvt_pk_bf16(v0[0], v0[1]); w.y = cvt_pk_bf16(v0[2], v0[3]); w.z = cvt_pk_bf16(v1[0], v1[1]); w.w = cvt_pk_bf16(v1[2], v1[3]);
                    *(u32x4*)(rowp + bj * 128) = w; } }
    }
};
__device__ __forceinline__ void rope8(f32x4& v0, f32x4& v1, const float* cosT, const float* sinT, int row, int i0) {
    const f32x4 c = *(const f32x4*)(cosT + (size_t)row * 32 + i0), s = *(const f32x4*)(sinT + (size_t)row * 32 + i0);
    const f32x4 a = v0, b = v1;
    v0[0] = a[0] * c[0] - a[1] * s[0]; v0[1] = a[1] * c[0] + a[0] * s[0]; v0[2] = a[2] * c[1] - a[3] * s[1]; v0[3] = a[3] * c[1] + a[2] * s[1];
    v1[0] = b[0] * c[2] - b[1] * s[2]; v1[1] = b[1] * c[2] + b[0] * s[2]; v1[2] = b[2] * c[3] - b[3] * s[3]; v1[3] = b[3] * c[3] + b[2] * s[3];
}
struct EpiZ {
    static constexpr bool PERM = true, MIDK = false;
    bf16_t* Z; bf16_t* KPE; float* ssq_cq; float* ssq_ckv; const float* cosT; const float* sinT; const float* ssq_x;
    __device__ __forceinline__ void operator()(Acc& acc, const pg8::Unit& u, int wr, int wc, int fr, int fq, LAS unsigned char*, int, int lane) const {
        { const int ln_ = lane_id(); fr = ln_ & 15; fq = ln_ >> 4; }
        const int row0 = u.pm * 256 + wr * 64 + fr, col0 = u.pn * 256 + wc * 32 + 8 * fq;
        const bool kpe_tile = (u.pn == 6);
#pragma unroll
        for (int ai = 0; ai < 2; ++ai)
#pragma unroll
            for (int m = 0; m < 4; ++m) { const float rsx = __builtin_amdgcn_rsqf(ssq_x[row0 + ai * 128 + m * 16] * (1.f / DM) + EPS);
#pragma unroll
                for (int bj = 0; bj < 2; ++bj)
#pragma unroll
                    for (int n = 0; n < 2; ++n) acc[ai][bj][m][n] = acc[ai][bj][m][n] * rsx; }
#pragma unroll
        for (int ai = 0; ai < 2; ++ai)
#pragma unroll
            for (int m = 0; m < 4; ++m) { const int row = row0 + ai * 128 + m * 16; bf16_t* rowp = Z + (size_t)row * DINP + col0;
#pragma unroll
                for (int bj = 0; bj < 2; ++bj) { f32x4 v0 = acc[ai][bj][m][0], v1 = acc[ai][bj][m][1];
                    if (kpe_tile && bj == 1) {
                        if (wc < 2) { rope8(v0, v1, cosT, sinT, row, 16 * (wc & 1) + 4 * fq);
                            u32x4 w; w.x = cvt_pk_bf16(v0[0], v0[1]); w.y = cvt_pk_bf16(v0[2], v0[3]); w.z = cvt_pk_bf16(v1[0], v1[1]); w.w = cvt_pk_bf16(v1[2], v1[3]);
                            *(u32x4*)(KPE + (size_t)row * 64 + wc * 32 + 8 * fq) = w; }
                    } else {
                        u32x4 w; w.x = cvt_pk_bf16(v0[0], v0[1]); w.y = cvt_pk_bf16(v0[2], v0[3]); w.z = cvt_pk_bf16(v1[0], v1[1]); w.w = cvt_pk_bf16(v1[2], v1[3]);
                        *(u32x4*)(rowp + bj * 128) = w; } } }
        const int rb = u.pm * 256 + wr * 64; lane = fq * 16 + fr;
        if (u.pn == 4) ssq_rows_atomic(acc, ssq_cq, rb, 3, fq, lane);
        else if (u.pn == 5) { ssq_rows_atomic(acc, ssq_cq, rb, 1, fq, lane); ssq_rows_atomic(acc, ssq_ckv, rb, 2, fq, lane); }
        else if (u.pn == 6) ssq_rows_atomic(acc, ssq_ckv, rb, 1, fq, lane);
    }
};
struct EpiQ {
    static constexpr bool PERM = true, MIDK = false;
    bf16_t* Q; const float* ssq; const float* cosT; const float* sinT;
    __device__ __forceinline__ void operator()(const Acc& acc, const pg8::Unit& u, int wr, int wc, int fr, int fq, LAS unsigned char*, int, int) const {
        { const int ln_ = lane_id(); fr = ln_ & 15; fq = ln_ >> 4; }
        const int row0 = u.pm * 256 + wr * 64 + fr, col0 = u.pn * 256 + wc * 32 + 8 * fq;
        const bool pe = (u.pn == 2);
#pragma unroll
        for (int ai = 0; ai < 2; ++ai)
#pragma unroll
            for (int m = 0; m < 4; ++m) { const int row = row0 + ai * 128 + m * 16;
                const float sc = QSCALE * __builtin_amdgcn_rsqf(ssq[row] * (1.f / QLR) + EPS);
                bf16_t* rowp = Q + (size_t)row * 768 + col0;
#pragma unroll
                for (int bj = 0; bj < 2; ++bj) { f32x4 v0 = acc[ai][bj][m][0] * sc, v1 = acc[ai][bj][m][1] * sc;
                    if (pe) rope8(v0, v1, cosT, sinT, row, 16 * (wc & 1) + 4 * fq);
                    u32x4 w; w.x = cvt_pk_bf16(v0[0], v0[1]); w.y = cvt_pk_bf16(v0[2], v0[3]); w.z = cvt_pk_bf16(v1[0], v1[1]); w.w = cvt_pk_bf16(v1[2], v1[3]);
                    *(u32x4*)(rowp + bj * 128) = w; } }
    }
};
struct EpiF32 {
    static constexpr bool PERM = false, MIDK = false;
    float* O; int ldc;
    __device__ __forceinline__ void operator()(const Acc& acc, const pg8::Unit& u, int wr, int wc, int fr, int fq, LAS unsigned char*, int, int) const {
        { const int ln_ = lane_id(); fr = ln_ & 15; fq = ln_ >> 4; }
        const int row0 = u.pm * 256 + wr * 64 + fr, col0 = u.pn * 256 + wc * 32 + 4 * fq;
#pragma unroll
        for (int ai = 0; ai < 2; ++ai)
#pragma unroll
            for (int m = 0; m < 4; ++m) { float* rowp = O + (size_t)(row0 + ai * 128 + m * 16) * ldc + col0;
#pragma unroll
                for (int bj = 0; bj < 2; ++bj)
#pragma unroll
                    for (int n = 0; n < 2; ++n) *(f32x4*)(rowp + bj * 128 + n * 16) = acc[ai][bj][m][n]; }
    }
};
struct EpiSwiGLU {
    static constexpr bool PERM = true, MIDK = false;
    bf16_t* F; const float* ssq;
    __device__ __forceinline__ void operator()(const Acc& acc, const pg8::Unit& u, int wr, int wc, int fr, int fq, LAS unsigned char*, int, int) const {
        { const int ln_ = lane_id(); fr = ln_ & 15; fq = ln_ >> 4; }
        const int row0 = u.pm * 256 + wr * 64 + fr, col0 = u.pn * 128 + wc * 32 + 8 * fq;
#pragma unroll
        for (int ai = 0; ai < 2; ++ai)
#pragma unroll
            for (int m = 0; m < 4; ++m) { bf16_t* rowp = F + (size_t)(row0 + ai * 128 + m * 16) * DFF + col0; float f[8];
                const float rsc = __builtin_amdgcn_rsqf(ssq[row0 + ai * 128 + m * 16] * (1.f / DM) + EPS);
#pragma unroll
                for (int n = 0; n < 2; ++n)
#pragma unroll
                    for (int e = 0; e < 4; ++e) { const float g = acc[ai][0][m][n][e] * rsc, up = acc[ai][1][m][n][e] * rsc;
                        f[n * 4 + e] = g * __builtin_amdgcn_rcpf(1.f + __builtin_amdgcn_exp2f(-g * LOG2E)) * up; }
                u32x4 w; w.x = cvt_pk_bf16(f[0], f[1]); w.y = cvt_pk_bf16(f[2], f[3]); w.z = cvt_pk_bf16(f[4], f[5]); w.w = cvt_pk_bf16(f[6], f[7]);
                *(u32x4*)rowp = w; }
    }
};
struct EpiSoftmax {
    static constexpr bool PERM = true, MIDK = false;
    bf16_t* P; const float* ssq;
    __device__ __forceinline__ void operator()(Acc& acc, const pg8::Unit& u, int wr, int wc, int fr, int fq, LAS unsigned char* lds, int, int) const {
        { const int ln_ = lane_id(); fr = ln_ & 15; fq = ln_ >> 4; }
        LAS float* PM = (LAS float*)(lds + EPI_OFF);
        LAS float* PS = (LAS float*)(lds + EPI_OFF + 4096);
        float mx[2][4];
#pragma unroll
        for (int ai = 0; ai < 2; ++ai)
#pragma unroll
            for (int m = 0; m < 4; ++m) { float q = -3.0e38f;
                { const float rsc = __builtin_amdgcn_rsqf(ssq[u.pm * 256 + ai * 128 + wr * 64 + m * 16 + fr] * (1.f / DM) + EPS);
#pragma unroll
                  for (int bj = 0; bj < 2; ++bj)
#pragma unroll
                      for (int n = 0; n < 2; ++n) acc[ai][bj][m][n] = acc[ai][bj][m][n] * rsc; }
#pragma unroll
                for (int bj = 0; bj < 2; ++bj)
#pragma unroll
                    for (int n = 0; n < 2; ++n) { const f32x4 x = acc[ai][bj][m][n]; q = fmaxf(q, fmaxf(fmaxf(x[0], x[1]), fmaxf(x[2], x[3]))); }
                q = fmaxf(q, __shfl_xor(q, 16)); q = fmaxf(q, __shfl_xor(q, 32));
                if (fq == 0) PM[(ai * 128 + wr * 64 + m * 16 + fr) * 4 + wc] = q; }
        LDS_WAIT(); __builtin_amdgcn_s_barrier(); asm volatile("" ::: "memory");
#pragma unroll
        for (int ai = 0; ai < 2; ++ai)
#pragma unroll
            for (int m = 0; m < 4; ++m) { const f32x4 t = *(const LAS f32x4*)(PM + (ai * 128 + wr * 64 + m * 16 + fr) * 4);
                const float rm = fmaxf(fmaxf(t[0], t[1]), fmaxf(t[2], t[3])); mx[ai][m] = rm; float s = 0.f;
#pragma unroll
                for (int bj = 0; bj < 2; ++bj)
#pragma unroll
                    for (int n = 0; n < 2; ++n) { f32x4 x = acc[ai][bj][m][n];
#pragma unroll
                        for (int e = 0; e < 4; ++e) { x[e] = __builtin_amdgcn_exp2f(x[e] - rm); s += x[e]; }
                        acc[ai][bj][m][n] = x; }
                s += __shfl_xor(s, 16); s += __shfl_xor(s, 32);
                if (fq == 0) PS[(ai * 128 + wr * 64 + m * 16 + fr) * 4 + wc] = s; }
        LDS_WAIT(); __builtin_amdgcn_s_barrier(); asm volatile("" ::: "memory");
        const int row0 = u.pm * 256 + wr * 64 + fr, col0 = u.pn * 256 + wc * 32 + 8 * fq;
#pragma unroll
        for (int ai = 0; ai < 2; ++ai)
#pragma unroll
            for (int m = 0; m < 4; ++m) { const f32x4 t = *(const LAS f32x4*)(PS + (ai * 128 + wr * 64 + m * 16 + fr) * 4);
                const float inv = __builtin_amdgcn_rcpf((t[0] + t[1]) + (t[2] + t[3]));
                bf16_t* rowp = P + (size_t)(row0 + ai * 128 + m * 16) * DM + col0;
#pragma unroll
                for (int bj = 0; bj < 2; ++bj) { const f32x4 v0 = acc[ai][bj][m][0] * inv, v1 = acc[ai][bj][m][1] * inv;
                    u32x4 w; w.x = cvt_pk_bf16(v0[0], v0[1]); w.y = cvt_pk_bf16(v0[2], v0[3]); w.z = cvt_pk_bf16(v1[0], v1[1]); w.w = cvt_pk_bf16(v1[2], v1[3]);
                    *(u32x4*)(rowp + bj * 128) = w; } }
        (void)mx;
    }
};


__device__ __forceinline__ unsigned ag_ld(const unsigned* p) { return __hip_atomic_load(p, __ATOMIC_RELAXED, __HIP_MEMORY_SCOPE_AGENT); }
template <bool MIDK_>
struct EpiNormResT {
    static constexpr bool PERM = true, MIDK = MIDK_; static constexpr int TSPLIT = 8;
    const float* hold_f; const bf16_t* hold_b; float* hout; const float* gpost; bf16_t* xn; float* ssq_next; float* slots; unsigned* cnt;
    const float* ssq_a; const float* ssq_b;
    __device__ __forceinline__ void prep(const pg8::Unit& u, LAS unsigned char* lds, int wid, int par) const {
        if (wid < 4) { const int ln = lane_id(), row = wid * 64 + ln; const float sa = ssq_a[u.pm * 256 + row], sb = ssq_b[u.pm * 256 + row];
            const float ra = __builtin_amdgcn_rsqf(sa * (1.f / 512) + EPS), rb = __builtin_amdgcn_rsqf(sb * (1.f / 512) + EPS);
            ((LAS f32x2*)(lds + EPI_OFF + 5120))[par * 256 + row] = (f32x2){ra * __builtin_amdgcn_rcpf(rb), rb}; }
    }
    __device__ __forceinline__ void midk(Acc& acc, LAS unsigned char* lds, int par, int wr) const {
        const int ln = lane_id(), fr = ln & 15; const LAS f32x2* RT = (const LAS f32x2*)(lds + EPI_OFF + 5120) + par * 256;
#pragma unroll
        for (int ai = 0; ai < 2; ++ai)
#pragma unroll
            for (int m = 0; m < 4; ++m) { const float r = RT[ai * 128 + wr * 64 + m * 16 + fr].x;
#pragma unroll
                for (int bj = 0; bj < 2; ++bj)
#pragma unroll
                    for (int n = 0; n < 2; ++n) acc[ai][bj][m][n] = acc[ai][bj][m][n] * r; }
    }
    __device__ __forceinline__ void operator()(Acc& acc, const pg8::Unit& u, int wr, int wc, int fr, int fq, LAS unsigned char* lds, int wid, int par) const {
        const int ln = lane_id(); fr = ln & 15; fq = ln >> 4;
        if constexpr (MIDK_) { const LAS f32x2* RT = (const LAS f32x2*)(lds + EPI_OFF + 5120) + par * 256;
#pragma unroll
            for (int ai = 0; ai < 2; ++ai)
#pragma unroll
                for (int m = 0; m < 4; ++m) { const float r = RT[ai * 128 + wr * 64 + m * 16 + fr].y;
#pragma unroll
                    for (int bj = 0; bj < 2; ++bj)
#pragma unroll
                        for (int n = 0; n < 2; ++n) acc[ai][bj][m][n] = acc[ai][bj][m][n] * r; } }
        LAS float* PT = (LAS float*)(lds + EPI_OFF);
        LAS float* SR = (LAS float*)(lds + EPI_OFF + 4096);
#pragma unroll
        for (int ai = 0; ai < 2; ++ai)
#pragma unroll
            for (int m = 0; m < 4; ++m) { float q = 0.f;
#pragma unroll
                for (int bj = 0; bj < 2; ++bj)
#pragma unroll
                    for (int n = 0; n < 2; ++n) { const f32x4 x = acc[ai][bj][m][n]; q += (x[0] * x[0] + x[1] * x[1]) + (x[2] * x[2] + x[3] * x[3]); }
                q += __shfl_xor(q, 16); q += __shfl_xor(q, 32);
                if (fq == 0) PT[(ai * 128 + wr * 64 + m * 16 + fr) * 4 + wc] = q; }
        LDS_WAIT(); __builtin_amdgcn_s_barrier(); asm volatile("" ::: "memory");
        unsigned* c = cnt + 64 * u.pm;
        if (wid < 4) { const int row = wid * 64 + ln; const f32x4 t = *(const LAS f32x4*)(PT + row * 4); const float sq = (t[0] + t[1]) + (t[2] + t[3]);
            __hip_atomic_store((unsigned*)slots + ((size_t)(u.pm * 256 + row) * 4 + u.pn), __float_as_uint(sq), __ATOMIC_RELAXED, __HIP_MEMORY_SCOPE_AGENT);
            asm volatile("s_waitcnt vmcnt(0)" ::: "memory");
            if (ln == 0) __hip_atomic_fetch_add(c, 1u, __ATOMIC_RELAXED, __HIP_MEMORY_SCOPE_AGENT); }
        if (wid == 0) { unsigned sp = 0;
            while ((unsigned)__builtin_amdgcn_readfirstlane(ag_ld(c)) < 16u) { __builtin_amdgcn_s_sleep(2); if (++sp > (1u << 21)) break; }
            __builtin_amdgcn_fence(__ATOMIC_ACQUIRE, "agent"); }
        asm volatile("s_waitcnt vmcnt(0) lgkmcnt(0)" ::: "memory"); __builtin_amdgcn_s_barrier(); asm volatile("" ::: "memory");
        if (wid < 4) { const int row = wid * 64 + ln; const unsigned* sl = (const unsigned*)slots + (size_t)(u.pm * 256 + row) * 4;
            const float tot = (__uint_as_float(ag_ld(sl)) + __uint_as_float(ag_ld(sl + 1))) + (__uint_as_float(ag_ld(sl + 2)) + __uint_as_float(ag_ld(sl + 3)));
            SR[row] = __builtin_amdgcn_rsqf(tot * (1.f / DM) + EPS); }
        LDS_WAIT(); __builtin_amdgcn_s_barrier(); asm volatile("" ::: "memory");
        const int col0 = u.pn * 256 + wc * 32 + 8 * fq;
        f32x4 gv[2][2];
#pragma unroll
        for (int bj = 0; bj < 2; ++bj)
#pragma unroll
            for (int n = 0; n < 2; ++n) gv[bj][n] = *(const f32x4*)(gpost + col0 + bj * 128 + n * 4);
#pragma unroll
        for (int ai = 0; ai < 2; ++ai) { float s[4];
#pragma unroll
            for (int m = 0; m < 4; ++m) { const int rl = ai * 128 + wr * 64 + m * 16 + fr; const float rs = SR[rl]; const size_t off = (size_t)(u.pm * 256 + rl) * DM + col0; float q = 0.f;
#pragma unroll
                for (int bj = 0; bj < 2; ++bj) { f32x4 h0, h1;
                    if (hold_f) { h0 = *(const f32x4*)(hold_f + off + bj * 128); h1 = *(const f32x4*)(hold_f + off + bj * 128 + 4); }
                    else { const u32x4 hb = *(const u32x4*)(hold_b + off + bj * 128); h0 = (f32x4){bflo(hb.x), bfhi(hb.x), bflo(hb.y), bfhi(hb.y)}; h1 = (f32x4){bflo(hb.z), bfhi(hb.z), bflo(hb.w), bfhi(hb.w)}; }
                    const f32x4 v0 = h0 + acc[ai][bj][m][0] * rs * gv[bj][0], v1 = h1 + acc[ai][bj][m][1] * rs * gv[bj][1];
                    q += ((v0[0] * v0[0] + v0[1] * v0[1]) + (v0[2] * v0[2] + v0[3] * v0[3])) + ((v1[0] * v1[0] + v1[1] * v1[1]) + (v1[2] * v1[2] + v1[3] * v1[3]));
                    if (hout) { *(f32x4*)(hout + off + bj * 128) = v0; *(f32x4*)(hout + off + bj * 128 + 4) = v1; }
                    if (xn) { u32x4 w; w.x = cvt_pk_bf16(v0[0], v0[1]); w.y = cvt_pk_bf16(v0[2], v0[3]); w.z = cvt_pk_bf16(v1[0], v1[1]); w.w = cvt_pk_bf16(v1[2], v1[3]); *(u32x4*)(xn + off + bj * 128) = w; } }
                q += __shfl_xor(q, 16); q += __shfl_xor(q, 32); s[m] = q; }
            if (ssq_next) { const float v = fq == 0 ? s[0] : fq == 1 ? s[1] : fq == 2 ? s[2] : s[3]; atomicAdd(ssq_next + u.pm * 256 + wr * 64 + ai * 128 + ln, v); } }
    }
};
typedef EpiNormResT<false> EpiNormRes;
typedef EpiNormResT<true> EpiNormResMid;

#define XB_TMO      128
#define XB_XCNT(j)  (256  + 64 * (j))
#define XB_XSUB(j)  (1280 + 64 * (j))
#define XB_XGEN(j)  (2304 + 64 * (j))
#define XB_TOP      3328
#define XB_TOPGEN   3392
#define XCD_BAR_WORDS 3456
#define XB_SPIN_CAP (1u << 20)
__device__ __forceinline__ unsigned xb_ld(unsigned* p)              { return __hip_atomic_load(p, __ATOMIC_RELAXED, __HIP_MEMORY_SCOPE_AGENT); }
__device__ __forceinline__ unsigned xb_add(unsigned* p, unsigned v) { return __hip_atomic_fetch_add(p, v, __ATOMIC_RELAXED, __HIP_MEMORY_SCOPE_AGENT); }
__device__ __forceinline__ unsigned xb_xcc_id() { return (unsigned)__builtin_amdgcn_s_getreg((3 << 11) | 20) & 0xFu; }
#define XB_SPIN(cond, bar) do { unsigned _sp = 0; while (cond) { __builtin_amdgcn_s_sleep(1); \
    if ((++_sp & 255u) == 0u) { if (xb_ld(&(bar)[XB_TMO])) break; if (_sp > XB_SPIN_CAP) { atomicAdd(&(bar)[XB_TMO], 1u); break; } } } } while (0)
struct XcdBarrier { unsigned* bar; unsigned x; volatile LAS unsigned* st; };
__device__ __forceinline__ XcdBarrier xcd_barrier_post(unsigned* bar, volatile LAS unsigned* st) {
    XcdBarrier b; b.bar = bar; b.x = xb_xcc_id(); b.st = st;
    if (threadIdx.x == 0) (void)xb_add(&bar[XB_XCNT(b.x)], 1u);
    return b;
}
__device__ __forceinline__ void xcd_barrier_complete(unsigned* bar, unsigned x, unsigned& nloc, unsigned& nx) {
    const unsigned G = gridDim.x * gridDim.y * gridDim.z;
    unsigned sum, cnt, mine, sp = 0u;
    for (;;) {
        sum = 0u; cnt = 0u; mine = 0u;
#pragma unroll
        for (unsigned j = 0; j < 16; ++j) { const unsigned c = xb_ld(&bar[XB_XCNT(j)]); sum += c; cnt += (c > 0u) ? 1u : 0u; mine = (j == x) ? c : mine; }
        if (sum == G) break;
        __builtin_amdgcn_s_sleep(1);
        if ((++sp & 255u) == 0u) { if (xb_ld(&bar[XB_TMO])) break; if (sp > XB_SPIN_CAP) { atomicAdd(&bar[XB_TMO], 1u); break; } }
    }
    nloc = mine > 0u ? mine : 1u; nx = cnt > 0u ? cnt : 1u;
}
__device__ __forceinline__ void xcd_barrier(const XcdBarrier& b, const int wv) {
    asm volatile("s_waitcnt vmcnt(0)" ::: "memory");
    __syncthreads();
    if (wv == 0 && lane_id() == 0) {
        unsigned* bar = b.bar;
        __builtin_amdgcn_s_waitcnt(0);
        unsigned nloc = b.st[0], nx = b.st[1];
        if (nloc == 0u) { xcd_barrier_complete(bar, b.x, nloc, nx); b.st[0] = nloc; b.st[1] = nx; }
        const unsigned old = xb_add(&bar[XB_XSUB(b.x)], 1u);
        const unsigned gen = old / nloc;
        if (old + 1u == (gen + 1u) * nloc) {
            __builtin_amdgcn_fence(__ATOMIC_RELEASE, "agent");
            asm volatile("s_waitcnt vmcnt(0)" ::: "memory");
            const unsigned og = xb_add(&bar[XB_TOP], 1u);
            const unsigned tg = og / nx;
            if (og + 1u == (tg + 1u) * nx) xb_add(&bar[XB_TOPGEN], 1u);
            else XB_SPIN(xb_ld(&bar[XB_TOPGEN]) == tg, bar);
            __builtin_amdgcn_fence(__ATOMIC_ACQUIRE, "agent");
            xb_add(&bar[XB_XGEN(b.x)], 1u);
            asm volatile("s_waitcnt vmcnt(0)" ::: "memory");
        } else {
            XB_SPIN(xb_ld(&bar[XB_XGEN(b.x)]) == gen, bar);
            __builtin_amdgcn_fence(__ATOMIC_ACQUIRE, "agent");
            asm volatile("s_waitcnt vmcnt(0)" ::: "memory");
        }
    }
    __syncthreads();
}

enum { MAP_ID = 0, MAP_WIN = 1, MAP_WUQ = 2, MAP_WUKV = 3, MAP_GATE = 4, MAP_UP = 5 };
__device__ __forceinline__ int map_n(int mode, int n) {
    switch (mode) {
    case MAP_WIN: { if (n < OFF_KPE) return n; const int j = n - OFF_KPE; return OFF_KPE + (j < 32 ? 2 * j : 2 * (j - 32) + 1); }
    case MAP_WUQ: { const int h = n / 192, d = n % 192; if (d < 128) return h * 128 + d; const int j = d - 128; return 512 + h * 64 + (j < 32 ? 2 * j : 2 * (j - 32) + 1); }
    case MAP_WUKV: { const int h = n / 256, d = n % 256; return d < 128 ? h * 128 + d : 512 + h * 128 + (d - 128); }
    case MAP_GATE: return (n >> 7) * 256 + (n & 127);
    case MAP_UP: return (n >> 7) * 256 + 128 + (n & 127);
    default: return n;
    }
}
__device__ __forceinline__ void p0_transpose_item(const float* W, int K, int N, bf16_t* WT, int row_off, int mode, const float* kscale, const float* kscale2, LAS float* scr, int item, int lane) {
    const int nblk = N / 64, kb = item / nblk, nb = item % nblk, k0 = 64 * kb, n0 = 64 * nb;
    float v[64];
#pragma unroll
    for (int i = 0; i < 64; ++i) v[i] = W[(size_t)(k0 + i) * N + n0 + lane];
    if (kscale) { const float* ks = (kscale2 && k0 >= 512) ? kscale2 - 512 : kscale;
#pragma unroll
        for (int i = 0; i < 64; ++i) v[i] *= ks[k0 + i]; }
#pragma unroll
    for (int i = 0; i < 64; ++i) scr[i * 65 + lane] = v[i];
    LDS_WAIT(); asm volatile("" ::: "memory");
    const int c = lane & 7;
#pragma unroll
    for (int j = 0; j < 8; ++j) { const int n = (lane >> 3) + 8 * j; const LAS float* sp = scr + (8 * c) * 65 + n;
        u32x4 o; o.x = cvt_pk_bf16(sp[0 * 65], sp[1 * 65]); o.y = cvt_pk_bf16(sp[2 * 65], sp[3 * 65]); o.z = cvt_pk_bf16(sp[4 * 65], sp[5 * 65]); o.w = cvt_pk_bf16(sp[6 * 65], sp[7 * 65]);
        *(u32x4*)(WT + (size_t)(row_off + map_n(mode, n0 + n)) * K + k0 + 8 * c) = o; }
    LDS_WAIT(); asm volatile("" ::: "memory");
}
template <int R, bool NORM>
__device__ __forceinline__ void rms_rows_to_bf16(const float* xrow, const float* g, bf16_t* orow, float* ssq_out, int lane) {
    f32x4 v[R][4]; float s[R];
#pragma unroll
    for (int r = 0; r < R; ++r)
#pragma unroll
        for (int j = 0; j < 4; ++j) v[r][j] = ((const f32x4*)(xrow + (size_t)r * DM) + lane)[64 * j];
    f32x4 gg[4];
#pragma unroll
    for (int j = 0; j < 4; ++j) gg[j] = ((const f32x4*)g + lane)[64 * j];
#pragma unroll
    for (int r = 0; r < R; ++r) { float q = 0.f;
#pragma unroll
        for (int j = 0; j < 4; ++j) q += (v[r][j].x * v[r][j].x + v[r][j].y * v[r][j].y) + (v[r][j].z * v[r][j].z + v[r][j].w * v[r][j].w);
        s[r] = q; }
#pragma unroll
    for (int o = 1; o < 64; o <<= 1)
#pragma unroll
        for (int r = 0; r < R; ++r) s[r] += __shfl_xor(s[r], o);
#pragma unroll
    for (int r = 0; r < R; ++r) { const float rs = NORM ? __builtin_amdgcn_rsqf(s[r] * (1.f / DM) + EPS) : 1.f; u32x2* o8 = (u32x2*)(orow + (size_t)r * DM) + lane;
        if (!NORM) { if (lane == 0) ssq_out[r] = s[r];
#pragma unroll
            for (int j = 0; j < 4; ++j) gg[j] = (f32x4){1.f, 1.f, 1.f, 1.f}; }
#pragma unroll
        for (int j = 0; j < 4; ++j) { u32x2 w; w.x = cvt_pk_bf16(v[r][j].x * rs * gg[j].x, v[r][j].y * rs * gg[j].y); w.y = cvt_pk_bf16(v[r][j].z * rs * gg[j].z, v[r][j].w * rs * gg[j].w); o8[64 * j] = w; } }
}
__device__ __forceinline__ void resid_row(const float* pre, const float* hold, const float* gpost, float* hout, const float* gnext, bf16_t* xn, int lane) {
    const f32x4* pr = (const f32x4*)pre + lane; const f32x4* hr = (const f32x4*)hold + lane; const f32x4* gp = (const f32x4*)gpost + lane;
    f32x4 v[4]; float s = 0.f;
#pragma unroll
    for (int j = 0; j < 4; ++j) { v[j] = pr[64 * j]; s += (v[j].x * v[j].x + v[j].y * v[j].y) + (v[j].z * v[j].z + v[j].w * v[j].w); }
    const float rs = __builtin_amdgcn_rsqf(wave_sum(s) * (1.f / DM) + EPS);
    float s2 = 0.f;
#pragma unroll
    for (int j = 0; j < 4; ++j) { const f32x4 h = hr[64 * j], g = gp[64 * j]; v[j] = h + v[j] * rs * g; s2 += (v[j].x * v[j].x + v[j].y * v[j].y) + (v[j].z * v[j].z + v[j].w * v[j].w); }
    f32x4* ho = (f32x4*)hout + lane;
#pragma unroll
    for (int j = 0; j < 4; ++j) ho[64 * j] = v[j];
    if (xn) { const float rs2 = __builtin_amdgcn_rsqf(wave_sum(s2) * (1.f / DM) + EPS); const f32x4* gn = (const f32x4*)gnext + lane; u32x2* o8 = (u32x2*)xn + lane;
#pragma unroll
        for (int j = 0; j < 4; ++j) { const f32x4 gg = gn[64 * j]; u32x2 w; w.x = cvt_pk_bf16(v[j].x * rs2 * gg.x, v[j].y * rs2 * gg.y); w.y = cvt_pk_bf16(v[j].z * rs2 * gg.z, v[j].w * rs2 * gg.w); o8[64 * j] = w; } }
}

namespace lru {
constexpr int TT = 128, NTILE = SEQ / TT, UP = 72;
constexpr int L_U = 0, L_UF = L_U + TT * UP * 2, L_WSEG = L_UF + TT * 33 * 4, L_CARRY = L_WSEG + 2 * 8 * 32 * 8, L_TSS = L_CARRY + 2 * 32 * 4, L_END = L_TSS + 2 * TT * 4;
static_assert(L_END <= RING_BYTES, "lru lds");
__device__ __forceinline__ float sigmoidf_(float x) { return __builtin_amdgcn_rcpf(1.f + __builtin_amdgcn_exp2f(-x * LOG2E)); }
__device__ __forceinline__ void unit(int b, int cb, const bf16_t* Z, bf16_t* Y, float* ssq_lru, const float* conv_w, const float* conv_b, const float* wa, const float* ba, const float* wx, const float* bx,
                                     const float* lam, LAS unsigned char* lds, const int wv) {
    const int lane = lane_id(), wid = wv, tid = wv * 64 + lane;
    const int hblk = cb >> 1, half = cb & 1, ib = hblk * 64, c0 = cb * 32;
    LAS bf16_t* U = (LAS bf16_t*)(lds + L_U); LAS float* UF = (LAS float*)(lds + L_UF); LAS f32x2* WSEG = (LAS f32x2*)(lds + L_WSEG);
    LAS float* CARRY = (LAS float*)(lds + L_CARRY); LAS float* TSS = (LAS float*)(lds + L_TSS);
    const int col = lane & 15, kq = lane >> 4;
    bf16x8 Bf[4][2];
#pragma unroll
    for (int nb = 0; nb < 4; ++nb)
#pragma unroll
        for (int ks = 0; ks < 2; ++ks) { const float* Wg = (nb < 2) ? wa : wx; const int oc = half * 32 + (nb & 1) * 16 + col; float w[8];
#pragma unroll
            for (int j = 0; j < 8; ++j) w[j] = Wg[((size_t)hblk * 64 + ks * 32 + 8 * kq + j) * 64 + oc];
            u32x4 p; p.x = cvt_pk_bf16(w[0], w[1]); p.y = cvt_pk_bf16(w[2], w[3]); p.z = cvt_pk_bf16(w[4], w[5]); p.w = cvt_pk_bf16(w[6], w[7]); Bf[nb][ks] = __builtin_bit_cast(bf16x8, p); }
    float cba[2], cbx[2], csp[2];
#pragma unroll
    for (int e = 0; e < 2; ++e) { const int ch = c0 + e * 16 + col; cba[e] = ba[ch]; cbx[e] = bx[ch]; const float l = lam[ch];
        csp[e] = 8.f * LOG2E * (fmaxf(-l, 0.f) + log1pf(expf(-fabsf(l)))); }
    const int cch = lane;
    const float cw0 = conv_w[0 * DLRU + ib + cch], cw1 = conv_w[1 * DLRU + ib + cch], cw2 = conv_w[2 * DLRU + ib + cch], cw3 = conv_w[3 * DLRU + ib + cch], cbb = conv_b[ib + cch];
    if (tid < 64) CARRY[tid] = 0.f;
    if (tid < 2 * TT) TSS[tid] = 0.f;
    const size_t rowb = (size_t)b * SEQ;
    const bf16_t* zx = Z + (rowb + wid * 16) * DINP + ib + cch;
    const bf16_t* zg = Z + (rowb + wid * 16 + kq * 4) * DINP + OFF_GATE + c0 + col;
    bf16_t* yp = Y + (rowb + wid * 16 + kq * 4) * DM + c0 + col;
    unsigned short xr[19], gr[8];
#define LRU_LOADX(t0_) do { _Pragma("unroll") for (int k = 0; k < 19; ++k) { const int tk = (t0_) + wid * 16 + k - 3; xr[k] = (tk >= 0) ? zx[(ptrdiff_t)((t0_) + k - 3) * DINP] : (unsigned short)0; } } while (0)
    LRU_LOADX(0);
    __syncthreads();
    for (int tile = 0; tile < NTILE; ++tile) {
        const int t0 = tile * TT, par = tile & 1;
        { float xm3 = bf2f(xr[0]), xm2 = bf2f(xr[1]), xm1 = bf2f(xr[2]);
#pragma unroll
          for (int k = 0; k < 16; ++k) { const float x0 = bf2f(xr[3 + k]); const float u = cbb + cw0 * xm3 + cw1 * xm2 + cw2 * xm1 + cw3 * x0; xm3 = xm2; xm2 = xm1; xm1 = x0;
              const int tl = wid * 16 + k; U[tl * UP + cch] = (bf16_t)(cvt_pk_bf16(u, 0.f) & 0xffffu);
              if ((cch >> 5) == half) UF[tl * 33 + (cch & 31)] = u; } }
#pragma unroll
        for (int e = 0; e < 2; ++e)
#pragma unroll
            for (int r = 0; r < 4; ++r) gr[e * 4 + r] = zg[(size_t)(t0 + r) * DINP + e * 16];
        if (tile + 1 < NTILE) LRU_LOADX(t0 + TT);
        LDS_WAIT();
        float av[2][4], uv[2][4], Ainc[2], Hinc[2];
        { f32x4 C[4];
#pragma unroll
          for (int nb = 0; nb < 4; ++nb) C[nb] = (f32x4){0.f, 0.f, 0.f, 0.f};
          const LAS bf16_t* ua = U + (wid * 16 + col) * UP + 8 * kq;
          const bf16x8 a0 = *(const LAS bf16x8*)ua, a1 = *(const LAS bf16x8*)(ua + 32);
#pragma unroll
          for (int nb = 0; nb < 4; ++nb) { C[nb] = __builtin_amdgcn_mfma_f32_16x16x32_bf16(a0, Bf[nb][0], C[nb], 0, 0, 0); C[nb] = __builtin_amdgcn_mfma_f32_16x16x32_bf16(a1, Bf[nb][1], C[nb], 0, 0, 0); }
#pragma unroll
          for (int e = 0; e < 2; ++e) { float Ap = 1.f, H = 0.f;
#pragma unroll
              for (int r = 0; r < 4; ++r) { const int tl = wid * 16 + kq * 4 + r, ch = e * 16 + col;
                  const float rg = sigmoidf_(C[e][r] + cba[e]), ig = sigmoidf_(C[e + 2][r] + cbx[e]);
                  const float a = __builtin_amdgcn_exp2f(-rg * csp[e]); const float mult = __builtin_amdgcn_sqrtf(fmaxf(1.f - a * a, 0.f));
                  const float uu = mult * ig * UF[tl * 33 + ch];
                  av[e][r] = a; uv[e][r] = uu; H = a * H + uu; Ap *= a; }
              { const float Ap1 = __shfl_up(Ap, 16), H1 = __shfl_up(H, 16); if (kq >= 1) { H = Ap * H1 + H; Ap = Ap * Ap1; } }
              { const float Ap2 = __shfl_up(Ap, 32), H2 = __shfl_up(H, 32); if (kq >= 2) { H = Ap * H2 + H; Ap = Ap * Ap2; } }
              Ainc[e] = Ap; Hinc[e] = H;
              if (kq == 3) WSEG[(par * 8 + wid) * 32 + e * 16 + col] = (f32x2){Ap, H}; } }
        __syncthreads();
        if (tid < TT) { const float v = TSS[(par ^ 1) * TT + tid]; if (tile > 0) atomicAdd(ssq_lru + rowb + t0 - TT + tid, v); }
        float qs[4] = {0.f, 0.f, 0.f, 0.f};
#pragma unroll
        for (int e = 0; e < 2; ++e) { const int ch = e * 16 + col;
            float h = CARRY[par * 32 + ch];
            for (int w2 = 0; w2 < wid; ++w2) { const f32x2 sg = WSEG[(par * 8 + w2) * 32 + ch]; h = sg.x * h + sg.y; }
            if (wid == 7 && kq == 0) { const f32x2 sg = WSEG[(par * 8 + 7) * 32 + ch]; CARRY[(par ^ 1) * 32 + ch] = sg.x * h + sg.y; }
            const float Ae = __shfl_up(Ainc[e], 16), He = __shfl_up(Hinc[e], 16);
            if (kq >= 1) h = Ae * h + He;
#pragma unroll
            for (int r = 0; r < 4; ++r) { h = av[e][r] * h + uv[e][r]; const float g = bf2f(gr[e * 4 + r]);
                const float ge = g * __builtin_amdgcn_rcpf(1.f + __builtin_amdgcn_exp2f(-1.5957691216057308f * LOG2E * (g + 0.044715f * g * g * g)));
                const float y = h * ge; yp[(size_t)(t0 + r) * DM + e * 16] = (bf16_t)(cvt_pk_bf16(y, 0.f) & 0xffffu); qs[r] += y * y; } }
#pragma unroll
        for (int r = 0; r < 4; ++r) { float q = qs[r]; q += __shfl_xor(q, 1); q += __shfl_xor(q, 2); q += __shfl_xor(q, 4); q += __shfl_xor(q, 8);
            if (col == 0) TSS[par * TT + wid * 16 + kq * 4 + r] = q; }
    }
    __syncthreads();
    if (tid < TT) atomicAdd(ssq_lru + rowb + (NTILE - 1) * TT + tid, TSS[((NTILE - 1) & 1) * TT + tid]);
    __syncthreads();
#undef LRU_LOADX
}
}

namespace mla {
constexpr int NW = 8, QBLK = 32, KVBLK = 64, QB = 256, KROW = 384, SHM_K = KVBLK * KROW, SHM_V = KVBLK * 128 * 2;
constexpr int L_V = 0, L_K = 2 * SHM_V, L_WS = L_K + 2 * SHM_K, L_END = L_WS + NW * 64 * 4;
static_assert(L_END <= RING_BYTES && NW * 8192 <= L_WS, "mla lds");
#define KSWZ(row, colB) ((row) * KROW + ((colB) ^ ((((row) >> 1) & 7) << 4)))
#define SBAR() __builtin_amdgcn_sched_barrier(0)
__device__ __forceinline__ int v_st(int k, int c) { const int kk = (k & ~0xC) | ((k & 4) << 1) | ((k & 8) >> 1); return ((kk >> 3) * 4 + (c >> 5)) * 512 + ((kk & 7) * 32 + (c & 31)) * 2; }
__device__ __forceinline__ int v_rd_base(int lane) { return ((lane & 3) << 3) | (((lane >> 2) & 3) << 6) | (((lane >> 4) & 1) << 5) | (((lane >> 5) & 1) << 8); }
constexpr int v_rd_off(int d0, int ks, int half) { return d0 * 512 + ks * 4096 + half * 2048; }
__device__ __forceinline__ int crow(int r, int hi) { return (r & 3) + 8 * (r >> 2) + 4 * hi; }
__device__ __forceinline__ void mask_tile(f32x16& p0, f32x16& p1, int dq) {
    const float NEG = -__builtin_inff();
#pragma unroll
    for (int r = 0; r < 16; ++r) { const int c = (r & 3) + 8 * (r >> 2); if (dq - c < 0) p0[r] = NEG; if (dq - c - 32 < 0) p1[r] = NEG; }
}
constexpr float THR2 = 8.f * LOG2E;
__device__ __forceinline__ void partialSM(f32x16& p0, f32x16& p1, float& m_reg, float& alpha) {
    float pmax = p0[0];
#pragma unroll
    for (int r = 1; r < 16; ++r) pmax = fmaxf(pmax, p0[r]);
#pragma unroll
    for (int r = 0; r < 16; ++r) pmax = fmaxf(pmax, p1[r]);
    { auto rr = __builtin_amdgcn_permlane32_swap(__float_as_uint(pmax), __float_as_uint(pmax), false, false); pmax = fmaxf(__uint_as_float(rr[0]), __uint_as_float(rr[1])); }
    float mn;
    if (__builtin_expect(__all((pmax - m_reg) <= THR2), 1)) { mn = m_reg; alpha = 1.f; }
    else { mn = fmaxf(m_reg, pmax); alpha = __builtin_amdgcn_exp2f(m_reg - mn); m_reg = mn; }
#pragma unroll
    for (int r = 0; r < 16; ++r) p0[r] = p0[r] - mn;
#pragma unroll
    for (int r = 0; r < 16; ++r) p1[r] = p1[r] - mn;
#pragma unroll
    for (int r = 0; r < 16; ++r) p0[r] = __builtin_amdgcn_exp2f(p0[r]);
}
__device__ __forceinline__ void finishSM(f32x16& p0, f32x16& p1, float alpha, float& l_reg, bf16x8& pa0, bf16x8& pa1, bf16x8& pa2, bf16x8& pa3) {
#pragma unroll
    for (int r = 0; r < 16; ++r) p1[r] = __builtin_amdgcn_exp2f(p1[r]);
    float ps = 0;
#pragma unroll
    for (int r = 0; r < 16; ++r) ps += p0[r];
#pragma unroll
    for (int r = 0; r < 16; ++r) ps += p1[r];
    { auto rr = __builtin_amdgcn_permlane32_swap(__float_as_uint(ps), __float_as_uint(ps), false, false); ps = __uint_as_float(rr[0]) + __uint_as_float(rr[1]); }
    l_reg = l_reg * alpha + ps;
#define PK4(P, B_, OUT) do { unsigned a0 = cvt_pk_bf16(P[B_+0], P[B_+1]), a1 = cvt_pk_bf16(P[B_+2], P[B_+3]);                          \
        unsigned b0 = cvt_pk_bf16(P[B_+4], P[B_+5]), b1 = cvt_pk_bf16(P[B_+6], P[B_+7]);                                             \
        auto r0 = __builtin_amdgcn_permlane32_swap(a0, b0, false, false); auto r1 = __builtin_amdgcn_permlane32_swap(a1, b1, false, false); \
        u32x4 w = {r0[0], r1[0], r0[1], r1[1]}; OUT = __builtin_bit_cast(bf16x8, w); } while (0)
    PK4(p0, 0, pa0); PK4(p0, 8, pa1); PK4(p1, 0, pa2); PK4(p1, 8, pa3);
#undef PK4
}
template <int KB>
__device__ __forceinline__ void qkt(f32x16& p0, f32x16& p1, const char* K_lds, int r32, int hi, const bf16x8* qr) {
    p0 = f32x16{}; p1 = f32x16{};
    const char* kb[4];
#pragma unroll
    for (int dd = 0; dd < 4; ++dd) kb[dd] = K_lds + KB * SHM_K + KSWZ(r32, (dd * 16 + hi * 8) * 2);
#pragma unroll
    for (int d0 = 0; d0 < 12; ++d0) { const char* a = kb[d0 & 3] + (d0 >> 2) * 128;
        bf16x8 b0 = *reinterpret_cast<const bf16x8*>(a);
        bf16x8 b1 = *reinterpret_cast<const bf16x8*>(a + 32 * KROW);
        p0 = __builtin_amdgcn_mfma_f32_32x32x16_bf16(b0, qr[d0], p0, 0, 0, 0);
        p1 = __builtin_amdgcn_mfma_f32_32x32x16_bf16(b1, qr[d0], p1, 0, 0, 0); }
}
template <int VB>
__device__ __forceinline__ void pv_tile(f32x16* o, int vb0, bf16x8 pa0, bf16x8 pa1, bf16x8 pa2, bf16x8 pa3) {
#define TRRD(dst, off) asm volatile("ds_read_b64_tr_b16 %0, %1 offset:%2" : "=&v"(dst) : "v"(vb0), "i"(off) : "memory")
#define PV_D0(d0) do { s16x4 l0, l1, l2, l3, h0, h1, h2, h3; constexpr int b_ = VB * SHM_V + v_rd_off(d0, 0, 0); \
        TRRD(l0, b_); TRRD(h0, b_ + 2048); TRRD(l1, b_ + 4096); TRRD(h1, b_ + 6144); TRRD(l2, b_ + 8192); TRRD(h2, b_ + 10240); TRRD(l3, b_ + 12288); TRRD(h3, b_ + 14336); \
        asm volatile("s_waitcnt lgkmcnt(0)" ::: "memory"); SBAR(); \
        o[d0] = __builtin_amdgcn_mfma_f32_32x32x16_bf16(pa0, (bf16x8){l0[0], l0[1], l0[2], l0[3], h0[0], h0[1], h0[2], h0[3]}, o[d0], 0, 0, 0);   \
        o[d0] = __builtin_amdgcn_mfma_f32_32x32x16_bf16(pa1, (bf16x8){l1[0], l1[1], l1[2], l1[3], h1[0], h1[1], h1[2], h1[3]}, o[d0], 0, 0, 0);   \
        o[d0] = __builtin_amdgcn_mfma_f32_32x32x16_bf16(pa2, (bf16x8){l2[0], l2[1], l2[2], l2[3], h2[0], h2[1], h2[2], h2[3]}, o[d0], 0, 0, 0);   \
        o[d0] = __builtin_amdgcn_mfma_f32_32x32x16_bf16(pa3, (bf16x8){l3[0], l3[1], l3[2], l3[3], h3[0], h3[1], h3[2], h3[3]}, o[d0], 0, 0, 0); } while (0)
    PV_D0(0); PV_D0(1); PV_D0(2); PV_D0(3);
#undef PV_D0
#undef TRRD
}
__device__ __forceinline__ void block(int b, int h, int qb, const bf16_t* Qb, const bf16_t* KVb, const bf16_t* KPE, bf16_t* Y, float* ssq_mla, char* lds, const int wv) {
    const int lane = lane_id(), wid = wv, tid = wv * 64 + lane, r32 = lane & 31, hi = lane >> 5;
    const size_t rowbase = (size_t)b * SEQ; const int q0 = qb * QB; const int NT = (q0 + QB) / KVBLK;
    const int qlo = q0 + wid * QBLK, qm = qlo + r32 - 4 * hi;
    char* V_lds = lds + L_V; char* K_lds = lds + L_K;
    float* ws = (float*)(lds + L_WS) + wid * 64; float* li_l = ws, * al_l = ws + 32;
    float m_reg = -1e30f, l_reg = 0; f32x16 o[4] = {};
    const int sr = tid >> 4, scc = (tid & 15) * 8, vst0 = v_st(sr, scc), vst1 = v_st(32 + sr, scc), kws = KSWZ(sr, (tid & 15) * 16);
    const int pr = tid >> 3, kws2 = KSWZ(pr, 256 + (tid & 7) * 16);
    const int vb0 = (int)(uintptr_t)V_lds + v_rd_base(lane);
    const bf16_t* Kn = KVb + rowbase * 1024 + h * 128 + scc;
    const bf16_t* Vn = KVb + rowbase * 1024 + 512 + h * 128 + scc;
    const bf16_t* Kp = KPE + rowbase * 64 + (tid & 7) * 8;
    bf16x8 qr[12];
    { const bf16_t* qp = Qb + (rowbase + q0 + wid * QBLK + r32) * 768;
#pragma unroll
      for (int d0 = 0; d0 < 8; ++d0) qr[d0] = *(const bf16x8*)(qp + h * 128 + d0 * 16 + hi * 8);
#pragma unroll
      for (int d0 = 0; d0 < 4; ++d0) qr[8 + d0] = *(const bf16x8*)(qp + 512 + h * 64 + d0 * 16 + hi * 8); }
    const int grp = wid >> 2;
    bf16x8 st_v0, st_v1, st_k0, st_k1, st_k2;
#define SLOADK(t) do { const size_t k0_ = (size_t)(t) * KVBLK; st_k0 = *(const bf16x8*)(Kn + (k0_ + sr) * 1024); st_k1 = *(const bf16x8*)(Kn + (k0_ + 32 + sr) * 1024); st_k2 = *(const bf16x8*)(Kp + (k0_ + pr) * 64); } while (0)
#define SLOADV(t) do { const size_t k0_ = (size_t)(t) * KVBLK; st_v0 = *(const bf16x8*)(Vn + (k0_ + sr) * 1024); st_v1 = *(const bf16x8*)(Vn + (k0_ + 32 + sr) * 1024); } while (0)
#define SWRITEK(off) do { *(bf16x8*)(K_lds + (off) + kws) = st_k0; *(bf16x8*)(K_lds + (off) + kws + 32 * KROW) = st_k1; *(bf16x8*)(K_lds + (off) + kws2) = st_k2; } while (0)
#define SWRITEV(off) do { *(bf16x8*)(V_lds + (off) + vst0) = st_v0; *(bf16x8*)(V_lds + (off) + vst1) = st_v1; } while (0)
#define BAR() asm volatile("s_waitcnt lgkmcnt(0)\n\ts_barrier" ::: "memory")
#define RESC(a) do { if (__any((a) < 1.f)) { if (hi == 0) al_l[r32] = (a); asm volatile("s_waitcnt lgkmcnt(0)" ::: "memory");              \
                     for (int d_ = 0; d_ < 4; ++d_) for (int r = 0; r < 16; ++r) o[d_][r] *= al_l[crow(r, hi)]; } } while (0)
#define MASKT(P0_, P1_, t) do { const int kb_ = (t) * KVBLK; if (kb_ + KVBLK - 1 > qlo) mask_tile(P0_, P1_, qm - kb_); } while (0)
    f32x16 p0, p1; float al; bf16x8 pa0, pa1, pa2, pa3;
    SLOADK(0); VM_WAIT(); SWRITEK(0);
    if (grp) { SLOADK(1); SLOADV(0); }
    BAR();
    if (grp) { VM_WAIT(); SWRITEK(SHM_K); SWRITEV(0); BAR(); }
#define SMSLOT(t, tk, tv) do { if ((tk) < NT || (tv) < NT) { VM_WAIT(); if ((tk) < NT) SWRITEK(((tk) & 1) * SHM_K); if ((tv) < NT) SWRITEV(((tv) & 1) * SHM_V); } \
        MASKT(p0, p1, (t)); partialSM(p0, p1, m_reg, al); RESC(al); finishSM(p0, p1, al, l_reg, pa0, pa1, pa2, pa3); SBAR(); } while (0)
    { const int tk = 1 + grp, tv = grp;
      SLOADK(tk); SLOADV(tv); SBAR(); qkt<0>(p0, p1, K_lds, r32, hi, qr); SBAR();
      BAR(); SMSLOT(0, tk, tv); BAR(); }
    for (int i = 0; i < NT; i += 2) {
        { const int tk = i + 2 + grp, tv = i + 1 + grp;
          if (tk < NT) SLOADK(tk); if (tv < NT) SLOADV(tv); SBAR();
          qkt<1>(p0, p1, K_lds, r32, hi, qr); SBAR(); pv_tile<0>(o, vb0, pa0, pa1, pa2, pa3); SBAR();
          BAR(); SMSLOT(i + 1, tk, tv); BAR(); }
        { const int tk = i + 3 + grp, tv = i + 2 + grp;
          if (tk < NT) SLOADK(tk); if (tv < NT) SLOADV(tv); SBAR();
          if (i + 2 < NT) { qkt<0>(p0, p1, K_lds, r32, hi, qr); SBAR(); }
          pv_tile<1>(o, vb0, pa0, pa1, pa2, pa3); SBAR();
          BAR(); if (i + 2 < NT) SMSLOT(i + 2, tk, tv); BAR(); }
    }
    if (!grp) BAR();
#undef SMSLOT
#undef SLOADK
#undef SLOADV
#undef SWRITEK
#undef SWRITEV
#undef BAR
    if (hi == 0) li_l[r32] = l_reg; asm volatile("s_waitcnt lgkmcnt(0)" ::: "memory");
    float rli[16];
#pragma unroll
    for (int r = 0; r < 16; ++r) rli[r] = __builtin_amdgcn_rcpf(li_l[crow(r, hi)]);
    { bf16_t* stg = (bf16_t*)lds + wid * 4096;
#pragma unroll
      for (int r = 0; r < 16; ++r) { const int orow = crow(r, hi);
#pragma unroll
          for (int d0 = 0; d0 < 4; ++d0) stg[orow * 128 + d0 * 32 + r32] = (bf16_t)(cvt_pk_bf16(o[d0][r] * rli[r], 0.f) & 0xffffu); }
      asm volatile("s_waitcnt lgkmcnt(0)" ::: "memory");
      const int row = lane >> 1, hf = lane & 1; float q = 0.f;
      bf16_t* yp = Y + (rowbase + q0 + wid * QBLK + row) * DM + 512 + h * 128 + hf * 64;
#pragma unroll
      for (int j = 0; j < 8; ++j) { const u32x4 v = *(const u32x4*)(stg + row * 128 + hf * 64 + j * 8);
          q += bflo(v.x) * bflo(v.x) + bfhi(v.x) * bfhi(v.x) + bflo(v.y) * bflo(v.y) + bfhi(v.y) * bfhi(v.y) + bflo(v.z) * bflo(v.z) + bfhi(v.z) * bfhi(v.z) + bflo(v.w) * bflo(v.w) + bfhi(v.w) * bfhi(v.w);
          *(u32x4*)(yp + j * 8) = v; }
      q += __shfl_xor(q, 1);
      if (hf == 0) atomicAdd(ssq_mla + rowbase + q0 + wid * QBLK + row, q); }
    __syncthreads();
#undef RESC
#undef MASKT
}
#undef KSWZ
#undef SBAR
}

constexpr int NWAVES = 8, NPHASE = 13;
struct Args { const void* in[32]; float* out; unsigned char* ws; int ph_lo, ph_hi; };

__global__ void __launch_bounds__(NWAVES * 64, 2) hymba_fwd(Args args) {
    extern __shared__ __attribute__((aligned(16))) unsigned char lds_raw[];
    LAS unsigned char* lds = (LAS unsigned char*)lds_raw;
    volatile LAS unsigned* MISC = (volatile LAS unsigned*)(lds + MISC_OFF);
    const int G = gridDim.x, bx = blockIdx.x, vcu = (G % 8 == 0) ? (bx % 8) * (G / 8) + bx / 8 : bx;
    const int wave_s = __builtin_amdgcn_readfirstlane((int)threadIdx.x >> 6);
#define lane (lane_id())
#define tid (wave_s * 64 + lane)
#define wave (wave_s)
#define gw (vcu * NWAVES + wave)
#define NGW (G * NWAVES)
    unsigned char* ws = args.ws;
#define x_in ((const float*)args.in[0])
#define mem ((const float*)args.in[1])
#define positions ((const int*)args.in[2])
#define g_pre_mix ((const float*)args.in[3])
#define w_in ((const float*)args.in[4])
#define conv_w ((const float*)args.in[5])
#define conv_b ((const float*)args.in[6])
#define lru_wa ((const float*)args.in[7])
#define lru_ba ((const float*)args.in[8])
#define lru_wx ((const float*)args.in[9])
#define lru_bx ((const float*)args.in[10])
#define lru_lambda ((const float*)args.in[11])
#define g_q_lat ((const float*)args.in[12])
#define w_uq ((const float*)args.in[13])
#define g_kv_lat ((const float*)args.in[14])
#define w_ukv ((const float*)args.in[15])
#define g_lru_out ((const float*)args.in[16])
#define g_mla_out ((const float*)args.in[17])
#define w_out ((const float*)args.in[18])
#define g_post_mix ((const float*)args.in[19])
#define g_pre_mem ((const float*)args.in[20])
#define g_mem_kv ((const float*)args.in[21])
#define w_mq ((const float*)args.in[22])
#define w_mk ((const float*)args.in[23])
#define w_mv ((const float*)args.in[24])
#define w_mo ((const float*)args.in[25])
#define g_post_mem ((const float*)args.in[26])
#define g_pre_ffn ((const float*)args.in[27])
#define w_gate ((const float*)args.in[28])
#define w_up ((const float*)args.in[29])
#define w_down ((const float*)args.in[30])
#define g_post_ffn ((const float*)args.in[31])
#define out_p (args.out)
#define ctl ((unsigned*)(ws + WS_CTL))
#define ssq_cq ((float*)(ws + WS_SSQ))
#define ssq_ckv (ssq_cq + T)
#define ssq_lru (ssq_cq + 2 * T)
#define ssq_mla (ssq_cq + 3 * T)
#define ssq_h1 (ssq_cq + 4 * T)
#define ssq_h2 (ssq_cq + 5 * T)
#define ssq_x (ssq_cq + 6 * T)
#define ssq_dummy (ssq_cq + 7 * T)
#define slots_p ((float*)(ws + WS_SLOTS))
#define cosT ((float*)(ws + WS_ROPE))
#define sinT (cosT + (size_t)T * 32)
#define Win_t ((bf16_t*)(ws + WS_WIN))
#define Wuq_t ((bf16_t*)(ws + WS_WUQ))
#define Wukv_t ((bf16_t*)(ws + WS_WUKV))
#define Wout_t ((bf16_t*)(ws + WS_WOUT))
#define Wmq_b ((bf16_t*)(ws + WS_WMQ))
#define Wmkv_t ((bf16_t*)(ws + WS_WMKV))
#define Wmo_t ((bf16_t*)(ws + WS_WMO))
#define Wgu_t ((bf16_t*)(ws + WS_WGU))
#define Wdown_t ((bf16_t*)(ws + WS_WDOWN))
#define MN ((bf16_t*)(ws + WS_MN))
#define MKV ((bf16_t*)(ws + WS_MKV))
#define WQK ((bf16_t*)(ws + WS_WQK))
#define WVO ((bf16_t*)(ws + WS_WVO))
#define XN ((bf16_t*)(ws + WS_XN))
#define KPE ((bf16_t*)(ws + WS_KPE))
#define Z ((bf16_t*)(ws + WS_Z))
#define Qb ((bf16_t*)(ws + WS_Q))
#define KVb ((bf16_t*)(ws + WS_KV))
#define Y ((bf16_t*)(ws + WS_Y))
#define PRE ((float*)(ws + WS_PRE))
#define Pb ((bf16_t*)(ws + WS_P))
#define Fb ((bf16_t*)(ws + WS_F))
    for (int u = tid; u < 256; u += NWAVES * 64) ((LAS unsigned*)(lds + MISC_OFF))[u] = 0u;
    __syncthreads();
    XcdBarrier bar = xcd_barrier_post(ctl + CW_BAR, MISC + 8);
    const int lo = args.ph_lo, hi = args.ph_hi;
#ifndef REP_PHASE
#define REP_PHASE -1
#endif
#define REPS(k) for (int rep = 0; rep < ((REP_PHASE) == (k) ? 2 : 1); ++rep)
#define RSQ(p) (rep ? ssq_dummy : (p))
#ifndef PHASE_MASK
#define PHASE_MASK 0x1fff
#endif
#define IN(k) (((PHASE_MASK >> (k)) & 1) && lo <= (k) && (k) < hi)
#ifndef ALIGN_P10
#define ALIGN_P10 true
#endif
#ifndef EXTRA_BAR
#define EXTRA_BAR 0
#endif
#define SEAM(k) do { if (IN(k) && IN((k) + 1)) { xcd_barrier(bar, wave_s); if ((k) == 4) for (int eb = 0; eb < EXTRA_BAR; ++eb) xcd_barrier(bar, wave_s); } } while (0)

    if (IN(0)) REPS(0) {
        LAS float* scr = (LAS float*)(lds + wave * 16640);
        constexpr int I_IN = 16 * 27, I_UQ = 6 * 12, I_UKV = 4 * 16, I_SQ = 16 * 16, I_GU = 16 * 44, I_DN = 44 * 16;
        int cum = 0;
#define P0_JOB(W, K_, N_, WT, ROFF, MODE, KS, KS2, CNT) do { for (int it = (gw + NGW - (cum % NGW)) % NGW; it < (CNT); it += NGW) p0_transpose_item(W, K_, N_, WT, ROFF, MODE, KS, KS2, scr, it, lane); cum += (CNT); } while (0)
        P0_JOB(w_in, DM, 1728, Win_t, 0, MAP_WIN, g_pre_mix, nullptr, I_IN);
        P0_JOB(w_uq, QLR, 768, Wuq_t, 0, MAP_WUQ, g_q_lat, nullptr, I_UQ);
        P0_JOB(w_ukv, KVLR, 1024, Wukv_t, 0, MAP_WUKV, g_kv_lat, nullptr, I_UKV);
        P0_JOB(w_out, DM, DM, Wout_t, 0, MAP_ID, g_lru_out, g_mla_out, I_SQ);
        P0_JOB(w_mk, DM, DM, Wmkv_t, 0, MAP_ID, nullptr, nullptr, I_SQ);
        P0_JOB(w_mv, DM, DM, Wmkv_t, 1024, MAP_ID, nullptr, nullptr, I_SQ);
        P0_JOB(w_mo, DM, DM, Wmo_t, 0, MAP_ID, nullptr, nullptr, I_SQ);
        P0_JOB(w_gate, DM, DFF, Wgu_t, 0, MAP_GATE, g_pre_ffn, nullptr, I_GU);
        P0_JOB(w_up, DM, DFF, Wgu_t, 0, MAP_UP, g_pre_ffn, nullptr, I_GU);
        P0_JOB(w_down, DFF, DM, Wdown_t, 0, MAP_ID, nullptr, nullptr, I_DN);
#undef P0_JOB
        const int gt = vcu * (NWAVES * 64) + tid, NGT = G * NWAVES * 64;
        for (int i = gt; i < 64 * 1024 / 8; i += NGT) *(u32x4*)(Win_t + (size_t)1728 * 1024 + (size_t)i * 8) = (u32x4){0u, 0u, 0u, 0u};
        for (int i = gt; i < DM * DM / 4; i += NGT) { const f32x4 v = *(const f32x4*)(w_mq + (size_t)i * 4) * g_pre_mem[i >> 8]; u32x2 w; w.x = cvt_pk_bf16(v.x, v.y); w.y = cvt_pk_bf16(v.z, v.w); *(u32x2*)(Wmq_b + (size_t)i * 4) = w; }
        for (int i = gt; i < T * 32; i += NGT) { const int row = i >> 5, k = i & 31; const double invf = exp2(-(double)k * (13.287712379549449 / 32.0));
            const double rev = (double)positions[row] * invf * 0.15915494309189535; const float fr_ = (float)(rev - rint(rev)); cosT[i] = __builtin_amdgcn_cosf(fr_); sinT[i] = __builtin_amdgcn_sinf(fr_); }
        for (int m = gw * 4; m < T; m += NGW * 4) rms_rows_to_bf16<4, false>(x_in + (size_t)m * DM, g_pre_mix, XN + (size_t)m * DM, ssq_x + m, lane);
        for (int m = gw * 2; m < TM; m += NGW * 2) rms_rows_to_bf16<2, true>(mem + (size_t)m * DM, g_mem_kv, MN + (size_t)m * DM, nullptr, lane);
    }
    SEAM(0);
    if (IN(1)) REPS(1) {
        { pg8::TileOrder S; S.init(T, DINP, G, bx, XN, DM, Win_t, DM); EpiZ E{Z, KPE, RSQ(ssq_cq), RSQ(ssq_ckv), cosT, sinT, ssq_x};
          pg8::gemm_phase<EpiZ, pg8::TileOrder>(lds, DM, DM, DM, S, E, wave_s); }
        { pg8::TileOrder S; S.init(TM, 2048, G, (bx + 128) % G, MN, DM, Wmkv_t, DM); EpiBf16 E{MKV, 2048, 1.f, nullptr, 0.f};
          pg8::gemm_phase<EpiBf16, pg8::TileOrder>(lds, DM, DM, DM, S, E, wave_s); }
    }
    SEAM(1);
    if (IN(2)) REPS(2) {
#ifndef P2SUB
#define P2SUB 31
#endif
#ifndef REP_P2SUB
#define REP_P2SUB 0
#endif
#define R2(i) for (int r2 = 0; r2 < (((REP_P2SUB) >> (i)) & 1) + 1; ++r2)
        if (P2SUB & 1) R2(0) for (int uidx = vcu; uidx < BATCH * 16; uidx += G) lru::unit(uidx >> 4, uidx & 15, Z, Y, (rep | r2) ? ssq_dummy : ssq_lru, conv_w, conv_b, lru_wa, lru_ba, lru_wx, lru_bx, lru_lambda, lds, wave_s);
        if (P2SUB & 2) R2(1) { pg8::TileOrder S; S.init(T, 768, G, bx, Z + OFF_CQ, DINP, Wuq_t, QLR); EpiQ E{Qb, ssq_cq, cosT, sinT};
          pg8::gemm_phase<EpiQ, pg8::TileOrder>(lds, DINP, QLR, QLR, S, E, wave_s); }
        if (P2SUB & 4) R2(2) { pg8::TileOrder S; S.init(T, 1024, G, (bx + 128) % G, Z + OFF_CKV, DINP, Wukv_t, KVLR); EpiBf16 E{KVb, 1024, 1.f, ssq_ckv, 1.f / KVLR};
          pg8::gemm_phase<EpiBf16, pg8::TileOrder>(lds, DINP, KVLR, KVLR, S, E, wave_s); }
        struct FormQK { int G, c; const bf16_t* mkv; const bf16_t* W;
            __device__ bool next(int i, pg8::Unit& u) const { const int L = i * G + c; if (L >= 256) return false; const int bh = L >> 2, q = L & 3, b = bh >> 2, h = bh & 3;
                u.pm = 0; u.pn = q; u.A = (const char*)(mkv + (size_t)(b * 256) * 2048 + h * 256); u.B = (const char*)(W + (size_t)(q * 256) * 1024 + h * 256); u.cofs = ((long)b * 1024 + h * 256) * 1024; return true; } };
        struct FormVO { int G, c; const bf16_t* mkv; const bf16_t* W;
            __device__ bool next(int i, pg8::Unit& u) const { const int L = i * G + c; if (L >= 256) return false; const int bh = L >> 2, q = L & 3, b = bh >> 2, h = bh & 3;
                u.pm = q; u.pn = 0; u.A = (const char*)(W + (size_t)(q * 256) * 1024 + h * 256); u.B = (const char*)(mkv + (size_t)(b * 256) * 2048 + 1024 + h * 256); u.cofs = (long)b * 1024 * 1024 + h * 256; return true; } };
        if (P2SUB & 8) R2(3) { FormQK S{G, vcu, MKV, Wmq_b}; EpiBf16 E{WQK, 1024, MSCALE, nullptr, 0.f}; pg8::gemm_phase<EpiBf16, FormQK>(lds, 2048, 1024, 256, S, E, wave_s); }
        if (P2SUB & 16) R2(3) { FormVO S{G, vcu, MKV, Wmo_t}; EpiBf16 E{WVO, 1024, 1.f, nullptr, 0.f}; pg8::gemm_phase<EpiBf16, FormVO>(lds, 1024, 2048, 256, S, E, wave_s); }
    }
    SEAM(2);
    if (IN(3)) REPS(3) {
        for (int it = vcu; it < BATCH * 4 * 4; it += G) { const int bh = it >> 2, xq = it & 3, b = bh >> 2, h = bh & 3;
            mla::block(b, h, xq, Qb, KVb, KPE, Y, RSQ(ssq_mla), (char*)lds_raw, wave_s);
            mla::block(b, h, 7 - xq, Qb, KVb, KPE, Y, RSQ(ssq_mla), (char*)lds_raw, wave_s); }
    }
    SEAM(3);
    if (IN(5)) REPS(5) { pg8::TileOrder S; S.init(T, DM, G, bx, Y, DM, Wout_t, DM);
        EpiNormResMid E{nullptr, XN, nullptr, g_post_mix, rep ? (bf16_t*)PRE : XN, RSQ(ssq_h1), slots_p, ctl + CW_SEAM, ssq_lru, ssq_mla};
        pg8::gemm_phase<EpiNormResMid, pg8::TileOrder>(lds, DM, DM, DM, S, E, wave_s); }
    SEAM(5);
    if (IN(7)) REPS(7) { pg8::TileOrder S; S.init(T, DM, G, bx, XN, DM, WQK, DM, (size_t)DM * DM * 2); EpiSoftmax E{Pb, ssq_h1}; pg8::gemm_phase<EpiSoftmax, pg8::TileOrder>(lds, DM, DM, DM, S, E, wave_s); }
    SEAM(7);
    if (IN(8)) REPS(8) { pg8::TileOrder S; S.init(T, DM, G, bx, Pb, DM, WVO, DM, (size_t)DM * DM * 2); EpiNormRes E{nullptr, XN, nullptr, g_post_mem, rep ? (bf16_t*)PRE : XN, RSQ(ssq_h2), slots_p + (size_t)4 * T, ctl + CW_SEAM + SEAM_BANK, nullptr, nullptr};
        pg8::gemm_phase<EpiNormRes, pg8::TileOrder>(lds, DM, DM, DM, S, E, wave_s); }
    SEAM(8);
    if (IN(10)) REPS(10) { pg8::TileOrder S; S.init(T, 2 * DFF, G, bx, XN, DM, Wgu_t, DM); EpiSwiGLU E{Fb, ssq_h2}; pg8::gemm_phase<EpiSwiGLU, pg8::TileOrder, ALIGN_P10>(lds, DM, DM, DM, S, E, wave_s); }
    SEAM(10);
    if (IN(11)) REPS(11) { pg8::TileOrder S; S.init(T, DM, G, bx, Fb, DFF, Wdown_t, DFF); EpiNormRes E{nullptr, XN, rep ? PRE : out_p, g_post_ffn, nullptr, nullptr, slots_p + (size_t)8 * T, ctl + CW_SEAM + 2 * SEAM_BANK, nullptr, nullptr};
        pg8::gemm_phase<EpiNormRes, pg8::TileOrder>(lds, DFF, DFF, DFF, S, E, wave_s); }
#undef IN
#undef SEAM
}

#undef tid
#undef lane
#undef wave
#undef gw
#undef NGW
#undef x_in
#undef ssq_h1
#undef ssq_h2
#undef ssq_dummy
#undef ssq_x
#undef slots_p
#undef mem
#undef positions
#undef g_pre_mix
#undef w_in
#undef conv_w
#undef conv_b
#undef lru_wa
#undef lru_ba
#undef lru_wx
#undef lru_bx
#undef lru_lambda
#undef g_q_lat
#undef w_uq
#undef g_kv_lat
#undef w_ukv
#undef g_lru_out
#undef g_mla_out
#undef w_out
#undef g_post_mix
#undef g_pre_mem
#undef g_mem_kv
#undef w_mq
#undef w_mk
#undef w_mv
#undef w_mo
#undef g_post_mem
#undef g_pre_ffn
#undef w_gate
#undef w_up
#undef w_down
#undef g_post_ffn
#undef out_p
#undef ctl
#undef ssq_cq
#undef ssq_ckv
#undef ssq_lru
#undef ssq_mla
#undef cosT
#undef sinT
#undef Win_t
#undef Wuq_t
#undef Wukv_t
#undef Wout_t
#undef Wmq_b
#undef Wmkv_t
#undef Wmo_t
#undef Wgu_t
#undef Wdown_t
#undef MN
#undef MKV
#undef WQK
#undef WVO
#undef XN
#undef KPE
#undef Z
#undef Qb
#undef KVb
#undef Y
#undef PRE
#undef Pb
#undef Fb
#ifndef N_LAUNCHES
#define N_LAUNCHES 1
#endif
extern "C" void kernel_launch(void* const* d_in, const int* in_sizes, int n_in, void* d_out, int out_size, void* d_ws, size_t ws_size, hipStream_t stream) {
    static int grid = 0;
    if (grid == 0) {
        if (n_in != 32 || in_sizes[0] != T * DM || out_size != T * DM || ws_size < WS_END) { fprintf(stderr, "kernel_launch: unexpected shapes (n_in %d, in0 %d, out %d, ws %zu)\n", n_in, n_in > 0 ? in_sizes[0] : -1, out_size, ws_size); grid = -1; return; }
        int dev = 0, cus = 0, per_cu = 0;
        (void)hipGetDevice(&dev); (void)hipDeviceGetAttribute(&cus, hipDeviceAttributeMultiprocessorCount, dev);
        if (hipFuncSetAttribute((const void*)hymba_fwd, hipFuncAttributeMaxDynamicSharedMemorySize, LDS_BYTES) != hipSuccess) { fprintf(stderr, "kernel_launch: hipFuncSetAttribute failed\n"); grid = -1; return; }
        if (hipOccupancyMaxActiveBlocksPerMultiprocessor(&per_cu, (const void*)hymba_fwd, NWAVES * 64, LDS_BYTES) != hipSuccess || per_cu < 1) { fprintf(stderr, "kernel_launch: occupancy query says %d\n", per_cu); per_cu = 1; }
        (void)hipGetLastError();
        grid = cus > 0 ? cus : 256;
    }
    if (grid < 0) return;
    (void)hipMemsetAsync((char*)d_ws + WS_CTL, 0, CTL_ZERO_BYTES, stream);
    Args a{};
    for (int i = 0; i < 32; ++i) a.in[i] = d_in[i];
    a.out = (float*)d_out; a.ws = (unsigned char*)d_ws;
#if N_LAUNCHES == 1
    a.ph_lo = 0; a.ph_hi = NPHASE;
    void* kargs[] = {&a};
#ifdef PLAIN_LAUNCH
    (void)kargs; hipLaunchKernelGGL(hymba_fwd, dim3(grid), dim3(NWAVES * 64), LDS_BYTES, stream, a); hipError_t e = hipPeekAtLastError();
#else
    hipError_t e = hipLaunchCooperativeKernel((const void*)hymba_fwd, dim3(grid), dim3(NWAVES * 64), kargs, LDS_BYTES, stream);
#endif
    if (e != hipSuccess) fprintf(stderr, "kernel_launch: cooperative launch failed: %s (grid %d)\n", hipGetErrorString(e), grid);
#else
    for (int p = 0; p < NPHASE; ++p) { a.ph_lo = p; a.ph_hi = p + 1; hipLaunchKernelGGL(hymba_fwd, dim3(grid), dim3(NWAVES * 64), LDS_BYTES, stream, a); }
#endif
}
```

```cpp
#include <hip/hip_runtime.h>
#include <hip/hip_bf16.h>
#include <cstdio>
#include <cstdint>

#define LAS __attribute__((address_space(3)))
#define GAS __attribute__((address_space(1)))
typedef unsigned short bf16_t;
typedef short bf16x8 __attribute__((ext_vector_type(8)));
typedef short s16x4 __attribute__((ext_vector_type(4)));
typedef float f32x4 __attribute__((ext_vector_type(4)));
typedef float f32x2 __attribute__((ext_vector_type(2)));
typedef float f32x16 __attribute__((ext_vector_type(16)));
typedef unsigned u32x4 __attribute__((ext_vector_type(4)));
typedef unsigned u32x2 __attribute__((ext_vector_type(2)));

constexpr int BATCH = 16, SEQ = 2048, DM = 1024, T = BATCH * SEQ;
constexpr int NMEM = 256, TM = BATCH * NMEM;
constexpr int DLRU = 512, DINP = 1792, QLR = 384, KVLR = 256, DFF = 2816;
constexpr int OFF_GATE = 512, OFF_CQ = 1024, OFF_CKV = 1408, OFF_KPE = 1664;
constexpr float EPS = 1e-6f;
constexpr float LOG2E = 1.4426950408889634f;
constexpr float QSCALE = 0.07216878364870322f * LOG2E;
constexpr float MSCALE = 0.0625f * LOG2E;

constexpr size_t MiB = 1u << 20;
constexpr size_t WS_CTL = 0, CTL_ZERO_BYTES = 2 * MiB;
constexpr size_t WS_SSQ = 1 * MiB;
constexpr size_t WS_SLOTS = 2 * MiB;
constexpr int CW_SEAM = 16384, SEAM_BANK = 8192;
constexpr size_t WS_ROPE = 4 * MiB;
constexpr size_t WS_WIN = 12 * MiB, WS_WUQ = 16 * MiB, WS_WUKV = 17 * MiB, WS_WOUT = 18 * MiB, WS_WMQ = 20 * MiB, WS_WMKV = 22 * MiB,
                 WS_WMO = 26 * MiB, WS_WGU = 28 * MiB, WS_WDOWN = 39 * MiB;
constexpr size_t WS_MN = 46 * MiB, WS_MKV = 54 * MiB, WS_WQK = 70 * MiB, WS_WVO = 102 * MiB, WS_XN = 134 * MiB, WS_KPE = 198 * MiB;
constexpr size_t WS_Z = 202 * MiB, WS_Q = 314 * MiB, WS_KV = 362 * MiB, WS_Y = 426 * MiB;
constexpr size_t WS_PRE = 202 * MiB, WS_P = 330 * MiB, WS_F = 330 * MiB, WS_END = 506 * MiB;
constexpr int CW_BAR = 4096;

constexpr int RING_BYTES = 131072, EPI_OFF = RING_BYTES, EPI_BYTES = 16384, MISC_OFF = EPI_OFF + EPI_BYTES, LDS_BYTES = MISC_OFF + 1024;

__device__ __forceinline__ unsigned cvt_pk_bf16(float lo, float hi) { unsigned r; asm volatile("v_cvt_pk_bf16_f32 %0, %1, %2" : "=v"(r) : "v"(lo), "v"(hi)); return r; }
__device__ __forceinline__ float bf2f(unsigned short v) { return __uint_as_float((unsigned)v << 16); }
__device__ __forceinline__ float bflo(unsigned w) { return __uint_as_float(w << 16); }
__device__ __forceinline__ float bfhi(unsigned w) { return __uint_as_float(w & 0xffff0000u); }
__device__ __forceinline__ float wave_sum(float v) {
#pragma unroll
    for (int o = 1; o < 64; o <<= 1) v += __shfl_xor(v, o);
    return v;
}
__device__ __forceinline__ int lane_id() { int l; asm volatile("v_mbcnt_lo_u32_b32 %0, -1, 0\n\tv_mbcnt_hi_u32_b32 %0, -1, %0" : "=v"(l)); return l; }
#define LDS_WAIT() asm volatile("s_waitcnt lgkmcnt(0)" ::: "memory")
#define VM_WAIT() asm volatile("s_waitcnt vmcnt(0)" ::: "memory")

namespace pg8 {
constexpr int BM = 256, BK = 64, HALF = 128, HTB = HALF * BK * 2, STAGE_BYTES = 8 * HTB, NXCD = 8, WGM = 8;
__host__ __device__ __forceinline__ int lds_byte(int r, int c) { const int st = (r >> 4) * 2 + (c >> 5), rr = r & 15, cc = c & 31, ob = rr * 64 + cc * 2; return st * 1024 + (ob ^ (((ob >> 9) & 1) << 5)); }
__host__ __device__ __forceinline__ void stage_rc(int b, int& R, int& C) { const int st = b / 1024, sb = b % 1024, swz = sb ^ (((sb >> 9) & 1) << 5); R = (st >> 1) * 16 + swz / 64; C = (st & 1) * 32 + (swz % 64) / 2; }
__host__ __device__ __forceinline__ int perm32(int rho) { const int n = rho >> 4, i = rho & 15; return 8 * (i >> 2) + 4 * n + (i & 3); }

struct Unit { int pm, pn; const char* A; const char* B; long cofs; };

struct TileOrder {
    int nM, nN, nwg, G, c; const char* A; const char* B; size_t tA, tB, bB;
    __device__ void init(int M, int N, int G_, int c_, const void* A_, int lda, const void* B_, int ldb, size_t batchB_bytes = 0) {
        nM = M / BM; nN = N / BM; nwg = nM * nN; G = G_; c = c_; A = (const char*)A_; B = (const char*)B_; tA = (size_t)BM * lda * 2; tB = (size_t)BM * ldb * 2; bB = batchB_bytes; }
    __device__ bool next(int i, Unit& u) const {
        const long L = (long)i * G + c; if (L >= nwg) return false;
        int wgid = (int)L; { const int q = nwg / NXCD, r = nwg % NXCD, xcd = wgid % NXCD, off = wgid / NXCD; wgid = (xcd < r ? xcd * (q + 1) : r * (q + 1) + (xcd - r) * q) + off; }
        const int nig = WGM * nN, gid = wgid / nig, fm = gid * WGM, gsz = (nM - fm) < WGM ? (nM - fm) : WGM;
        u.pm = fm + ((wgid % nig) % gsz); u.pn = (wgid % nig) / gsz; u.A = A + (size_t)u.pm * tA; u.B = B + (size_t)u.pn * tB + (size_t)(u.pm >> 3) * bB; u.cofs = 0; return true;
    }
};

template <class Epi, class Sched, bool ALIGN_EPI = true, bool SP2 = true>
__device__ __forceinline__ void gemm_phase(LAS unsigned char* lds, const int lda, const int ldb, const int K, const Sched& S, const Epi& E, const int wv) {
    int lane = lane_id(); asm volatile("" : "+v"(lane));
    const int wid = wv, tid = wv * 64 + lane, wr = wid >> 2, wc = wid & 3, fr = lane & 15, fq = lane >> 4;
    const int nt = K / BK;
    unsigned voffA[2], voffB[2];
#pragma unroll
    for (int i = 0; i < 2; ++i) { int R, C; stage_rc(tid * 16 + i * 8192, R, C); const int Rb = Epi::PERM ? ((R & ~31) + perm32(R & 31)) : R;
        voffA[i] = (unsigned)(R * lda + C) * 2u; voffB[i] = (unsigned)(Rb * ldb + C) * 2u; }
    const size_t kstep = (size_t)(BK * 2);
    const size_t hstepA = (size_t)HALF * lda * 2, hstepB = (size_t)HALF * ldb * 2;
    const unsigned ldsw = (unsigned)wid * 1024u;
    const int aoff = lds_byte(wr * 64 + fr, fq * 8), boff = lds_byte(wc * 32 + fr, fq * 8);
#define PG8_SA(b, h) (((b) * 2 + (h)) * HTB)
#define PG8_SB(b, h) ((4 + (b) * 2 + (h)) * HTB)
#define PG8_STAGE(bufoff, gbase, voff) do { _Pragma("unroll") for (int _i = 0; _i < 2; ++_i) \
        __builtin_amdgcn_global_load_lds((const unsigned*)((const char*)(gbase) + (voff)[_i]), (LAS unsigned*)(lds + (bufoff) + ldsw + _i * 8192), 16, 0, 0); } while (0)
#define PG8_LDA(dst, b, h) do { _Pragma("unroll") for (int m = 0; m < 4; ++m) _Pragma("unroll") for (int k = 0; k < 2; ++k) dst[m][k] = *(const LAS bf16x8*)(lds + PG8_SA(b, h) + aoff + m * 2048 + k * 1024); } while (0)
#define PG8_LDB(dst, b, h) do { _Pragma("unroll") for (int n = 0; n < 2; ++n) _Pragma("unroll") for (int k = 0; k < 2; ++k) dst[n][k] = *(const LAS bf16x8*)(lds + PG8_SB(b, h) + boff + n * 2048 + k * 1024); } while (0)
#define PG8_MMA(ai, bj, At, Bt) do { __builtin_amdgcn_s_setprio(1); _Pragma("unroll") for (int m = 0; m < 4; ++m) _Pragma("unroll") for (int n = 0; n < 2; ++n) _Pragma("unroll") for (int k = 0; k < 2; ++k) \
        acc[ai][bj][m][n] = __builtin_amdgcn_mfma_f32_16x16x32_bf16(Bt[n][k], At[m][k], acc[ai][bj][m][n], 0, 0, 0); __builtin_amdgcn_s_setprio(0); } while (0)
#define PG8_WAIT_V(n) asm volatile("s_waitcnt vmcnt(" #n ")" ::: "memory")
#define PG8_WAIT_L(n) asm volatile("s_waitcnt lgkmcnt(" #n ")" ::: "memory")
#define PG8_BAR __builtin_amdgcn_s_barrier()
#define PG8_SCHED __builtin_amdgcn_sched_barrier(0)
    Unit cur, nxt; int ui = 0;
    if (!S.next(0, cur)) return;
    if constexpr (Epi::MIDK) E.prep(cur, lds, wid, 0);
    f32x4 acc[2][2][4][2];
#pragma unroll
    for (int a = 0; a < 2; ++a)
#pragma unroll
        for (int b = 0; b < 2; ++b)
#pragma unroll
            for (int m = 0; m < 4; ++m)
#pragma unroll
                for (int n = 0; n < 2; ++n) acc[a][b][m][n] = (f32x4){0.f, 0.f, 0.f, 0.f};
    bf16x8 At[4][2], B0[2][2], B1[2][2];
    const char* cA = cur.A; const char* cB = cur.B;
    static_assert(SP2, "only the SP2 loop is kept");
    PG8_STAGE(PG8_SB(0, 0), cB, voffB); PG8_STAGE(PG8_SB(0, 1), cB + hstepB, voffB); PG8_STAGE(PG8_SA(0, 0), cA, voffA); PG8_STAGE(PG8_SA(0, 1), cA + hstepA, voffA);
    if (wr == 1) PG8_BAR;
    PG8_WAIT_V(2); PG8_BAR;
    PG8_STAGE(PG8_SB(1, 0), cB + kstep, voffB); PG8_STAGE(PG8_SA(1, 0), cA + kstep, voffA); PG8_STAGE(PG8_SB(1, 1), cB + hstepB + kstep, voffB);
    PG8_WAIT_V(6); PG8_BAR;
    for (;;) {
        const bool has_next = S.next(ui + 1, nxt);
        const char* nA = has_next ? nxt.A : cA; const char* nB = has_next ? nxt.B : cB;
        for (int t = 0; t < nt; t += 2) {
            if constexpr (Epi::MIDK) { if (t == Epi::TSPLIT) E.midk(acc, lds, ui & 1, wr); }
            const bool last = (t == nt - 2);
            const char* a1 = cA + (size_t)(t + 1) * kstep;
            const char* a2 = last ? nA : cA + (size_t)(t + 2) * kstep; const char* b2 = last ? nB : cB + (size_t)(t + 2) * kstep;
            const char* a3 = a2 + kstep; const char* b3 = b2 + kstep;
            PG8_LDB(B0, 0, 0); PG8_LDB(B1, 0, 1); PG8_SCHED; PG8_LDA(At, 0, 0); PG8_STAGE(PG8_SA(1, 1), a1 + hstepA, voffA);
            PG8_WAIT_V(8); PG8_WAIT_L(0); PG8_BAR; PG8_MMA(0, 0, At, B0); PG8_MMA(0, 1, At, B1); PG8_BAR; PG8_SCHED;
            PG8_LDA(At, 0, 1); PG8_STAGE(PG8_SB(0, 0), b2, voffB); PG8_STAGE(PG8_SB(0, 1), b2 + hstepB, voffB); PG8_STAGE(PG8_SA(0, 0), a2, voffA);
            PG8_WAIT_V(8); PG8_WAIT_L(0); PG8_BAR; PG8_MMA(1, 0, At, B0); PG8_MMA(1, 1, At, B1); PG8_BAR; PG8_SCHED;
            PG8_LDB(B0, 1, 0); PG8_LDB(B1, 1, 1); PG8_SCHED; PG8_LDA(At, 1, 0); PG8_STAGE(PG8_SA(0, 1), a2 + hstepA, voffA);
            PG8_WAIT_V(8); PG8_WAIT_L(0); PG8_BAR; PG8_MMA(0, 0, At, B0); PG8_MMA(0, 1, At, B1); PG8_BAR; PG8_SCHED;
            PG8_LDA(At, 1, 1); PG8_STAGE(PG8_SB(1, 0), b3, voffB); PG8_STAGE(PG8_SB(1, 1), b3 + hstepB, voffB); PG8_STAGE(PG8_SA(1, 0), a3, voffA);
            PG8_WAIT_V(8); PG8_WAIT_L(0); PG8_BAR; PG8_MMA(1, 0, At, B0); PG8_MMA(1, 1, At, B1); PG8_BAR; PG8_SCHED;
        }
        if constexpr (ALIGN_EPI) { if (wr == 0) PG8_BAR; }
        E(acc, cur, wr, wc, fr, fq, lds, wid, ui & 1);
        if (!has_next) break;
        if constexpr (Epi::MIDK) E.prep(nxt, lds, wid, (ui + 1) & 1);
#pragma unroll
        for (int a = 0; a < 2; ++a)
#pragma unroll
            for (int b = 0; b < 2; ++b)
#pragma unroll
                for (int m = 0; m < 4; ++m)
#pragma unroll
                    for (int n = 0; n < 2; ++n) acc[a][b][m][n] = (f32x4){0.f, 0.f, 0.f, 0.f};
        cur = nxt; cA = nA; cB = nB; ++ui;
        if constexpr (ALIGN_EPI) { if (wr == 1) PG8_BAR; }
    }
    PG8_WAIT_V(0);
    if constexpr (!ALIGN_EPI) { if (wr == 0) PG8_BAR; }
    PG8_BAR;
#undef PG8_SA
#undef PG8_SB
#undef PG8_STAGE
#undef PG8_LDA
#undef PG8_LDB
#undef PG8_MMA
#undef PG8_WAIT_V
#undef PG8_WAIT_L
#undef PG8_BAR
#undef PG8_SCHED
}
}

typedef f32x4 Acc[2][2][4][2];
__device__ __forceinline__ void ssq_rows_atomic(const Acc& acc, float* ssq, int row_base  , int bjmask, int fq, int lane) {
#pragma unroll
    for (int ai = 0; ai < 2; ++ai) {
        float s[4];
#pragma unroll
        for (int m = 0; m < 4; ++m) { float q = 0.f;
#pragma unroll
            for (int bj = 0; bj < 2; ++bj) if (bjmask & (1 << bj))
#pragma unroll
                for (int n = 0; n < 2; ++n) { const f32x4 x = acc[ai][bj][m][n]; q += (x[0] * x[0] + x[1] * x[1]) + (x[2] * x[2] + x[3] * x[3]); }
            q += __shfl_xor(q, 16); q += __shfl_xor(q, 32); s[m] = q; }
        const float v = fq == 0 ? s[0] : fq == 1 ? s[1] : fq == 2 ? s[2] : s[3];
        atomicAdd(ssq + row_base + ai * 128 + lane, v);
    }
}
struct EpiBf16 {
    static constexpr bool PERM = true, MIDK = false;
    bf16_t* O; int ldc; float scale; const float* ssq; float rdim_inv;
    __device__ __forceinline__ void operator()(const Acc& acc, const pg8::Unit& u, int wr, int wc, int fr, int fq, LAS unsigned char*, int, int) const {
        { const int ln_ = lane_id(); fr = ln_ & 15; fq = ln_ >> 4; }
        const int row0 = u.pm * 256 + wr * 64 + fr, col0 = u.pn * 256 + wc * 32 + 8 * fq;
#pragma unroll
        for (int ai = 0; ai < 2; ++ai)
#pragma unroll
            for (int m = 0; m < 4; ++m) { const int row = row0 + ai * 128 + m * 16; float sc = scale;
                if (ssq) sc *= __builtin_amdgcn_rsqf(ssq[row] * rdim_inv + EPS);
                bf16_t* rowp = O + u.cofs + (size_t)row * ldc + col0;
#pragma unroll
                for (int bj = 0; bj < 2; ++bj) { const f32x4 v0 = acc[ai][bj][m][0] * sc, v1 = acc[ai][bj][m][1] * sc;
                    u32x4 w; w.x = cvt_pk_bf16(v0[0], v0[1]); w.y = cvt_pk_bf16(v0[2], v0[3]); w.z = cvt_pk_bf16(v1[0], v1[1]); w.w = cvt_pk_bf16(v1[2], v1[3]);
                    *(u32x4*)(rowp + bj * 128) = w; } }
    }
};
__device__ __forceinline__ void rope8(f32x4& v0, f32x4& v1, const float* cosT, const float* sinT, int row, int i0) {
    const f32x4 c = *(const f32x4*)(cosT + (size_t)row * 32 + i0), s = *(const f32x4*)(sinT + (size_t)row * 32 + i0);
    const f32x4 a = v0, b = v1;
    v0[0] = a[0] * c[0] - a[1] * s[0]; v0[1] = a[1] * c[0] + a[0] * s[0]; v0[2] = a[2] * c[1] - a[3] * s[1]; v0[3] = a[3] * c[1] + a[2] * s[1];
    v1[0] = b[0] * c[2] - b[1] * s[2]; v1[1] = b[1] * c[2] + b[0] * s[2]; v1[2] = b[2] * c[3] - b[3] * s[3]; v1[3] = b[3] * c[3] + b[2] * s[3];
}
struct EpiZ {
    static constexpr bool PERM = true, MIDK = false;
    bf16_t* Z; bf16_t* KPE; float* ssq_cq; float* ssq_ckv; const float* cosT; const float* sinT; const float* ssq_x;
    __device__ __forceinline__ void operator()(Acc& acc, const pg8::Unit& u, int wr, int wc, int fr, int fq, LAS unsigned char*, int, int lane) const {
        { const int ln_ = lane_id(); fr = ln_ & 15; fq = ln_ >> 4; }
        const int row0 = u.pm * 256 + wr * 64 + fr, col0 = u.pn * 256 + wc * 32 + 8 * fq;
        const bool kpe_tile = (u.pn == 6);
#pragma unroll
        for (int ai = 0; ai < 2; ++ai)
#pragma unroll
            for (int m = 0; m < 4; ++m) { const float rsx = __builtin_amdgcn_rsqf(ssq_x[row0 + ai * 128 + m * 16] * (1.f / DM) + EPS);
#pragma unroll
                for (int bj = 0; bj < 2; ++bj)
#pragma unroll
                    for (int n = 0; n < 2; ++n) acc[ai][bj][m][n] = acc[ai][bj][m][n] * rsx; }
#pragma unroll
        for (int ai = 0; ai < 2; ++ai)
#pragma unroll
            for (int m = 0; m < 4; ++m) { const int row = row0 + ai * 128 + m * 16; bf16_t* rowp = Z + (size_t)row * DINP + col0;
#pragma unroll
                for (int bj = 0; bj < 2; ++bj) { f32x4 v0 = acc[ai][bj][m][0], v1 = acc[ai][bj][m][1];
                    if (kpe_tile && bj == 1) {
                        if (wc < 2) { rope8(v0, v1, cosT, sinT, row, 16 * (wc & 1) + 4 * fq);
                            u32x4 w; w.x = cvt_pk_bf16(v0[0], v0[1]); w.y = cvt_pk_bf16(v0[2], v0[3]); w.z = cvt_pk_bf16(v1[0], v1[1]); w.w = cvt_pk_bf16(v1[2], v1[3]);
                            *(u32x4*)(KPE + (size_t)row * 64 + wc * 32 + 8 * fq) = w; }
                    } else {
                        u32x4 w; w.x = cvt_pk_bf16(v0[0], v0[1]); w.y = cvt_pk_bf16(v0[2], v0[3]); w.z = cvt_pk_bf16(v1[0], v1[1]); w.w = cvt_pk_bf16(v1[2], v1[3]);
                        *(u32x4*)(rowp + bj * 128) = w; } } }
        const int rb = u.pm * 256 + wr * 64; lane = fq * 16 + fr;
        if (u.pn == 4) ssq_rows_atomic(acc, ssq_cq, rb, 3, fq, lane);
        else if (u.pn == 5) { ssq_rows_atomic(acc, ssq_cq, rb, 1, fq, lane); ssq_rows_atomic(acc, ssq_ckv, rb, 2, fq, lane); }
        else if (u.pn == 6) ssq_rows_atomic(acc, ssq_ckv, rb, 1, fq, lane);
    }
};
struct EpiQ {
    static constexpr bool PERM = true, MIDK = false;
    bf16_t* Q; const float* ssq; const float* cosT; const float* sinT;
    __device__ __forceinline__ void operator()(const Acc& acc, const pg8::Unit& u, int wr, int wc, int fr, int fq, LAS unsigned char*, int, int) const {
        { const int ln_ = lane_id(); fr = ln_ & 15; fq = ln_ >> 4; }
        const int row0 = u.pm * 256 + wr * 64 + fr, col0 = u.pn * 256 + wc * 32 + 8 * fq;
        const bool pe = (u.pn == 2);
#pragma unroll
        for (int ai = 0; ai < 2; ++ai)
#pragma unroll
            for (int m = 0; m < 4; ++m) { const int row = row0 + ai * 128 + m * 16;
                const float sc = QSCALE * __builtin_amdgcn_rsqf(ssq[row] * (1.f / QLR) + EPS);
                bf16_t* rowp = Q + (size_t)row * 768 + col0;
#pragma unroll
                for (int bj = 0; bj < 2; ++bj) { f32x4 v0 = acc[ai][bj][m][0] * sc, v1 = acc[ai][bj][m][1] * sc;
                    if (pe) rope8(v0, v1, cosT, sinT, row, 16 * (wc & 1) + 4 * fq);
                    u32x4 w; w.x = cvt_pk_bf16(v0[0], v0[1]); w.y = cvt_pk_bf16(v0[2], v0[3]); w.z = cvt_pk_bf16(v1[0], v1[1]); w.w = cvt_pk_bf16(v1[2], v1[3]);
                    *(u32x4*)(rowp + bj * 128) = w; } }
    }
};
struct EpiF32 {
    static constexpr bool PERM = false, MIDK = false;
    float* O; int ldc;
    __device__ __forceinline__ void operator()(const Acc& acc, const pg8::Unit& u, int wr, int wc, int fr, int fq, LAS unsigned char*, int, int) const {
        { const int ln_ = lane_id(); fr = ln_ & 15; fq = ln_ >> 4; }
        const int row0 = u.pm * 256 + wr * 64 + fr, col0 = u.pn * 256 + wc * 32 + 4 * fq;
#pragma unroll
        for (int ai = 0; ai < 2; ++ai)
#pragma unroll
            for (int m = 0; m < 4; ++m) { float* rowp = O + (size_t)(row0 + ai * 128 + m * 16) * ldc + col0;
#pragma unroll
                for (int bj = 0; bj < 2; ++bj)
#pragma unroll
                    for (int n = 0; n < 2; ++n) *(f32x4*)(rowp + bj * 128 + n * 16) = acc[ai][bj][m][n]; }
    }
};
struct EpiSwiGLU {
    static constexpr bool PERM = true, MIDK = false;
    bf16_t* F; const float* ssq;
    __device__ __forceinline__ void operator()(const Acc& acc, const pg8::Unit& u, int wr, int wc, int fr, int fq, LAS unsigned char*, int, int) const {
        { const int ln_ = lane_id(); fr = ln_ & 15; fq = ln_ >> 4; }
        const int row0 = u.pm * 256 + wr * 64 + fr, col0 = u.pn * 128 + wc * 32 + 8 * fq;
        float sq[2][4];
#pragma unroll
        for (int ai = 0; ai < 2; ++ai)
#pragma unroll
            for (int m = 0; m < 4; ++m) sq[ai][m] = ssq[row0 + ai * 128 + m * 16];
#pragma unroll
        for (int ai = 0; ai < 2; ++ai)
#pragma unroll
            for (int m = 0; m < 4; ++m) { bf16_t* rowp = F + (size_t)(row0 + ai * 128 + m * 16) * DFF + col0; float f[8];
                const float rsc = __builtin_amdgcn_rsqf(sq[ai][m] * (1.f / DM) + EPS);
#pragma unroll
                for (int n = 0; n < 2; ++n)
#pragma unroll
                    for (int e = 0; e < 4; ++e) { const float g = acc[ai][0][m][n][e] * rsc, up = acc[ai][1][m][n][e] * rsc;
                        f[n * 4 + e] = g * __builtin_amdgcn_rcpf(1.f + __builtin_amdgcn_exp2f(-g * LOG2E)) * up; }
                u32x4 w; w.x = cvt_pk_bf16(f[0], f[1]); w.y = cvt_pk_bf16(f[2], f[3]); w.z = cvt_pk_bf16(f[4], f[5]); w.w = cvt_pk_bf16(f[6], f[7]);
                *(u32x4*)rowp = w; }
    }
};
struct EpiSoftmax {
    static constexpr bool PERM = true, MIDK = false;
    bf16_t* P; const float* ssq;
    __device__ __forceinline__ void operator()(Acc& acc, const pg8::Unit& u, int wr, int wc, int fr, int fq, LAS unsigned char* lds, int, int) const {
        { const int ln_ = lane_id(); fr = ln_ & 15; fq = ln_ >> 4; }
        LAS float* PM = (LAS float*)(lds + EPI_OFF);
        LAS float* PS = (LAS float*)(lds + EPI_OFF + 4096);
        float sq[2][4];
#pragma unroll
        for (int ai = 0; ai < 2; ++ai)
#pragma unroll
            for (int m = 0; m < 4; ++m) sq[ai][m] = ssq[u.pm * 256 + ai * 128 + wr * 64 + m * 16 + fr];
        float mxr[2][4];
#pragma unroll
        for (int ai = 0; ai < 2; ++ai)
#pragma unroll
            for (int m = 0; m < 4; ++m) { float q = -3.0e38f;
#pragma unroll
                for (int bj = 0; bj < 2; ++bj)
#pragma unroll
                    for (int n = 0; n < 2; ++n) { const f32x4 x = acc[ai][bj][m][n]; q = fmaxf(q, fmaxf(fmaxf(x[0], x[1]), fmaxf(x[2], x[3]))); }
                q = fmaxf(q, __shfl_xor(q, 16)); q = fmaxf(q, __shfl_xor(q, 32)); mxr[ai][m] = q; }
#pragma unroll
        for (int ai = 0; ai < 2; ++ai)
#pragma unroll
            for (int m = 0; m < 4; ++m) { sq[ai][m] = __builtin_amdgcn_rsqf(sq[ai][m] * (1.f / DM) + EPS);
                if (fq == 0) PM[(ai * 128 + wr * 64 + m * 16 + fr) * 4 + wc] = mxr[ai][m] * sq[ai][m]; }
        LDS_WAIT(); __builtin_amdgcn_s_barrier(); asm volatile("" ::: "memory");
#pragma unroll
        for (int ai = 0; ai < 2; ++ai)
#pragma unroll
            for (int m = 0; m < 4; ++m) { const f32x4 t = *(const LAS f32x4*)(PM + (ai * 128 + wr * 64 + m * 16 + fr) * 4);
                const float rm = fmaxf(fmaxf(t[0], t[1]), fmaxf(t[2], t[3])), rsc = sq[ai][m]; float s = 0.f;
#pragma unroll
                for (int bj = 0; bj < 2; ++bj)
#pragma unroll
                    for (int n = 0; n < 2; ++n) { f32x4 x = acc[ai][bj][m][n];
#pragma unroll
                        for (int e = 0; e < 4; ++e) { x[e] = __builtin_amdgcn_exp2f(fmaf(x[e], rsc, -rm)); s += x[e]; }
                        acc[ai][bj][m][n] = x; }
                s += __shfl_xor(s, 16); s += __shfl_xor(s, 32);
                if (fq == 0) PS[(ai * 128 + wr * 64 + m * 16 + fr) * 4 + wc] = s; }
        LDS_WAIT(); __builtin_amdgcn_s_barrier(); asm volatile("" ::: "memory");
        const int row0 = u.pm * 256 + wr * 64 + fr, col0 = u.pn * 256 + wc * 32 + 8 * fq;
#pragma unroll
        for (int ai = 0; ai < 2; ++ai)
#pragma unroll
            for (int m = 0; m < 4; ++m) { const f32x4 t = *(const LAS f32x4*)(PS + (ai * 128 + wr * 64 + m * 16 + fr) * 4);
                const float inv = __builtin_amdgcn_rcpf((t[0] + t[1]) + (t[2] + t[3]));
                bf16_t* rowp = P + (size_t)(row0 + ai * 128 + m * 16) * DM + col0;
#pragma unroll
                for (int bj = 0; bj < 2; ++bj) { const f32x4 v0 = acc[ai][bj][m][0] * inv, v1 = acc[ai][bj][m][1] * inv;
                    u32x4 w; w.x = cvt_pk_bf16(v0[0], v0[1]); w.y = cvt_pk_bf16(v0[2], v0[3]); w.z = cvt_pk_bf16(v1[0], v1[1]); w.w = cvt_pk_bf16(v1[2], v1[3]);
                    *(u32x4*)(rowp + bj * 128) = w; } }
    }
};

__device__ __forceinline__ unsigned ag_ld(const unsigned* p) { return __hip_atomic_load(p, __ATOMIC_RELAXED, __HIP_MEMORY_SCOPE_AGENT); }
template <bool MIDK_>
struct EpiNormResT {
    static constexpr bool PERM = true, MIDK = MIDK_; static constexpr int TSPLIT = 8;
    const float* hold_f; const bf16_t* hold_b; float* hout; const float* gpost; bf16_t* xn; float* ssq_next; float* slots; unsigned* cnt;
    const float* ssq_a; const float* ssq_b;
    __device__ __forceinline__ void prep(const pg8::Unit& u, LAS unsigned char* lds, int wid, int par) const {
        if (wid < 4) { const int ln = lane_id(), row = wid * 64 + ln; const float sa = ssq_a[u.pm * 256 + row], sb = ssq_b[u.pm * 256 + row];
            const float ra = __builtin_amdgcn_rsqf(sa * (1.f / 512) + EPS), rb = __builtin_amdgcn_rsqf(sb * (1.f / 512) + EPS);
            ((LAS f32x2*)(lds + EPI_OFF + 5120))[par * 256 + row] = (f32x2){ra * __builtin_amdgcn_rcpf(rb), rb}; }
    }
    __device__ __forceinline__ void midk(Acc& acc, LAS unsigned char* lds, int par, int wr) const {
        const int ln = lane_id(), fr = ln & 15; const LAS f32x2* RT = (const LAS f32x2*)(lds + EPI_OFF + 5120) + par * 256;
#pragma unroll
        for (int ai = 0; ai < 2; ++ai)
#pragma unroll
            for (int m = 0; m < 4; ++m) { const float r = RT[ai * 128 + wr * 64 + m * 16 + fr].x;
#pragma unroll
                for (int bj = 0; bj < 2; ++bj)
#pragma unroll
                    for (int n = 0; n < 2; ++n) acc[ai][bj][m][n] = acc[ai][bj][m][n] * r; }
    }
    __device__ __forceinline__ void operator()(Acc& acc, const pg8::Unit& u, int wr, int wc, int fr, int fq, LAS unsigned char* lds, int wid, int par) const {
        const int ln = lane_id(); fr = ln & 15; fq = ln >> 4;
        if constexpr (MIDK_) { const LAS f32x2* RT = (const LAS f32x2*)(lds + EPI_OFF + 5120) + par * 256;
#pragma unroll
            for (int ai = 0; ai < 2; ++ai)
#pragma unroll
                for (int m = 0; m < 4; ++m) { const float r = RT[ai * 128 + wr * 64 + m * 16 + fr].y;
#pragma unroll
                    for (int bj = 0; bj < 2; ++bj)
#pragma unroll
                        for (int n = 0; n < 2; ++n) acc[ai][bj][m][n] = acc[ai][bj][m][n] * r; } }
        LAS float* PT = (LAS float*)(lds + EPI_OFF);
        LAS float* SR = (LAS float*)(lds + EPI_OFF + 4096);
        const int col0 = u.pn * 256 + wc * 32 + 8 * fq;
        f32x4 gv[2][2];
#pragma unroll
        for (int bj = 0; bj < 2; ++bj)
#pragma unroll
            for (int n = 0; n < 2; ++n) gv[bj][n] = *(const f32x4*)(gpost + col0 + bj * 128 + n * 4);
        u32x4 hb[2][4][2];
        if (!hold_f) {
#pragma unroll
            for (int ai = 0; ai < 2; ++ai)
#pragma unroll
                for (int m = 0; m < 4; ++m)
#pragma unroll
                    for (int bj = 0; bj < 2; ++bj) hb[ai][m][bj] = *(const u32x4*)(hold_b + (size_t)(u.pm * 256 + ai * 128 + wr * 64 + m * 16 + fr) * DM + col0 + bj * 128); }
#pragma unroll
        for (int ai = 0; ai < 2; ++ai)
#pragma unroll
            for (int m = 0; m < 4; ++m) { float q = 0.f;
#pragma unroll
                for (int bj = 0; bj < 2; ++bj)
#pragma unroll
                    for (int n = 0; n < 2; ++n) { const f32x4 x = acc[ai][bj][m][n]; q += (x[0] * x[0] + x[1] * x[1]) + (x[2] * x[2] + x[3] * x[3]); }
                q += __shfl_xor(q, 16); q += __shfl_xor(q, 32);
                if (fq == 0) PT[(ai * 128 + wr * 64 + m * 16 + fr) * 4 + wc] = q; }
        LDS_WAIT(); __builtin_amdgcn_s_barrier(); asm volatile("" ::: "memory");
        unsigned* c = cnt + 64 * u.pm;
        if (wid < 4) { const int row = wid * 64 + ln; const f32x4 t = *(const LAS f32x4*)(PT + row * 4); const float sq = (t[0] + t[1]) + (t[2] + t[3]);
            __hip_atomic_store((unsigned*)slots + ((size_t)(u.pm * 256 + row) * 4 + u.pn), __float_as_uint(sq), __ATOMIC_RELAXED, __HIP_MEMORY_SCOPE_AGENT);
            asm volatile("s_waitcnt vmcnt(0)" ::: "memory");
            if (ln == 0) __hip_atomic_fetch_add(c, 1u, __ATOMIC_RELAXED, __HIP_MEMORY_SCOPE_AGENT); }
        if (wid == 0) { unsigned sp = 0;
            while ((unsigned)__builtin_amdgcn_readfirstlane(ag_ld(c)) < 16u) { __builtin_amdgcn_s_sleep(2); if (++sp > (1u << 21)) break; }
            __builtin_amdgcn_fence(__ATOMIC_ACQUIRE, "agent"); }
        asm volatile("s_waitcnt vmcnt(0) lgkmcnt(0)" ::: "memory"); __builtin_amdgcn_s_barrier(); asm volatile("" ::: "memory");
        if (wid < 4) { const int row = wid * 64 + ln; const unsigned* sl = (const unsigned*)slots + (size_t)(u.pm * 256 + row) * 4;
            const float tot = (__uint_as_float(ag_ld(sl)) + __uint_as_float(ag_ld(sl + 1))) + (__uint_as_float(ag_ld(sl + 2)) + __uint_as_float(ag_ld(sl + 3)));
            SR[row] = __builtin_amdgcn_rsqf(tot * (1.f / DM) + EPS); }
        LDS_WAIT(); __builtin_amdgcn_s_barrier(); asm volatile("" ::: "memory");
#pragma unroll
        for (int ai = 0; ai < 2; ++ai) { float s[4];
#pragma unroll
            for (int m = 0; m < 4; ++m) { const int rl = ai * 128 + wr * 64 + m * 16 + fr; const float rs = SR[rl]; const size_t off = (size_t)(u.pm * 256 + rl) * DM + col0; float q = 0.f;
#pragma unroll
                for (int bj = 0; bj < 2; ++bj) { f32x4 h0, h1;
                    if (hold_f) { h0 = *(const f32x4*)(hold_f + off + bj * 128); h1 = *(const f32x4*)(hold_f + off + bj * 128 + 4); }
                    else { const u32x4 hv = hb[ai][m][bj]; h0 = (f32x4){bflo(hv.x), bfhi(hv.x), bflo(hv.y), bfhi(hv.y)}; h1 = (f32x4){bflo(hv.z), bfhi(hv.z), bflo(hv.w), bfhi(hv.w)}; }
                    const f32x4 v0 = h0 + acc[ai][bj][m][0] * rs * gv[bj][0], v1 = h1 + acc[ai][bj][m][1] * rs * gv[bj][1];
                    q += ((v0[0] * v0[0] + v0[1] * v0[1]) + (v0[2] * v0[2] + v0[3] * v0[3])) + ((v1[0] * v1[0] + v1[1] * v1[1]) + (v1[2] * v1[2] + v1[3] * v1[3]));
                    if (hout) { *(f32x4*)(hout + off + bj * 128) = v0; *(f32x4*)(hout + off + bj * 128 + 4) = v1; }
                    if (xn) { u32x4 w; w.x = cvt_pk_bf16(v0[0], v0[1]); w.y = cvt_pk_bf16(v0[2], v0[3]); w.z = cvt_pk_bf16(v1[0], v1[1]); w.w = cvt_pk_bf16(v1[2], v1[3]); *(u32x4*)(xn + off + bj * 128) = w; } }
                q += __shfl_xor(q, 16); q += __shfl_xor(q, 32); s[m] = q; }
            if (ssq_next) { const float v = fq == 0 ? s[0] : fq == 1 ? s[1] : fq == 2 ? s[2] : s[3]; atomicAdd(ssq_next + u.pm * 256 + wr * 64 + ai * 128 + ln, v); } }
    }
};
typedef EpiNormResT<false> EpiNormRes;
typedef EpiNormResT<true> EpiNormResMid;

#define XB_TMO      128
#define XB_XCNT(j)  (256  + 64 * (j))
#define XB_XSUB(j)  (1280 + 64 * (j))
#define XB_XGEN(j)  (2304 + 64 * (j))
#define XB_TOP      3328
#define XB_TOPGEN   3392
#define XCD_BAR_WORDS 3456
#define XB_SPIN_CAP (1u << 20)
__device__ __forceinline__ unsigned xb_ld(unsigned* p)              { return __hip_atomic_load(p, __ATOMIC_RELAXED, __HIP_MEMORY_SCOPE_AGENT); }
__device__ __forceinline__ unsigned xb_add(unsigned* p, unsigned v) { return __hip_atomic_fetch_add(p, v, __ATOMIC_RELAXED, __HIP_MEMORY_SCOPE_AGENT); }
__device__ __forceinline__ unsigned xb_xcc_id() { return (unsigned)__builtin_amdgcn_s_getreg((3 << 11) | 20) & 0xFu; }
#define XB_SPIN(cond, bar) do { unsigned _sp = 0; while (cond) { __builtin_amdgcn_s_sleep(1); \
    if ((++_sp & 255u) == 0u) { if (xb_ld(&(bar)[XB_TMO])) break; if (_sp > XB_SPIN_CAP) { atomicAdd(&(bar)[XB_TMO], 1u); break; } } } } while (0)
struct XcdBarrier { unsigned* bar; unsigned x; volatile LAS unsigned* st; };
__device__ __forceinline__ XcdBarrier xcd_barrier_post(unsigned* bar, volatile LAS unsigned* st) {
    XcdBarrier b; b.bar = bar; b.x = xb_xcc_id(); b.st = st;
    if (threadIdx.x == 0) (void)xb_add(&bar[XB_XCNT(b.x)], 1u);
    return b;
}
__device__ __forceinline__ void xcd_barrier_complete(unsigned* bar, unsigned x, unsigned& nloc, unsigned& nx) {
    const unsigned G = gridDim.x * gridDim.y * gridDim.z;
    unsigned sum, cnt, mine, sp = 0u;
    for (;;) {
        sum = 0u; cnt = 0u; mine = 0u;
#pragma unroll
        for (unsigned j = 0; j < 16; ++j) { const unsigned c = xb_ld(&bar[XB_XCNT(j)]); sum += c; cnt += (c > 0u) ? 1u : 0u; mine = (j == x) ? c : mine; }
        if (sum == G) break;
        __builtin_amdgcn_s_sleep(1);
        if ((++sp & 255u) == 0u) { if (xb_ld(&bar[XB_TMO])) break; if (sp > XB_SPIN_CAP) { atomicAdd(&bar[XB_TMO], 1u); break; } }
    }
    nloc = mine > 0u ? mine : 1u; nx = cnt > 0u ? cnt : 1u;
}
__device__ __forceinline__ void xcd_barrier(const XcdBarrier& b, const int wv) {
    asm volatile("s_waitcnt vmcnt(0)" ::: "memory");
    __syncthreads();
    if (wv == 0 && lane_id() == 0) {
        unsigned* bar = b.bar;
        __builtin_amdgcn_s_waitcnt(0);
        unsigned nloc = b.st[0], nx = b.st[1];
        if (nloc == 0u) { xcd_barrier_complete(bar, b.x, nloc, nx); b.st[0] = nloc; b.st[1] = nx; }
        const unsigned old = xb_add(&bar[XB_XSUB(b.x)], 1u);
        const unsigned gen = old / nloc;
        if (old + 1u == (gen + 1u) * nloc) {
            __builtin_amdgcn_fence(__ATOMIC_RELEASE, "agent");
            asm volatile("s_waitcnt vmcnt(0)" ::: "memory");
            const unsigned og = xb_add(&bar[XB_TOP], 1u);
            const unsigned tg = og / nx;
            if (og + 1u == (tg + 1u) * nx) xb_add(&bar[XB_TOPGEN], 1u);
            else XB_SPIN(xb_ld(&bar[XB_TOPGEN]) == tg, bar);
            __builtin_amdgcn_fence(__ATOMIC_ACQUIRE, "agent");
            xb_add(&bar[XB_XGEN(b.x)], 1u);
            asm volatile("s_waitcnt vmcnt(0)" ::: "memory");
        } else {
            XB_SPIN(xb_ld(&bar[XB_XGEN(b.x)]) == gen, bar);
            __builtin_amdgcn_fence(__ATOMIC_ACQUIRE, "agent");
            asm volatile("s_waitcnt vmcnt(0)" ::: "memory");
        }
    }
    __syncthreads();
}

enum { MAP_ID = 0, MAP_WIN = 1, MAP_WUQ = 2, MAP_WUKV = 3, MAP_GATE = 4, MAP_UP = 5 };
__device__ __forceinline__ int map_n(int mode, int n) {
    switch (mode) {
    case MAP_WIN: { if (n < OFF_KPE) return n; const int j = n - OFF_KPE; return OFF_KPE + (j < 32 ? 2 * j : 2 * (j - 32) + 1); }
    case MAP_WUQ: { const int h = n / 192, d = n % 192; if (d < 128) return h * 128 + d; const int j = d - 128; return 512 + h * 64 + (j < 32 ? 2 * j : 2 * (j - 32) + 1); }
    case MAP_WUKV: { const int h = n / 256, d = n % 256; return d < 128 ? h * 128 + d : 512 + h * 128 + (d - 128); }
    case MAP_GATE: return (n >> 7) * 256 + (n & 127);
    case MAP_UP: return (n >> 7) * 256 + 128 + (n & 127);
    default: return n;
    }
}
__device__ __forceinline__ void p0_transpose_item(const float* W, int K, int N, bf16_t* WT, int row_off, int mode, const float* kscale, const float* kscale2, LAS float* scr, int item, int lane) {
    const int nblk = N / 64, kb = item / nblk, nb = item % nblk, k0 = 64 * kb, n0 = 64 * nb;
    float v[64];
#pragma unroll
    for (int i = 0; i < 64; ++i) v[i] = W[(size_t)(k0 + i) * N + n0 + lane];
    if (kscale) { const float* ks = (kscale2 && k0 >= 512) ? kscale2 - 512 : kscale;
#pragma unroll
        for (int i = 0; i < 64; ++i) v[i] *= ks[k0 + i]; }
#pragma unroll
    for (int i = 0; i < 64; ++i) scr[i * 65 + lane] = v[i];
    LDS_WAIT(); asm volatile("" ::: "memory");
    const int c = lane & 7;
#pragma unroll
    for (int j = 0; j < 8; ++j) { const int n = (lane >> 3) + 8 * j; const LAS float* sp = scr + (8 * c) * 65 + n;
        u32x4 o; o.x = cvt_pk_bf16(sp[0 * 65], sp[1 * 65]); o.y = cvt_pk_bf16(sp[2 * 65], sp[3 * 65]); o.z = cvt_pk_bf16(sp[4 * 65], sp[5 * 65]); o.w = cvt_pk_bf16(sp[6 * 65], sp[7 * 65]);
        *(u32x4*)(WT + (size_t)(row_off + map_n(mode, n0 + n)) * K + k0 + 8 * c) = o; }
    LDS_WAIT(); asm volatile("" ::: "memory");
}
template <int R, bool NORM>
__device__ __forceinline__ void rms_rows_to_bf16(const float* xrow, const float* g, bf16_t* orow, float* ssq_out, int lane) {
    f32x4 v[R][4]; float s[R];
#pragma unroll
    for (int r = 0; r < R; ++r)
#pragma unroll
        for (int j = 0; j < 4; ++j) v[r][j] = ((const f32x4*)(xrow + (size_t)r * DM) + lane)[64 * j];
    f32x4 gg[4];
#pragma unroll
    for (int j = 0; j < 4; ++j) gg[j] = ((const f32x4*)g + lane)[64 * j];
#pragma unroll
    for (int r = 0; r < R; ++r) { float q = 0.f;
#pragma unroll
        for (int j = 0; j < 4; ++j) q += (v[r][j].x * v[r][j].x + v[r][j].y * v[r][j].y) + (v[r][j].z * v[r][j].z + v[r][j].w * v[r][j].w);
        s[r] = q; }
#pragma unroll
    for (int o = 1; o < 64; o <<= 1)
#pragma unroll
        for (int r = 0; r < R; ++r) s[r] += __shfl_xor(s[r], o);
#pragma unroll
    for (int r = 0; r < R; ++r) { const float rs = NORM ? __builtin_amdgcn_rsqf(s[r] * (1.f / DM) + EPS) : 1.f; u32x2* o8 = (u32x2*)(orow + (size_t)r * DM) + lane;
        if (!NORM) { if (lane == 0) ssq_out[r] = s[r];
#pragma unroll
            for (int j = 0; j < 4; ++j) gg[j] = (f32x4){1.f, 1.f, 1.f, 1.f}; }
#pragma unroll
        for (int j = 0; j < 4; ++j) { u32x2 w; w.x = cvt_pk_bf16(v[r][j].x * rs * gg[j].x, v[r][j].y * rs * gg[j].y); w.y = cvt_pk_bf16(v[r][j].z * rs * gg[j].z, v[r][j].w * rs * gg[j].w); o8[64 * j] = w; } }
}
__device__ __forceinline__ void resid_row(const float* pre, const float* hold, const float* gpost, float* hout, const float* gnext, bf16_t* xn, int lane) {
    const f32x4* pr = (const f32x4*)pre + lane; const f32x4* hr = (const f32x4*)hold + lane; const f32x4* gp = (const f32x4*)gpost + lane;
    f32x4 v[4]; float s = 0.f;
#pragma unroll
    for (int j = 0; j < 4; ++j) { v[j] = pr[64 * j]; s += (v[j].x * v[j].x + v[j].y * v[j].y) + (v[j].z * v[j].z + v[j].w * v[j].w); }
    const float rs = __builtin_amdgcn_rsqf(wave_sum(s) * (1.f / DM) + EPS);
    float s2 = 0.f;
#pragma unroll
    for (int j = 0; j < 4; ++j) { const f32x4 h = hr[64 * j], g = gp[64 * j]; v[j] = h + v[j] * rs * g; s2 += (v[j].x * v[j].x + v[j].y * v[j].y) + (v[j].z * v[j].z + v[j].w * v[j].w); }
    f32x4* ho = (f32x4*)hout + lane;
#pragma unroll
    for (int j = 0; j < 4; ++j) ho[64 * j] = v[j];
    if (xn) { const float rs2 = __builtin_amdgcn_rsqf(wave_sum(s2) * (1.f / DM) + EPS); const f32x4* gn = (const f32x4*)gnext + lane; u32x2* o8 = (u32x2*)xn + lane;
#pragma unroll
        for (int j = 0; j < 4; ++j) { const f32x4 gg = gn[64 * j]; u32x2 w; w.x = cvt_pk_bf16(v[j].x * rs2 * gg.x, v[j].y * rs2 * gg.y); w.y = cvt_pk_bf16(v[j].z * rs2 * gg.z, v[j].w * rs2 * gg.w); o8[64 * j] = w; } }
}

namespace lru {
constexpr int TT = 128, NTILE = SEQ / TT, UP = 72;
constexpr int L_U = 0, L_UF = L_U + TT * UP * 2, L_WSEG = L_UF + TT * 33 * 4, L_CARRY = L_WSEG + 2 * 8 * 32 * 8, L_TSS = L_CARRY + 2 * 32 * 4, L_END = L_TSS + 2 * TT * 4;
static_assert(L_END <= RING_BYTES, "lru lds");
__device__ __forceinline__ float sigmoidf_(float x) { return __builtin_amdgcn_rcpf(1.f + __builtin_amdgcn_exp2f(-x * LOG2E)); }
__device__ __forceinline__ void unit(int b, int cb, const bf16_t* Z, bf16_t* Y, float* ssq_lru, const float* conv_w, const float* conv_b, const float* wa, const float* ba, const float* wx, const float* bx,
                                     const float* lam, LAS unsigned char* lds, const int wv) {
    const int lane = lane_id(), wid = wv, tid = wv * 64 + lane;
    const int hblk = cb >> 1, half = cb & 1, ib = hblk * 64, c0 = cb * 32;
    LAS bf16_t* U = (LAS bf16_t*)(lds + L_U); LAS float* UF = (LAS float*)(lds + L_UF); LAS f32x2* WSEG = (LAS f32x2*)(lds + L_WSEG);
    LAS float* CARRY = (LAS float*)(lds + L_CARRY); LAS float* TSS = (LAS float*)(lds + L_TSS);
    const int col = lane & 15, kq = lane >> 4;
    bf16x8 Bf[4][2];
#pragma unroll
    for (int nb = 0; nb < 4; ++nb)
#pragma unroll
        for (int ks = 0; ks < 2; ++ks) { const float* Wg = (nb < 2) ? wa : wx; const int oc = half * 32 + (nb & 1) * 16 + col; float w[8];
#pragma unroll
            for (int j = 0; j < 8; ++j) w[j] = Wg[((size_t)hblk * 64 + ks * 32 + 8 * kq + j) * 64 + oc];
            u32x4 p; p.x = cvt_pk_bf16(w[0], w[1]); p.y = cvt_pk_bf16(w[2], w[3]); p.z = cvt_pk_bf16(w[4], w[5]); p.w = cvt_pk_bf16(w[6], w[7]); Bf[nb][ks] = __builtin_bit_cast(bf16x8, p); }
    float cba[2], cbx[2], csp[2];
#pragma unroll
    for (int e = 0; e < 2; ++e) { const int ch = c0 + e * 16 + col; cba[e] = ba[ch]; cbx[e] = bx[ch]; const float l = lam[ch];
        csp[e] = 8.f * LOG2E * (fmaxf(-l, 0.f) + log1pf(expf(-fabsf(l)))); }
    const int cch = lane;
    const float cw0 = conv_w[0 * DLRU + ib + cch], cw1 = conv_w[1 * DLRU + ib + cch], cw2 = conv_w[2 * DLRU + ib + cch], cw3 = conv_w[3 * DLRU + ib + cch], cbb = conv_b[ib + cch];
    if (tid < 64) CARRY[tid] = 0.f;
    if (tid < 2 * TT) TSS[tid] = 0.f;
    const size_t rowb = (size_t)b * SEQ;
    const bf16_t* zx = Z + (rowb + wid * 16) * DINP + ib + cch;
    const bf16_t* zg = Z + (rowb + wid * 16 + kq * 4) * DINP + OFF_GATE + c0 + col;
    bf16_t* yp = Y + (rowb + wid * 16 + kq * 4) * DM + c0 + col;
    unsigned short xr[19], gr[8];
#define LRU_LOADX(t0_) do { _Pragma("unroll") for (int k = 0; k < 19; ++k) { const int tk = (t0_) + wid * 16 + k - 3; xr[k] = (tk >= 0) ? zx[(ptrdiff_t)((t0_) + k - 3) * DINP] : (unsigned short)0; } } while (0)
    LRU_LOADX(0);
    __syncthreads();
    for (int tile = 0; tile < NTILE; ++tile) {
        const int t0 = tile * TT, par = tile & 1;
        { float xm3 = bf2f(xr[0]), xm2 = bf2f(xr[1]), xm1 = bf2f(xr[2]);
#pragma unroll
          for (int k = 0; k < 16; ++k) { const float x0 = bf2f(xr[3 + k]); const float u = cbb + cw0 * xm3 + cw1 * xm2 + cw2 * xm1 + cw3 * x0; xm3 = xm2; xm2 = xm1; xm1 = x0;
              const int tl = wid * 16 + k; U[tl * UP + cch] = (bf16_t)(cvt_pk_bf16(u, 0.f) & 0xffffu);
              if ((cch >> 5) == half) UF[tl * 33 + (cch & 31)] = u; } }
#pragma unroll
        for (int e = 0; e < 2; ++e)
#pragma unroll
            for (int r = 0; r < 4; ++r) gr[e * 4 + r] = zg[(size_t)(t0 + r) * DINP + e * 16];
        if (tile + 1 < NTILE) LRU_LOADX(t0 + TT);
        LDS_WAIT();
        float av[2][4], uv[2][4], Ainc[2], Hinc[2];
        { f32x4 C[4];
#pragma unroll
          for (int nb = 0; nb < 4; ++nb) C[nb] = (f32x4){0.f, 0.f, 0.f, 0.f};
          const LAS bf16_t* ua = U + (wid * 16 + col) * UP + 8 * kq;
          const bf16x8 a0 = *(const LAS bf16x8*)ua, a1 = *(const LAS bf16x8*)(ua + 32);
#pragma unroll
          for (int nb = 0; nb < 4; ++nb) { C[nb] = __builtin_amdgcn_mfma_f32_16x16x32_bf16(a0, Bf[nb][0], C[nb], 0, 0, 0); C[nb] = __builtin_amdgcn_mfma_f32_16x16x32_bf16(a1, Bf[nb][1], C[nb], 0, 0, 0); }
#pragma unroll
          for (int e = 0; e < 2; ++e) { float Ap = 1.f, H = 0.f;
#pragma unroll
              for (int r = 0; r < 4; ++r) { const int tl = wid * 16 + kq * 4 + r, ch = e * 16 + col;
                  const float rg = sigmoidf_(C[e][r] + cba[e]), ig = sigmoidf_(C[e + 2][r] + cbx[e]);
                  const float a = __builtin_amdgcn_exp2f(-rg * csp[e]); const float mult = __builtin_amdgcn_sqrtf(fmaxf(1.f - a * a, 0.f));
                  const float uu = mult * ig * UF[tl * 33 + ch];
                  av[e][r] = a; uv[e][r] = uu; H = a * H + uu; Ap *= a; }
              { const float Ap1 = __shfl_up(Ap, 16), H1 = __shfl_up(H, 16); if (kq >= 1) { H = Ap * H1 + H; Ap = Ap * Ap1; } }
              { const float Ap2 = __shfl_up(Ap, 32), H2 = __shfl_up(H, 32); if (kq >= 2) { H = Ap * H2 + H; Ap = Ap * Ap2; } }
              Ainc[e] = Ap; Hinc[e] = H;
              if (kq == 3) WSEG[(par * 8 + wid) * 32 + e * 16 + col] = (f32x2){Ap, H}; } }
        __syncthreads();
        if (tid < TT) { const float v = TSS[(par ^ 1) * TT + tid]; if (tile > 0) atomicAdd(ssq_lru + rowb + t0 - TT + tid, v); }
        float qs[4] = {0.f, 0.f, 0.f, 0.f};
#pragma unroll
        for (int e = 0; e < 2; ++e) { const int ch = e * 16 + col;
            float h = CARRY[par * 32 + ch];
            for (int w2 = 0; w2 < wid; ++w2) { const f32x2 sg = WSEG[(par * 8 + w2) * 32 + ch]; h = sg.x * h + sg.y; }
            if (wid == 7 && kq == 0) { const f32x2 sg = WSEG[(par * 8 + 7) * 32 + ch]; CARRY[(par ^ 1) * 32 + ch] = sg.x * h + sg.y; }
            const float Ae = __shfl_up(Ainc[e], 16), He = __shfl_up(Hinc[e], 16);
            if (kq >= 1) h = Ae * h + He;
#pragma unroll
            for (int r = 0; r < 4; ++r) { h = av[e][r] * h + uv[e][r]; const float g = bf2f(gr[e * 4 + r]);
                const float ge = g * __builtin_amdgcn_rcpf(1.f + __builtin_amdgcn_exp2f(-1.5957691216057308f * LOG2E * (g + 0.044715f * g * g * g)));
                const float y = h * ge; yp[(size_t)(t0 + r) * DM + e * 16] = (bf16_t)(cvt_pk_bf16(y, 0.f) & 0xffffu); qs[r] += y * y; } }
#pragma unroll
        for (int r = 0; r < 4; ++r) { float q = qs[r]; q += __shfl_xor(q, 1); q += __shfl_xor(q, 2); q += __shfl_xor(q, 4); q += __shfl_xor(q, 8);
            if (col == 0) TSS[par * TT + wid * 16 + kq * 4 + r] = q; }
    }
    __syncthreads();
    if (tid < TT) atomicAdd(ssq_lru + rowb + (NTILE - 1) * TT + tid, TSS[((NTILE - 1) & 1) * TT + tid]);
    __syncthreads();
#undef LRU_LOADX
}
}

namespace mla {
constexpr int NW = 8, QBLK = 32, KVBLK = 64, QB = 256, KROW = 384, SHM_K = KVBLK * KROW, SHM_V = KVBLK * 128 * 2;
constexpr int L_V = 0, L_K = 2 * SHM_V, L_WS = L_K + 2 * SHM_K, L_END = L_WS + NW * 64 * 4;
static_assert(L_END <= RING_BYTES && NW * 8192 <= L_WS, "mla lds");
#define KSWZ(row, colB) ((row) * KROW + ((colB) ^ ((((row) >> 1) & 7) << 4)))
#define SBAR() __builtin_amdgcn_sched_barrier(0)
__device__ __forceinline__ int v_st(int k, int c) { const int kk = (k & ~0xC) | ((k & 4) << 1) | ((k & 8) >> 1); return ((kk >> 3) * 4 + (c >> 5)) * 512 + ((kk & 7) * 32 + (c & 31)) * 2; }
__device__ __forceinline__ int v_rd_base(int lane) { return ((lane & 3) << 3) | (((lane >> 2) & 3) << 6) | (((lane >> 4) & 1) << 5) | (((lane >> 5) & 1) << 8); }
constexpr int v_rd_off(int d0, int ks, int half) { return d0 * 512 + ks * 4096 + half * 2048; }
__device__ __forceinline__ int crow(int r, int hi) { return (r & 3) + 8 * (r >> 2) + 4 * hi; }
__device__ __forceinline__ void mask_tile(f32x16& p0, f32x16& p1, int dq) {
    const float NEG = -__builtin_inff();
#pragma unroll
    for (int r = 0; r < 16; ++r) { const int c = (r & 3) + 8 * (r >> 2); if (dq - c < 0) p0[r] = NEG; if (dq - c - 32 < 0) p1[r] = NEG; }
}
constexpr float THR2 = 8.f * LOG2E;
__device__ __forceinline__ void partialSM(f32x16& p0, f32x16& p1, float& m_reg, float& alpha) {
    float pmax = p0[0];
#pragma unroll
    for (int r = 1; r < 16; ++r) pmax = fmaxf(pmax, p0[r]);
#pragma unroll
    for (int r = 0; r < 16; ++r) pmax = fmaxf(pmax, p1[r]);
    { auto rr = __builtin_amdgcn_permlane32_swap(__float_as_uint(pmax), __float_as_uint(pmax), false, false); pmax = fmaxf(__uint_as_float(rr[0]), __uint_as_float(rr[1])); }
    float mn;
    if (__builtin_expect(__all((pmax - m_reg) <= THR2), 1)) { mn = m_reg; alpha = 1.f; }
    else { mn = fmaxf(m_reg, pmax); alpha = __builtin_amdgcn_exp2f(m_reg - mn); m_reg = mn; }
#pragma unroll
    for (int r = 0; r < 16; ++r) p0[r] = p0[r] - mn;
#pragma unroll
    for (int r = 0; r < 16; ++r) p1[r] = p1[r] - mn;
#pragma unroll
    for (int r = 0; r < 16; ++r) p0[r] = __builtin_amdgcn_exp2f(p0[r]);
}
__device__ __forceinline__ void finishSM(f32x16& p0, f32x16& p1, float alpha, float& l_reg, bf16x8& pa0, bf16x8& pa1, bf16x8& pa2, bf16x8& pa3) {
#pragma unroll
    for (int r = 0; r < 16; ++r) p1[r] = __builtin_amdgcn_exp2f(p1[r]);
    float ps = 0;
#pragma unroll
    for (int r = 0; r < 16; ++r) ps += p0[r];
#pragma unroll
    for (int r = 0; r < 16; ++r) ps += p1[r];
    { auto rr = __builtin_amdgcn_permlane32_swap(__float_as_uint(ps), __float_as_uint(ps), false, false); ps = __uint_as_float(rr[0]) + __uint_as_float(rr[1]); }
    l_reg = l_reg * alpha + ps;
#define PK4(P, B_, OUT) do { unsigned a0 = cvt_pk_bf16(P[B_+0], P[B_+1]), a1 = cvt_pk_bf16(P[B_+2], P[B_+3]);                          \
        unsigned b0 = cvt_pk_bf16(P[B_+4], P[B_+5]), b1 = cvt_pk_bf16(P[B_+6], P[B_+7]);                                             \
        auto r0 = __builtin_amdgcn_permlane32_swap(a0, b0, false, false); auto r1 = __builtin_amdgcn_permlane32_swap(a1, b1, false, false); \
        u32x4 w = {r0[0], r1[0], r0[1], r1[1]}; OUT = __builtin_bit_cast(bf16x8, w); } while (0)
    PK4(p0, 0, pa0); PK4(p0, 8, pa1); PK4(p1, 0, pa2); PK4(p1, 8, pa3);
#undef PK4
}
template <int KB>
__device__ __forceinline__ void qkt(f32x16& p0, f32x16& p1, const char* K_lds, int r32, int hi, const bf16x8* qr) {
    p0 = f32x16{}; p1 = f32x16{};
    const char* kb[4];
#pragma unroll
    for (int dd = 0; dd < 4; ++dd) kb[dd] = K_lds + KB * SHM_K + KSWZ(r32, (dd * 16 + hi * 8) * 2);
#pragma unroll
    for (int d0 = 0; d0 < 12; ++d0) { const char* a = kb[d0 & 3] + (d0 >> 2) * 128;
        bf16x8 b0 = *reinterpret_cast<const bf16x8*>(a);
        bf16x8 b1 = *reinterpret_cast<const bf16x8*>(a + 32 * KROW);
        p0 = __builtin_amdgcn_mfma_f32_32x32x16_bf16(b0, qr[d0], p0, 0, 0, 0);
        p1 = __builtin_amdgcn_mfma_f32_32x32x16_bf16(b1, qr[d0], p1, 0, 0, 0); }
}
template <int VB>
__device__ __forceinline__ void pv_tile(f32x16* o, int vb0, bf16x8 pa0, bf16x8 pa1, bf16x8 pa2, bf16x8 pa3) {
#define TRRD(dst, off) asm volatile("ds_read_b64_tr_b16 %0, %1 offset:%2" : "=&v"(dst) : "v"(vb0), "i"(off) : "memory")
#define PV_D0(d0) do { s16x4 l0, l1, l2, l3, h0, h1, h2, h3; constexpr int b_ = VB * SHM_V + v_rd_off(d0, 0, 0); \
        TRRD(l0, b_); TRRD(h0, b_ + 2048); TRRD(l1, b_ + 4096); TRRD(h1, b_ + 6144); TRRD(l2, b_ + 8192); TRRD(h2, b_ + 10240); TRRD(l3, b_ + 12288); TRRD(h3, b_ + 14336); \
        asm volatile("s_waitcnt lgkmcnt(0)" ::: "memory"); SBAR(); \
        o[d0] = __builtin_amdgcn_mfma_f32_32x32x16_bf16(pa0, (bf16x8){l0[0], l0[1], l0[2], l0[3], h0[0], h0[1], h0[2], h0[3]}, o[d0], 0, 0, 0);   \
        o[d0] = __builtin_amdgcn_mfma_f32_32x32x16_bf16(pa1, (bf16x8){l1[0], l1[1], l1[2], l1[3], h1[0], h1[1], h1[2], h1[3]}, o[d0], 0, 0, 0);   \
        o[d0] = __builtin_amdgcn_mfma_f32_32x32x16_bf16(pa2, (bf16x8){l2[0], l2[1], l2[2], l2[3], h2[0], h2[1], h2[2], h2[3]}, o[d0], 0, 0, 0);   \
        o[d0] = __builtin_amdgcn_mfma_f32_32x32x16_bf16(pa3, (bf16x8){l3[0], l3[1], l3[2], l3[3], h3[0], h3[1], h3[2], h3[3]}, o[d0], 0, 0, 0); } while (0)
    PV_D0(0); PV_D0(1); PV_D0(2); PV_D0(3);
#undef PV_D0
#undef TRRD
}
__device__ __forceinline__ void block(int b, int h, int qb, const bf16_t* Qb, const bf16_t* KVb, const bf16_t* KPE, bf16_t* Y, float* ssq_mla, char* lds, const int wv) {
    const int lane = lane_id(), wid = wv, tid = wv * 64 + lane, r32 = lane & 31, hi = lane >> 5;
    const size_t rowbase = (size_t)b * SEQ; const int q0 = qb * QB; const int NT = (q0 + QB) / KVBLK;
    const int qlo = q0 + wid * QBLK, qm = qlo + r32 - 4 * hi;
    char* V_lds = lds + L_V; char* K_lds = lds + L_K;
    float* ws = (float*)(lds + L_WS) + wid * 64; float* li_l = ws, * al_l = ws + 32;
    float m_reg = -1e30f, l_reg = 0; f32x16 o[4] = {};
    const int sr = tid >> 4, scc = (tid & 15) * 8, vst0 = v_st(sr, scc), vst1 = v_st(32 + sr, scc), kws = KSWZ(sr, (tid & 15) * 16);
    const int pr = tid >> 3, kws2 = KSWZ(pr, 256 + (tid & 7) * 16);
    const int vb0 = (int)(uintptr_t)V_lds + v_rd_base(lane);
    const bf16_t* Kn = KVb + rowbase * 1024 + h * 128 + scc;
    const bf16_t* Vn = KVb + rowbase * 1024 + 512 + h * 128 + scc;
    const bf16_t* Kp = KPE + rowbase * 64 + (tid & 7) * 8;
    bf16x8 qr[12];
    { const bf16_t* qp = Qb + (rowbase + q0 + wid * QBLK + r32) * 768;
#pragma unroll
      for (int d0 = 0; d0 < 8; ++d0) qr[d0] = *(const bf16x8*)(qp + h * 128 + d0 * 16 + hi * 8);
#pragma unroll
      for (int d0 = 0; d0 < 4; ++d0) qr[8 + d0] = *(const bf16x8*)(qp + 512 + h * 64 + d0 * 16 + hi * 8); }
    const int grp = wid >> 2;
    bf16x8 st_v0, st_v1, st_k0, st_k1, st_k2;
#define SLOADK(t) do { const size_t k0_ = (size_t)(t) * KVBLK; st_k0 = *(const bf16x8*)(Kn + (k0_ + sr) * 1024); st_k1 = *(const bf16x8*)(Kn + (k0_ + 32 + sr) * 1024); st_k2 = *(const bf16x8*)(Kp + (k0_ + pr) * 64); } while (0)
#define SLOADV(t) do { const size_t k0_ = (size_t)(t) * KVBLK; st_v0 = *(const bf16x8*)(Vn + (k0_ + sr) * 1024); st_v1 = *(const bf16x8*)(Vn + (k0_ + 32 + sr) * 1024); } while (0)
#define SWRITEK(off) do { *(bf16x8*)(K_lds + (off) + kws) = st_k0; *(bf16x8*)(K_lds + (off) + kws + 32 * KROW) = st_k1; *(bf16x8*)(K_lds + (off) + kws2) = st_k2; } while (0)
#define SWRITEV(off) do { *(bf16x8*)(V_lds + (off) + vst0) = st_v0; *(bf16x8*)(V_lds + (off) + vst1) = st_v1; } while (0)
#define BAR() asm volatile("s_waitcnt lgkmcnt(0)\n\ts_barrier" ::: "memory")
#define RESC(a) do { if (__any((a) < 1.f)) { if (hi == 0) al_l[r32] = (a); asm volatile("s_waitcnt lgkmcnt(0)" ::: "memory");              \
                     for (int d_ = 0; d_ < 4; ++d_) for (int r = 0; r < 16; ++r) o[d_][r] *= al_l[crow(r, hi)]; } } while (0)
#define MASKT(P0_, P1_, t) do { const int kb_ = (t) * KVBLK; if (kb_ + KVBLK - 1 > qlo) mask_tile(P0_, P1_, qm - kb_); } while (0)
    f32x16 p0, p1; float al; bf16x8 pa0, pa1, pa2, pa3;
    SLOADK(0); VM_WAIT(); SWRITEK(0);
    if (grp) { SLOADK(1); SLOADV(0); }
    BAR();
    if (grp) { VM_WAIT(); SWRITEK(SHM_K); SWRITEV(0); BAR(); }
#define SMSLOT(t, tk, tv) do { if ((tk) < NT || (tv) < NT) { VM_WAIT(); if ((tk) < NT) SWRITEK(((tk) & 1) * SHM_K); if ((tv) < NT) SWRITEV(((tv) & 1) * SHM_V); } \
        MASKT(p0, p1, (t)); partialSM(p0, p1, m_reg, al); RESC(al); finishSM(p0, p1, al, l_reg, pa0, pa1, pa2, pa3); SBAR(); } while (0)
    { const int tk = 1 + grp, tv = grp;
      SLOADK(tk); SLOADV(tv); SBAR(); qkt<0>(p0, p1, K_lds, r32, hi, qr); SBAR();
      BAR(); SMSLOT(0, tk, tv); BAR(); }
    for (int i = 0; i < NT; i += 2) {
        { const int tk = i + 2 + grp, tv = i + 1 + grp;
          if (tk < NT) SLOADK(tk); if (tv < NT) SLOADV(tv); SBAR();
          qkt<1>(p0, p1, K_lds, r32, hi, qr); SBAR(); pv_tile<0>(o, vb0, pa0, pa1, pa2, pa3); SBAR();
          BAR(); SMSLOT(i + 1, tk, tv); BAR(); }
        { const int tk = i + 3 + grp, tv = i + 2 + grp;
          if (tk < NT) SLOADK(tk); if (tv < NT) SLOADV(tv); SBAR();
          if (i + 2 < NT) { qkt<0>(p0, p1, K_lds, r32, hi, qr); SBAR(); }
          pv_tile<1>(o, vb0, pa0, pa1, pa2, pa3); SBAR();
          BAR(); if (i + 2 < NT) SMSLOT(i + 2, tk, tv); BAR(); }
    }
    if (!grp) BAR();
#undef SMSLOT
#undef SLOADK
#undef SLOADV
#undef SWRITEK
#undef SWRITEV
#undef BAR
    if (hi == 0) li_l[r32] = l_reg; asm volatile("s_waitcnt lgkmcnt(0)" ::: "memory");
    float rli[16];
#pragma unroll
    for (int r = 0; r < 16; ++r) rli[r] = __builtin_amdgcn_rcpf(li_l[crow(r, hi)]);
    { bf16_t* stg = (bf16_t*)lds + wid * 4096;
#pragma unroll
      for (int r = 0; r < 16; ++r) { const int orow = crow(r, hi);
#pragma unroll
          for (int d0 = 0; d0 < 4; ++d0) stg[orow * 128 + d0 * 32 + r32] = (bf16_t)(cvt_pk_bf16(o[d0][r] * rli[r], 0.f) & 0xffffu); }
      asm volatile("s_waitcnt lgkmcnt(0)" ::: "memory");
      const int row = lane >> 1, hf = lane & 1; float q = 0.f;
      bf16_t* yp = Y + (rowbase + q0 + wid * QBLK + row) * DM + 512 + h * 128 + hf * 64;
#pragma unroll
      for (int j = 0; j < 8; ++j) { const u32x4 v = *(const u32x4*)(stg + row * 128 + hf * 64 + j * 8);
          q += bflo(v.x) * bflo(v.x) + bfhi(v.x) * bfhi(v.x) + bflo(v.y) * bflo(v.y) + bfhi(v.y) * bfhi(v.y) + bflo(v.z) * bflo(v.z) + bfhi(v.z) * bfhi(v.z) + bflo(v.w) * bflo(v.w) + bfhi(v.w) * bfhi(v.w);
          *(u32x4*)(yp + j * 8) = v; }
      q += __shfl_xor(q, 1);
      if (hf == 0) atomicAdd(ssq_mla + rowbase + q0 + wid * QBLK + row, q); }
    __syncthreads();
#undef RESC
#undef MASKT
}
#undef KSWZ
#undef SBAR
}

constexpr int NWAVES = 8, NPHASE = 13;
struct Args { const void* in[32]; float* out; unsigned char* ws; int ph_lo, ph_hi; };

__global__ void __launch_bounds__(NWAVES * 64, 2) hymba_fwd(Args args) {
    extern __shared__ __attribute__((aligned(16))) unsigned char lds_raw[];
    LAS unsigned char* lds = (LAS unsigned char*)lds_raw;
    volatile LAS unsigned* MISC = (volatile LAS unsigned*)(lds + MISC_OFF);
    const int G = gridDim.x, bx = blockIdx.x, vcu = (G % 8 == 0) ? (bx % 8) * (G / 8) + bx / 8 : bx;
    const int wave_s = __builtin_amdgcn_readfirstlane((int)threadIdx.x >> 6);
#define lane (lane_id())
#define tid (wave_s * 64 + lane)
#define wave (wave_s)
#define gw (vcu * NWAVES + wave)
#define NGW (G * NWAVES)
    unsigned char* ws = args.ws;
#define x_in ((const float*)args.in[0])
#define mem ((const float*)args.in[1])
#define positions ((const int*)args.in[2])
#define g_pre_mix ((const float*)args.in[3])
#define w_in ((const float*)args.in[4])
#define conv_w ((const float*)args.in[5])
#define conv_b ((const float*)args.in[6])
#define lru_wa ((const float*)args.in[7])
#define lru_ba ((const float*)args.in[8])
#define lru_wx ((const float*)args.in[9])
#define lru_bx ((const float*)args.in[10])
#define lru_lambda ((const float*)args.in[11])
#define g_q_lat ((const float*)args.in[12])
#define w_uq ((const float*)args.in[13])
#define g_kv_lat ((const float*)args.in[14])
#define w_ukv ((const float*)args.in[15])
#define g_lru_out ((const float*)args.in[16])
#define g_mla_out ((const float*)args.in[17])
#define w_out ((const float*)args.in[18])
#define g_post_mix ((const float*)args.in[19])
#define g_pre_mem ((const float*)args.in[20])
#define g_mem_kv ((const float*)args.in[21])
#define w_mq ((const float*)args.in[22])
#define w_mk ((const float*)args.in[23])
#define w_mv ((const float*)args.in[24])
#define w_mo ((const float*)args.in[25])
#define g_post_mem ((const float*)args.in[26])
#define g_pre_ffn ((const float*)args.in[27])
#define w_gate ((const float*)args.in[28])
#define w_up ((const float*)args.in[29])
#define w_down ((const float*)args.in[30])
#define g_post_ffn ((const float*)args.in[31])
#define out_p (args.out)
#define ctl ((unsigned*)(ws + WS_CTL))
#define ssq_cq ((float*)(ws + WS_SSQ))
#define ssq_ckv (ssq_cq + T)
#define ssq_lru (ssq_cq + 2 * T)
#define ssq_mla (ssq_cq + 3 * T)
#define ssq_h1 (ssq_cq + 4 * T)
#define ssq_h2 (ssq_cq + 5 * T)
#define ssq_x (ssq_cq + 6 * T)
#define ssq_dummy (ssq_cq + 7 * T)
#define slots_p ((float*)(ws + WS_SLOTS))
#define cosT ((float*)(ws + WS_ROPE))
#define sinT (cosT + (size_t)T * 32)
#define Win_t ((bf16_t*)(ws + WS_WIN))
#define Wuq_t ((bf16_t*)(ws + WS_WUQ))
#define Wukv_t ((bf16_t*)(ws + WS_WUKV))
#define Wout_t ((bf16_t*)(ws + WS_WOUT))
#define Wmq_b ((bf16_t*)(ws + WS_WMQ))
#define Wmkv_t ((bf16_t*)(ws + WS_WMKV))
#define Wmo_t ((bf16_t*)(ws + WS_WMO))
#define Wgu_t ((bf16_t*)(ws + WS_WGU))
#define Wdown_t ((bf16_t*)(ws + WS_WDOWN))
#define MN ((bf16_t*)(ws + WS_MN))
#define MKV ((bf16_t*)(ws + WS_MKV))
#define WQK ((bf16_t*)(ws + WS_WQK))
#define WVO ((bf16_t*)(ws + WS_WVO))
#define XN ((bf16_t*)(ws + WS_XN))
#define KPE ((bf16_t*)(ws + WS_KPE))
#define Z ((bf16_t*)(ws + WS_Z))
#define Qb ((bf16_t*)(ws + WS_Q))
#define KVb ((bf16_t*)(ws + WS_KV))
#define Y ((bf16_t*)(ws + WS_Y))
#define PRE ((float*)(ws + WS_PRE))
#define Pb ((bf16_t*)(ws + WS_P))
#define Fb ((bf16_t*)(ws + WS_F))
    for (int u = tid; u < 256; u += NWAVES * 64) ((LAS unsigned*)(lds + MISC_OFF))[u] = 0u;
    __syncthreads();
    XcdBarrier bar = xcd_barrier_post(ctl + CW_BAR, MISC + 8);
    const int lo = args.ph_lo, hi = args.ph_hi;
#ifndef REP_PHASE
#define REP_PHASE -1
#endif
#define REPS(k) for (int rep = 0; rep < ((REP_PHASE) == (k) ? 2 : 1); ++rep)
#define RSQ(p) (rep ? ssq_dummy : (p))
#ifndef PHASE_MASK
#define PHASE_MASK 0x1fff
#endif
#define IN(k) (((PHASE_MASK >> (k)) & 1) && lo <= (k) && (k) < hi)
#ifndef ALIGN_P10
#define ALIGN_P10 true
#endif
#ifndef EXTRA_BAR
#define EXTRA_BAR 0
#endif
#define SEAM(k) do { if (IN(k) && IN((k) + 1)) { xcd_barrier(bar, wave_s); if ((k) == 4) for (int eb = 0; eb < EXTRA_BAR; ++eb) xcd_barrier(bar, wave_s); } } while (0)

    if (IN(0)) REPS(0) {
        LAS float* scr = (LAS float*)(lds + wave * 16640);
        constexpr int I_IN = 16 * 27, I_UQ = 6 * 12, I_UKV = 4 * 16, I_SQ = 16 * 16, I_GU = 16 * 44, I_DN = 44 * 16;
        int cum = 0;
#define P0_JOB(W, K_, N_, WT, ROFF, MODE, KS, KS2, CNT) do { for (int it = (gw + NGW - (cum % NGW)) % NGW; it < (CNT); it += NGW) p0_transpose_item(W, K_, N_, WT, ROFF, MODE, KS, KS2, scr, it, lane); cum += (CNT); } while (0)
        P0_JOB(w_in, DM, 1728, Win_t, 0, MAP_WIN, g_pre_mix, nullptr, I_IN);
        P0_JOB(w_uq, QLR, 768, Wuq_t, 0, MAP_WUQ, g_q_lat, nullptr, I_UQ);
        P0_JOB(w_ukv, KVLR, 1024, Wukv_t, 0, MAP_WUKV, g_kv_lat, nullptr, I_UKV);
        P0_JOB(w_out, DM, DM, Wout_t, 0, MAP_ID, g_lru_out, g_mla_out, I_SQ);
        P0_JOB(w_mk, DM, DM, Wmkv_t, 0, MAP_ID, nullptr, nullptr, I_SQ);
        P0_JOB(w_mv, DM, DM, Wmkv_t, 1024, MAP_ID, nullptr, nullptr, I_SQ);
        P0_JOB(w_mo, DM, DM, Wmo_t, 0, MAP_ID, nullptr, nullptr, I_SQ);
        P0_JOB(w_gate, DM, DFF, Wgu_t, 0, MAP_GATE, g_pre_ffn, nullptr, I_GU);
        P0_JOB(w_up, DM, DFF, Wgu_t, 0, MAP_UP, g_pre_ffn, nullptr, I_GU);
        P0_JOB(w_down, DFF, DM, Wdown_t, 0, MAP_ID, nullptr, nullptr, I_DN);
#undef P0_JOB
        const int gt = vcu * (NWAVES * 64) + tid, NGT = G * NWAVES * 64;
        for (int i = gt; i < 64 * 1024 / 8; i += NGT) *(u32x4*)(Win_t + (size_t)1728 * 1024 + (size_t)i * 8) = (u32x4){0u, 0u, 0u, 0u};
        for (int i = gt; i < DM * DM / 4; i += NGT) { const f32x4 v = *(const f32x4*)(w_mq + (size_t)i * 4) * g_pre_mem[i >> 8]; u32x2 w; w.x = cvt_pk_bf16(v.x, v.y); w.y = cvt_pk_bf16(v.z, v.w); *(u32x2*)(Wmq_b + (size_t)i * 4) = w; }
        for (int i = gt; i < T * 32; i += NGT) { const int row = i >> 5, k = i & 31; const double invf = exp2(-(double)k * (13.287712379549449 / 32.0));
            const double rev = (double)positions[row] * invf * 0.15915494309189535; const float fr_ = (float)(rev - rint(rev)); cosT[i] = __builtin_amdgcn_cosf(fr_); sinT[i] = __builtin_amdgcn_sinf(fr_); }
        for (int m = gw * 4; m < T; m += NGW * 4) rms_rows_to_bf16<4, false>(x_in + (size_t)m * DM, g_pre_mix, XN + (size_t)m * DM, ssq_x + m, lane);
        for (int m = gw * 2; m < TM; m += NGW * 2) rms_rows_to_bf16<2, true>(mem + (size_t)m * DM, g_mem_kv, MN + (size_t)m * DM, nullptr, lane);
    }
    SEAM(0);
    if (IN(1)) REPS(1) {
        { pg8::TileOrder S; S.init(T, DINP, G, bx, XN, DM, Win_t, DM); EpiZ E{Z, KPE, RSQ(ssq_cq), RSQ(ssq_ckv), cosT, sinT, ssq_x};
          pg8::gemm_phase<EpiZ, pg8::TileOrder>(lds, DM, DM, DM, S, E, wave_s); }
        { pg8::TileOrder S; S.init(TM, 2048, G, (bx + 128) % G, MN, DM, Wmkv_t, DM); EpiBf16 E{MKV, 2048, 1.f, nullptr, 0.f};
          pg8::gemm_phase<EpiBf16, pg8::TileOrder>(lds, DM, DM, DM, S, E, wave_s); }
    }
    SEAM(1);
    if (IN(2)) REPS(2) {
#ifndef P2SUB
#define P2SUB 31
#endif
#ifndef REP_P2SUB
#define REP_P2SUB 0
#endif
#define R2(i) for (int r2 = 0; r2 < (((REP_P2SUB) >> (i)) & 1) + 1; ++r2)
        if (P2SUB & 1) R2(0) for (int uidx = vcu; uidx < BATCH * 16; uidx += G) lru::unit(uidx >> 4, uidx & 15, Z, Y, (rep | r2) ? ssq_dummy : ssq_lru, conv_w, conv_b, lru_wa, lru_ba, lru_wx, lru_bx, lru_lambda, lds, wave_s);
        if (P2SUB & 2) R2(1) { pg8::TileOrder S; S.init(T, 768, G, bx, Z + OFF_CQ, DINP, Wuq_t, QLR); EpiQ E{Qb, ssq_cq, cosT, sinT};
          pg8::gemm_phase<EpiQ, pg8::TileOrder>(lds, DINP, QLR, QLR, S, E, wave_s); }
        if (P2SUB & 4) R2(2) { pg8::TileOrder S; S.init(T, 1024, G, (bx + 128) % G, Z + OFF_CKV, DINP, Wukv_t, KVLR); EpiBf16 E{KVb, 1024, 1.f, ssq_ckv, 1.f / KVLR};
          pg8::gemm_phase<EpiBf16, pg8::TileOrder>(lds, DINP, KVLR, KVLR, S, E, wave_s); }
        struct FormQK { int G, c; const bf16_t* mkv; const bf16_t* W;
            __device__ bool next(int i, pg8::Unit& u) const { const int L = i * G + c; if (L >= 256) return false; const int bh = L >> 2, q = L & 3, b = bh >> 2, h = bh & 3;
                u.pm = 0; u.pn = q; u.A = (const char*)(mkv + (size_t)(b * 256) * 2048 + h * 256); u.B = (const char*)(W + (size_t)(q * 256) * 1024 + h * 256); u.cofs = ((long)b * 1024 + h * 256) * 1024; return true; } };
        struct FormVO { int G, c; const bf16_t* mkv; const bf16_t* W;
            __device__ bool next(int i, pg8::Unit& u) const { const int L = i * G + c; if (L >= 256) return false; const int bh = L >> 2, q = L & 3, b = bh >> 2, h = bh & 3;
                u.pm = q; u.pn = 0; u.A = (const char*)(W + (size_t)(q * 256) * 1024 + h * 256); u.B = (const char*)(mkv + (size_t)(b * 256) * 2048 + 1024 + h * 256); u.cofs = (long)b * 1024 * 1024 + h * 256; return true; } };
        if (P2SUB & 8) R2(3) { FormQK S{G, vcu, MKV, Wmq_b}; EpiBf16 E{WQK, 1024, MSCALE, nullptr, 0.f}; pg8::gemm_phase<EpiBf16, FormQK>(lds, 2048, 1024, 256, S, E, wave_s); }
        if (P2SUB & 16) R2(3) { FormVO S{G, vcu, MKV, Wmo_t}; EpiBf16 E{WVO, 1024, 1.f, nullptr, 0.f}; pg8::gemm_phase<EpiBf16, FormVO>(lds, 1024, 2048, 256, S, E, wave_s); }
    }
    SEAM(2);
    if (IN(3)) REPS(3) {
        for (int it = vcu; it < BATCH * 4 * 4; it += G) { const int bh = it >> 2, xq = it & 3, b = bh >> 2, h = bh & 3;
            mla::block(b, h, xq, Qb, KVb, KPE, Y, RSQ(ssq_mla), (char*)lds_raw, wave_s);
            mla::block(b, h, 7 - xq, Qb, KVb, KPE, Y, RSQ(ssq_mla), (char*)lds_raw, wave_s); }
    }
    SEAM(3);
    if (IN(5)) REPS(5) { pg8::TileOrder S; S.init(T, DM, G, bx, Y, DM, Wout_t, DM);
        EpiNormResMid E{nullptr, XN, nullptr, g_post_mix, rep ? (bf16_t*)PRE : XN, RSQ(ssq_h1), slots_p, ctl + CW_SEAM, ssq_lru, ssq_mla};
        pg8::gemm_phase<EpiNormResMid, pg8::TileOrder>(lds, DM, DM, DM, S, E, wave_s); }
    SEAM(5);
    if (IN(7)) REPS(7) { pg8::TileOrder S; S.init(T, DM, G, bx, XN, DM, WQK, DM, (size_t)DM * DM * 2); EpiSoftmax E{Pb, ssq_h1}; pg8::gemm_phase<EpiSoftmax, pg8::TileOrder>(lds, DM, DM, DM, S, E, wave_s); }
    SEAM(7);
    if (IN(8)) REPS(8) { pg8::TileOrder S; S.init(T, DM, G, bx, Pb, DM, WVO, DM, (size_t)DM * DM * 2); EpiNormRes E{nullptr, XN, nullptr, g_post_mem, rep ? (bf16_t*)PRE : XN, RSQ(ssq_h2), slots_p + (size_t)4 * T, ctl + CW_SEAM + SEAM_BANK, nullptr, nullptr};
        pg8::gemm_phase<EpiNormRes, pg8::TileOrder>(lds, DM, DM, DM, S, E, wave_s); }
    SEAM(8);
    if (IN(10)) REPS(10) { pg8::TileOrder S; S.init(T, 2 * DFF, G, bx, XN, DM, Wgu_t, DM); EpiSwiGLU E{Fb, ssq_h2}; pg8::gemm_phase<EpiSwiGLU, pg8::TileOrder, ALIGN_P10>(lds, DM, DM, DM, S, E, wave_s); }
    SEAM(10);
    if (IN(11)) REPS(11) { pg8::TileOrder S; S.init(T, DM, G, bx, Fb, DFF, Wdown_t, DFF); EpiNormRes E{nullptr, XN, rep ? PRE : out_p, g_post_ffn, nullptr, nullptr, slots_p + (size_t)8 * T, ctl + CW_SEAM + 2 * SEAM_BANK, nullptr, nullptr};
        pg8::gemm_phase<EpiNormRes, pg8::TileOrder>(lds, DFF, DFF, DFF, S, E, wave_s); }
#undef IN
#undef SEAM
}

#undef tid
#undef lane
#undef wave
#undef gw
#undef NGW
#undef x_in
#undef ssq_h1
#undef ssq_h2
#undef ssq_dummy
#undef ssq_x
#undef slots_p
#undef mem
#undef positions
#undef g_pre_mix
#undef w_in
#undef conv_w
#undef conv_b
#undef lru_wa
#undef lru_ba
#undef lru_wx
#undef lru_bx
#undef lru_lambda
#undef g_q_lat
#undef w_uq
#undef g_kv_lat
#undef w_ukv
#undef g_lru_out
#undef g_mla_out
#undef w_out
#undef g_post_mix
#undef g_pre_mem
#undef g_mem_kv
#undef w_mq
#undef w_mk
#undef w_mv
#undef w_mo
#undef g_post_mem
#undef g_pre_ffn
#undef w_gate
#undef w_up
#undef w_down
#undef g_post_ffn
#undef out_p
#undef ctl
#undef ssq_cq
#undef ssq_ckv
#undef ssq_lru
#undef ssq_mla
#undef cosT
#undef sinT
#undef Win_t
#undef Wuq_t
#undef Wukv_t
#undef Wout_t
#undef Wmq_b
#undef Wmkv_t
#undef Wmo_t
#undef Wgu_t
#undef Wdown_t
#undef MN
#undef MKV
#undef WQK
#undef WVO
#undef XN
#undef KPE
#undef Z
#undef Qb
#undef KVb
#undef Y
#undef PRE
#undef Pb
#undef Fb
#ifndef N_LAUNCHES
#define N_LAUNCHES 1
#endif
extern "C" void kernel_launch(void* const* d_in, const int* in_sizes, int n_in, void* d_out, int out_size, void* d_ws, size_t ws_size, hipStream_t stream) {
    static int grid = 0;
    if (grid == 0) {
        if (n_in != 32 || in_sizes[0] != T * DM || out_size != T * DM || ws_size < WS_END) { fprintf(stderr, "kernel_launch: unexpected shapes (n_in %d, in0 %d, out %d, ws %zu)\n", n_in, n_in > 0 ? in_sizes[0] : -1, out_size, ws_size); grid = -1; return; }
        int dev = 0, cus = 0, per_cu = 0;
        (void)hipGetDevice(&dev); (void)hipDeviceGetAttribute(&cus, hipDeviceAttributeMultiprocessorCount, dev);
        if (hipFuncSetAttribute((const void*)hymba_fwd, hipFuncAttributeMaxDynamicSharedMemorySize, LDS_BYTES) != hipSuccess) { fprintf(stderr, "kernel_launch: hipFuncSetAttribute failed\n"); grid = -1; return; }
        if (hipOccupancyMaxActiveBlocksPerMultiprocessor(&per_cu, (const void*)hymba_fwd, NWAVES * 64, LDS_BYTES) != hipSuccess || per_cu < 1) { fprintf(stderr, "kernel_launch: occupancy query says %d\n", per_cu); per_cu = 1; }
        (void)hipGetLastError();
        grid = cus > 0 ? cus : 256;
    }
    if (grid < 0) return;
    (void)hipMemsetAsync((char*)d_ws + WS_CTL, 0, CTL_ZERO_BYTES, stream);
    Args a{};
    for (int i = 0; i < 32; ++i) a.in[i] = d_in[i];
    a.out = (float*)d_out; a.ws = (unsigned char*)d_ws;
#if N_LAUNCHES == 1
    a.ph_lo = 0; a.ph_hi = NPHASE;
    void* kargs[] = {&a};
#ifdef PLAIN_LAUNCH
    (void)kargs; hipLaunchKernelGGL(hymba_fwd, dim3(grid), dim3(NWAVES * 64), LDS_BYTES, stream, a); hipError_t e = hipPeekAtLastError();
#else
    hipError_t e = hipLaunchCooperativeKernel((const void*)hymba_fwd, dim3(grid), dim3(NWAVES * 64), kargs, LDS_BYTES, stream);
#endif
    if (e != hipSuccess) fprintf(stderr, "kernel_launch: cooperative launch failed: %s (grid %d)\n", hipGetErrorString(e), grid);
#else
    for (int p = 0; p < NPHASE; ++p) { a.ph_lo = p; a.ph_hi = p + 1; hipLaunchKernelGGL(hymba_fwd, dim3(grid), dim3(NWAVES * 64), LDS_BYTES, stream, a); }
#endif
}
```

```cpp
#include <hip/hip_runtime.h>
#include <hip/hip_bf16.h>
#include <cstdio>
#include <cstdint>

#define LAS __attribute__((address_space(3)))
#define GAS __attribute__((address_space(1)))
typedef unsigned short bf16_t;
typedef short bf16x8 __attribute__((ext_vector_type(8)));
typedef short s16x4 __attribute__((ext_vector_type(4)));
typedef float f32x4 __attribute__((ext_vector_type(4)));
typedef float f32x2 __attribute__((ext_vector_type(2)));
typedef float f32x16 __attribute__((ext_vector_type(16)));
typedef unsigned u32x4 __attribute__((ext_vector_type(4)));
typedef unsigned u32x2 __attribute__((ext_vector_type(2)));

constexpr int BATCH = 16, SEQ = 2048, DM = 1024, T = BATCH * SEQ;
constexpr int NMEM = 256, TM = BATCH * NMEM;
constexpr int DLRU = 512, DINP = 1792, QLR = 384, KVLR = 256, DFF = 2816;
constexpr int OFF_GATE = 512, OFF_CQ = 1024, OFF_CKV = 1408, OFF_KPE = 1664;
constexpr float EPS = 1e-6f;
constexpr float LOG2E = 1.4426950408889634f;
constexpr float QSCALE = 0.07216878364870322f * LOG2E;
constexpr float MSCALE = 0.0625f * LOG2E;

constexpr size_t MiB = 1u << 20;
constexpr size_t WS_CTL = 0, CTL_ZERO_BYTES = 2 * MiB;
constexpr size_t WS_SSQ = 1 * MiB;
constexpr size_t WS_SLOTS = 2 * MiB;
constexpr int CW_SEAM = 65536, SEAM_BANK = 8192;
constexpr size_t WS_ROPE = 4 * MiB;
constexpr size_t WS_WIN = 12 * MiB, WS_WUQ = 16 * MiB, WS_WUKV = 17 * MiB, WS_WOUT = 18 * MiB, WS_WMQ = 20 * MiB, WS_WMKV = 22 * MiB,
                 WS_WMO = 26 * MiB, WS_WGU = 28 * MiB, WS_WDOWN = 39 * MiB;
constexpr size_t WS_MN = 46 * MiB, WS_MKV = 54 * MiB, WS_WQK = 70 * MiB, WS_WVO = 102 * MiB, WS_XN = 134 * MiB, WS_KPE = 198 * MiB;
constexpr size_t WS_Z = 202 * MiB, WS_Q = 314 * MiB, WS_KV = 362 * MiB, WS_Y = 426 * MiB;
constexpr size_t WS_PRE = 202 * MiB, WS_P = 330 * MiB, WS_F = 330 * MiB, WS_END = 506 * MiB;
constexpr int CW_BAR = 4096;

constexpr int RING_BYTES = 131072, EPI_OFF = RING_BYTES, EPI_BYTES = 16384, MISC_OFF = EPI_OFF + EPI_BYTES, LDS_BYTES = MISC_OFF + 1024;

__device__ __forceinline__ unsigned cvt_pk_bf16(float lo, float hi) { unsigned r; asm volatile("v_cvt_pk_bf16_f32 %0, %1, %2" : "=v"(r) : "v"(lo), "v"(hi)); return r; }
__device__ __forceinline__ float bf2f(unsigned short v) { return __uint_as_float((unsigned)v << 16); }
__device__ __forceinline__ float bflo(unsigned w) { return __uint_as_float(w << 16); }
__device__ __forceinline__ float bfhi(unsigned w) { return __uint_as_float(w & 0xffff0000u); }
__device__ __forceinline__ float wave_sum(float v) {
#pragma unroll
    for (int o = 1; o < 64; o <<= 1) v += __shfl_xor(v, o);
    return v;
}
__device__ __forceinline__ int lane_id() { int l; asm volatile("v_mbcnt_lo_u32_b32 %0, -1, 0\n\tv_mbcnt_hi_u32_b32 %0, -1, %0" : "=v"(l)); return l; }
#define LDS_WAIT() asm volatile("s_waitcnt lgkmcnt(0)" ::: "memory")
#define VM_WAIT() asm volatile("s_waitcnt vmcnt(0)" ::: "memory")

namespace pg8 {
constexpr int BM = 256, BK = 64, HALF = 128, HTB = HALF * BK * 2, STAGE_BYTES = 8 * HTB, NXCD = 8, WGM = 8;
__host__ __device__ __forceinline__ int lds_byte(int r, int c) { const int st = (r >> 4) * 2 + (c >> 5), rr = r & 15, cc = c & 31, ob = rr * 64 + cc * 2; return st * 1024 + (ob ^ (((ob >> 9) & 1) << 5)); }
__host__ __device__ __forceinline__ void stage_rc(int b, int& R, int& C) { const int st = b / 1024, sb = b % 1024, swz = sb ^ (((sb >> 9) & 1) << 5); R = (st >> 1) * 16 + swz / 64; C = (st & 1) * 32 + (swz % 64) / 2; }
__host__ __device__ __forceinline__ int perm32(int rho) { const int n = rho >> 4, i = rho & 15; return 8 * (i >> 2) + 4 * n + (i & 3); }

struct Unit { int pm, pn; const char* A; const char* B; long cofs; };

struct TileOrder {
    int nM, nN, nwg, G, c; const char* A; const char* B; size_t tA, tB, bB;
    __device__ void init(int M, int N, int G_, int c_, const void* A_, int lda, const void* B_, int ldb, size_t batchB_bytes = 0) {
        nM = M / BM; nN = N / BM; nwg = nM * nN; G = G_; c = c_; A = (const char*)A_; B = (const char*)B_; tA = (size_t)BM * lda * 2; tB = (size_t)BM * ldb * 2; bB = batchB_bytes; }
    __device__ bool next(int i, Unit& u) const {
        const long L = (long)i * G + c; if (L >= nwg) return false;
        int wgid = (int)L; { const int q = nwg / NXCD, r = nwg % NXCD, xcd = wgid % NXCD, off = wgid / NXCD; wgid = (xcd < r ? xcd * (q + 1) : r * (q + 1) + (xcd - r) * q) + off; }
        const int nig = WGM * nN, gid = wgid / nig, fm = gid * WGM, gsz = (nM - fm) < WGM ? (nM - fm) : WGM;
        u.pm = fm + ((wgid % nig) % gsz); u.pn = (wgid % nig) / gsz; u.A = A + (size_t)u.pm * tA; u.B = B + (size_t)u.pn * tB + (size_t)(u.pm >> 3) * bB; u.cofs = 0; return true;
    }
};

template <class Epi, class Sched, bool ALIGN_EPI = true, bool SP2 = true>
__device__ __forceinline__ void gemm_phase(LAS unsigned char* lds, const int lda, const int ldb, const int K, const Sched& S, const Epi& E, const int wv) {
    int lane = lane_id(); asm volatile("" : "+v"(lane));
    const int wid = wv, tid = wv * 64 + lane, wr = wid >> 2, wc = wid & 3, fr = lane & 15, fq = lane >> 4;
    const int nt = K / BK;
    unsigned voffA[2], voffB[2];
#pragma unroll
    for (int i = 0; i < 2; ++i) { int R, C; stage_rc(tid * 16 + i * 8192, R, C); const int Rb = Epi::PERM ? ((R & ~31) + perm32(R & 31)) : R;
        voffA[i] = (unsigned)(R * lda + C) * 2u; voffB[i] = (unsigned)(Rb * ldb + C) * 2u; }
    const size_t kstep = (size_t)(BK * 2);
    const size_t hstepA = (size_t)HALF * lda * 2, hstepB = (size_t)HALF * ldb * 2;
    const unsigned ldsw = (unsigned)wid * 1024u;
    const int aoff = lds_byte(wr * 64 + fr, fq * 8), boff = lds_byte(wc * 32 + fr, fq * 8);
#define PG8_SA(b, h) (((b) * 2 + (h)) * HTB)
#define PG8_SB(b, h) ((4 + (b) * 2 + (h)) * HTB)
#define PG8_STAGE(bufoff, gbase, voff) do { _Pragma("unroll") for (int _i = 0; _i < 2; ++_i) \
        __builtin_amdgcn_global_load_lds((const unsigned*)((const char*)(gbase) + (voff)[_i]), (LAS unsigned*)(lds + (bufoff) + ldsw + _i * 8192), 16, 0, 0); } while (0)
#define PG8_LDA(dst, b, h) do { _Pragma("unroll") for (int m = 0; m < 4; ++m) _Pragma("unroll") for (int k = 0; k < 2; ++k) dst[m][k] = *(const LAS bf16x8*)(lds + PG8_SA(b, h) + aoff + m * 2048 + k * 1024); } while (0)
#define PG8_LDB(dst, b, h) do { _Pragma("unroll") for (int n = 0; n < 2; ++n) _Pragma("unroll") for (int k = 0; k < 2; ++k) dst[n][k] = *(const LAS bf16x8*)(lds + PG8_SB(b, h) + boff + n * 2048 + k * 1024); } while (0)
#define PG8_MMA(ai, bj, At, Bt) do { __builtin_amdgcn_s_setprio(1); _Pragma("unroll") for (int m = 0; m < 4; ++m) _Pragma("unroll") for (int n = 0; n < 2; ++n) _Pragma("unroll") for (int k = 0; k < 2; ++k) \
        acc[ai][bj][m][n] = __builtin_amdgcn_mfma_f32_16x16x32_bf16(Bt[n][k], At[m][k], acc[ai][bj][m][n], 0, 0, 0); __builtin_amdgcn_s_setprio(0); } while (0)
#define PG8_WAIT_V(n) asm volatile("s_waitcnt vmcnt(" #n ")" ::: "memory")
#define PG8_WAIT_L(n) asm volatile("s_waitcnt lgkmcnt(" #n ")" ::: "memory")
#define PG8_BAR __builtin_amdgcn_s_barrier()
#define PG8_SCHED __builtin_amdgcn_sched_barrier(0)
    Unit cur, nxt; int ui = 0;
    if (!S.next(0, cur)) return;
    if constexpr (Epi::MIDK) E.prep(cur, lds, wid, 0);
    f32x4 acc[2][2][4][2];
#pragma unroll
    for (int a = 0; a < 2; ++a)
#pragma unroll
        for (int b = 0; b < 2; ++b)
#pragma unroll
            for (int m = 0; m < 4; ++m)
#pragma unroll
                for (int n = 0; n < 2; ++n) acc[a][b][m][n] = (f32x4){0.f, 0.f, 0.f, 0.f};
    bf16x8 At[4][2], B0[2][2], B1[2][2];
    const char* cA = cur.A; const char* cB = cur.B;
    static_assert(SP2, "only the SP2 loop is kept");
    PG8_STAGE(PG8_SB(0, 0), cB, voffB); PG8_STAGE(PG8_SB(0, 1), cB + hstepB, voffB); PG8_STAGE(PG8_SA(0, 0), cA, voffA); PG8_STAGE(PG8_SA(0, 1), cA + hstepA, voffA);
    if (wr == 1) PG8_BAR;
    PG8_WAIT_V(2); PG8_BAR;
    PG8_STAGE(PG8_SB(1, 0), cB + kstep, voffB); PG8_STAGE(PG8_SA(1, 0), cA + kstep, voffA); PG8_STAGE(PG8_SB(1, 1), cB + hstepB + kstep, voffB);
    PG8_WAIT_V(6); PG8_BAR;
    for (;;) {
        const bool has_next = S.next(ui + 1, nxt);
        const char* nA = has_next ? nxt.A : cA; const char* nB = has_next ? nxt.B : cB;
        for (int t = 0; t < nt; t += 2) {
            if constexpr (Epi::MIDK) { if (t == Epi::TSPLIT) E.midk(acc, lds, ui & 1, wr); }
            const bool last = (t == nt - 2);
            const char* a1 = cA + (size_t)(t + 1) * kstep;
            const char* a2 = last ? nA : cA + (size_t)(t + 2) * kstep; const char* b2 = last ? nB : cB + (size_t)(t + 2) * kstep;
            const char* a3 = a2 + kstep; const char* b3 = b2 + kstep;
            PG8_LDB(B0, 0, 0); PG8_LDB(B1, 0, 1); PG8_SCHED; PG8_LDA(At, 0, 0); PG8_STAGE(PG8_SA(1, 1), a1 + hstepA, voffA);
            PG8_WAIT_V(8); PG8_WAIT_L(0); PG8_BAR; PG8_MMA(0, 0, At, B0); PG8_MMA(0, 1, At, B1); PG8_BAR; PG8_SCHED;
            PG8_LDA(At, 0, 1); PG8_STAGE(PG8_SB(0, 0), b2, voffB); PG8_STAGE(PG8_SB(0, 1), b2 + hstepB, voffB); PG8_STAGE(PG8_SA(0, 0), a2, voffA);
            PG8_WAIT_V(8); PG8_WAIT_L(0); PG8_BAR; PG8_MMA(1, 0, At, B0); PG8_MMA(1, 1, At, B1); PG8_BAR; PG8_SCHED;
            PG8_LDB(B0, 1, 0); PG8_LDB(B1, 1, 1); PG8_SCHED; PG8_LDA(At, 1, 0); PG8_STAGE(PG8_SA(0, 1), a2 + hstepA, voffA);
            PG8_WAIT_V(8); PG8_WAIT_L(0); PG8_BAR; PG8_MMA(0, 0, At, B0); PG8_MMA(0, 1, At, B1); PG8_BAR; PG8_SCHED;
            PG8_LDA(At, 1, 1); PG8_STAGE(PG8_SB(1, 0), b3, voffB); PG8_STAGE(PG8_SB(1, 1), b3 + hstepB, voffB); PG8_STAGE(PG8_SA(1, 0), a3, voffA);
            PG8_WAIT_V(8); PG8_WAIT_L(0); PG8_BAR; PG8_MMA(1, 0, At, B0); PG8_MMA(1, 1, At, B1); PG8_BAR; PG8_SCHED;
        }
        if constexpr (ALIGN_EPI) { if (wr == 0) PG8_BAR; }
        E(acc, cur, wr, wc, fr, fq, lds, wid, ui & 1);
        if (!has_next) break;
        if constexpr (Epi::MIDK) E.prep(nxt, lds, wid, (ui + 1) & 1);
#pragma unroll
        for (int a = 0; a < 2; ++a)
#pragma unroll
            for (int b = 0; b < 2; ++b)
#pragma unroll
                for (int m = 0; m < 4; ++m)
#pragma unroll
                    for (int n = 0; n < 2; ++n) acc[a][b][m][n] = (f32x4){0.f, 0.f, 0.f, 0.f};
        cur = nxt; cA = nA; cB = nB; ++ui;
        if constexpr (ALIGN_EPI) { if (wr == 1) PG8_BAR; }
    }
    PG8_WAIT_V(0);
    if constexpr (!ALIGN_EPI) { if (wr == 0) PG8_BAR; }
    PG8_BAR;
#undef PG8_SA
#undef PG8_SB
#undef PG8_STAGE
#undef PG8_LDA
#undef PG8_LDB
#undef PG8_MMA
#undef PG8_WAIT_V
#undef PG8_WAIT_L
#undef PG8_BAR
#undef PG8_SCHED
}
}

typedef f32x4 Acc[2][2][4][2];
__device__ __forceinline__ void ssq_rows_atomic(const Acc& acc, float* ssq, int row_base  , int bjmask, int fq, int lane) {
#pragma unroll
    for (int ai = 0; ai < 2; ++ai) {
        float s[4];
#pragma unroll
        for (int m = 0; m < 4; ++m) { float q = 0.f;
#pragma unroll
            for (int bj = 0; bj < 2; ++bj) if (bjmask & (1 << bj))
#pragma unroll
                for (int n = 0; n < 2; ++n) { const f32x4 x = acc[ai][bj][m][n]; q += (x[0] * x[0] + x[1] * x[1]) + (x[2] * x[2] + x[3] * x[3]); }
            q += __shfl_xor(q, 16); q += __shfl_xor(q, 32); s[m] = q; }
        const float v = fq == 0 ? s[0] : fq == 1 ? s[1] : fq == 2 ? s[2] : s[3];
        atomicAdd(ssq + row_base + ai * 128 + lane, v);
    }
}
struct EpiBf16 {
    static constexpr bool PERM = true, MIDK = false;
    bf16_t* O; int ldc; float scale; const float* ssq; float rdim_inv;
    __device__ __forceinline__ void operator()(const Acc& acc, const pg8::Unit& u, int wr, int wc, int fr, int fq, LAS unsigned char*, int, int) const {
        { const int ln_ = lane_id(); fr = ln_ & 15; fq = ln_ >> 4; }
        const int row0 = u.pm * 256 + wr * 64 + fr, col0 = u.pn * 256 + wc * 32 + 8 * fq;
#pragma unroll
        for (int ai = 0; ai < 2; ++ai)
#pragma unroll
            for (int m = 0; m < 4; ++m) { const int row = row0 + ai * 128 + m * 16; float sc = scale;
                if (ssq) sc *= __builtin_amdgcn_rsqf(ssq[row] * rdim_inv + EPS);
                bf16_t* rowp = O + u.cofs + (size_t)row * ldc + col0;
#pragma unroll
                for (int bj = 0; bj < 2; ++bj) { const f32x4 v0 = acc[ai][bj][m][0] * sc, v1 = acc[ai][bj][m][1] * sc;
                    u32x4 w; w.x = cvt_pk_bf16(v0[0], v0[1]); w.y = cvt_pk_bf16(v0[2], v0[3]); w.z = cvt_pk_bf16(v1[0], v1[1]); w.w = cvt_pk_bf16(v1[2], v1[3]);
                    *(u32x4*)(rowp + bj * 128) = w; } }
    }
};
__device__ __forceinline__ void rope8(f32x4& v0, f32x4& v1, const float* cosT, const float* sinT, int row, int i0) {
    const f32x4 c = *(const f32x4*)(cosT + (size_t)row * 32 + i0), s = *(const f32x4*)(sinT + (size_t)row * 32 + i0);
    const f32x4 a = v0, b = v1;
    v0[0] = a[0] * c[0] - a[1] * s[0]; v0[1] = a[1] * c[0] + a[0] * s[0]; v0[2] = a[2] * c[1] - a[3] * s[1]; v0[3] = a[3] * c[1] + a[2] * s[1];
    v1[0] = b[0] * c[2] - b[1] * s[2]; v1[1] = b[1] * c[2] + b[0] * s[2]; v1[2] = b[2] * c[3] - b[3] * s[3]; v1[3] = b[3] * c[3] + b[2] * s[3];
}
struct EpiZ {
    static constexpr bool PERM = true, MIDK = false;
    bf16_t* Z; bf16_t* KPE; float* ssq_cq; float* ssq_ckv; const float* cosT; const float* sinT; const float* ssq_x;
    __device__ __forceinline__ void operator()(Acc& acc, const pg8::Unit& u, int wr, int wc, int fr, int fq, LAS unsigned char*, int, int lane) const {
        { const int ln_ = lane_id(); fr = ln_ & 15; fq = ln_ >> 4; }
        const int row0 = u.pm * 256 + wr * 64 + fr, col0 = u.pn * 256 + wc * 32 + 8 * fq;
        const bool kpe_tile = (u.pn == 6);
#pragma unroll
        for (int ai = 0; ai < 2; ++ai)
#pragma unroll
            for (int m = 0; m < 4; ++m) { const float rsx = __builtin_amdgcn_rsqf(ssq_x[row0 + ai * 128 + m * 16] * (1.f / DM) + EPS);
#pragma unroll
                for (int bj = 0; bj < 2; ++bj)
#pragma unroll
                    for (int n = 0; n < 2; ++n) acc[ai][bj][m][n] = acc[ai][bj][m][n] * rsx; }
#pragma unroll
        for (int ai = 0; ai < 2; ++ai)
#pragma unroll
            for (int m = 0; m < 4; ++m) { const int row = row0 + ai * 128 + m * 16; bf16_t* rowp = Z + (size_t)row * DINP + col0;
#pragma unroll
                for (int bj = 0; bj < 2; ++bj) { f32x4 v0 = acc[ai][bj][m][0], v1 = acc[ai][bj][m][1];
                    if (kpe_tile && bj == 1) {
                        if (wc < 2) { rope8(v0, v1, cosT, sinT, row, 16 * (wc & 1) + 4 * fq);
                            u32x4 w; w.x = cvt_pk_bf16(v0[0], v0[1]); w.y = cvt_pk_bf16(v0[2], v0[3]); w.z = cvt_pk_bf16(v1[0], v1[1]); w.w = cvt_pk_bf16(v1[2], v1[3]);
                            *(u32x4*)(KPE + (size_t)row * 64 + wc * 32 + 8 * fq) = w; }
                    } else {
                        u32x4 w; w.x = cvt_pk_bf16(v0[0], v0[1]); w.y = cvt_pk_bf16(v0[2], v0[3]); w.z = cvt_pk_bf16(v1[0], v1[1]); w.w = cvt_pk_bf16(v1[2], v1[3]);
                        *(u32x4*)(rowp + bj * 128) = w; } } }
        const int rb = u.pm * 256 + wr * 64; lane = fq * 16 + fr;
        if (u.pn == 4) ssq_rows_atomic(acc, ssq_cq, rb, 3, fq, lane);
        else if (u.pn == 5) { ssq_rows_atomic(acc, ssq_cq, rb, 1, fq, lane); ssq_rows_atomic(acc, ssq_ckv, rb, 2, fq, lane); }
        else if (u.pn == 6) ssq_rows_atomic(acc, ssq_ckv, rb, 1, fq, lane);
    }
};
struct EpiQ {
    static constexpr bool PERM = true, MIDK = false;
    bf16_t* Q; const float* ssq; const float* cosT; const float* sinT;
    __device__ __forceinline__ void operator()(const Acc& acc, const pg8::Unit& u, int wr, int wc, int fr, int fq, LAS unsigned char*, int, int) const {
        { const int ln_ = lane_id(); fr = ln_ & 15; fq = ln_ >> 4; }
        const int row0 = u.pm * 256 + wr * 64 + fr, col0 = u.pn * 256 + wc * 32 + 8 * fq;
        const bool pe = (u.pn == 2);
#pragma unroll
        for (int ai = 0; ai < 2; ++ai)
#pragma unroll
            for (int m = 0; m < 4; ++m) { const int row = row0 + ai * 128 + m * 16;
                const float sc = QSCALE * __builtin_amdgcn_rsqf(ssq[row] * (1.f / QLR) + EPS);
                bf16_t* rowp = Q + (size_t)row * 768 + col0;
#pragma unroll
                for (int bj = 0; bj < 2; ++bj) { f32x4 v0 = acc[ai][bj][m][0] * sc, v1 = acc[ai][bj][m][1] * sc;
                    if (pe) rope8(v0, v1, cosT, sinT, row, 16 * (wc & 1) + 4 * fq);
                    u32x4 w; w.x = cvt_pk_bf16(v0[0], v0[1]); w.y = cvt_pk_bf16(v0[2], v0[3]); w.z = cvt_pk_bf16(v1[0], v1[1]); w.w = cvt_pk_bf16(v1[2], v1[3]);
                    *(u32x4*)(rowp + bj * 128) = w; } }
    }
};
struct EpiF32 {
    static constexpr bool PERM = false, MIDK = false;
    float* O; int ldc;
    __device__ __forceinline__ void operator()(const Acc& acc, const pg8::Unit& u, int wr, int wc, int fr, int fq, LAS unsigned char*, int, int) const {
        { const int ln_ = lane_id(); fr = ln_ & 15; fq = ln_ >> 4; }
        const int row0 = u.pm * 256 + wr * 64 + fr, col0 = u.pn * 256 + wc * 32 + 4 * fq;
#pragma unroll
        for (int ai = 0; ai < 2; ++ai)
#pragma unroll
            for (int m = 0; m < 4; ++m) { float* rowp = O + (size_t)(row0 + ai * 128 + m * 16) * ldc + col0;
#pragma unroll
                for (int bj = 0; bj < 2; ++bj)
#pragma unroll
                    for (int n = 0; n < 2; ++n) *(f32x4*)(rowp + bj * 128 + n * 16) = acc[ai][bj][m][n]; }
    }
};
struct EpiSwiGLU {
    static constexpr bool PERM = true, MIDK = false;
    bf16_t* F; const float* ssq;
    __device__ __forceinline__ void operator()(const Acc& acc, const pg8::Unit& u, int wr, int wc, int fr, int fq, LAS unsigned char*, int, int) const {
        { const int ln_ = lane_id(); fr = ln_ & 15; fq = ln_ >> 4; }
        const int row0 = u.pm * 256 + wr * 64 + fr, col0 = u.pn * 128 + wc * 32 + 8 * fq;
        float sq[2][4];
#pragma unroll
        for (int ai = 0; ai < 2; ++ai)
#pragma unroll
            for (int m = 0; m < 4; ++m) sq[ai][m] = ssq[row0 + ai * 128 + m * 16];
#pragma unroll
        for (int ai = 0; ai < 2; ++ai)
#pragma unroll
            for (int m = 0; m < 4; ++m) { bf16_t* rowp = F + (size_t)(row0 + ai * 128 + m * 16) * DFF + col0; float f[8];
                const float rsc = __builtin_amdgcn_rsqf(sq[ai][m] * (1.f / DM) + EPS);
#pragma unroll
                for (int n = 0; n < 2; ++n)
#pragma unroll
                    for (int e = 0; e < 4; ++e) { const float g = acc[ai][0][m][n][e] * rsc, up = acc[ai][1][m][n][e] * rsc;
                        f[n * 4 + e] = g * __builtin_amdgcn_rcpf(1.f + __builtin_amdgcn_exp2f(-g * LOG2E)) * up; }
                u32x4 w; w.x = cvt_pk_bf16(f[0], f[1]); w.y = cvt_pk_bf16(f[2], f[3]); w.z = cvt_pk_bf16(f[4], f[5]); w.w = cvt_pk_bf16(f[6], f[7]);
                *(u32x4*)rowp = w; }
    }
};
struct EpiSoftmax {
    static constexpr bool PERM = true, MIDK = false;
    bf16_t* P; const float* ssq;
    __device__ __forceinline__ void operator()(Acc& acc, const pg8::Unit& u, int wr, int wc, int fr, int fq, LAS unsigned char* lds, int, int) const {
        { const int ln_ = lane_id(); fr = ln_ & 15; fq = ln_ >> 4; }
        LAS float* PM = (LAS float*)(lds + EPI_OFF);
        LAS float* PS = (LAS float*)(lds + EPI_OFF + 4096);
        float sq[2][4];
#pragma unroll
        for (int ai = 0; ai < 2; ++ai)
#pragma unroll
            for (int m = 0; m < 4; ++m) sq[ai][m] = ssq[u.pm * 256 + ai * 128 + wr * 64 + m * 16 + fr];
        float mxr[2][4];
#pragma unroll
        for (int ai = 0; ai < 2; ++ai)
#pragma unroll
            for (int m = 0; m < 4; ++m) { float q = -3.0e38f;
#pragma unroll
                for (int bj = 0; bj < 2; ++bj)
#pragma unroll
                    for (int n = 0; n < 2; ++n) { const f32x4 x = acc[ai][bj][m][n]; q = fmaxf(q, fmaxf(fmaxf(x[0], x[1]), fmaxf(x[2], x[3]))); }
                q = fmaxf(q, __shfl_xor(q, 16)); q = fmaxf(q, __shfl_xor(q, 32)); mxr[ai][m] = q; }
#pragma unroll
        for (int ai = 0; ai < 2; ++ai)
#pragma unroll
            for (int m = 0; m < 4; ++m) { sq[ai][m] = __builtin_amdgcn_rsqf(sq[ai][m] * (1.f / DM) + EPS);
                if (fq == 0) PM[(ai * 128 + wr * 64 + m * 16 + fr) * 4 + wc] = mxr[ai][m] * sq[ai][m]; }
        LDS_WAIT(); __builtin_amdgcn_s_barrier(); asm volatile("" ::: "memory");
#pragma unroll
        for (int ai = 0; ai < 2; ++ai)
#pragma unroll
            for (int m = 0; m < 4; ++m) { const f32x4 t = *(const LAS f32x4*)(PM + (ai * 128 + wr * 64 + m * 16 + fr) * 4);
                const float rm = fmaxf(fmaxf(t[0], t[1]), fmaxf(t[2], t[3])), rsc = sq[ai][m]; float s = 0.f;
#pragma unroll
                for (int bj = 0; bj < 2; ++bj)
#pragma unroll
                    for (int n = 0; n < 2; ++n) { f32x4 x = acc[ai][bj][m][n];
#pragma unroll
                        for (int e = 0; e < 4; ++e) { x[e] = __builtin_amdgcn_exp2f(fmaf(x[e], rsc, -rm)); s += x[e]; }
                        acc[ai][bj][m][n] = x; }
                s += __shfl_xor(s, 16); s += __shfl_xor(s, 32);
                if (fq == 0) PS[(ai * 128 + wr * 64 + m * 16 + fr) * 4 + wc] = s; }
        LDS_WAIT(); __builtin_amdgcn_s_barrier(); asm volatile("" ::: "memory");
        const int row0 = u.pm * 256 + wr * 64 + fr, col0 = u.pn * 256 + wc * 32 + 8 * fq;
#pragma unroll
        for (int ai = 0; ai < 2; ++ai)
#pragma unroll
            for (int m = 0; m < 4; ++m) { const f32x4 t = *(const LAS f32x4*)(PS + (ai * 128 + wr * 64 + m * 16 + fr) * 4);
                const float inv = __builtin_amdgcn_rcpf((t[0] + t[1]) + (t[2] + t[3]));
                bf16_t* rowp = P + (size_t)(row0 + ai * 128 + m * 16) * DM + col0;
#pragma unroll
                for (int bj = 0; bj < 2; ++bj) { const f32x4 v0 = acc[ai][bj][m][0] * inv, v1 = acc[ai][bj][m][1] * inv;
                    u32x4 w; w.x = cvt_pk_bf16(v0[0], v0[1]); w.y = cvt_pk_bf16(v0[2], v0[3]); w.z = cvt_pk_bf16(v1[0], v1[1]); w.w = cvt_pk_bf16(v1[2], v1[3]);
                    *(u32x4*)(rowp + bj * 128) = w; } }
    }
};

__device__ __forceinline__ unsigned ag_ld(const unsigned* p) { return __hip_atomic_load(p, __ATOMIC_RELAXED, __HIP_MEMORY_SCOPE_AGENT); }
template <bool MIDK_>
struct EpiNormResT {
    static constexpr bool PERM = true, MIDK = MIDK_; static constexpr int TSPLIT = 8;
    const float* hold_f; const bf16_t* hold_b; float* hout; const float* gpost; bf16_t* xn; float* ssq_next; float* slots; unsigned* cnt;
    const float* ssq_a; const float* ssq_b;
    __device__ __forceinline__ void prep(const pg8::Unit& u, LAS unsigned char* lds, int wid, int par) const {
        if (wid < 4) { const int ln = lane_id(), row = wid * 64 + ln; const float sa = ssq_a[u.pm * 256 + row], sb = ssq_b[u.pm * 256 + row];
            const float ra = __builtin_amdgcn_rsqf(sa * (1.f / 512) + EPS), rb = __builtin_amdgcn_rsqf(sb * (1.f / 512) + EPS);
            ((LAS f32x2*)(lds + EPI_OFF + 5120))[par * 256 + row] = (f32x2){ra * __builtin_amdgcn_rcpf(rb), rb}; }
    }
    __device__ __forceinline__ void midk(Acc& acc, LAS unsigned char* lds, int par, int wr) const {
        const int ln = lane_id(), fr = ln & 15; const LAS f32x2* RT = (const LAS f32x2*)(lds + EPI_OFF + 5120) + par * 256;
#pragma unroll
        for (int ai = 0; ai < 2; ++ai)
#pragma unroll
            for (int m = 0; m < 4; ++m) { const float r = RT[ai * 128 + wr * 64 + m * 16 + fr].x;
#pragma unroll
                for (int bj = 0; bj < 2; ++bj)
#pragma unroll
                    for (int n = 0; n < 2; ++n) acc[ai][bj][m][n] = acc[ai][bj][m][n] * r; }
    }
    __device__ __forceinline__ void operator()(Acc& acc, const pg8::Unit& u, int wr, int wc, int fr, int fq, LAS unsigned char* lds, int wid, int par) const {
        const int ln = lane_id(); fr = ln & 15; fq = ln >> 4;
        if constexpr (MIDK_) { const LAS f32x2* RT = (const LAS f32x2*)(lds + EPI_OFF + 5120) + par * 256;
#pragma unroll
            for (int ai = 0; ai < 2; ++ai)
#pragma unroll
                for (int m = 0; m < 4; ++m) { const float r = RT[ai * 128 + wr * 64 + m * 16 + fr].y;
#pragma unroll
                    for (int bj = 0; bj < 2; ++bj)
#pragma unroll
                        for (int n = 0; n < 2; ++n) acc[ai][bj][m][n] = acc[ai][bj][m][n] * r; } }
        LAS float* PT = (LAS float*)(lds + EPI_OFF);
        LAS float* SR = (LAS float*)(lds + EPI_OFF + 4096);
        const int col0 = u.pn * 256 + wc * 32 + 8 * fq;
        f32x4 gv[2][2];
#pragma unroll
        for (int bj = 0; bj < 2; ++bj)
#pragma unroll
            for (int n = 0; n < 2; ++n) gv[bj][n] = *(const f32x4*)(gpost + col0 + bj * 128 + n * 4);
        u32x4 hb[2][4][2];
        if (!hold_f) {
#pragma unroll
            for (int ai = 0; ai < 2; ++ai)
#pragma unroll
                for (int m = 0; m < 4; ++m)
#pragma unroll
                    for (int bj = 0; bj < 2; ++bj) hb[ai][m][bj] = *(const u32x4*)(hold_b + (size_t)(u.pm * 256 + ai * 128 + wr * 64 + m * 16 + fr) * DM + col0 + bj * 128); }
#pragma unroll
        for (int ai = 0; ai < 2; ++ai)
#pragma unroll
            for (int m = 0; m < 4; ++m) { float q = 0.f;
#pragma unroll
                for (int bj = 0; bj < 2; ++bj)
#pragma unroll
                    for (int n = 0; n < 2; ++n) { const f32x4 x = acc[ai][bj][m][n]; q += (x[0] * x[0] + x[1] * x[1]) + (x[2] * x[2] + x[3] * x[3]); }
                q += __shfl_xor(q, 16); q += __shfl_xor(q, 32);
                if (fq == 0) PT[(ai * 128 + wr * 64 + m * 16 + fr) * 4 + wc] = q; }
        LDS_WAIT(); __builtin_amdgcn_s_barrier(); asm volatile("" ::: "memory");
        unsigned* c = cnt + 64 * u.pm;
        if (wid < 4) { const int row = wid * 64 + ln; const f32x4 t = *(const LAS f32x4*)(PT + row * 4); const float sq = (t[0] + t[1]) + (t[2] + t[3]);
            __hip_atomic_store((unsigned*)slots + ((size_t)(u.pm * 256 + row) * 4 + u.pn), __float_as_uint(sq), __ATOMIC_RELAXED, __HIP_MEMORY_SCOPE_AGENT);
            asm volatile("s_waitcnt vmcnt(0)" ::: "memory");
            if (ln == 0) __hip_atomic_fetch_add(c, 1u, __ATOMIC_RELAXED, __HIP_MEMORY_SCOPE_AGENT); }
        if (wid == 0) { unsigned sp = 0;
            while ((unsigned)__builtin_amdgcn_readfirstlane(ag_ld(c)) < 16u) { __builtin_amdgcn_s_sleep(2); if (++sp > (1u << 21)) break; }
            __builtin_amdgcn_fence(__ATOMIC_ACQUIRE, "agent"); }
        asm volatile("s_waitcnt vmcnt(0) lgkmcnt(0)" ::: "memory"); __builtin_amdgcn_s_barrier(); asm volatile("" ::: "memory");
        if (wid < 4) { const int row = wid * 64 + ln; const unsigned* sl = (const unsigned*)slots + (size_t)(u.pm * 256 + row) * 4;
            const float tot = (__uint_as_float(ag_ld(sl)) + __uint_as_float(ag_ld(sl + 1))) + (__uint_as_float(ag_ld(sl + 2)) + __uint_as_float(ag_ld(sl + 3)));
            SR[row] = __builtin_amdgcn_rsqf(tot * (1.f / DM) + EPS); }
        LDS_WAIT(); __builtin_amdgcn_s_barrier(); asm volatile("" ::: "memory");
#pragma unroll
        for (int ai = 0; ai < 2; ++ai) { float s[4];
#pragma unroll
            for (int m = 0; m < 4; ++m) { const int rl = ai * 128 + wr * 64 + m * 16 + fr; const float rs = SR[rl]; const size_t off = (size_t)(u.pm * 256 + rl) * DM + col0; float q = 0.f;
#pragma unroll
                for (int bj = 0; bj < 2; ++bj) { f32x4 h0, h1;
                    if (hold_f) { h0 = *(const f32x4*)(hold_f + off + bj * 128); h1 = *(const f32x4*)(hold_f + off + bj * 128 + 4); }
                    else { const u32x4 hv = hb[ai][m][bj]; h0 = (f32x4){bflo(hv.x), bfhi(hv.x), bflo(hv.y), bfhi(hv.y)}; h1 = (f32x4){bflo(hv.z), bfhi(hv.z), bflo(hv.w), bfhi(hv.w)}; }
                    const f32x4 v0 = h0 + acc[ai][bj][m][0] * rs * gv[bj][0], v1 = h1 + acc[ai][bj][m][1] * rs * gv[bj][1];
                    q += ((v0[0] * v0[0] + v0[1] * v0[1]) + (v0[2] * v0[2] + v0[3] * v0[3])) + ((v1[0] * v1[0] + v1[1] * v1[1]) + (v1[2] * v1[2] + v1[3] * v1[3]));
                    if (hout) { *(f32x4*)(hout + off + bj * 128) = v0; *(f32x4*)(hout + off + bj * 128 + 4) = v1; }
                    if (xn) { u32x4 w; w.x = cvt_pk_bf16(v0[0], v0[1]); w.y = cvt_pk_bf16(v0[2], v0[3]); w.z = cvt_pk_bf16(v1[0], v1[1]); w.w = cvt_pk_bf16(v1[2], v1[3]); *(u32x4*)(xn + off + bj * 128) = w; } }
                q += __shfl_xor(q, 16); q += __shfl_xor(q, 32); s[m] = q; }
            if (ssq_next) { const float v = fq == 0 ? s[0] : fq == 1 ? s[1] : fq == 2 ? s[2] : s[3]; atomicAdd(ssq_next + u.pm * 256 + wr * 64 + ai * 128 + ln, v); } }
    }
};
typedef EpiNormResT<false> EpiNormRes;
typedef EpiNormResT<true> EpiNormResMid;

#define XB_TMO      128
#define XB_XCNT(j)  (256  + 64 * (j))
#define XB_XSUB(j)  (1280 + 64 * (j))
#define XB_XGEN(j)  (2304 + 64 * (j))
#define XB_TOP      3328
#define XB_TOPGEN   3392
#define XCD_BAR_WORDS 3456
#define XB_SPIN_CAP (1u << 20)
__device__ __forceinline__ unsigned xb_ld(unsigned* p)              { return __hip_atomic_load(p, __ATOMIC_RELAXED, __HIP_MEMORY_SCOPE_AGENT); }
__device__ __forceinline__ unsigned xb_add(unsigned* p, unsigned v) { return __hip_atomic_fetch_add(p, v, __ATOMIC_RELAXED, __HIP_MEMORY_SCOPE_AGENT); }
__device__ __forceinline__ unsigned xb_xcc_id() { return (unsigned)__builtin_amdgcn_s_getreg((3 << 11) | 20) & 0xFu; }
#define XB_SPIN(cond, bar) do { unsigned _sp = 0; while (cond) { __builtin_amdgcn_s_sleep(1); \
    if ((++_sp & 255u) == 0u) { if (xb_ld(&(bar)[XB_TMO])) break; if (_sp > XB_SPIN_CAP) { atomicAdd(&(bar)[XB_TMO], 1u); break; } } } } while (0)
struct XcdBarrier { unsigned* bar; unsigned x; volatile LAS unsigned* st; unsigned G; };
__device__ __forceinline__ XcdBarrier xcd_barrier_post(unsigned* bar, volatile LAS unsigned* st, unsigned G) {
    XcdBarrier b; b.bar = bar; b.x = xb_xcc_id(); b.st = st; b.G = G;
    if (threadIdx.x == 0) (void)xb_add(&bar[XB_XCNT(b.x)], 1u);
    return b;
}
__device__ __forceinline__ void xcd_barrier_complete(unsigned* bar, unsigned x, unsigned& nloc, unsigned& nx, const unsigned G) {
    unsigned sum, cnt, mine, sp = 0u;
    for (;;) {
        sum = 0u; cnt = 0u; mine = 0u;
#pragma unroll
        for (unsigned j = 0; j < 16; ++j) { const unsigned c = xb_ld(&bar[XB_XCNT(j)]); sum += c; cnt += (c > 0u) ? 1u : 0u; mine = (j == x) ? c : mine; }
        if (sum == G) break;
        __builtin_amdgcn_s_sleep(1);
        if ((++sp & 255u) == 0u) { if (xb_ld(&bar[XB_TMO])) break; if (sp > XB_SPIN_CAP) { atomicAdd(&bar[XB_TMO], 1u); break; } }
    }
    nloc = mine > 0u ? mine : 1u; nx = cnt > 0u ? cnt : 1u;
}
__device__ __forceinline__ void xcd_barrier(const XcdBarrier& b, const int wv) {
    asm volatile("s_waitcnt vmcnt(0)" ::: "memory");
    __syncthreads();
    if (wv == 0 && lane_id() == 0) {
        unsigned* bar = b.bar;
        __builtin_amdgcn_s_waitcnt(0);
        unsigned nloc = b.st[0], nx = b.st[1];
        if (nloc == 0u) { xcd_barrier_complete(bar, b.x, nloc, nx, b.G); b.st[0] = nloc; b.st[1] = nx; }
        const unsigned old = xb_add(&bar[XB_XSUB(b.x)], 1u);
        const unsigned gen = old / nloc;
        if (old + 1u == (gen + 1u) * nloc) {
            __builtin_amdgcn_fence(__ATOMIC_RELEASE, "agent");
            asm volatile("s_waitcnt vmcnt(0)" ::: "memory");
            const unsigned og = xb_add(&bar[XB_TOP], 1u);
            const unsigned tg = og / nx;
            if (og + 1u == (tg + 1u) * nx) xb_add(&bar[XB_TOPGEN], 1u);
            else XB_SPIN(xb_ld(&bar[XB_TOPGEN]) == tg, bar);
            __builtin_amdgcn_fence(__ATOMIC_ACQUIRE, "agent");
            xb_add(&bar[XB_XGEN(b.x)], 1u);
            asm volatile("s_waitcnt vmcnt(0)" ::: "memory");
        } else {
            XB_SPIN(xb_ld(&bar[XB_XGEN(b.x)]) == gen, bar);
            __builtin_amdgcn_fence(__ATOMIC_ACQUIRE, "agent");
            asm volatile("s_waitcnt vmcnt(0)" ::: "memory");
        }
    }
    __syncthreads();
}

enum { MAP_ID = 0, MAP_WIN = 1, MAP_WUQ = 2, MAP_WUKV = 3, MAP_GATE = 4, MAP_UP = 5 };
__device__ __forceinline__ int map_n(int mode, int n) {
    switch (mode) {
    case MAP_WIN: { if (n < OFF_KPE) return n; const int j = n - OFF_KPE; return OFF_KPE + (j < 32 ? 2 * j : 2 * (j - 32) + 1); }
    case MAP_WUQ: { const int h = n / 192, d = n % 192; if (d < 128) return h * 128 + d; const int j = d - 128; return 512 + h * 64 + (j < 32 ? 2 * j : 2 * (j - 32) + 1); }
    case MAP_WUKV: { const int h = n / 256, d = n % 256; return d < 128 ? h * 128 + d : 512 + h * 128 + (d - 128); }
    case MAP_GATE: return (n >> 7) * 256 + (n & 127);
    case MAP_UP: return (n >> 7) * 256 + 128 + (n & 127);
    default: return n;
    }
}
__device__ __forceinline__ void p0_transpose_item(const float* W, int K, int N, bf16_t* WT, int row_off, int mode, const float* kscale, const float* kscale2, LAS float* scr, int item, int lane) {
    const int nblk = N / 64, kb = item / nblk, nb = item % nblk, k0 = 64 * kb, n0 = 64 * nb;
    float v[64];
#pragma unroll
    for (int i = 0; i < 64; ++i) v[i] = W[(size_t)(k0 + i) * N + n0 + lane];
    if (kscale) { const float* ks = (kscale2 && k0 >= 512) ? kscale2 - 512 : kscale;
#pragma unroll
        for (int i = 0; i < 64; ++i) v[i] *= ks[k0 + i]; }
#pragma unroll
    for (int i = 0; i < 64; ++i) scr[i * 65 + lane] = v[i];
    LDS_WAIT(); asm volatile("" ::: "memory");
    const int c = lane & 7;
#pragma unroll
    for (int j = 0; j < 8; ++j) { const int n = (lane >> 3) + 8 * j; const LAS float* sp = scr + (8 * c) * 65 + n;
        u32x4 o; o.x = cvt_pk_bf16(sp[0 * 65], sp[1 * 65]); o.y = cvt_pk_bf16(sp[2 * 65], sp[3 * 65]); o.z = cvt_pk_bf16(sp[4 * 65], sp[5 * 65]); o.w = cvt_pk_bf16(sp[6 * 65], sp[7 * 65]);
        *(u32x4*)(WT + (size_t)(row_off + map_n(mode, n0 + n)) * K + k0 + 8 * c) = o; }
    LDS_WAIT(); asm volatile("" ::: "memory");
}
template <int R, bool NORM>
__device__ __forceinline__ void rms_rows_to_bf16(const float* xrow, const float* g, bf16_t* orow, float* ssq_out, int lane) {
    f32x4 v[R][4]; float s[R];
#pragma unroll
    for (int r = 0; r < R; ++r)
#pragma unroll
        for (int j = 0; j < 4; ++j) v[r][j] = ((const f32x4*)(xrow + (size_t)r * DM) + lane)[64 * j];
    f32x4 gg[4];
#pragma unroll
    for (int j = 0; j < 4; ++j) gg[j] = ((const f32x4*)g + lane)[64 * j];
#pragma unroll
    for (int r = 0; r < R; ++r) { float q = 0.f;
#pragma unroll
        for (int j = 0; j < 4; ++j) q += (v[r][j].x * v[r][j].x + v[r][j].y * v[r][j].y) + (v[r][j].z * v[r][j].z + v[r][j].w * v[r][j].w);
        s[r] = q; }
#pragma unroll
    for (int o = 1; o < 64; o <<= 1)
#pragma unroll
        for (int r = 0; r < R; ++r) s[r] += __shfl_xor(s[r], o);
#pragma unroll
    for (int r = 0; r < R; ++r) { const float rs = NORM ? __builtin_amdgcn_rsqf(s[r] * (1.f / DM) + EPS) : 1.f; u32x2* o8 = (u32x2*)(orow + (size_t)r * DM) + lane;
        if (!NORM) { if (lane == 0) ssq_out[r] = s[r];
#pragma unroll
            for (int j = 0; j < 4; ++j) gg[j] = (f32x4){1.f, 1.f, 1.f, 1.f}; }
#pragma unroll
        for (int j = 0; j < 4; ++j) { u32x2 w; w.x = cvt_pk_bf16(v[r][j].x * rs * gg[j].x, v[r][j].y * rs * gg[j].y); w.y = cvt_pk_bf16(v[r][j].z * rs * gg[j].z, v[r][j].w * rs * gg[j].w); o8[64 * j] = w; } }
}
__device__ __forceinline__ void resid_row(const float* pre, const float* hold, const float* gpost, float* hout, const float* gnext, bf16_t* xn, int lane) {
    const f32x4* pr = (const f32x4*)pre + lane; const f32x4* hr = (const f32x4*)hold + lane; const f32x4* gp = (const f32x4*)gpost + lane;
    f32x4 v[4]; float s = 0.f;
#pragma unroll
    for (int j = 0; j < 4; ++j) { v[j] = pr[64 * j]; s += (v[j].x * v[j].x + v[j].y * v[j].y) + (v[j].z * v[j].z + v[j].w * v[j].w); }
    const float rs = __builtin_amdgcn_rsqf(wave_sum(s) * (1.f / DM) + EPS);
    float s2 = 0.f;
#pragma unroll
    for (int j = 0; j < 4; ++j) { const f32x4 h = hr[64 * j], g = gp[64 * j]; v[j] = h + v[j] * rs * g; s2 += (v[j].x * v[j].x + v[j].y * v[j].y) + (v[j].z * v[j].z + v[j].w * v[j].w); }
    f32x4* ho = (f32x4*)hout + lane;
#pragma unroll
    for (int j = 0; j < 4; ++j) ho[64 * j] = v[j];
    if (xn) { const float rs2 = __builtin_amdgcn_rsqf(wave_sum(s2) * (1.f / DM) + EPS); const f32x4* gn = (const f32x4*)gnext + lane; u32x2* o8 = (u32x2*)xn + lane;
#pragma unroll
        for (int j = 0; j < 4; ++j) { const f32x4 gg = gn[64 * j]; u32x2 w; w.x = cvt_pk_bf16(v[j].x * rs2 * gg.x, v[j].y * rs2 * gg.y); w.y = cvt_pk_bf16(v[j].z * rs2 * gg.z, v[j].w * rs2 * gg.w); o8[64 * j] = w; } }
}

namespace lru {
constexpr int TT = 128, NTILE = SEQ / TT, UP = 72;
constexpr int L_U = 0, L_UF = L_U + TT * UP * 2, L_WSEG = L_UF + TT * 33 * 4, L_CARRY = L_WSEG + 2 * 8 * 32 * 8, L_TSS = L_CARRY + 2 * 32 * 4, L_END = L_TSS + 2 * TT * 4;
static_assert(L_END <= RING_BYTES, "lru lds");
__device__ __forceinline__ float sigmoidf_(float x) { return __builtin_amdgcn_rcpf(1.f + __builtin_amdgcn_exp2f(-x * LOG2E)); }
__device__ __forceinline__ void unit(int b, int cb, const bf16_t* Z, bf16_t* Y, float* ssq_lru, const float* conv_w, const float* conv_b, const float* wa, const float* ba, const float* wx, const float* bx,
                                     const float* lam, LAS unsigned char* lds, const int wv) {
    const int lane = lane_id(), wid = wv, tid = wv * 64 + lane;
    const int hblk = cb >> 1, half = cb & 1, ib = hblk * 64, c0 = cb * 32;
    LAS bf16_t* U = (LAS bf16_t*)(lds + L_U); LAS float* UF = (LAS float*)(lds + L_UF); LAS f32x2* WSEG = (LAS f32x2*)(lds + L_WSEG);
    LAS float* CARRY = (LAS float*)(lds + L_CARRY); LAS float* TSS = (LAS float*)(lds + L_TSS);
    const int col = lane & 15, kq = lane >> 4;
    bf16x8 Bf[4][2];
#pragma unroll
    for (int nb = 0; nb < 4; ++nb)
#pragma unroll
        for (int ks = 0; ks < 2; ++ks) { const float* Wg = (nb < 2) ? wa : wx; const int oc = half * 32 + (nb & 1) * 16 + col; float w[8];
#pragma unroll
            for (int j = 0; j < 8; ++j) w[j] = Wg[((size_t)hblk * 64 + ks * 32 + 8 * kq + j) * 64 + oc];
            u32x4 p; p.x = cvt_pk_bf16(w[0], w[1]); p.y = cvt_pk_bf16(w[2], w[3]); p.z = cvt_pk_bf16(w[4], w[5]); p.w = cvt_pk_bf16(w[6], w[7]); Bf[nb][ks] = __builtin_bit_cast(bf16x8, p); }
    float cba[2], cbx[2], csp[2];
#pragma unroll
    for (int e = 0; e < 2; ++e) { const int ch = c0 + e * 16 + col; cba[e] = ba[ch]; cbx[e] = bx[ch]; const float l = lam[ch];
        csp[e] = 8.f * LOG2E * (fmaxf(-l, 0.f) + log1pf(expf(-fabsf(l)))); }
    const int cch = lane;
    const float cw0 = conv_w[0 * DLRU + ib + cch], cw1 = conv_w[1 * DLRU + ib + cch], cw2 = conv_w[2 * DLRU + ib + cch], cw3 = conv_w[3 * DLRU + ib + cch], cbb = conv_b[ib + cch];
    if (tid < 64) CARRY[tid] = 0.f;
    if (tid < 2 * TT) TSS[tid] = 0.f;
    const size_t rowb = (size_t)b * SEQ;
    const bf16_t* zx = Z + (rowb + wid * 16) * DINP + ib + cch;
    const bf16_t* zg = Z + (rowb + wid * 16 + kq * 4) * DINP + OFF_GATE + c0 + col;
    bf16_t* yp = Y + (rowb + wid * 16 + kq * 4) * DM + c0 + col;
    unsigned short xr[19], gr[8];
#define LRU_LOADX(t0_) do { _Pragma("unroll") for (int k = 0; k < 19; ++k) { const int tk = (t0_) + wid * 16 + k - 3; xr[k] = (tk >= 0) ? zx[(ptrdiff_t)((t0_) + k - 3) * DINP] : (unsigned short)0; } } while (0)
    LRU_LOADX(0);
    __syncthreads();
    for (int tile = 0; tile < NTILE; ++tile) {
        const int t0 = tile * TT, par = tile & 1;
        { float xm3 = bf2f(xr[0]), xm2 = bf2f(xr[1]), xm1 = bf2f(xr[2]);
#pragma unroll
          for (int k = 0; k < 16; ++k) { const float x0 = bf2f(xr[3 + k]); const float u = cbb + cw0 * xm3 + cw1 * xm2 + cw2 * xm1 + cw3 * x0; xm3 = xm2; xm2 = xm1; xm1 = x0;
              const int tl = wid * 16 + k; U[tl * UP + cch] = (bf16_t)(cvt_pk_bf16(u, 0.f) & 0xffffu);
              if ((cch >> 5) == half) UF[tl * 33 + (cch & 31)] = u; } }
#pragma unroll
        for (int e = 0; e < 2; ++e)
#pragma unroll
            for (int r = 0; r < 4; ++r) gr[e * 4 + r] = zg[(size_t)(t0 + r) * DINP + e * 16];
        if (tile + 1 < NTILE) LRU_LOADX(t0 + TT);
        LDS_WAIT();
        float av[2][4], uv[2][4], Ainc[2], Hinc[2];
        { f32x4 C[4];
#pragma unroll
          for (int nb = 0; nb < 4; ++nb) C[nb] = (f32x4){0.f, 0.f, 0.f, 0.f};
          const LAS bf16_t* ua = U + (wid * 16 + col) * UP + 8 * kq;
          const bf16x8 a0 = *(const LAS bf16x8*)ua, a1 = *(const LAS bf16x8*)(ua + 32);
#pragma unroll
          for (int nb = 0; nb < 4; ++nb) { C[nb] = __builtin_amdgcn_mfma_f32_16x16x32_bf16(a0, Bf[nb][0], C[nb], 0, 0, 0); C[nb] = __builtin_amdgcn_mfma_f32_16x16x32_bf16(a1, Bf[nb][1], C[nb], 0, 0, 0); }
#pragma unroll
          for (int e = 0; e < 2; ++e) { float Ap = 1.f, H = 0.f;
#pragma unroll
              for (int r = 0; r < 4; ++r) { const int tl = wid * 16 + kq * 4 + r, ch = e * 16 + col;
                  const float rg = sigmoidf_(C[e][r] + cba[e]), ig = sigmoidf_(C[e + 2][r] + cbx[e]);
                  const float a = __builtin_amdgcn_exp2f(-rg * csp[e]); const float mult = __builtin_amdgcn_sqrtf(fmaxf(1.f - a * a, 0.f));
                  const float uu = mult * ig * UF[tl * 33 + ch];
                  av[e][r] = a; uv[e][r] = uu; H = a * H + uu; Ap *= a; }
              { const float Ap1 = __shfl_up(Ap, 16), H1 = __shfl_up(H, 16); if (kq >= 1) { H = Ap * H1 + H; Ap = Ap * Ap1; } }
              { const float Ap2 = __shfl_up(Ap, 32), H2 = __shfl_up(H, 32); if (kq >= 2) { H = Ap * H2 + H; Ap = Ap * Ap2; } }
              Ainc[e] = Ap; Hinc[e] = H;
              if (kq == 3) WSEG[(par * 8 + wid) * 32 + e * 16 + col] = (f32x2){Ap, H}; } }
        __syncthreads();
        if (tid < TT) { const float v = TSS[(par ^ 1) * TT + tid]; if (tile > 0) atomicAdd(ssq_lru + rowb + t0 - TT + tid, v); }
        float qs[4] = {0.f, 0.f, 0.f, 0.f};
#pragma unroll
        for (int e = 0; e < 2; ++e) { const int ch = e * 16 + col;
            float h = CARRY[par * 32 + ch];
            for (int w2 = 0; w2 < wid; ++w2) { const f32x2 sg = WSEG[(par * 8 + w2) * 32 + ch]; h = sg.x * h + sg.y; }
            if (wid == 7 && kq == 0) { const f32x2 sg = WSEG[(par * 8 + 7) * 32 + ch]; CARRY[(par ^ 1) * 32 + ch] = sg.x * h + sg.y; }
            const float Ae = __shfl_up(Ainc[e], 16), He = __shfl_up(Hinc[e], 16);
            if (kq >= 1) h = Ae * h + He;
#pragma unroll
            for (int r = 0; r < 4; ++r) { h = av[e][r] * h + uv[e][r]; const float g = bf2f(gr[e * 4 + r]);
                const float ge = g * __builtin_amdgcn_rcpf(1.f + __builtin_amdgcn_exp2f(-1.5957691216057308f * LOG2E * (g + 0.044715f * g * g * g)));
                const float y = h * ge; yp[(size_t)(t0 + r) * DM + e * 16] = (bf16_t)(cvt_pk_bf16(y, 0.f) & 0xffffu); qs[r] += y * y; } }
#pragma unroll
        for (int r = 0; r < 4; ++r) { float q = qs[r]; q += __shfl_xor(q, 1); q += __shfl_xor(q, 2); q += __shfl_xor(q, 4); q += __shfl_xor(q, 8);
            if (col == 0) TSS[par * TT + wid * 16 + kq * 4 + r] = q; }
    }
    __syncthreads();
    if (tid < TT) atomicAdd(ssq_lru + rowb + (NTILE - 1) * TT + tid, TSS[((NTILE - 1) & 1) * TT + tid]);
    __syncthreads();
#undef LRU_LOADX
}
}

namespace mla {
constexpr int NW = 8, QBLK = 32, KVBLK = 64, QB = 256, KROW = 384, SHM_K = KVBLK * KROW, SHM_V = KVBLK * 128 * 2;
constexpr int L_V = 0, L_K = 2 * SHM_V, L_WS = L_K + 2 * SHM_K, L_END = L_WS + NW * 64 * 4;
static_assert(L_END <= RING_BYTES && NW * 8192 <= L_WS, "mla lds");
#define KSWZ(row, colB) ((row) * KROW + ((colB) ^ ((((row) >> 1) & 7) << 4)))
#define SBAR() __builtin_amdgcn_sched_barrier(0)
__device__ __forceinline__ int v_st(int k, int c) { const int kk = (k & ~0xC) | ((k & 4) << 1) | ((k & 8) >> 1); return ((kk >> 3) * 4 + (c >> 5)) * 512 + ((kk & 7) * 32 + (c & 31)) * 2; }
__device__ __forceinline__ int v_rd_base(int lane) { return ((lane & 3) << 3) | (((lane >> 2) & 3) << 6) | (((lane >> 4) & 1) << 5) | (((lane >> 5) & 1) << 8); }
constexpr int v_rd_off(int d0, int ks, int half) { return d0 * 512 + ks * 4096 + half * 2048; }
__device__ __forceinline__ int crow(int r, int hi) { return (r & 3) + 8 * (r >> 2) + 4 * hi; }
__device__ __forceinline__ void mask_tile(f32x16& p0, f32x16& p1, int dq) {
    const float NEG = -__builtin_inff();
#pragma unroll
    for (int r = 0; r < 16; ++r) { const int c = (r & 3) + 8 * (r >> 2); if (dq - c < 0) p0[r] = NEG; if (dq - c - 32 < 0) p1[r] = NEG; }
}
constexpr float THR2 = 8.f * LOG2E;
__device__ __forceinline__ void partialSM(f32x16& p0, f32x16& p1, float& m_reg, float& alpha) {
    float pmax = p0[0];
#pragma unroll
    for (int r = 1; r < 16; ++r) pmax = fmaxf(pmax, p0[r]);
#pragma unroll
    for (int r = 0; r < 16; ++r) pmax = fmaxf(pmax, p1[r]);
    { auto rr = __builtin_amdgcn_permlane32_swap(__float_as_uint(pmax), __float_as_uint(pmax), false, false); pmax = fmaxf(__uint_as_float(rr[0]), __uint_as_float(rr[1])); }
    float mn;
    if (__builtin_expect(__all((pmax - m_reg) <= THR2), 1)) { mn = m_reg; alpha = 1.f; }
    else { mn = fmaxf(m_reg, pmax); alpha = __builtin_amdgcn_exp2f(m_reg - mn); m_reg = mn; }
#pragma unroll
    for (int r = 0; r < 16; ++r) p0[r] = p0[r] - mn;
#pragma unroll
    for (int r = 0; r < 16; ++r) p1[r] = p1[r] - mn;
#pragma unroll
    for (int r = 0; r < 16; ++r) p0[r] = __builtin_amdgcn_exp2f(p0[r]);
}
__device__ __forceinline__ void finishSM(f32x16& p0, f32x16& p1, float alpha, float& l_reg, bf16x8& pa0, bf16x8& pa1, bf16x8& pa2, bf16x8& pa3) {
#pragma unroll
    for (int r = 0; r < 16; ++r) p1[r] = __builtin_amdgcn_exp2f(p1[r]);
    float ps = 0;
#pragma unroll
    for (int r = 0; r < 16; ++r) ps += p0[r];
#pragma unroll
    for (int r = 0; r < 16; ++r) ps += p1[r];
    { auto rr = __builtin_amdgcn_permlane32_swap(__float_as_uint(ps), __float_as_uint(ps), false, false); ps = __uint_as_float(rr[0]) + __uint_as_float(rr[1]); }
    l_reg = l_reg * alpha + ps;
#define PK4(P, B_, OUT) do { unsigned a0 = cvt_pk_bf16(P[B_+0], P[B_+1]), a1 = cvt_pk_bf16(P[B_+2], P[B_+3]);                          \
        unsigned b0 = cvt_pk_bf16(P[B_+4], P[B_+5]), b1 = cvt_pk_bf16(P[B_+6], P[B_+7]);                                             \
        auto r0 = __builtin_amdgcn_permlane32_swap(a0, b0, false, false); auto r1 = __builtin_amdgcn_permlane32_swap(a1, b1, false, false); \
        u32x4 w = {r0[0], r1[0], r0[1], r1[1]}; OUT = __builtin_bit_cast(bf16x8, w); } while (0)
    PK4(p0, 0, pa0); PK4(p0, 8, pa1); PK4(p1, 0, pa2); PK4(p1, 8, pa3);
#undef PK4
}
template <int KB>
__device__ __forceinline__ void qkt(f32x16& p0, f32x16& p1, const char* K_lds, int r32, int hi, const bf16x8* qr) {
    p0 = f32x16{}; p1 = f32x16{};
    const char* kb[4];
#pragma unroll
    for (int dd = 0; dd < 4; ++dd) kb[dd] = K_lds + KB * SHM_K + KSWZ(r32, (dd * 16 + hi * 8) * 2);
#pragma unroll
    for (int d0 = 0; d0 < 12; ++d0) { const char* a = kb[d0 & 3] + (d0 >> 2) * 128;
        bf16x8 b0 = *reinterpret_cast<const bf16x8*>(a);
        bf16x8 b1 = *reinterpret_cast<const bf16x8*>(a + 32 * KROW);
        p0 = __builtin_amdgcn_mfma_f32_32x32x16_bf16(b0, qr[d0], p0, 0, 0, 0);
        p1 = __builtin_amdgcn_mfma_f32_32x32x16_bf16(b1, qr[d0], p1, 0, 0, 0); }
}
template <int VB>
__device__ __forceinline__ void pv_tile(f32x16* o, int vb0, bf16x8 pa0, bf16x8 pa1, bf16x8 pa2, bf16x8 pa3) {
#define TRRD(dst, off) asm volatile("ds_read_b64_tr_b16 %0, %1 offset:%2" : "=&v"(dst) : "v"(vb0), "i"(off) : "memory")
#define PV_D0(d0) do { s16x4 l0, l1, l2, l3, h0, h1, h2, h3; constexpr int b_ = VB * SHM_V + v_rd_off(d0, 0, 0); \
        TRRD(l0, b_); TRRD(h0, b_ + 2048); TRRD(l1, b_ + 4096); TRRD(h1, b_ + 6144); TRRD(l2, b_ + 8192); TRRD(h2, b_ + 10240); TRRD(l3, b_ + 12288); TRRD(h3, b_ + 14336); \
        asm volatile("s_waitcnt lgkmcnt(0)" ::: "memory"); SBAR(); \
        o[d0] = __builtin_amdgcn_mfma_f32_32x32x16_bf16(pa0, (bf16x8){l0[0], l0[1], l0[2], l0[3], h0[0], h0[1], h0[2], h0[3]}, o[d0], 0, 0, 0);   \
        o[d0] = __builtin_amdgcn_mfma_f32_32x32x16_bf16(pa1, (bf16x8){l1[0], l1[1], l1[2], l1[3], h1[0], h1[1], h1[2], h1[3]}, o[d0], 0, 0, 0);   \
        o[d0] = __builtin_amdgcn_mfma_f32_32x32x16_bf16(pa2, (bf16x8){l2[0], l2[1], l2[2], l2[3], h2[0], h2[1], h2[2], h2[3]}, o[d0], 0, 0, 0);   \
        o[d0] = __builtin_amdgcn_mfma_f32_32x32x16_bf16(pa3, (bf16x8){l3[0], l3[1], l3[2], l3[3], h3[0], h3[1], h3[2], h3[3]}, o[d0], 0, 0, 0); } while (0)
    PV_D0(0); PV_D0(1); PV_D0(2); PV_D0(3);
#undef PV_D0
#undef TRRD
}
__device__ __forceinline__ void block(int b, int h, int qb, const bf16_t* Qb, const bf16_t* KVb, const bf16_t* KPE, bf16_t* Y, float* ssq_mla, char* lds, const int wv) {
    const int lane = lane_id(), wid = wv, tid = wv * 64 + lane, r32 = lane & 31, hi = lane >> 5;
    const size_t rowbase = (size_t)b * SEQ; const int q0 = qb * QB; const int NT = (q0 + QB) / KVBLK;
    const int qlo = q0 + wid * QBLK, qm = qlo + r32 - 4 * hi;
    char* V_lds = lds + L_V; char* K_lds = lds + L_K;
    float* ws = (float*)(lds + L_WS) + wid * 64; float* li_l = ws, * al_l = ws + 32;
    float m_reg = -1e30f, l_reg = 0; f32x16 o[4] = {};
    const int sr = tid >> 4, scc = (tid & 15) * 8, vst0 = v_st(sr, scc), vst1 = v_st(32 + sr, scc), kws = KSWZ(sr, (tid & 15) * 16);
    const int pr = tid >> 3, kws2 = KSWZ(pr, 256 + (tid & 7) * 16);
    const int vb0 = (int)(uintptr_t)V_lds + v_rd_base(lane);
    const bf16_t* Kn = KVb + rowbase * 1024 + h * 128 + scc;
    const bf16_t* Vn = KVb + rowbase * 1024 + 512 + h * 128 + scc;
    const bf16_t* Kp = KPE + rowbase * 64 + (tid & 7) * 8;
    bf16x8 qr[12];
    { const bf16_t* qp = Qb + (rowbase + q0 + wid * QBLK + r32) * 768;
#pragma unroll
      for (int d0 = 0; d0 < 8; ++d0) qr[d0] = *(const bf16x8*)(qp + h * 128 + d0 * 16 + hi * 8);
#pragma unroll
      for (int d0 = 0; d0 < 4; ++d0) qr[8 + d0] = *(const bf16x8*)(qp + 512 + h * 64 + d0 * 16 + hi * 8); }
    const int grp = wid >> 2;
    bf16x8 st_v0, st_v1, st_k0, st_k1, st_k2;
#define SLOADK(t) do { const size_t k0_ = (size_t)(t) * KVBLK; st_k0 = *(const bf16x8*)(Kn + (k0_ + sr) * 1024); st_k1 = *(const bf16x8*)(Kn + (k0_ + 32 + sr) * 1024); st_k2 = *(const bf16x8*)(Kp + (k0_ + pr) * 64); } while (0)
#define SLOADV(t) do { const size_t k0_ = (size_t)(t) * KVBLK; st_v0 = *(const bf16x8*)(Vn + (k0_ + sr) * 1024); st_v1 = *(const bf16x8*)(Vn + (k0_ + 32 + sr) * 1024); } while (0)
#define SWRITEK(off) do { *(bf16x8*)(K_lds + (off) + kws) = st_k0; *(bf16x8*)(K_lds + (off) + kws + 32 * KROW) = st_k1; *(bf16x8*)(K_lds + (off) + kws2) = st_k2; } while (0)
#define SWRITEV(off) do { *(bf16x8*)(V_lds + (off) + vst0) = st_v0; *(bf16x8*)(V_lds + (off) + vst1) = st_v1; } while (0)
#define BAR() asm volatile("s_waitcnt lgkmcnt(0)\n\ts_barrier" ::: "memory")
#define RESC(a) do { if (__any((a) < 1.f)) { if (hi == 0) al_l[r32] = (a); asm volatile("s_waitcnt lgkmcnt(0)" ::: "memory");              \
                     for (int d_ = 0; d_ < 4; ++d_) for (int r = 0; r < 16; ++r) o[d_][r] *= al_l[crow(r, hi)]; } } while (0)
#define MASKT(P0_, P1_, t) do { const int kb_ = (t) * KVBLK; if (kb_ + KVBLK - 1 > qlo) mask_tile(P0_, P1_, qm - kb_); } while (0)
    f32x16 p0, p1; float al; bf16x8 pa0, pa1, pa2, pa3;
    SLOADK(0); VM_WAIT(); SWRITEK(0);
    if (grp) { SLOADK(1); SLOADV(0); }
    BAR();
    if (grp) { VM_WAIT(); SWRITEK(SHM_K); SWRITEV(0); BAR(); }
#define SMSLOT(t, tk, tv) do { if ((tk) < NT || (tv) < NT) { VM_WAIT(); if ((tk) < NT) SWRITEK(((tk) & 1) * SHM_K); if ((tv) < NT) SWRITEV(((tv) & 1) * SHM_V); } \
        MASKT(p0, p1, (t)); partialSM(p0, p1, m_reg, al); RESC(al); finishSM(p0, p1, al, l_reg, pa0, pa1, pa2, pa3); SBAR(); } while (0)
    { const int tk = 1 + grp, tv = grp;
      SLOADK(tk); SLOADV(tv); SBAR(); qkt<0>(p0, p1, K_lds, r32, hi, qr); SBAR();
      BAR(); SMSLOT(0, tk, tv); BAR(); }
    for (int i = 0; i < NT; i += 2) {
        { const int tk = i + 2 + grp, tv = i + 1 + grp;
          if (tk < NT) SLOADK(tk); if (tv < NT) SLOADV(tv); SBAR();
          qkt<1>(p0, p1, K_lds, r32, hi, qr); SBAR(); pv_tile<0>(o, vb0, pa0, pa1, pa2, pa3); SBAR();
          BAR(); SMSLOT(i + 1, tk, tv); BAR(); }
        { const int tk = i + 3 + grp, tv = i + 2 + grp;
          if (tk < NT) SLOADK(tk); if (tv < NT) SLOADV(tv); SBAR();
          if (i + 2 < NT) { qkt<0>(p0, p1, K_lds, r32, hi, qr); SBAR(); }
          pv_tile<1>(o, vb0, pa0, pa1, pa2, pa3); SBAR();
          BAR(); if (i + 2 < NT) SMSLOT(i + 2, tk, tv); BAR(); }
    }
    if (!grp) BAR();
#undef SMSLOT
#undef SLOADK
#undef SLOADV
#undef SWRITEK
#undef SWRITEV
#undef BAR
    if (hi == 0) li_l[r32] = l_reg; asm volatile("s_waitcnt lgkmcnt(0)" ::: "memory");
    float rli[16];
#pragma unroll
    for (int r = 0; r < 16; ++r) rli[r] = __builtin_amdgcn_rcpf(li_l[crow(r, hi)]);
    { bf16_t* stg = (bf16_t*)lds + wid * 4096;
#pragma unroll
      for (int r = 0; r < 16; ++r) { const int orow = crow(r, hi);
#pragma unroll
          for (int d0 = 0; d0 < 4; ++d0) stg[orow * 128 + d0 * 32 + r32] = (bf16_t)(cvt_pk_bf16(o[d0][r] * rli[r], 0.f) & 0xffffu); }
      asm volatile("s_waitcnt lgkmcnt(0)" ::: "memory");
      const int row = lane >> 1, hf = lane & 1; float q = 0.f;
      bf16_t* yp = Y + (rowbase + q0 + wid * QBLK + row) * DM + 512 + h * 128 + hf * 64;
#pragma unroll
      for (int j = 0; j < 8; ++j) { const u32x4 v = *(const u32x4*)(stg + row * 128 + hf * 64 + j * 8);
          q += bflo(v.x) * bflo(v.x) + bfhi(v.x) * bfhi(v.x) + bflo(v.y) * bflo(v.y) + bfhi(v.y) * bfhi(v.y) + bflo(v.z) * bflo(v.z) + bfhi(v.z) * bfhi(v.z) + bflo(v.w) * bflo(v.w) + bfhi(v.w) * bfhi(v.w);
          *(u32x4*)(yp + j * 8) = v; }
      q += __shfl_xor(q, 1);
      if (hf == 0) atomicAdd(ssq_mla + rowbase + q0 + wid * QBLK + row, q); }
    __syncthreads();
#undef RESC
#undef MASKT
}
#undef KSWZ
#undef SBAR
}

constexpr int NWAVES = 8, NPHASE = 13;
struct Args { const void* in[32]; float* out; unsigned char* ws; int ph_lo, ph_hi; };

__global__ void __launch_bounds__(NWAVES * 64, 2) hymba_fwd(Args args) {
    extern __shared__ __attribute__((aligned(16))) unsigned char lds_raw[];
    LAS unsigned char* lds = (LAS unsigned char*)lds_raw;
    volatile LAS unsigned* MISC = (volatile LAS unsigned*)(lds + MISC_OFF);
    const int G = gridDim.x, bx = blockIdx.x, vcu = (G % 8 == 0) ? (bx % 8) * (G / 8) + bx / 8 : bx;
    const int wave_s = __builtin_amdgcn_readfirstlane((int)threadIdx.x >> 6);
#define lane (lane_id())
#define tid (wave_s * 64 + lane)
#define wave (wave_s)
#define gw (vcu * NWAVES + wave)
#define NGW (G * NWAVES)
    unsigned char* ws = args.ws;
#define x_in ((const float*)args.in[0])
#define mem ((const float*)args.in[1])
#define positions ((const int*)args.in[2])
#define g_pre_mix ((const float*)args.in[3])
#define w_in ((const float*)args.in[4])
#define conv_w ((const float*)args.in[5])
#define conv_b ((const float*)args.in[6])
#define lru_wa ((const float*)args.in[7])
#define lru_ba ((const float*)args.in[8])
#define lru_wx ((const float*)args.in[9])
#define lru_bx ((const float*)args.in[10])
#define lru_lambda ((const float*)args.in[11])
#define g_q_lat ((const float*)args.in[12])
#define w_uq ((const float*)args.in[13])
#define g_kv_lat ((const float*)args.in[14])
#define w_ukv ((const float*)args.in[15])
#define g_lru_out ((const float*)args.in[16])
#define g_mla_out ((const float*)args.in[17])
#define w_out ((const float*)args.in[18])
#define g_post_mix ((const float*)args.in[19])
#define g_pre_mem ((const float*)args.in[20])
#define g_mem_kv ((const float*)args.in[21])
#define w_mq ((const float*)args.in[22])
#define w_mk ((const float*)args.in[23])
#define w_mv ((const float*)args.in[24])
#define w_mo ((const float*)args.in[25])
#define g_post_mem ((const float*)args.in[26])
#define g_pre_ffn ((const float*)args.in[27])
#define w_gate ((const float*)args.in[28])
#define w_up ((const float*)args.in[29])
#define w_down ((const float*)args.in[30])
#define g_post_ffn ((const float*)args.in[31])
#define out_p (args.out)
#define ctl ((unsigned*)(ws + WS_CTL))
#define ssq_cq ((float*)(ws + WS_SSQ))
#define ssq_ckv (ssq_cq + T)
#define ssq_lru (ssq_cq + 2 * T)
#define ssq_mla (ssq_cq + 3 * T)
#define ssq_h1 (ssq_cq + 4 * T)
#define ssq_h2 (ssq_cq + 5 * T)
#define ssq_x (ssq_cq + 6 * T)
#define ssq_dummy (ssq_cq + 7 * T)
#define slots_p ((float*)(ws + WS_SLOTS))
#define cosT ((float*)(ws + WS_ROPE))
#define sinT (cosT + (size_t)T * 32)
#define Win_t ((bf16_t*)(ws + WS_WIN))
#define Wuq_t ((bf16_t*)(ws + WS_WUQ))
#define Wukv_t ((bf16_t*)(ws + WS_WUKV))
#define Wout_t ((bf16_t*)(ws + WS_WOUT))
#define Wmq_b ((bf16_t*)(ws + WS_WMQ))
#define Wmkv_t ((bf16_t*)(ws + WS_WMKV))
#define Wmo_t ((bf16_t*)(ws + WS_WMO))
#define Wgu_t ((bf16_t*)(ws + WS_WGU))
#define Wdown_t ((bf16_t*)(ws + WS_WDOWN))
#define MN ((bf16_t*)(ws + WS_MN))
#define MKV ((bf16_t*)(ws + WS_MKV))
#define WQK ((bf16_t*)(ws + WS_WQK))
#define WVO ((bf16_t*)(ws + WS_WVO))
#define XN ((bf16_t*)(ws + WS_XN))
#define KPE ((bf16_t*)(ws + WS_KPE))
#define Z ((bf16_t*)(ws + WS_Z))
#define Qb ((bf16_t*)(ws + WS_Q))
#define KVb ((bf16_t*)(ws + WS_KV))
#define Y ((bf16_t*)(ws + WS_Y))
#define PRE ((float*)(ws + WS_PRE))
#define Pb ((bf16_t*)(ws + WS_P))
#define Fb ((bf16_t*)(ws + WS_F))
    for (int u = tid; u < 256; u += NWAVES * 64) ((LAS unsigned*)(lds + MISC_OFF))[u] = 0u;
    __syncthreads();
    XcdBarrier bar = xcd_barrier_post(ctl + CW_BAR, MISC + 8, (unsigned)G);
    const bool grouped = (G == 256);
    XcdBarrier gbar = grouped ? xcd_barrier_post(ctl + CW_BAR + XCD_BAR_WORDS * (1 + (bx & 7)), MISC + 10, (unsigned)(G >> 3)) : bar;
    const int lo = args.ph_lo, hi = args.ph_hi;
#ifndef REP_PHASE
#define REP_PHASE -1
#endif
#define REPS(k) for (int rep = 0; rep < ((REP_PHASE) == (k) ? 2 : 1); ++rep)
#define RSQ(p) (rep ? ssq_dummy : (p))
#ifndef PHASE_MASK
#define PHASE_MASK 0x1fff
#endif
#define IN(k) (((PHASE_MASK >> (k)) & 1) && lo <= (k) && (k) < hi)
#ifndef ALIGN_P10
#define ALIGN_P10 true
#endif
#ifndef EXTRA_BAR
#define EXTRA_BAR 0
#endif
#define SEAM(k) do { if (IN(k) && IN((k) + 1)) { if ((k) == 0 || !grouped) xcd_barrier(bar, wave_s); else xcd_barrier(gbar, wave_s); } } while (0)

    if (IN(0)) REPS(0) {
        LAS float* scr = (LAS float*)(lds + wave * 16640);
        constexpr int I_IN = 16 * 27, I_UQ = 6 * 12, I_UKV = 4 * 16, I_SQ = 16 * 16, I_GU = 16 * 44, I_DN = 44 * 16;
        int cum = 0;
#define P0_JOB(W, K_, N_, WT, ROFF, MODE, KS, KS2, CNT) do { for (int it = (gw + NGW - (cum % NGW)) % NGW; it < (CNT); it += NGW) p0_transpose_item(W, K_, N_, WT, ROFF, MODE, KS, KS2, scr, it, lane); cum += (CNT); } while (0)
        P0_JOB(w_in, DM, 1728, Win_t, 0, MAP_WIN, g_pre_mix, nullptr, I_IN);
        P0_JOB(w_uq, QLR, 768, Wuq_t, 0, MAP_WUQ, g_q_lat, nullptr, I_UQ);
        P0_JOB(w_ukv, KVLR, 1024, Wukv_t, 0, MAP_WUKV, g_kv_lat, nullptr, I_UKV);
        P0_JOB(w_out, DM, DM, Wout_t, 0, MAP_ID, g_lru_out, g_mla_out, I_SQ);
        P0_JOB(w_mk, DM, DM, Wmkv_t, 0, MAP_ID, nullptr, nullptr, I_SQ);
        P0_JOB(w_mv, DM, DM, Wmkv_t, 1024, MAP_ID, nullptr, nullptr, I_SQ);
        P0_JOB(w_mo, DM, DM, Wmo_t, 0, MAP_ID, nullptr, nullptr, I_SQ);
        P0_JOB(w_gate, DM, DFF, Wgu_t, 0, MAP_GATE, g_pre_ffn, nullptr, I_GU);
        P0_JOB(w_up, DM, DFF, Wgu_t, 0, MAP_UP, g_pre_ffn, nullptr, I_GU);
        P0_JOB(w_down, DFF, DM, Wdown_t, 0, MAP_ID, nullptr, nullptr, I_DN);
#undef P0_JOB
        const int gt = vcu * (NWAVES * 64) + tid, NGT = G * NWAVES * 64;
        for (int i = gt; i < 64 * 1024 / 8; i += NGT) *(u32x4*)(Win_t + (size_t)1728 * 1024 + (size_t)i * 8) = (u32x4){0u, 0u, 0u, 0u};
        for (int i = gt; i < DM * DM / 4; i += NGT) { const f32x4 v = *(const f32x4*)(w_mq + (size_t)i * 4) * g_pre_mem[i >> 8]; u32x2 w; w.x = cvt_pk_bf16(v.x, v.y); w.y = cvt_pk_bf16(v.z, v.w); *(u32x2*)(Wmq_b + (size_t)i * 4) = w; }
        for (int i = gt; i < T * 32; i += NGT) { const int row = i >> 5, k = i & 31; const double invf = exp2(-(double)k * (13.287712379549449 / 32.0));
            const double rev = (double)positions[row] * invf * 0.15915494309189535; const float fr_ = (float)(rev - rint(rev)); cosT[i] = __builtin_amdgcn_cosf(fr_); sinT[i] = __builtin_amdgcn_sinf(fr_); }
        for (int m = gw * 4; m < T; m += NGW * 4) rms_rows_to_bf16<4, false>(x_in + (size_t)m * DM, g_pre_mix, XN + (size_t)m * DM, ssq_x + m, lane);
        for (int m = gw * 2; m < TM; m += NGW * 2) rms_rows_to_bf16<2, true>(mem + (size_t)m * DM, g_mem_kv, MN + (size_t)m * DM, nullptr, lane);
    }
    SEAM(0);
    if (IN(1)) REPS(1) {
        { pg8::TileOrder S; S.init(T, DINP, G, bx, XN, DM, Win_t, DM); EpiZ E{Z, KPE, RSQ(ssq_cq), RSQ(ssq_ckv), cosT, sinT, ssq_x};
          pg8::gemm_phase<EpiZ, pg8::TileOrder>(lds, DM, DM, DM, S, E, wave_s); }
        {
          struct MkvOrder { int u; const char* A; const char* B;
              __device__ bool next(int i, pg8::Unit& un) const { if (i > 0 || u < 0) return false; un.pm = u >> 3; un.pn = u & 7; un.A = A + (size_t)un.pm * 256 * DM * 2; un.B = B + (size_t)un.pn * 256 * DM * 2; un.cofs = 0; return true; } };
          const int j = bx >> 3; MkvOrder S{(G == 256) ? (j >= 16 ? ((bx & 7) * 2 + ((j - 16) >> 3)) * 8 + ((j - 16) & 7) : -1) : (bx < 128 ? bx : -1), (const char*)MN, (const char*)Wmkv_t};
          EpiBf16 E{MKV, 2048, 1.f, nullptr, 0.f};
          pg8::gemm_phase<EpiBf16, MkvOrder>(lds, DM, DM, DM, S, E, wave_s); }
    }
    SEAM(1);
    if (IN(2)) REPS(2) {
#ifndef P2SUB
#define P2SUB 31
#endif
#ifndef REP_P2SUB
#define REP_P2SUB 0
#endif
#define R2(i) for (int r2 = 0; r2 < (((REP_P2SUB) >> (i)) & 1) + 1; ++r2)
        if (P2SUB & 1) R2(0) for (int uidx = vcu; uidx < BATCH * 16; uidx += G) lru::unit(uidx >> 4, uidx & 15, Z, Y, (rep | r2) ? ssq_dummy : ssq_lru, conv_w, conv_b, lru_wa, lru_ba, lru_wx, lru_bx, lru_lambda, lds, wave_s);
        if (P2SUB & 2) R2(1) { pg8::TileOrder S; S.init(T, 768, G, bx, Z + OFF_CQ, DINP, Wuq_t, QLR); EpiQ E{Qb, ssq_cq, cosT, sinT};
          pg8::gemm_phase<EpiQ, pg8::TileOrder>(lds, DINP, QLR, QLR, S, E, wave_s); }
        if (P2SUB & 4) R2(2) { pg8::TileOrder S; S.init(T, 1024, G, (bx + 128) % G, Z + OFF_CKV, DINP, Wukv_t, KVLR); EpiBf16 E{KVb, 1024, 1.f, ssq_ckv, 1.f / KVLR};
          pg8::gemm_phase<EpiBf16, pg8::TileOrder>(lds, DINP, KVLR, KVLR, S, E, wave_s); }
        struct FormQK { int G, c; const bf16_t* mkv; const bf16_t* W;
            __device__ bool next(int i, pg8::Unit& u) const { const int L = i * G + c; if (L >= 256) return false; const int bh = L >> 2, q = L & 3, b = bh >> 2, h = bh & 3;
                u.pm = 0; u.pn = q; u.A = (const char*)(mkv + (size_t)(b * 256) * 2048 + h * 256); u.B = (const char*)(W + (size_t)(q * 256) * 1024 + h * 256); u.cofs = ((long)b * 1024 + h * 256) * 1024; return true; } };
        struct FormVO { int G, c; const bf16_t* mkv; const bf16_t* W;
            __device__ bool next(int i, pg8::Unit& u) const { const int L = i * G + c; if (L >= 256) return false; const int bh = L >> 2, q = L & 3, b = bh >> 2, h = bh & 3;
                u.pm = q; u.pn = 0; u.A = (const char*)(W + (size_t)(q * 256) * 1024 + h * 256); u.B = (const char*)(mkv + (size_t)(b * 256) * 2048 + 1024 + h * 256); u.cofs = (long)b * 1024 * 1024 + h * 256; return true; } };
        if (P2SUB & 8) R2(3) { FormQK S{G, vcu, MKV, Wmq_b}; EpiBf16 E{WQK, 1024, MSCALE, nullptr, 0.f}; pg8::gemm_phase<EpiBf16, FormQK>(lds, 2048, 1024, 256, S, E, wave_s); }
        if (P2SUB & 16) R2(3) { FormVO S{G, vcu, MKV, Wmo_t}; EpiBf16 E{WVO, 1024, 1.f, nullptr, 0.f}; pg8::gemm_phase<EpiBf16, FormVO>(lds, 1024, 2048, 256, S, E, wave_s); }
    }
    SEAM(2);
    if (IN(3)) REPS(3) {
        for (int it = vcu; it < BATCH * 4 * 4; it += G) { const int bh = it >> 2, xq = it & 3, b = bh >> 2, h = bh & 3;
            mla::block(b, h, xq, Qb, KVb, KPE, Y, RSQ(ssq_mla), (char*)lds_raw, wave_s);
            mla::block(b, h, 7 - xq, Qb, KVb, KPE, Y, RSQ(ssq_mla), (char*)lds_raw, wave_s); }
    }
    SEAM(3);
    if (IN(5)) REPS(5) { pg8::TileOrder S; S.init(T, DM, G, bx, Y, DM, Wout_t, DM);
        EpiNormResMid E{nullptr, XN, nullptr, g_post_mix, rep ? (bf16_t*)PRE : XN, RSQ(ssq_h1), slots_p, ctl + CW_SEAM, ssq_lru, ssq_mla};
        pg8::gemm_phase<EpiNormResMid, pg8::TileOrder>(lds, DM, DM, DM, S, E, wave_s); }
    SEAM(5);
    if (IN(7)) REPS(7) { pg8::TileOrder S; S.init(T, DM, G, bx, XN, DM, WQK, DM, (size_t)DM * DM * 2); EpiSoftmax E{Pb, ssq_h1}; pg8::gemm_phase<EpiSoftmax, pg8::TileOrder>(lds, DM, DM, DM, S, E, wave_s); }
    SEAM(7);
    if (IN(8)) REPS(8) { pg8::TileOrder S; S.init(T, DM, G, bx, Pb, DM, WVO, DM, (size_t)DM * DM * 2); EpiNormRes E{nullptr, XN, nullptr, g_post_mem, rep ? (bf16_t*)PRE : XN, RSQ(ssq_h2), slots_p + (size_t)4 * T, ctl + CW_SEAM + SEAM_BANK, nullptr, nullptr};
        pg8::gemm_phase<EpiNormRes, pg8::TileOrder>(lds, DM, DM, DM, S, E, wave_s); }
    SEAM(8);
    if (IN(10)) REPS(10) { pg8::TileOrder S; S.init(T, 2 * DFF, G, bx, XN, DM, Wgu_t, DM); EpiSwiGLU E{Fb, ssq_h2}; pg8::gemm_phase<EpiSwiGLU, pg8::TileOrder, ALIGN_P10>(lds, DM, DM, DM, S, E, wave_s); }
    SEAM(10);
    if (IN(11)) REPS(11) { pg8::TileOrder S; S.init(T, DM, G, bx, Fb, DFF, Wdown_t, DFF); EpiNormRes E{nullptr, XN, rep ? PRE : out_p, g_post_ffn, nullptr, nullptr, slots_p + (size_t)8 * T, ctl + CW_SEAM + 2 * SEAM_BANK, nullptr, nullptr};
        pg8::gemm_phase<EpiNormRes, pg8::TileOrder>(lds, DFF, DFF, DFF, S, E, wave_s); }
#undef IN
#undef SEAM
}

#undef tid
#undef lane
#undef wave
#undef gw
#undef NGW
#undef x_in
#undef ssq_h1
#undef ssq_h2
#undef ssq_dummy
#undef ssq_x
#undef slots_p
#undef mem
#undef positions
#undef g_pre_mix
#undef w_in
#undef conv_w
#undef conv_b
#undef lru_wa
#undef lru_ba
#undef lru_wx
#undef lru_bx
#undef lru_lambda
#undef g_q_lat
#undef w_uq
#undef g_kv_lat
#undef w_ukv
#undef g_lru_out
#undef g_mla_out
#undef w_out
#undef g_post_mix
#undef g_pre_mem
#undef g_mem_kv
#undef w_mq
#undef w_mk
#undef w_mv
#undef w_mo
#undef g_post_mem
#undef g_pre_ffn
#undef w_gate
#undef w_up
#undef w_down
#undef g_post_ffn
#undef out_p
#undef ctl
#undef ssq_cq
#undef ssq_ckv
#undef ssq_lru
#undef ssq_mla
#undef cosT
#undef sinT
#undef Win_t
#undef Wuq_t
#undef Wukv_t
#undef Wout_t
#undef Wmq_b
#undef Wmkv_t
#undef Wmo_t
#undef Wgu_t
#undef Wdown_t
#undef MN
#undef MKV
#undef WQK
#undef WVO
#undef XN
#undef KPE
#undef Z
#undef Qb
#undef KVb
#undef Y
#undef PRE
#undef Pb
#undef Fb
#ifndef N_LAUNCHES
#define N_LAUNCHES 1
#endif
extern "C" void kernel_launch(void* const* d_in, const int* in_sizes, int n_in, void* d_out, int out_size, void* d_ws, size_t ws_size, hipStream_t stream) {
    static int grid = 0;
    if (grid == 0) {
        if (n_in != 32 || in_sizes[0] != T * DM || out_size != T * DM || ws_size < WS_END) { fprintf(stderr, "kernel_launch: unexpected shapes (n_in %d, in0 %d, out %d, ws %zu)\n", n_in, n_in > 0 ? in_sizes[0] : -1, out_size, ws_size); grid = -1; return; }
        int dev = 0, cus = 0, per_cu = 0;
        (void)hipGetDevice(&dev); (void)hipDeviceGetAttribute(&cus, hipDeviceAttributeMultiprocessorCount, dev);
        if (hipFuncSetAttribute((const void*)hymba_fwd, hipFuncAttributeMaxDynamicSharedMemorySize, LDS_BYTES) != hipSuccess) { fprintf(stderr, "kernel_launch: hipFuncSetAttribute failed\n"); grid = -1; return; }
        if (hipOccupancyMaxActiveBlocksPerMultiprocessor(&per_cu, (const void*)hymba_fwd, NWAVES * 64, LDS_BYTES) != hipSuccess || per_cu < 1) { fprintf(stderr, "kernel_launch: occupancy query says %d\n", per_cu); per_cu = 1; }
        (void)hipGetLastError();
        grid = cus > 0 ? cus : 256;
    }
    if (grid < 0) return;
    (void)hipMemsetAsync((char*)d_ws + WS_CTL, 0, CTL_ZERO_BYTES, stream);
    Args a{};
    for (int i = 0; i < 32; ++i) a.in[i] = d_in[i];
    a.out = (float*)d_out; a.ws = (unsigned char*)d_ws;
#if N_LAUNCHES == 1
    a.ph_lo = 0; a.ph_hi = NPHASE;
    void* kargs[] = {&a};
#ifdef PLAIN_LAUNCH
    (void)kargs; hipLaunchKernelGGL(hymba_fwd, dim3(grid), dim3(NWAVES * 64), LDS_BYTES, stream, a); hipError_t e = hipPeekAtLastError();
#else
    hipError_t e = hipLaunchCooperativeKernel((const void*)hymba_fwd, dim3(grid), dim3(NWAVES * 64), kargs, LDS_BYTES, stream);
#endif
    if (e != hipSuccess) fprintf(stderr, "kernel_launch: cooperative launch failed: %s (grid %d)\n", hipGetErrorString(e), grid);
#else
    for (int p = 0; p < NPHASE; ++p) { a.ph_lo = p; a.ph_hi = p + 1; hipLaunchKernelGGL(hymba_fwd, dim3(grid), dim3(NWAVES * 64), LDS_BYTES, stream, a); }
#endif
}
```

```cpp
#include <hip/hip_runtime.h>
#include <hip/hip_bf16.h>
#include <cstdio>
#include <cstdint>

#define LAS __attribute__((address_space(3)))
#define GAS __attribute__((address_space(1)))
typedef unsigned short bf16_t;
typedef short bf16x8 __attribute__((ext_vector_type(8)));
typedef short s16x4 __attribute__((ext_vector_type(4)));
typedef float f32x4 __attribute__((ext_vector_type(4)));
typedef float f32x2 __attribute__((ext_vector_type(2)));
typedef float f32x16 __attribute__((ext_vector_type(16)));
typedef unsigned u32x4 __attribute__((ext_vector_type(4)));
typedef unsigned u32x2 __attribute__((ext_vector_type(2)));

constexpr int BATCH = 16, SEQ = 2048, DM = 1024, T = BATCH * SEQ;
constexpr int NMEM = 256, TM = BATCH * NMEM;
constexpr int DLRU = 512, DINP = 1792, QLR = 384, KVLR = 256, DFF = 2816;
constexpr int OFF_GATE = 512, OFF_CQ = 1024, OFF_CKV = 1408, OFF_KPE = 1664;
constexpr float EPS = 1e-6f;
constexpr float LOG2E = 1.4426950408889634f;
constexpr float QSCALE = 0.07216878364870322f * LOG2E;
constexpr float MSCALE = 0.0625f * LOG2E;

constexpr size_t MiB = 1u << 20;
constexpr size_t WS_CTL = 0, CTL_ZERO_BYTES = 2 * MiB;
constexpr size_t WS_SSQ = 1 * MiB;
constexpr size_t WS_SLOTS = 2 * MiB;
constexpr int CW_SEAM = 65536, SEAM_BANK = 8192;
constexpr size_t WS_ROPE = 4 * MiB;
constexpr size_t WS_WIN = 12 * MiB, WS_WUQ = 16 * MiB, WS_WUKV = 17 * MiB, WS_WOUT = 18 * MiB, WS_WMQ = 20 * MiB, WS_WMKV = 22 * MiB,
                 WS_WMO = 26 * MiB, WS_WGU = 28 * MiB, WS_WDOWN = 39 * MiB;
constexpr size_t WS_MN = 46 * MiB, WS_MKV = 54 * MiB, WS_WQK = 70 * MiB, WS_WVO = 102 * MiB, WS_XN = 134 * MiB, WS_KPE = 198 * MiB;
constexpr size_t WS_Z = 202 * MiB, WS_Q = 314 * MiB, WS_KV = 362 * MiB, WS_Y = 426 * MiB;
constexpr size_t WS_PRE = 202 * MiB, WS_P = 330 * MiB, WS_F = 330 * MiB, WS_END = 506 * MiB;
constexpr int CW_BAR = 4096;

constexpr int RING_BYTES = 131072, EPI_OFF = RING_BYTES, EPI_BYTES = 16384, MISC_OFF = EPI_OFF + EPI_BYTES, LDS_BYTES = MISC_OFF + 1024;

__device__ __forceinline__ unsigned cvt_pk_bf16(float lo, float hi) { unsigned r; asm volatile("v_cvt_pk_bf16_f32 %0, %1, %2" : "=v"(r) : "v"(lo), "v"(hi)); return r; }
__device__ __forceinline__ float bf2f(unsigned short v) { return __uint_as_float((unsigned)v << 16); }
__device__ __forceinline__ float bflo(unsigned w) { return __uint_as_float(w << 16); }
__device__ __forceinline__ float bfhi(unsigned w) { return __uint_as_float(w & 0xffff0000u); }
__device__ __forceinline__ float wave_sum(float v) {
#pragma unroll
    for (int o = 1; o < 64; o <<= 1) v += __shfl_xor(v, o);
    return v;
}
__device__ __forceinline__ int lane_id() { int l; asm volatile("v_mbcnt_lo_u32_b32 %0, -1, 0\n\tv_mbcnt_hi_u32_b32 %0, -1, %0" : "=v"(l)); return l; }
#define LDS_WAIT() asm volatile("s_waitcnt lgkmcnt(0)" ::: "memory")
#define VM_WAIT() asm volatile("s_waitcnt vmcnt(0)" ::: "memory")

namespace pg8 {
constexpr int BM = 256, BK = 64, HALF = 128, HTB = HALF * BK * 2, STAGE_BYTES = 8 * HTB, NXCD = 8, WGM = 8;
__host__ __device__ __forceinline__ int lds_byte(int r, int c) { const int st = (r >> 4) * 2 + (c >> 5), rr = r & 15, cc = c & 31, ob = rr * 64 + cc * 2; return st * 1024 + (ob ^ (((ob >> 9) & 1) << 5)); }
__host__ __device__ __forceinline__ void stage_rc(int b, int& R, int& C) { const int st = b / 1024, sb = b % 1024, swz = sb ^ (((sb >> 9) & 1) << 5); R = (st >> 1) * 16 + swz / 64; C = (st & 1) * 32 + (swz % 64) / 2; }
__host__ __device__ __forceinline__ int perm32(int rho) { const int n = rho >> 4, i = rho & 15; return 8 * (i >> 2) + 4 * n + (i & 3); }

struct Unit { int pm, pn; const char* A; const char* B; long cofs; };

struct TileOrder {
    int nM, nN, nwg, G, c; const char* A; const char* B; size_t tA, tB, bB;
    __device__ void init(int M, int N, int G_, int c_, const void* A_, int lda, const void* B_, int ldb, size_t batchB_bytes = 0) {
        nM = M / BM; nN = N / BM; nwg = nM * nN; G = G_; c = c_; A = (const char*)A_; B = (const char*)B_; tA = (size_t)BM * lda * 2; tB = (size_t)BM * ldb * 2; bB = batchB_bytes; }
    __device__ bool next(int i, Unit& u) const {
        const long L = (long)i * G + c; if (L >= nwg) return false;
        int wgid = (int)L; { const int q = nwg / NXCD, r = nwg % NXCD, xcd = wgid % NXCD, off = wgid / NXCD; wgid = (xcd < r ? xcd * (q + 1) : r * (q + 1) + (xcd - r) * q) + off; }
        const int nig = WGM * nN, gid = wgid / nig, fm = gid * WGM, gsz = (nM - fm) < WGM ? (nM - fm) : WGM;
        u.pm = fm + ((wgid % nig) % gsz); u.pn = (wgid % nig) / gsz; u.A = A + (size_t)u.pm * tA; u.B = B + (size_t)u.pn * tB + (size_t)(u.pm >> 3) * bB; u.cofs = 0; return true;
    }
};

template <class Epi, class Sched, bool ALIGN_EPI = true, bool SP2 = true>
__device__ __forceinline__ void gemm_phase(LAS unsigned char* lds, const int lda, const int ldb, const int K, const Sched& S, const Epi& E, const int wv) {
    int lane = lane_id(); asm volatile("" : "+v"(lane));
    const int wid = wv, tid = wv * 64 + lane, wr = wid >> 2, wc = wid & 3, fr = lane & 15, fq = lane >> 4;
    const int nt = K / BK;
    unsigned voffA[2], voffB[2];
#pragma unroll
    for (int i = 0; i < 2; ++i) { int R, C; stage_rc(tid * 16 + i * 8192, R, C); const int Rb = Epi::PERM ? ((R & ~31) + perm32(R & 31)) : R;
        voffA[i] = (unsigned)(R * lda + C) * 2u; voffB[i] = (unsigned)(Rb * ldb + C) * 2u; }
    const size_t kstep = (size_t)(BK * 2);
    const size_t hstepA = (size_t)HALF * lda * 2, hstepB = (size_t)HALF * ldb * 2;
    const unsigned ldsw = (unsigned)wid * 1024u;
    const int aoff = lds_byte(wr * 64 + fr, fq * 8), boff = lds_byte(wc * 32 + fr, fq * 8);
#define PG8_SA(b, h) (((b) * 2 + (h)) * HTB)
#define PG8_SB(b, h) ((4 + (b) * 2 + (h)) * HTB)
#define PG8_STAGE(bufoff, gbase, voff) do { _Pragma("unroll") for (int _i = 0; _i < 2; ++_i) \
        __builtin_amdgcn_global_load_lds((const unsigned*)((const char*)(gbase) + (voff)[_i]), (LAS unsigned*)(lds + (bufoff) + ldsw + _i * 8192), 16, 0, 0); } while (0)
#define PG8_LDA(dst, b, h) do { _Pragma("unroll") for (int m = 0; m < 4; ++m) _Pragma("unroll") for (int k = 0; k < 2; ++k) dst[m][k] = *(const LAS bf16x8*)(lds + PG8_SA(b, h) + aoff + m * 2048 + k * 1024); } while (0)
#define PG8_LDB(dst, b, h) do { _Pragma("unroll") for (int n = 0; n < 2; ++n) _Pragma("unroll") for (int k = 0; k < 2; ++k) dst[n][k] = *(const LAS bf16x8*)(lds + PG8_SB(b, h) + boff + n * 2048 + k * 1024); } while (0)
#define PG8_MMA(ai, bj, At, Bt) do { __builtin_amdgcn_s_setprio(1); _Pragma("unroll") for (int m = 0; m < 4; ++m) _Pragma("unroll") for (int n = 0; n < 2; ++n) _Pragma("unroll") for (int k = 0; k < 2; ++k) \
        acc[ai][bj][m][n] = __builtin_amdgcn_mfma_f32_16x16x32_bf16(Bt[n][k], At[m][k], acc[ai][bj][m][n], 0, 0, 0); __builtin_amdgcn_s_setprio(0); } while (0)
#define PG8_WAIT_V(n) asm volatile("s_waitcnt vmcnt(" #n ")" ::: "memory")
#define PG8_WAIT_L(n) asm volatile("s_waitcnt lgkmcnt(" #n ")" ::: "memory")
#define PG8_BAR __builtin_amdgcn_s_barrier()
#define PG8_SCHED __builtin_amdgcn_sched_barrier(0)
    Unit cur, nxt; int ui = 0;
    if (!S.next(0, cur)) return;
    if constexpr (Epi::MIDK) E.prep(cur, lds, wid, 0);
    f32x4 acc[2][2][4][2];
#pragma unroll
    for (int a = 0; a < 2; ++a)
#pragma unroll
        for (int b = 0; b < 2; ++b)
#pragma unroll
            for (int m = 0; m < 4; ++m)
#pragma unroll
                for (int n = 0; n < 2; ++n) acc[a][b][m][n] = (f32x4){0.f, 0.f, 0.f, 0.f};
    bf16x8 At[4][2], B0[2][2], B1[2][2];
    const char* cA = cur.A; const char* cB = cur.B;
    static_assert(SP2, "only the SP2 loop is kept");
    PG8_STAGE(PG8_SB(0, 0), cB, voffB); PG8_STAGE(PG8_SB(0, 1), cB + hstepB, voffB); PG8_STAGE(PG8_SA(0, 0), cA, voffA); PG8_STAGE(PG8_SA(0, 1), cA + hstepA, voffA);
    if (wr == 1) PG8_BAR;
    PG8_WAIT_V(2); PG8_BAR;
    PG8_STAGE(PG8_SB(1, 0), cB + kstep, voffB); PG8_STAGE(PG8_SA(1, 0), cA + kstep, voffA); PG8_STAGE(PG8_SB(1, 1), cB + hstepB + kstep, voffB);
    PG8_WAIT_V(6); PG8_BAR;
    for (;;) {
        const bool has_next = S.next(ui + 1, nxt);
        const char* nA = has_next ? nxt.A : cA; const char* nB = has_next ? nxt.B : cB;
        for (int t = 0; t < nt; t += 2) {
            if constexpr (Epi::MIDK) { if (t == Epi::TSPLIT) E.midk(acc, lds, ui & 1, wr); }
            const bool last = (t == nt - 2);
            const char* a1 = cA + (size_t)(t + 1) * kstep;
            const char* a2 = last ? nA : cA + (size_t)(t + 2) * kstep; const char* b2 = last ? nB : cB + (size_t)(t + 2) * kstep;
            const char* a3 = a2 + kstep; const char* b3 = b2 + kstep;
            PG8_LDB(B0, 0, 0); PG8_LDB(B1, 0, 1); PG8_SCHED; PG8_LDA(At, 0, 0); PG8_STAGE(PG8_SA(1, 1), a1 + hstepA, voffA);
            PG8_WAIT_V(8); PG8_WAIT_L(0); PG8_BAR; PG8_MMA(0, 0, At, B0); PG8_MMA(0, 1, At, B1); PG8_BAR; PG8_SCHED;
            PG8_LDA(At, 0, 1); PG8_STAGE(PG8_SB(0, 0), b2, voffB); PG8_STAGE(PG8_SB(0, 1), b2 + hstepB, voffB); PG8_STAGE(PG8_SA(0, 0), a2, voffA);
            PG8_WAIT_V(8); PG8_WAIT_L(0); PG8_BAR; PG8_MMA(1, 0, At, B0); PG8_MMA(1, 1, At, B1); PG8_BAR; PG8_SCHED;
            PG8_LDB(B0, 1, 0); PG8_LDB(B1, 1, 1); PG8_SCHED; PG8_LDA(At, 1, 0); PG8_STAGE(PG8_SA(0, 1), a2 + hstepA, voffA);
            PG8_WAIT_V(8); PG8_WAIT_L(0); PG8_BAR; PG8_MMA(0, 0, At, B0); PG8_MMA(0, 1, At, B1); PG8_BAR; PG8_SCHED;
            PG8_LDA(At, 1, 1); PG8_STAGE(PG8_SB(1, 0), b3, voffB); PG8_STAGE(PG8_SB(1, 1), b3 + hstepB, voffB); PG8_STAGE(PG8_SA(1, 0), a3, voffA);
            PG8_WAIT_V(8); PG8_WAIT_L(0); PG8_BAR; PG8_MMA(1, 0, At, B0); PG8_MMA(1, 1, At, B1); PG8_BAR; PG8_SCHED;
        }
        if constexpr (ALIGN_EPI) { if (wr == 0) PG8_BAR; }
        E(acc, cur, wr, wc, fr, fq, lds, wid, ui & 1);
        if (!has_next) break;
        if constexpr (Epi::MIDK) E.prep(nxt, lds, wid, (ui + 1) & 1);
#pragma unroll
        for (int a = 0; a < 2; ++a)
#pragma unroll
            for (int b = 0; b < 2; ++b)
#pragma unroll
                for (int m = 0; m < 4; ++m)
#pragma unroll
                    for (int n = 0; n < 2; ++n) acc[a][b][m][n] = (f32x4){0.f, 0.f, 0.f, 0.f};
        cur = nxt; cA = nA; cB = nB; ++ui;
        if constexpr (ALIGN_EPI) { if (wr == 1) PG8_BAR; }
    }
    PG8_WAIT_V(0);
    if constexpr (!ALIGN_EPI) { if (wr == 0) PG8_BAR; }
    PG8_BAR;
#undef PG8_SA
#undef PG8_SB
#undef PG8_STAGE
#undef PG8_LDA
#undef PG8_LDB
#undef PG8_MMA
#undef PG8_WAIT_V
#undef PG8_WAIT_L
#undef PG8_BAR
#undef PG8_SCHED
}
}

typedef f32x4 Acc[2][2][4][2];
__device__ __forceinline__ void ssq_rows_atomic(const Acc& acc, float* ssq, int row_base  , int bjmask, int fq, int lane) {
#pragma unroll
    for (int ai = 0; ai < 2; ++ai) {
        float s[4];
#pragma unroll
        for (int m = 0; m < 4; ++m) { float q = 0.f;
#pragma unroll
            for (int bj = 0; bj < 2; ++bj) if (bjmask & (1 << bj))
#pragma unroll
                for (int n = 0; n < 2; ++n) { const f32x4 x = acc[ai][bj][m][n]; q += (x[0] * x[0] + x[1] * x[1]) + (x[2] * x[2] + x[3] * x[3]); }
            q += __shfl_xor(q, 16); q += __shfl_xor(q, 32); s[m] = q; }
        const float v = fq == 0 ? s[0] : fq == 1 ? s[1] : fq == 2 ? s[2] : s[3];
        atomicAdd(ssq + row_base + ai * 128 + lane, v);
    }
}
struct EpiBf16 {
    static constexpr bool PERM = true, MIDK = false;
    bf16_t* O; int ldc; float scale; const float* ssq; float rdim_inv;
    __device__ __forceinline__ void operator()(const Acc& acc, const pg8::Unit& u, int wr, int wc, int fr, int fq, LAS unsigned char*, int, int) const {
        { const int ln_ = lane_id(); fr = ln_ & 15; fq = ln_ >> 4; }
        const int row0 = u.pm * 256 + wr * 64 + fr, col0 = u.pn * 256 + wc * 32 + 8 * fq;
#pragma unroll
        for (int ai = 0; ai < 2; ++ai)
#pragma unroll
            for (int m = 0; m < 4; ++m) { const int row = row0 + ai * 128 + m * 16; float sc = scale;
                if (ssq) sc *= __builtin_amdgcn_rsqf(ssq[row] * rdim_inv + EPS);
                bf16_t* rowp = O + u.cofs + (size_t)row * ldc + col0;
#pragma unroll
                for (int bj = 0; bj < 2; ++bj) { const f32x4 v0 = acc[ai][bj][m][0] * sc, v1 = acc[ai][bj][m][1] * sc;
                    u32x4 w; w.x = cvt_pk_bf16(v0[0], v0[1]); w.y = cvt_pk_bf16(v0[2], v0[3]); w.z = cvt_pk_bf16(v1[0], v1[1]); w.w = cvt_pk_bf16(v1[2], v1[3]);
                    *(u32x4*)(rowp + bj * 128) = w; } }
    }
};
__device__ __forceinline__ void rope8(f32x4& v0, f32x4& v1, const float* cosT, const float* sinT, int row, int i0) {
    const f32x4 c = *(const f32x4*)(cosT + (size_t)row * 32 + i0), s = *(const f32x4*)(sinT + (size_t)row * 32 + i0);
    const f32x4 a = v0, b = v1;
    v0[0] = a[0] * c[0] - a[1] * s[0]; v0[1] = a[1] * c[0] + a[0] * s[0]; v0[2] = a[2] * c[1] - a[3] * s[1]; v0[3] = a[3] * c[1] + a[2] * s[1];
    v1[0] = b[0] * c[2] - b[1] * s[2]; v1[1] = b[1] * c[2] + b[0] * s[2]; v1[2] = b[2] * c[3] - b[3] * s[3]; v1[3] = b[3] * c[3] + b[2] * s[3];
}
struct EpiZ {
    static constexpr bool PERM = true, MIDK = false;
    bf16_t* Z; bf16_t* KPE; float* ssq_cq; float* ssq_ckv; const float* cosT; const float* sinT; const float* ssq_x;
    __device__ __forceinline__ void operator()(Acc& acc, const pg8::Unit& u, int wr, int wc, int fr, int fq, LAS unsigned char*, int, int lane) const {
        { const int ln_ = lane_id(); fr = ln_ & 15; fq = ln_ >> 4; }
        const int row0 = u.pm * 256 + wr * 64 + fr, col0 = u.pn * 256 + wc * 32 + 8 * fq;
        const bool kpe_tile = (u.pn == 6);
#pragma unroll
        for (int ai = 0; ai < 2; ++ai)
#pragma unroll
            for (int m = 0; m < 4; ++m) { const float rsx = __builtin_amdgcn_rsqf(ssq_x[row0 + ai * 128 + m * 16] * (1.f / DM) + EPS);
#pragma unroll
                for (int bj = 0; bj < 2; ++bj)
#pragma unroll
                    for (int n = 0; n < 2; ++n) acc[ai][bj][m][n] = acc[ai][bj][m][n] * rsx; }
#pragma unroll
        for (int ai = 0; ai < 2; ++ai)
#pragma unroll
            for (int m = 0; m < 4; ++m) { const int row = row0 + ai * 128 + m * 16; bf16_t* rowp = Z + (size_t)row * DINP + col0;
#pragma unroll
                for (int bj = 0; bj < 2; ++bj) { f32x4 v0 = acc[ai][bj][m][0], v1 = acc[ai][bj][m][1];
                    if (kpe_tile && bj == 1) {
                        if (wc < 2) { rope8(v0, v1, cosT, sinT, row, 16 * (wc & 1) + 4 * fq);
                            u32x4 w; w.x = cvt_pk_bf16(v0[0], v0[1]); w.y = cvt_pk_bf16(v0[2], v0[3]); w.z = cvt_pk_bf16(v1[0], v1[1]); w.w = cvt_pk_bf16(v1[2], v1[3]);
                            *(u32x4*)(KPE + (size_t)row * 64 + wc * 32 + 8 * fq) = w; }
                    } else {
                        u32x4 w; w.x = cvt_pk_bf16(v0[0], v0[1]); w.y = cvt_pk_bf16(v0[2], v0[3]); w.z = cvt_pk_bf16(v1[0], v1[1]); w.w = cvt_pk_bf16(v1[2], v1[3]);
                        *(u32x4*)(rowp + bj * 128) = w; } } }
        const int rb = u.pm * 256 + wr * 64; lane = fq * 16 + fr;
        if (u.pn == 4) ssq_rows_atomic(acc, ssq_cq, rb, 3, fq, lane);
        else if (u.pn == 5) { ssq_rows_atomic(acc, ssq_cq, rb, 1, fq, lane); ssq_rows_atomic(acc, ssq_ckv, rb, 2, fq, lane); }
        else if (u.pn == 6) ssq_rows_atomic(acc, ssq_ckv, rb, 1, fq, lane);
    }
};
struct EpiQ {
    static constexpr bool PERM = true, MIDK = false;
    bf16_t* Q; const float* ssq; const float* cosT; const float* sinT;
    __device__ __forceinline__ void operator()(const Acc& acc, const pg8::Unit& u, int wr, int wc, int fr, int fq, LAS unsigned char*, int, int) const {
        { const int ln_ = lane_id(); fr = ln_ & 15; fq = ln_ >> 4; }
        const int row0 = u.pm * 256 + wr * 64 + fr, col0 = u.pn * 256 + wc * 32 + 8 * fq;
        const bool pe = (u.pn == 2);
#pragma unroll
        for (int ai = 0; ai < 2; ++ai)
#pragma unroll
            for (int m = 0; m < 4; ++m) { const int row = row0 + ai * 128 + m * 16;
                const float sc = QSCALE * __builtin_amdgcn_rsqf(ssq[row] * (1.f / QLR) + EPS);
                bf16_t* rowp = Q + (size_t)row * 768 + col0;
#pragma unroll
                for (int bj = 0; bj < 2; ++bj) { f32x4 v0 = acc[ai][bj][m][0] * sc, v1 = acc[ai][bj][m][1] * sc;
                    if (pe) rope8(v0, v1, cosT, sinT, row, 16 * (wc & 1) + 4 * fq);
                    u32x4 w; w.x = cvt_pk_bf16(v0[0], v0[1]); w.y = cvt_pk_bf16(v0[2], v0[3]); w.z = cvt_pk_bf16(v1[0], v1[1]); w.w = cvt_pk_bf16(v1[2], v1[3]);
                    *(u32x4*)(rowp + bj * 128) = w; } }
    }
};
struct EpiF32 {
    static constexpr bool PERM = false, MIDK = false;
    float* O; int ldc;
    __device__ __forceinline__ void operator()(const Acc& acc, const pg8::Unit& u, int wr, int wc, int fr, int fq, LAS unsigned char*, int, int) const {
        { const int ln_ = lane_id(); fr = ln_ & 15; fq = ln_ >> 4; }
        const int row0 = u.pm * 256 + wr * 64 + fr, col0 = u.pn * 256 + wc * 32 + 4 * fq;
#pragma unroll
        for (int ai = 0; ai < 2; ++ai)
#pragma unroll
            for (int m = 0; m < 4; ++m) { float* rowp = O + (size_t)(row0 + ai * 128 + m * 16) * ldc + col0;
#pragma unroll
                for (int bj = 0; bj < 2; ++bj)
#pragma unroll
                    for (int n = 0; n < 2; ++n) *(f32x4*)(rowp + bj * 128 + n * 16) = acc[ai][bj][m][n]; }
    }
};
struct EpiSwiGLU {
    static constexpr bool PERM = true, MIDK = false;
    bf16_t* F; const float* ssq;
    __device__ __forceinline__ void operator()(const Acc& acc, const pg8::Unit& u, int wr, int wc, int fr, int fq, LAS unsigned char*, int, int) const {
        { const int ln_ = lane_id(); fr = ln_ & 15; fq = ln_ >> 4; }
        const int row0 = u.pm * 256 + wr * 64 + fr, col0 = u.pn * 128 + wc * 32 + 8 * fq;
        float sq[2][4];
#pragma unroll
        for (int ai = 0; ai < 2; ++ai)
#pragma unroll
            for (int m = 0; m < 4; ++m) sq[ai][m] = ssq[row0 + ai * 128 + m * 16];
#pragma unroll
        for (int ai = 0; ai < 2; ++ai)
#pragma unroll
            for (int m = 0; m < 4; ++m) { bf16_t* rowp = F + (size_t)(row0 + ai * 128 + m * 16) * DFF + col0; float f[8];
                const float rsc = __builtin_amdgcn_rsqf(sq[ai][m] * (1.f / DM) + EPS);
#pragma unroll
                for (int n = 0; n < 2; ++n)
#pragma unroll
                    for (int e = 0; e < 4; ++e) { const float g = acc[ai][0][m][n][e] * rsc, up = acc[ai][1][m][n][e] * rsc;
                        f[n * 4 + e] = g * __builtin_amdgcn_rcpf(1.f + __builtin_amdgcn_exp2f(-g * LOG2E)) * up; }
                u32x4 w; w.x = cvt_pk_bf16(f[0], f[1]); w.y = cvt_pk_bf16(f[2], f[3]); w.z = cvt_pk_bf16(f[4], f[5]); w.w = cvt_pk_bf16(f[6], f[7]);
                *(u32x4*)rowp = w; }
    }
};
struct EpiSoftmax {
    static constexpr bool PERM = true, MIDK = false;
    bf16_t* P; const float* ssq;
    __device__ __forceinline__ void operator()(Acc& acc, const pg8::Unit& u, int wr, int wc, int fr, int fq, LAS unsigned char* lds, int, int) const {
        { const int ln_ = lane_id(); fr = ln_ & 15; fq = ln_ >> 4; }
        LAS float* PM = (LAS float*)(lds + EPI_OFF);
        LAS float* PS = (LAS float*)(lds + EPI_OFF + 4096);
        float sq[2][4];
#pragma unroll
        for (int ai = 0; ai < 2; ++ai)
#pragma unroll
            for (int m = 0; m < 4; ++m) sq[ai][m] = ssq[u.pm * 256 + ai * 128 + wr * 64 + m * 16 + fr];
        float mxr[2][4];
#pragma unroll
        for (int ai = 0; ai < 2; ++ai)
#pragma unroll
            for (int m = 0; m < 4; ++m) { float q = -3.0e38f;
#pragma unroll
                for (int bj = 0; bj < 2; ++bj)
#pragma unroll
                    for (int n = 0; n < 2; ++n) { const f32x4 x = acc[ai][bj][m][n]; q = fmaxf(q, fmaxf(fmaxf(x[0], x[1]), fmaxf(x[2], x[3]))); }
                q = fmaxf(q, __shfl_xor(q, 16)); q = fmaxf(q, __shfl_xor(q, 32)); mxr[ai][m] = q; }
#pragma unroll
        for (int ai = 0; ai < 2; ++ai)
#pragma unroll
            for (int m = 0; m < 4; ++m) { sq[ai][m] = __builtin_amdgcn_rsqf(sq[ai][m] * (1.f / DM) + EPS);
                if (fq == 0) PM[(ai * 128 + wr * 64 + m * 16 + fr) * 4 + wc] = mxr[ai][m] * sq[ai][m]; }
        LDS_WAIT(); __builtin_amdgcn_s_barrier(); asm volatile("" ::: "memory");
#pragma unroll
        for (int ai = 0; ai < 2; ++ai)
#pragma unroll
            for (int m = 0; m < 4; ++m) { const f32x4 t = *(const LAS f32x4*)(PM + (ai * 128 + wr * 64 + m * 16 + fr) * 4);
                const float rm = fmaxf(fmaxf(t[0], t[1]), fmaxf(t[2], t[3])), rsc = sq[ai][m]; float s = 0.f;
#pragma unroll
                for (int bj = 0; bj < 2; ++bj)
#pragma unroll
                    for (int n = 0; n < 2; ++n) { f32x4 x = acc[ai][bj][m][n];
#pragma unroll
                        for (int e = 0; e < 4; ++e) { x[e] = __builtin_amdgcn_exp2f(fmaf(x[e], rsc, -rm)); s += x[e]; }
                        acc[ai][bj][m][n] = x; }
                s += __shfl_xor(s, 16); s += __shfl_xor(s, 32);
                if (fq == 0) PS[(ai * 128 + wr * 64 + m * 16 + fr) * 4 + wc] = s; }
        LDS_WAIT(); __builtin_amdgcn_s_barrier(); asm volatile("" ::: "memory");
        const int row0 = u.pm * 256 + wr * 64 + fr, col0 = u.pn * 256 + wc * 32 + 8 * fq;
#pragma unroll
        for (int ai = 0; ai < 2; ++ai)
#pragma unroll
            for (int m = 0; m < 4; ++m) { const f32x4 t = *(const LAS f32x4*)(PS + (ai * 128 + wr * 64 + m * 16 + fr) * 4);
                const float inv = __builtin_amdgcn_rcpf((t[0] + t[1]) + (t[2] + t[3]));
                bf16_t* rowp = P + (size_t)(row0 + ai * 128 + m * 16) * DM + col0;
#pragma unroll
                for (int bj = 0; bj < 2; ++bj) { const f32x4 v0 = acc[ai][bj][m][0] * inv, v1 = acc[ai][bj][m][1] * inv;
                    u32x4 w; w.x = cvt_pk_bf16(v0[0], v0[1]); w.y = cvt_pk_bf16(v0[2], v0[3]); w.z = cvt_pk_bf16(v1[0], v1[1]); w.w = cvt_pk_bf16(v1[2], v1[3]);
                    *(u32x4*)(rowp + bj * 128) = w; } }
    }
};

__device__ __forceinline__ unsigned ag_ld(const unsigned* p) { return __hip_atomic_load(p, __ATOMIC_RELAXED, __HIP_MEMORY_SCOPE_AGENT); }
template <bool MIDK_>
struct EpiNormResT {
    static constexpr bool PERM = true, MIDK = MIDK_; static constexpr int TSPLIT = 8;
    const float* hold_f; const bf16_t* hold_b; float* hout; const float* gpost; bf16_t* xn; float* ssq_next; float* slots; unsigned* cnt;
    const float* ssq_a; const float* ssq_b;
    __device__ __forceinline__ void prep(const pg8::Unit& u, LAS unsigned char* lds, int wid, int par) const {
        if (wid < 4) { const int ln = lane_id(), row = wid * 64 + ln; const float sa = ssq_a[u.pm * 256 + row], sb = ssq_b[u.pm * 256 + row];
            const float ra = __builtin_amdgcn_rsqf(sa * (1.f / 512) + EPS), rb = __builtin_amdgcn_rsqf(sb * (1.f / 512) + EPS);
            ((LAS f32x2*)(lds + EPI_OFF + 5120))[par * 256 + row] = (f32x2){ra * __builtin_amdgcn_rcpf(rb), rb}; }
    }
    __device__ __forceinline__ void midk(Acc& acc, LAS unsigned char* lds, int par, int wr) const {
        const int ln = lane_id(), fr = ln & 15; const LAS f32x2* RT = (const LAS f32x2*)(lds + EPI_OFF + 5120) + par * 256;
#pragma unroll
        for (int ai = 0; ai < 2; ++ai)
#pragma unroll
            for (int m = 0; m < 4; ++m) { const float r = RT[ai * 128 + wr * 64 + m * 16 + fr].x;
#pragma unroll
                for (int bj = 0; bj < 2; ++bj)
#pragma unroll
                    for (int n = 0; n < 2; ++n) acc[ai][bj][m][n] = acc[ai][bj][m][n] * r; }
    }
    __device__ __forceinline__ void operator()(Acc& acc, const pg8::Unit& u, int wr, int wc, int fr, int fq, LAS unsigned char* lds, int wid, int par) const {
        const int ln = lane_id(); fr = ln & 15; fq = ln >> 4;
        if constexpr (MIDK_) { const LAS f32x2* RT = (const LAS f32x2*)(lds + EPI_OFF + 5120) + par * 256;
#pragma unroll
            for (int ai = 0; ai < 2; ++ai)
#pragma unroll
                for (int m = 0; m < 4; ++m) { const float r = RT[ai * 128 + wr * 64 + m * 16 + fr].y;
#pragma unroll
                    for (int bj = 0; bj < 2; ++bj)
#pragma unroll
                        for (int n = 0; n < 2; ++n) acc[ai][bj][m][n] = acc[ai][bj][m][n] * r; } }
        LAS float* PT = (LAS float*)(lds + EPI_OFF);
        LAS float* SR = (LAS float*)(lds + EPI_OFF + 4096);
        const int col0 = u.pn * 256 + wc * 32 + 8 * fq;
        f32x4 gv[2][2];
#pragma unroll
        for (int bj = 0; bj < 2; ++bj)
#pragma unroll
            for (int n = 0; n < 2; ++n) gv[bj][n] = *(const f32x4*)(gpost + col0 + bj * 128 + n * 4);
        u32x4 hb[2][4][2];
        if (!hold_f) {
#pragma unroll
            for (int ai = 0; ai < 2; ++ai)
#pragma unroll
                for (int m = 0; m < 4; ++m)
#pragma unroll
                    for (int bj = 0; bj < 2; ++bj) hb[ai][m][bj] = *(const u32x4*)(hold_b + (size_t)(u.pm * 256 + ai * 128 + wr * 64 + m * 16 + fr) * DM + col0 + bj * 128); }
#pragma unroll
        for (int ai = 0; ai < 2; ++ai)
#pragma unroll
            for (int m = 0; m < 4; ++m) { float q = 0.f;
#pragma unroll
                for (int bj = 0; bj < 2; ++bj)
#pragma unroll
                    for (int n = 0; n < 2; ++n) { const f32x4 x = acc[ai][bj][m][n]; q += (x[0] * x[0] + x[1] * x[1]) + (x[2] * x[2] + x[3] * x[3]); }
                q += __shfl_xor(q, 16); q += __shfl_xor(q, 32);
                if (fq == 0) PT[(ai * 128 + wr * 64 + m * 16 + fr) * 4 + wc] = q; }
        LDS_WAIT(); __builtin_amdgcn_s_barrier(); asm volatile("" ::: "memory");
        unsigned* c = cnt + 64 * u.pm;
        if (wid < 4) { const int row = wid * 64 + ln; const f32x4 t = *(const LAS f32x4*)(PT + row * 4); const float sq = (t[0] + t[1]) + (t[2] + t[3]);
            __hip_atomic_store((unsigned*)slots + ((size_t)(u.pm * 256 + row) * 4 + u.pn), __float_as_uint(sq), __ATOMIC_RELAXED, __HIP_MEMORY_SCOPE_AGENT);
            asm volatile("s_waitcnt vmcnt(0)" ::: "memory");
            if (ln == 0) __hip_atomic_fetch_add(c, 1u, __ATOMIC_RELAXED, __HIP_MEMORY_SCOPE_AGENT); }
        if (wid == 0) { unsigned sp = 0;
            while ((unsigned)__builtin_amdgcn_readfirstlane(ag_ld(c)) < 16u) { __builtin_amdgcn_s_sleep(2); if (++sp > (1u << 21)) break; }
            __builtin_amdgcn_fence(__ATOMIC_ACQUIRE, "agent"); }
        asm volatile("s_waitcnt vmcnt(0) lgkmcnt(0)" ::: "memory"); __builtin_amdgcn_s_barrier(); asm volatile("" ::: "memory");
        if (wid < 4) { const int row = wid * 64 + ln; const unsigned* sl = (const unsigned*)slots + (size_t)(u.pm * 256 + row) * 4;
            const float tot = (__uint_as_float(ag_ld(sl)) + __uint_as_float(ag_ld(sl + 1))) + (__uint_as_float(ag_ld(sl + 2)) + __uint_as_float(ag_ld(sl + 3)));
            SR[row] = __builtin_amdgcn_rsqf(tot * (1.f / DM) + EPS); }
        LDS_WAIT(); __builtin_amdgcn_s_barrier(); asm volatile("" ::: "memory");
#pragma unroll
        for (int ai = 0; ai < 2; ++ai) { float s[4];
#pragma unroll
            for (int m = 0; m < 4; ++m) { const int rl = ai * 128 + wr * 64 + m * 16 + fr; const float rs = SR[rl]; const size_t off = (size_t)(u.pm * 256 + rl) * DM + col0; float q = 0.f;
#pragma unroll
                for (int bj = 0; bj < 2; ++bj) { f32x4 h0, h1;
                    if (hold_f) { h0 = *(const f32x4*)(hold_f + off + bj * 128); h1 = *(const f32x4*)(hold_f + off + bj * 128 + 4); }
                    else { const u32x4 hv = hb[ai][m][bj]; h0 = (f32x4){bflo(hv.x), bfhi(hv.x), bflo(hv.y), bfhi(hv.y)}; h1 = (f32x4){bflo(hv.z), bfhi(hv.z), bflo(hv.w), bfhi(hv.w)}; }
                    const f32x4 v0 = h0 + acc[ai][bj][m][0] * rs * gv[bj][0], v1 = h1 + acc[ai][bj][m][1] * rs * gv[bj][1];
                    q += ((v0[0] * v0[0] + v0[1] * v0[1]) + (v0[2] * v0[2] + v0[3] * v0[3])) + ((v1[0] * v1[0] + v1[1] * v1[1]) + (v1[2] * v1[2] + v1[3] * v1[3]));
                    if (hout) { *(f32x4*)(hout + off + bj * 128) = v0; *(f32x4*)(hout + off + bj * 128 + 4) = v1; }
                    if (xn) { u32x4 w; w.x = cvt_pk_bf16(v0[0], v0[1]); w.y = cvt_pk_bf16(v0[2], v0[3]); w.z = cvt_pk_bf16(v1[0], v1[1]); w.w = cvt_pk_bf16(v1[2], v1[3]); *(u32x4*)(xn + off + bj * 128) = w; } }
                q += __shfl_xor(q, 16); q += __shfl_xor(q, 32); s[m] = q; }
            if (ssq_next) { const float v = fq == 0 ? s[0] : fq == 1 ? s[1] : fq == 2 ? s[2] : s[3]; atomicAdd(ssq_next + u.pm * 256 + wr * 64 + ai * 128 + ln, v); } }
    }
};
typedef EpiNormResT<false> EpiNormRes;
typedef EpiNormResT<true> EpiNormResMid;

#define XB_TMO      128
#define XB_XCNT(j)  (256  + 64 * (j))
#define XB_XSUB(j)  (1280 + 64 * (j))
#define XB_XGEN(j)  (2304 + 64 * (j))
#define XB_TOP      3328
#define XB_TOPGEN   3392
#define XCD_BAR_WORDS 3456
#define XB_SPIN_CAP (1u << 20)
__device__ __forceinline__ unsigned xb_ld(unsigned* p)              { return __hip_atomic_load(p, __ATOMIC_RELAXED, __HIP_MEMORY_SCOPE_AGENT); }
__device__ __forceinline__ unsigned xb_add(unsigned* p, unsigned v) { return __hip_atomic_fetch_add(p, v, __ATOMIC_RELAXED, __HIP_MEMORY_SCOPE_AGENT); }
__device__ __forceinline__ unsigned xb_xcc_id() { return (unsigned)__builtin_amdgcn_s_getreg((3 << 11) | 20) & 0xFu; }
#define XB_SPIN(cond, bar) do { unsigned _sp = 0; while (cond) { __builtin_amdgcn_s_sleep(1); \
    if ((++_sp & 255u) == 0u) { if (xb_ld(&(bar)[XB_TMO])) break; if (_sp > XB_SPIN_CAP) { atomicAdd(&(bar)[XB_TMO], 1u); break; } } } } while (0)
struct XcdBarrier { unsigned* bar; unsigned x; volatile LAS unsigned* st; unsigned G; };
__device__ __forceinline__ XcdBarrier xcd_barrier_post(unsigned* bar, volatile LAS unsigned* st, unsigned G) {
    XcdBarrier b; b.bar = bar; b.x = xb_xcc_id(); b.st = st; b.G = G;
    if (threadIdx.x == 0) (void)xb_add(&bar[XB_XCNT(b.x)], 1u);
    return b;
}
__device__ __forceinline__ void xcd_barrier_complete(unsigned* bar, unsigned x, unsigned& nloc, unsigned& nx, const unsigned G) {
    unsigned sum, cnt, mine, sp = 0u;
    for (;;) {
        sum = 0u; cnt = 0u; mine = 0u;
#pragma unroll
        for (unsigned j = 0; j < 16; ++j) { const unsigned c = xb_ld(&bar[XB_XCNT(j)]); sum += c; cnt += (c > 0u) ? 1u : 0u; mine = (j == x) ? c : mine; }
        if (sum == G) break;
        __builtin_amdgcn_s_sleep(1);
        if ((++sp & 255u) == 0u) { if (xb_ld(&bar[XB_TMO])) break; if (sp > XB_SPIN_CAP) { atomicAdd(&bar[XB_TMO], 1u); break; } }
    }
    nloc = mine > 0u ? mine : 1u; nx = cnt > 0u ? cnt : 1u;
}
__device__ __forceinline__ void xcd_barrier(const XcdBarrier& b, const int wv) {
    asm volatile("s_waitcnt vmcnt(0)" ::: "memory");
    __syncthreads();
    if (wv == 0 && lane_id() == 0) {
        unsigned* bar = b.bar;
        __builtin_amdgcn_s_waitcnt(0);
        unsigned nloc = b.st[0], nx = b.st[1];
        if (nloc == 0u) { xcd_barrier_complete(bar, b.x, nloc, nx, b.G); b.st[0] = nloc; b.st[1] = nx; }
        const unsigned old = xb_add(&bar[XB_XSUB(b.x)], 1u);
        const unsigned gen = old / nloc;
        if (old + 1u == (gen + 1u) * nloc) {
            __builtin_amdgcn_fence(__ATOMIC_RELEASE, "agent");
            asm volatile("s_waitcnt vmcnt(0)" ::: "memory");
            const unsigned og = xb_add(&bar[XB_TOP], 1u);
            const unsigned tg = og / nx;
            if (og + 1u == (tg + 1u) * nx) xb_add(&bar[XB_TOPGEN], 1u);
            else XB_SPIN(xb_ld(&bar[XB_TOPGEN]) == tg, bar);
            __builtin_amdgcn_fence(__ATOMIC_ACQUIRE, "agent");
            xb_add(&bar[XB_XGEN(b.x)], 1u);
            asm volatile("s_waitcnt vmcnt(0)" ::: "memory");
        } else {
            XB_SPIN(xb_ld(&bar[XB_XGEN(b.x)]) == gen, bar);
            __builtin_amdgcn_fence(__ATOMIC_ACQUIRE, "agent");
            asm volatile("s_waitcnt vmcnt(0)" ::: "memory");
        }
    }
    __syncthreads();
}

enum { MAP_ID = 0, MAP_WIN = 1, MAP_WUQ = 2, MAP_WUKV = 3, MAP_GATE = 4, MAP_UP = 5 };
__device__ __forceinline__ int map_n(int mode, int n) {
    switch (mode) {
    case MAP_WIN: { if (n < OFF_KPE) return n; const int j = n - OFF_KPE; return OFF_KPE + (j < 32 ? 2 * j : 2 * (j - 32) + 1); }
    case MAP_WUQ: { const int h = n / 192, d = n % 192; if (d < 128) return h * 128 + d; const int j = d - 128; return 512 + h * 64 + (j < 32 ? 2 * j : 2 * (j - 32) + 1); }
    case MAP_WUKV: { const int h = n / 256, d = n % 256; return d < 128 ? h * 128 + d : 512 + h * 128 + (d - 128); }
    case MAP_GATE: return (n >> 7) * 256 + (n & 127);
    case MAP_UP: return (n >> 7) * 256 + 128 + (n & 127);
    default: return n;
    }
}
__device__ __forceinline__ void p0_transpose_item(const float* W, int K, int N, bf16_t* WT, int row_off, int mode, const float* kscale, const float* kscale2, LAS float* scr, int item, int lane) {
    const int nblk = N / 64, kb = item / nblk, nb = item % nblk, k0 = 64 * kb, n0 = 64 * nb;
    float v[64];
#pragma unroll
    for (int i = 0; i < 64; ++i) v[i] = W[(size_t)(k0 + i) * N + n0 + lane];
    if (kscale) { const float* ks = (kscale2 && k0 >= 512) ? kscale2 - 512 : kscale;
#pragma unroll
        for (int i = 0; i < 64; ++i) v[i] *= ks[k0 + i]; }
#pragma unroll
    for (int i = 0; i < 64; ++i) scr[i * 65 + lane] = v[i];
    LDS_WAIT(); asm volatile("" ::: "memory");
    const int c = lane & 7;
#pragma unroll
    for (int j = 0; j < 8; ++j) { const int n = (lane >> 3) + 8 * j; const LAS float* sp = scr + (8 * c) * 65 + n;
        u32x4 o; o.x = cvt_pk_bf16(sp[0 * 65], sp[1 * 65]); o.y = cvt_pk_bf16(sp[2 * 65], sp[3 * 65]); o.z = cvt_pk_bf16(sp[4 * 65], sp[5 * 65]); o.w = cvt_pk_bf16(sp[6 * 65], sp[7 * 65]);
        *(u32x4*)(WT + (size_t)(row_off + map_n(mode, n0 + n)) * K + k0 + 8 * c) = o; }
    LDS_WAIT(); asm volatile("" ::: "memory");
}
template <int R, bool NORM>
__device__ __forceinline__ void rms_rows_to_bf16(const float* xrow, const float* g, bf16_t* orow, float* ssq_out, int lane) {
    f32x4 v[R][4]; float s[R];
#pragma unroll
    for (int r = 0; r < R; ++r)
#pragma unroll
        for (int j = 0; j < 4; ++j) v[r][j] = ((const f32x4*)(xrow + (size_t)r * DM) + lane)[64 * j];
    f32x4 gg[4];
#pragma unroll
    for (int j = 0; j < 4; ++j) gg[j] = ((const f32x4*)g + lane)[64 * j];
#pragma unroll
    for (int r = 0; r < R; ++r) { float q = 0.f;
#pragma unroll
        for (int j = 0; j < 4; ++j) q += (v[r][j].x * v[r][j].x + v[r][j].y * v[r][j].y) + (v[r][j].z * v[r][j].z + v[r][j].w * v[r][j].w);
        s[r] = q; }
#pragma unroll
    for (int o = 1; o < 64; o <<= 1)
#pragma unroll
        for (int r = 0; r < R; ++r) s[r] += __shfl_xor(s[r], o);
#pragma unroll
    for (int r = 0; r < R; ++r) { const float rs = NORM ? __builtin_amdgcn_rsqf(s[r] * (1.f / DM) + EPS) : 1.f; u32x2* o8 = (u32x2*)(orow + (size_t)r * DM) + lane;
        if (!NORM) { if (lane == 0) ssq_out[r] = s[r];
#pragma unroll
            for (int j = 0; j < 4; ++j) gg[j] = (f32x4){1.f, 1.f, 1.f, 1.f}; }
#pragma unroll
        for (int j = 0; j < 4; ++j) { u32x2 w; w.x = cvt_pk_bf16(v[r][j].x * rs * gg[j].x, v[r][j].y * rs * gg[j].y); w.y = cvt_pk_bf16(v[r][j].z * rs * gg[j].z, v[r][j].w * rs * gg[j].w); o8[64 * j] = w; } }
}
__device__ __forceinline__ void resid_row(const float* pre, const float* hold, const float* gpost, float* hout, const float* gnext, bf16_t* xn, int lane) {
    const f32x4* pr = (const f32x4*)pre + lane; const f32x4* hr = (const f32x4*)hold + lane; const f32x4* gp = (const f32x4*)gpost + lane;
    f32x4 v[4]; float s = 0.f;
#pragma unroll
    for (int j = 0; j < 4; ++j) { v[j] = pr[64 * j]; s += (v[j].x * v[j].x + v[j].y * v[j].y) + (v[j].z * v[j].z + v[j].w * v[j].w); }
    const float rs = __builtin_amdgcn_rsqf(wave_sum(s) * (1.f / DM) + EPS);
    float s2 = 0.f;
#pragma unroll
    for (int j = 0; j < 4; ++j) { const f32x4 h = hr[64 * j], g = gp[64 * j]; v[j] = h + v[j] * rs * g; s2 += (v[j].x * v[j].x + v[j].y * v[j].y) + (v[j].z * v[j].z + v[j].w * v[j].w); }
    f32x4* ho = (f32x4*)hout + lane;
#pragma unroll
    for (int j = 0; j < 4; ++j) ho[64 * j] = v[j];
    if (xn) { const float rs2 = __builtin_amdgcn_rsqf(wave_sum(s2) * (1.f / DM) + EPS); const f32x4* gn = (const f32x4*)gnext + lane; u32x2* o8 = (u32x2*)xn + lane;
#pragma unroll
        for (int j = 0; j < 4; ++j) { const f32x4 gg = gn[64 * j]; u32x2 w; w.x = cvt_pk_bf16(v[j].x * rs2 * gg.x, v[j].y * rs2 * gg.y); w.y = cvt_pk_bf16(v[j].z * rs2 * gg.z, v[j].w * rs2 * gg.w); o8[64 * j] = w; } }
}

namespace lru {
constexpr int TT = 128, NTILE = SEQ / TT, UP = 72;
constexpr int L_U = 0, L_UF = L_U + TT * UP * 2, L_WSEG = L_UF + TT * 33 * 4, L_CARRY = L_WSEG + 2 * 8 * 32 * 8, L_TSS = L_CARRY + 2 * 32 * 4, L_END = L_TSS + 2 * TT * 4;
static_assert(L_END <= RING_BYTES, "lru lds");
__device__ __forceinline__ float sigmoidf_(float x) { return __builtin_amdgcn_rcpf(1.f + __builtin_amdgcn_exp2f(-x * LOG2E)); }
__device__ __forceinline__ void unit(int b, int cb, const bf16_t* Z, bf16_t* Y, float* ssq_lru, const float* conv_w, const float* conv_b, const float* wa, const float* ba, const float* wx, const float* bx,
                                     const float* lam, LAS unsigned char* lds, const int wv) {
    const int lane = lane_id(), wid = wv, tid = wv * 64 + lane;
    const int hblk = cb >> 1, half = cb & 1, ib = hblk * 64, c0 = cb * 32;
    LAS bf16_t* U = (LAS bf16_t*)(lds + L_U); LAS float* UF = (LAS float*)(lds + L_UF); LAS f32x2* WSEG = (LAS f32x2*)(lds + L_WSEG);
    LAS float* CARRY = (LAS float*)(lds + L_CARRY); LAS float* TSS = (LAS float*)(lds + L_TSS);
    const int col = lane & 15, kq = lane >> 4;
    bf16x8 Bf[4][2];
#pragma unroll
    for (int nb = 0; nb < 4; ++nb)
#pragma unroll
        for (int ks = 0; ks < 2; ++ks) { const float* Wg = (nb < 2) ? wa : wx; const int oc = half * 32 + (nb & 1) * 16 + col; float w[8];
#pragma unroll
            for (int j = 0; j < 8; ++j) w[j] = Wg[((size_t)hblk * 64 + ks * 32 + 8 * kq + j) * 64 + oc];
            u32x4 p; p.x = cvt_pk_bf16(w[0], w[1]); p.y = cvt_pk_bf16(w[2], w[3]); p.z = cvt_pk_bf16(w[4], w[5]); p.w = cvt_pk_bf16(w[6], w[7]); Bf[nb][ks] = __builtin_bit_cast(bf16x8, p); }
    float cba[2], cbx[2], csp[2];
#pragma unroll
    for (int e = 0; e < 2; ++e) { const int ch = c0 + e * 16 + col; cba[e] = ba[ch]; cbx[e] = bx[ch]; const float l = lam[ch];
        csp[e] = 8.f * LOG2E * (fmaxf(-l, 0.f) + log1pf(expf(-fabsf(l)))); }
    const int cch = lane;
    const float cw0 = conv_w[0 * DLRU + ib + cch], cw1 = conv_w[1 * DLRU + ib + cch], cw2 = conv_w[2 * DLRU + ib + cch], cw3 = conv_w[3 * DLRU + ib + cch], cbb = conv_b[ib + cch];
    if (tid < 64) CARRY[tid] = 0.f;
    if (tid < 2 * TT) TSS[tid] = 0.f;
    const size_t rowb = (size_t)b * SEQ;
    const bf16_t* zx = Z + (rowb + wid * 16) * DINP + ib + cch;
    const bf16_t* zg = Z + (rowb + wid * 16 + kq * 4) * DINP + OFF_GATE + c0 + col;
    bf16_t* yp = Y + (rowb + wid * 16 + kq * 4) * DM + c0 + col;
    unsigned short xr[19], gr[8];
#define LRU_LOADX(t0_) do { _Pragma("unroll") for (int k = 0; k < 19; ++k) { const int tk = (t0_) + wid * 16 + k - 3; xr[k] = (tk >= 0) ? zx[(ptrdiff_t)((t0_) + k - 3) * DINP] : (unsigned short)0; } } while (0)
    LRU_LOADX(0);
    __syncthreads();
    for (int tile = 0; tile < NTILE; ++tile) {
        const int t0 = tile * TT, par = tile & 1;
        { float xm3 = bf2f(xr[0]), xm2 = bf2f(xr[1]), xm1 = bf2f(xr[2]);
#pragma unroll
          for (int k = 0; k < 16; ++k) { const float x0 = bf2f(xr[3 + k]); const float u = cbb + cw0 * xm3 + cw1 * xm2 + cw2 * xm1 + cw3 * x0; xm3 = xm2; xm2 = xm1; xm1 = x0;
              const int tl = wid * 16 + k; U[tl * UP + cch] = (bf16_t)(cvt_pk_bf16(u, 0.f) & 0xffffu);
              if ((cch >> 5) == half) UF[tl * 33 + (cch & 31)] = u; } }
#pragma unroll
        for (int e = 0; e < 2; ++e)
#pragma unroll
            for (int r = 0; r < 4; ++r) gr[e * 4 + r] = zg[(size_t)(t0 + r) * DINP + e * 16];
        if (tile + 1 < NTILE) LRU_LOADX(t0 + TT);
        LDS_WAIT();
        float av[2][4], uv[2][4], Ainc[2], Hinc[2];
        { f32x4 C[4];
#pragma unroll
          for (int nb = 0; nb < 4; ++nb) C[nb] = (f32x4){0.f, 0.f, 0.f, 0.f};
          const LAS bf16_t* ua = U + (wid * 16 + col) * UP + 8 * kq;
          const bf16x8 a0 = *(const LAS bf16x8*)ua, a1 = *(const LAS bf16x8*)(ua + 32);
#pragma unroll
          for (int nb = 0; nb < 4; ++nb) { C[nb] = __builtin_amdgcn_mfma_f32_16x16x32_bf16(a0, Bf[nb][0], C[nb], 0, 0, 0); C[nb] = __builtin_amdgcn_mfma_f32_16x16x32_bf16(a1, Bf[nb][1], C[nb], 0, 0, 0); }
#pragma unroll
          for (int e = 0; e < 2; ++e) { float Ap = 1.f, H = 0.f;
#pragma unroll
              for (int r = 0; r < 4; ++r) { const int tl = wid * 16 + kq * 4 + r, ch = e * 16 + col;
                  const float rg = sigmoidf_(C[e][r] + cba[e]), ig = sigmoidf_(C[e + 2][r] + cbx[e]);
                  const float a = __builtin_amdgcn_exp2f(-rg * csp[e]); const float mult = __builtin_amdgcn_sqrtf(fmaxf(1.f - a * a, 0.f));
                  const float uu = mult * ig * UF[tl * 33 + ch];
                  av[e][r] = a; uv[e][r] = uu; H = a * H + uu; Ap *= a; }
              { const float Ap1 = __shfl_up(Ap, 16), H1 = __shfl_up(H, 16); if (kq >= 1) { H = Ap * H1 + H; Ap = Ap * Ap1; } }
              { const float Ap2 = __shfl_up(Ap, 32), H2 = __shfl_up(H, 32); if (kq >= 2) { H = Ap * H2 + H; Ap = Ap * Ap2; } }
              Ainc[e] = Ap; Hinc[e] = H;
              if (kq == 3) WSEG[(par * 8 + wid) * 32 + e * 16 + col] = (f32x2){Ap, H}; } }
        __syncthreads();
        if (tid < TT) { const float v = TSS[(par ^ 1) * TT + tid]; if (tile > 0) atomicAdd(ssq_lru + rowb + t0 - TT + tid, v); }
        float qs[4] = {0.f, 0.f, 0.f, 0.f};
#pragma unroll
        for (int e = 0; e < 2; ++e) { const int ch = e * 16 + col;
            float h = CARRY[par * 32 + ch];
            for (int w2 = 0; w2 < wid; ++w2) { const f32x2 sg = WSEG[(par * 8 + w2) * 32 + ch]; h = sg.x * h + sg.y; }
            if (wid == 7 && kq == 0) { const f32x2 sg = WSEG[(par * 8 + 7) * 32 + ch]; CARRY[(par ^ 1) * 32 + ch] = sg.x * h + sg.y; }
            const float Ae = __shfl_up(Ainc[e], 16), He = __shfl_up(Hinc[e], 16);
            if (kq >= 1) h = Ae * h + He;
#pragma unroll
            for (int r = 0; r < 4; ++r) { h = av[e][r] * h + uv[e][r]; const float g = bf2f(gr[e * 4 + r]);
                const float ge = g * __builtin_amdgcn_rcpf(1.f + __builtin_amdgcn_exp2f(-1.5957691216057308f * LOG2E * (g + 0.044715f * g * g * g)));
                const float y = h * ge; yp[(size_t)(t0 + r) * DM + e * 16] = (bf16_t)(cvt_pk_bf16(y, 0.f) & 0xffffu); qs[r] += y * y; } }
#pragma unroll
        for (int r = 0; r < 4; ++r) { float q = qs[r]; q += __shfl_xor(q, 1); q += __shfl_xor(q, 2); q += __shfl_xor(q, 4); q += __shfl_xor(q, 8);
            if (col == 0) TSS[par * TT + wid * 16 + kq * 4 + r] = q; }
    }
    __syncthreads();
    if (tid < TT) atomicAdd(ssq_lru + rowb + (NTILE - 1) * TT + tid, TSS[((NTILE - 1) & 1) * TT + tid]);
    __syncthreads();
#undef LRU_LOADX
}
}

namespace mla {
constexpr int NW = 8, QBLK = 32, KVBLK = 64, QB = 256, KROW = 384, SHM_K = KVBLK * KROW, SHM_V = KVBLK * 128 * 2;
constexpr int L_V = 0, L_K = 2 * SHM_V, L_WS = L_K + 2 * SHM_K, L_END = L_WS + NW * 64 * 4;
static_assert(L_END <= RING_BYTES && NW * 8192 <= L_WS, "mla lds");
#define KSWZ(row, colB) ((row) * KROW + ((colB) ^ ((((row) >> 1) & 7) << 4)))
#define SBAR() __builtin_amdgcn_sched_barrier(0)
__device__ __forceinline__ int v_st(int k, int c) { const int kk = (k & ~0xC) | ((k & 4) << 1) | ((k & 8) >> 1); return ((kk >> 3) * 4 + (c >> 5)) * 512 + ((kk & 7) * 32 + (c & 31)) * 2; }
__device__ __forceinline__ int v_rd_base(int lane) { return ((lane & 3) << 3) | (((lane >> 2) & 3) << 6) | (((lane >> 4) & 1) << 5) | (((lane >> 5) & 1) << 8); }
constexpr int v_rd_off(int d0, int ks, int half) { return d0 * 512 + ks * 4096 + half * 2048; }
__device__ __forceinline__ int crow(int r, int hi) { return (r & 3) + 8 * (r >> 2) + 4 * hi; }
__device__ __forceinline__ void mask_tile(f32x16& p0, f32x16& p1, int dq) {
    const float NEG = -__builtin_inff();
#pragma unroll
    for (int r = 0; r < 16; ++r) { const int c = (r & 3) + 8 * (r >> 2); if (dq - c < 0) p0[r] = NEG; if (dq - c - 32 < 0) p1[r] = NEG; }
}
constexpr float THR2 = 8.f * LOG2E;
__device__ __forceinline__ void partialSM(f32x16& p0, f32x16& p1, float& m_reg, float& alpha) {
    float pmax = p0[0];
#pragma unroll
    for (int r = 1; r < 16; ++r) pmax = fmaxf(pmax, p0[r]);
#pragma unroll
    for (int r = 0; r < 16; ++r) pmax = fmaxf(pmax, p1[r]);
    { auto rr = __builtin_amdgcn_permlane32_swap(__float_as_uint(pmax), __float_as_uint(pmax), false, false); pmax = fmaxf(__uint_as_float(rr[0]), __uint_as_float(rr[1])); }
    float mn;
    if (__builtin_expect(__all((pmax - m_reg) <= THR2), 1)) { mn = m_reg; alpha = 1.f; }
    else { mn = fmaxf(m_reg, pmax); alpha = __builtin_amdgcn_exp2f(m_reg - mn); m_reg = mn; }
#pragma unroll
    for (int r = 0; r < 16; ++r) p0[r] = p0[r] - mn;
#pragma unroll
    for (int r = 0; r < 16; ++r) p1[r] = p1[r] - mn;
#pragma unroll
    for (int r = 0; r < 16; ++r) p0[r] = __builtin_amdgcn_exp2f(p0[r]);
}
__device__ __forceinline__ void finishSM(f32x16& p0, f32x16& p1, float alpha, float& l_reg, bf16x8& pa0, bf16x8& pa1, bf16x8& pa2, bf16x8& pa3) {
#pragma unroll
    for (int r = 0; r < 16; ++r) p1[r] = __builtin_amdgcn_exp2f(p1[r]);
    float ps = 0;
#pragma unroll
    for (int r = 0; r < 16; ++r) ps += p0[r];
#pragma unroll
    for (int r = 0; r < 16; ++r) ps += p1[r];
    { auto rr = __builtin_amdgcn_permlane32_swap(__float_as_uint(ps), __float_as_uint(ps), false, false); ps = __uint_as_float(rr[0]) + __uint_as_float(rr[1]); }
    l_reg = l_reg * alpha + ps;
#define PK4(P, B_, OUT) do { unsigned a0 = cvt_pk_bf16(P[B_+0], P[B_+1]), a1 = cvt_pk_bf16(P[B_+2], P[B_+3]);                          \
        unsigned b0 = cvt_pk_bf16(P[B_+4], P[B_+5]), b1 = cvt_pk_bf16(P[B_+6], P[B_+7]);                                             \
        auto r0 = __builtin_amdgcn_permlane32_swap(a0, b0, false, false); auto r1 = __builtin_amdgcn_permlane32_swap(a1, b1, false, false); \
        u32x4 w = {r0[0], r1[0], r0[1], r1[1]}; OUT = __builtin_bit_cast(bf16x8, w); } while (0)
    PK4(p0, 0, pa0); PK4(p0, 8, pa1); PK4(p1, 0, pa2); PK4(p1, 8, pa3);
#undef PK4
}
template <int KB>
__device__ __forceinline__ void qkt(f32x16& p0, f32x16& p1, const char* K_lds, int r32, int hi, const bf16x8* qr) {
    p0 = f32x16{}; p1 = f32x16{};
    unsigned kb[4];
#pragma unroll
    for (int dd = 0; dd < 4; ++dd) kb[dd] = (unsigned)(uintptr_t)(K_lds + KB * SHM_K + KSWZ(r32, (dd * 16 + hi * 8) * 2));
    bf16x8 fa[4], fb[4];
#define KRD(slot, d0) do { asm volatile("ds_read_b128 %0, %1 offset:%2" : "=v"(fa[slot]) : "v"(kb[(d0) & 3]), "i"(((d0) >> 2) * 128)); \
                           asm volatile("ds_read_b128 %0, %1 offset:%2" : "=v"(fb[slot]) : "v"(kb[(d0) & 3]), "i"(((d0) >> 2) * 128 + 32 * KROW)); } while (0)
#define KMM(slot, d0, N) do { asm volatile("s_waitcnt lgkmcnt(%0)" :: "i"(N) : "memory"); SBAR(); \
        p0 = __builtin_amdgcn_mfma_f32_32x32x16_bf16(fa[slot], qr[d0], p0, 0, 0, 0); p1 = __builtin_amdgcn_mfma_f32_32x32x16_bf16(fb[slot], qr[d0], p1, 0, 0, 0); SBAR(); } while (0)
    KRD(0, 0); KRD(1, 1); KRD(2, 2); KRD(3, 3);
    KMM(0, 0, 6); KRD(0, 4); KMM(1, 1, 6); KRD(1, 5); KMM(2, 2, 6); KRD(2, 6); KMM(3, 3, 6); KRD(3, 7);
    KMM(0, 4, 6); KRD(0, 8); KMM(1, 5, 6); KRD(1, 9); KMM(2, 6, 6); KRD(2, 10); KMM(3, 7, 6); KRD(3, 11);
    KMM(0, 8, 6); KMM(1, 9, 4); KMM(2, 10, 2); KMM(3, 11, 0);
#undef KRD
#undef KMM
}
template <int VB>
__device__ __forceinline__ void pv_tile(f32x16* o, int vb0, bf16x8 pa0, bf16x8 pa1, bf16x8 pa2, bf16x8 pa3) {
    s16x4 lo[2][4], hh[2][4];
#define TRRD(dst, off) asm volatile("ds_read_b64_tr_b16 %0, %1 offset:%2" : "=v"(dst) : "v"(vb0), "i"(off))
#define VRD(set, d0) do { constexpr int b_ = VB * SHM_V + v_rd_off(d0, 0, 0); \
        TRRD(lo[set][0], b_); TRRD(hh[set][0], b_ + 2048); TRRD(lo[set][1], b_ + 4096); TRRD(hh[set][1], b_ + 6144); \
        TRRD(lo[set][2], b_ + 8192); TRRD(hh[set][2], b_ + 10240); TRRD(lo[set][3], b_ + 12288); TRRD(hh[set][3], b_ + 14336); } while (0)
#define VFR(set, k) (bf16x8){lo[set][k][0], lo[set][k][1], lo[set][k][2], lo[set][k][3], hh[set][k][0], hh[set][k][1], hh[set][k][2], hh[set][k][3]}
#define VMM(set, d0, N) do { asm volatile("s_waitcnt lgkmcnt(%0)" :: "i"(N) : "memory"); SBAR(); \
        o[d0] = __builtin_amdgcn_mfma_f32_32x32x16_bf16(pa0, VFR(set, 0), o[d0], 0, 0, 0); o[d0] = __builtin_amdgcn_mfma_f32_32x32x16_bf16(pa1, VFR(set, 1), o[d0], 0, 0, 0); \
        o[d0] = __builtin_amdgcn_mfma_f32_32x32x16_bf16(pa2, VFR(set, 2), o[d0], 0, 0, 0); o[d0] = __builtin_amdgcn_mfma_f32_32x32x16_bf16(pa3, VFR(set, 3), o[d0], 0, 0, 0); SBAR(); } while (0)
    VRD(0, 0); VRD(1, 1);
    VMM(0, 0, 8); VRD(0, 2); VMM(1, 1, 8); VRD(1, 3); VMM(0, 2, 8); VMM(1, 3, 0);
#undef TRRD
#undef VRD
#undef VFR
#undef VMM
}
__device__ __forceinline__ void block(int b, int h, int qb, const bf16_t* Qb, const bf16_t* KVb, const bf16_t* KPE, bf16_t* Y, float* ssq_mla, char* lds, const int wv) {
    const int lane = lane_id(), wid = wv, tid = wv * 64 + lane, r32 = lane & 31, hi = lane >> 5;
    const size_t rowbase = (size_t)b * SEQ; const int q0 = qb * QB; const int NT = (q0 + QB) / KVBLK;
    const int qlo = q0 + wid * QBLK, qm = qlo + r32 - 4 * hi;
    char* V_lds = lds + L_V; char* K_lds = lds + L_K;
    float* ws = (float*)(lds + L_WS) + wid * 64; float* li_l = ws, * al_l = ws + 32;
    float m_reg = -1e30f, l_reg = 0; f32x16 o[4] = {};
    const int sr = tid >> 4, scc = (tid & 15) * 8, vst0 = v_st(sr, scc), vst1 = v_st(32 + sr, scc), kws = KSWZ(sr, (tid & 15) * 16);
    const int pr = tid >> 3, kws2 = KSWZ(pr, 256 + (tid & 7) * 16);
    const int vb0 = (int)(uintptr_t)V_lds + v_rd_base(lane);
    const bf16_t* Kn = KVb + rowbase * 1024 + h * 128 + scc;
    const bf16_t* Vn = KVb + rowbase * 1024 + 512 + h * 128 + scc;
    const bf16_t* Kp = KPE + rowbase * 64 + (tid & 7) * 8;
    bf16x8 qr[12];
    { const bf16_t* qp = Qb + (rowbase + q0 + wid * QBLK + r32) * 768;
#pragma unroll
      for (int d0 = 0; d0 < 8; ++d0) qr[d0] = *(const bf16x8*)(qp + h * 128 + d0 * 16 + hi * 8);
#pragma unroll
      for (int d0 = 0; d0 < 4; ++d0) qr[8 + d0] = *(const bf16x8*)(qp + 512 + h * 64 + d0 * 16 + hi * 8); }
    const int grp = wid >> 2;
    bf16x8 st_v0, st_v1, st_k0, st_k1, st_k2;
#define SLOADK(t) do { const size_t k0_ = (size_t)(t) * KVBLK; st_k0 = *(const bf16x8*)(Kn + (k0_ + sr) * 1024); st_k1 = *(const bf16x8*)(Kn + (k0_ + 32 + sr) * 1024); st_k2 = *(const bf16x8*)(Kp + (k0_ + pr) * 64); } while (0)
#define SLOADV(t) do { const size_t k0_ = (size_t)(t) * KVBLK; st_v0 = *(const bf16x8*)(Vn + (k0_ + sr) * 1024); st_v1 = *(const bf16x8*)(Vn + (k0_ + 32 + sr) * 1024); } while (0)
#define SWRITEK(off) do { *(bf16x8*)(K_lds + (off) + kws) = st_k0; *(bf16x8*)(K_lds + (off) + kws + 32 * KROW) = st_k1; *(bf16x8*)(K_lds + (off) + kws2) = st_k2; } while (0)
#define SWRITEV(off) do { *(bf16x8*)(V_lds + (off) + vst0) = st_v0; *(bf16x8*)(V_lds + (off) + vst1) = st_v1; } while (0)
#define BAR() asm volatile("s_waitcnt lgkmcnt(0)\n\ts_barrier" ::: "memory")
#define RESC(a) do { if (__any((a) < 1.f)) { if (hi == 0) al_l[r32] = (a); asm volatile("s_waitcnt lgkmcnt(0)" ::: "memory");              \
                     for (int d_ = 0; d_ < 4; ++d_) for (int r = 0; r < 16; ++r) o[d_][r] *= al_l[crow(r, hi)]; } } while (0)
#define MASKT(P0_, P1_, t) do { const int kb_ = (t) * KVBLK; if (kb_ + KVBLK - 1 > qlo) mask_tile(P0_, P1_, qm - kb_); } while (0)
    f32x16 p0, p1; float al; bf16x8 pa0, pa1, pa2, pa3;
    SLOADK(0); VM_WAIT(); SWRITEK(0);
    if (grp) { SLOADK(1); SLOADV(0); }
    BAR();
    if (grp) { VM_WAIT(); SWRITEK(SHM_K); SWRITEV(0); BAR(); }
#define SMSLOT(t, tk, tv) do { if ((tk) < NT || (tv) < NT) { VM_WAIT(); if ((tk) < NT) SWRITEK(((tk) & 1) * SHM_K); if ((tv) < NT) SWRITEV(((tv) & 1) * SHM_V); } \
        MASKT(p0, p1, (t)); partialSM(p0, p1, m_reg, al); RESC(al); finishSM(p0, p1, al, l_reg, pa0, pa1, pa2, pa3); SBAR(); } while (0)
    { const int tk = 1 + grp, tv = grp;
      SLOADK(tk); SLOADV(tv); SBAR(); qkt<0>(p0, p1, K_lds, r32, hi, qr); SBAR();
      BAR(); SMSLOT(0, tk, tv); BAR(); }
    for (int i = 0; i < NT; i += 2) {
        { const int tk = i + 2 + grp, tv = i + 1 + grp;
          if (tk < NT) SLOADK(tk); if (tv < NT) SLOADV(tv); SBAR();
          qkt<1>(p0, p1, K_lds, r32, hi, qr); SBAR(); pv_tile<0>(o, vb0, pa0, pa1, pa2, pa3); SBAR();
          BAR(); SMSLOT(i + 1, tk, tv); BAR(); }
        { const int tk = i + 3 + grp, tv = i + 2 + grp;
          if (tk < NT) SLOADK(tk); if (tv < NT) SLOADV(tv); SBAR();
          if (i + 2 < NT) { qkt<0>(p0, p1, K_lds, r32, hi, qr); SBAR(); }
          pv_tile<1>(o, vb0, pa0, pa1, pa2, pa3); SBAR();
          BAR(); if (i + 2 < NT) SMSLOT(i + 2, tk, tv); BAR(); }
    }
    if (!grp) BAR();
#undef SMSLOT
#undef SLOADK
#undef SLOADV
#undef SWRITEK
#undef SWRITEV
#undef BAR
    if (hi == 0) li_l[r32] = l_reg; asm volatile("s_waitcnt lgkmcnt(0)" ::: "memory");
    float rli[16];
#pragma unroll
    for (int r = 0; r < 16; ++r) rli[r] = __builtin_amdgcn_rcpf(li_l[crow(r, hi)]);
    { bf16_t* stg = (bf16_t*)lds + wid * 4096;
#pragma unroll
      for (int r = 0; r < 16; ++r) { const int orow = crow(r, hi);
#pragma unroll
          for (int d0 = 0; d0 < 4; ++d0) stg[orow * 128 + d0 * 32 + r32] = (bf16_t)(cvt_pk_bf16(o[d0][r] * rli[r], 0.f) & 0xffffu); }
      asm volatile("s_waitcnt lgkmcnt(0)" ::: "memory");
      const int row = lane >> 1, hf = lane & 1; float q = 0.f;
      bf16_t* yp = Y + (rowbase + q0 + wid * QBLK + row) * DM + 512 + h * 128 + hf * 64;
#pragma unroll
      for (int j = 0; j < 8; ++j) { const u32x4 v = *(const u32x4*)(stg + row * 128 + hf * 64 + j * 8);
          q += bflo(v.x) * bflo(v.x) + bfhi(v.x) * bfhi(v.x) + bflo(v.y) * bflo(v.y) + bfhi(v.y) * bfhi(v.y) + bflo(v.z) * bflo(v.z) + bfhi(v.z) * bfhi(v.z) + bflo(v.w) * bflo(v.w) + bfhi(v.w) * bfhi(v.w);
          *(u32x4*)(yp + j * 8) = v; }
      q += __shfl_xor(q, 1);
      if (hf == 0) atomicAdd(ssq_mla + rowbase + q0 + wid * QBLK + row, q); }
    __syncthreads();
#undef RESC
#undef MASKT
}
#undef KSWZ
#undef SBAR
}

constexpr int NWAVES = 8, NPHASE = 13;
struct Args { const void* in[32]; float* out; unsigned char* ws; int ph_lo, ph_hi; };

__global__ void __launch_bounds__(NWAVES * 64, 2) hymba_fwd(Args args) {
    extern __shared__ __attribute__((aligned(16))) unsigned char lds_raw[];
    LAS unsigned char* lds = (LAS unsigned char*)lds_raw;
    volatile LAS unsigned* MISC = (volatile LAS unsigned*)(lds + MISC_OFF);
    const int G = gridDim.x, bx = blockIdx.x, vcu = (G % 8 == 0) ? (bx % 8) * (G / 8) + bx / 8 : bx;
    const int wave_s = __builtin_amdgcn_readfirstlane((int)threadIdx.x >> 6);
#define lane (lane_id())
#define tid (wave_s * 64 + lane)
#define wave (wave_s)
#define gw (vcu * NWAVES + wave)
#define NGW (G * NWAVES)
    unsigned char* ws = args.ws;
#define x_in ((const float*)args.in[0])
#define mem ((const float*)args.in[1])
#define positions ((const int*)args.in[2])
#define g_pre_mix ((const float*)args.in[3])
#define w_in ((const float*)args.in[4])
#define conv_w ((const float*)args.in[5])
#define conv_b ((const float*)args.in[6])
#define lru_wa ((const float*)args.in[7])
#define lru_ba ((const float*)args.in[8])
#define lru_wx ((const float*)args.in[9])
#define lru_bx ((const float*)args.in[10])
#define lru_lambda ((const float*)args.in[11])
#define g_q_lat ((const float*)args.in[12])
#define w_uq ((const float*)args.in[13])
#define g_kv_lat ((const float*)args.in[14])
#define w_ukv ((const float*)args.in[15])
#define g_lru_out ((const float*)args.in[16])
#define g_mla_out ((const float*)args.in[17])
#define w_out ((const float*)args.in[18])
#define g_post_mix ((const float*)args.in[19])
#define g_pre_mem ((const float*)args.in[20])
#define g_mem_kv ((const float*)args.in[21])
#define w_mq ((const float*)args.in[22])
#define w_mk ((const float*)args.in[23])
#define w_mv ((const float*)args.in[24])
#define w_mo ((const float*)args.in[25])
#define g_post_mem ((const float*)args.in[26])
#define g_pre_ffn ((const float*)args.in[27])
#define w_gate ((const float*)args.in[28])
#define w_up ((const float*)args.in[29])
#define w_down ((const float*)args.in[30])
#define g_post_ffn ((const float*)args.in[31])
#define out_p (args.out)
#define ctl ((unsigned*)(ws + WS_CTL))
#define ssq_cq ((float*)(ws + WS_SSQ))
#define ssq_ckv (ssq_cq + T)
#define ssq_lru (ssq_cq + 2 * T)
#define ssq_mla (ssq_cq + 3 * T)
#define ssq_h1 (ssq_cq + 4 * T)
#define ssq_h2 (ssq_cq + 5 * T)
#define ssq_x (ssq_cq + 6 * T)
#define ssq_dummy (ssq_cq + 7 * T)
#define slots_p ((float*)(ws + WS_SLOTS))
#define cosT ((float*)(ws + WS_ROPE))
#define sinT (cosT + (size_t)T * 32)
#define Win_t ((bf16_t*)(ws + WS_WIN))
#define Wuq_t ((bf16_t*)(ws + WS_WUQ))
#define Wukv_t ((bf16_t*)(ws + WS_WUKV))
#define Wout_t ((bf16_t*)(ws + WS_WOUT))
#define Wmq_b ((bf16_t*)(ws + WS_WMQ))
#define Wmkv_t ((bf16_t*)(ws + WS_WMKV))
#define Wmo_t ((bf16_t*)(ws + WS_WMO))
#define Wgu_t ((bf16_t*)(ws + WS_WGU))
#define Wdown_t ((bf16_t*)(ws + WS_WDOWN))
#define MN ((bf16_t*)(ws + WS_MN))
#define MKV ((bf16_t*)(ws + WS_MKV))
#define WQK ((bf16_t*)(ws + WS_WQK))
#define WVO ((bf16_t*)(ws + WS_WVO))
#define XN ((bf16_t*)(ws + WS_XN))
#define KPE ((bf16_t*)(ws + WS_KPE))
#define Z ((bf16_t*)(ws + WS_Z))
#define Qb ((bf16_t*)(ws + WS_Q))
#define KVb ((bf16_t*)(ws + WS_KV))
#define Y ((bf16_t*)(ws + WS_Y))
#define PRE ((float*)(ws + WS_PRE))
#define Pb ((bf16_t*)(ws + WS_P))
#define Fb ((bf16_t*)(ws + WS_F))
    for (int u = tid; u < 256; u += NWAVES * 64) ((LAS unsigned*)(lds + MISC_OFF))[u] = 0u;
    __syncthreads();
    XcdBarrier bar = xcd_barrier_post(ctl + CW_BAR, MISC + 8, (unsigned)G);
    const bool grouped = (G == 256);
    XcdBarrier gbar = grouped ? xcd_barrier_post(ctl + CW_BAR + XCD_BAR_WORDS * (1 + (bx & 7)), MISC + 10, (unsigned)(G >> 3)) : bar;
    const int lo = args.ph_lo, hi = args.ph_hi;
#ifndef REP_PHASE
#define REP_PHASE -1
#endif
#define REPS(k) for (int rep = 0; rep < ((REP_PHASE) == (k) ? 2 : 1); ++rep)
#define RSQ(p) (rep ? ssq_dummy : (p))
#ifndef PHASE_MASK
#define PHASE_MASK 0x1fff
#endif
#define IN(k) (((PHASE_MASK >> (k)) & 1) && lo <= (k) && (k) < hi)
#ifndef ALIGN_P10
#define ALIGN_P10 true
#endif
#ifndef EXTRA_BAR
#define EXTRA_BAR 0
#endif
#define SEAM(k) do { if (IN(k) && IN((k) + 1)) { if ((k) == 0 || !grouped) xcd_barrier(bar, wave_s); else xcd_barrier(gbar, wave_s); } } while (0)

    if (IN(0)) REPS(0) {
        LAS float* scr = (LAS float*)(lds + wave * 16640);
        constexpr int I_IN = 16 * 27, I_UQ = 6 * 12, I_UKV = 4 * 16, I_SQ = 16 * 16, I_GU = 16 * 44, I_DN = 44 * 16;
        int cum = 0;
#define P0_JOB(W, K_, N_, WT, ROFF, MODE, KS, KS2, CNT) do { for (int it = (gw + NGW - (cum % NGW)) % NGW; it < (CNT); it += NGW) p0_transpose_item(W, K_, N_, WT, ROFF, MODE, KS, KS2, scr, it, lane); cum += (CNT); } while (0)
        P0_JOB(w_in, DM, 1728, Win_t, 0, MAP_WIN, g_pre_mix, nullptr, I_IN);
        P0_JOB(w_uq, QLR, 768, Wuq_t, 0, MAP_WUQ, g_q_lat, nullptr, I_UQ);
        P0_JOB(w_ukv, KVLR, 1024, Wukv_t, 0, MAP_WUKV, g_kv_lat, nullptr, I_UKV);
        P0_JOB(w_out, DM, DM, Wout_t, 0, MAP_ID, g_lru_out, g_mla_out, I_SQ);
        P0_JOB(w_mk, DM, DM, Wmkv_t, 0, MAP_ID, nullptr, nullptr, I_SQ);
        P0_JOB(w_mv, DM, DM, Wmkv_t, 1024, MAP_ID, nullptr, nullptr, I_SQ);
        P0_JOB(w_mo, DM, DM, Wmo_t, 0, MAP_ID, nullptr, nullptr, I_SQ);
        P0_JOB(w_gate, DM, DFF, Wgu_t, 0, MAP_GATE, g_pre_ffn, nullptr, I_GU);
        P0_JOB(w_up, DM, DFF, Wgu_t, 0, MAP_UP, g_pre_ffn, nullptr, I_GU);
        P0_JOB(w_down, DFF, DM, Wdown_t, 0, MAP_ID, nullptr, nullptr, I_DN);
#undef P0_JOB
        const int gt = vcu * (NWAVES * 64) + tid, NGT = G * NWAVES * 64;
        for (int i = gt; i < 64 * 1024 / 8; i += NGT) *(u32x4*)(Win_t + (size_t)1728 * 1024 + (size_t)i * 8) = (u32x4){0u, 0u, 0u, 0u};
        for (int i = gt; i < DM * DM / 4; i += NGT) { const f32x4 v = *(const f32x4*)(w_mq + (size_t)i * 4) * g_pre_mem[i >> 8]; u32x2 w; w.x = cvt_pk_bf16(v.x, v.y); w.y = cvt_pk_bf16(v.z, v.w); *(u32x2*)(Wmq_b + (size_t)i * 4) = w; }
        for (int i = gt; i < T * 32; i += NGT) { const int row = i >> 5, k = i & 31; const double invf = exp2(-(double)k * (13.287712379549449 / 32.0));
            const double rev = (double)positions[row] * invf * 0.15915494309189535; const float fr_ = (float)(rev - rint(rev)); cosT[i] = __builtin_amdgcn_cosf(fr_); sinT[i] = __builtin_amdgcn_sinf(fr_); }
        for (int m = gw * 4; m < T; m += NGW * 4) rms_rows_to_bf16<4, false>(x_in + (size_t)m * DM, g_pre_mix, XN + (size_t)m * DM, ssq_x + m, lane);
        for (int m = gw * 2; m < TM; m += NGW * 2) rms_rows_to_bf16<2, true>(mem + (size_t)m * DM, g_mem_kv, MN + (size_t)m * DM, nullptr, lane);
    }
    SEAM(0);
    if (IN(1)) REPS(1) {
        { pg8::TileOrder S; S.init(T, DINP, G, bx, XN, DM, Win_t, DM); EpiZ E{Z, KPE, RSQ(ssq_cq), RSQ(ssq_ckv), cosT, sinT, ssq_x};
          pg8::gemm_phase<EpiZ, pg8::TileOrder>(lds, DM, DM, DM, S, E, wave_s); }
        {
          struct MkvOrder { int u; const char* A; const char* B;
              __device__ bool next(int i, pg8::Unit& un) const { if (i > 0 || u < 0) return false; un.pm = u >> 3; un.pn = u & 7; un.A = A + (size_t)un.pm * 256 * DM * 2; un.B = B + (size_t)un.pn * 256 * DM * 2; un.cofs = 0; return true; } };
          const int j = bx >> 3; MkvOrder S{(G == 256) ? (j >= 16 ? ((bx & 7) * 2 + ((j - 16) >> 3)) * 8 + ((j - 16) & 7) : -1) : (bx < 128 ? bx : -1), (const char*)MN, (const char*)Wmkv_t};
          EpiBf16 E{MKV, 2048, 1.f, nullptr, 0.f};
          pg8::gemm_phase<EpiBf16, MkvOrder>(lds, DM, DM, DM, S, E, wave_s); }
    }
    SEAM(1);
    if (IN(2)) REPS(2) {
#ifndef P2SUB
#define P2SUB 31
#endif
#ifndef REP_P2SUB
#define REP_P2SUB 0
#endif
#define R2(i) for (int r2 = 0; r2 < (((REP_P2SUB) >> (i)) & 1) + 1; ++r2)
        if (P2SUB & 1) R2(0) for (int uidx = vcu; uidx < BATCH * 16; uidx += G) lru::unit(uidx >> 4, uidx & 15, Z, Y, (rep | r2) ? ssq_dummy : ssq_lru, conv_w, conv_b, lru_wa, lru_ba, lru_wx, lru_bx, lru_lambda, lds, wave_s);
        if (P2SUB & 2) R2(1) { pg8::TileOrder S; S.init(T, 768, G, bx, Z + OFF_CQ, DINP, Wuq_t, QLR); EpiQ E{Qb, ssq_cq, cosT, sinT};
          pg8::gemm_phase<EpiQ, pg8::TileOrder>(lds, DINP, QLR, QLR, S, E, wave_s); }
        if (P2SUB & 4) R2(2) { pg8::TileOrder S; S.init(T, 1024, G, (bx + 128) % G, Z + OFF_CKV, DINP, Wukv_t, KVLR); EpiBf16 E{KVb, 1024, 1.f, ssq_ckv, 1.f / KVLR};
          pg8::gemm_phase<EpiBf16, pg8::TileOrder>(lds, DINP, KVLR, KVLR, S, E, wave_s); }
        struct FormQK { int G, c; const bf16_t* mkv; const bf16_t* W;
            __device__ bool next(int i, pg8::Unit& u) const { const int L = i * G + c; if (L >= 256) return false; const int bh = L >> 2, q = L & 3, b = bh >> 2, h = bh & 3;
                u.pm = 0; u.pn = q; u.A = (const char*)(mkv + (size_t)(b * 256) * 2048 + h * 256); u.B = (const char*)(W + (size_t)(q * 256) * 1024 + h * 256); u.cofs = ((long)b * 1024 + h * 256) * 1024; return true; } };
        struct FormVO { int G, c; const bf16_t* mkv; const bf16_t* W;
            __device__ bool next(int i, pg8::Unit& u) const { const int L = i * G + c; if (L >= 256) return false; const int bh = L >> 2, q = L & 3, b = bh >> 2, h = bh & 3;
                u.pm = q; u.pn = 0; u.A = (const char*)(W + (size_t)(q * 256) * 1024 + h * 256); u.B = (const char*)(mkv + (size_t)(b * 256) * 2048 + 1024 + h * 256); u.cofs = (long)b * 1024 * 1024 + h * 256; return true; } };
        if (P2SUB & 8) R2(3) { FormQK S{G, vcu, MKV, Wmq_b}; EpiBf16 E{WQK, 1024, MSCALE, nullptr, 0.f}; pg8::gemm_phase<EpiBf16, FormQK>(lds, 2048, 1024, 256, S, E, wave_s); }
        if (P2SUB & 16) R2(3) { FormVO S{G, vcu, MKV, Wmo_t}; EpiBf16 E{WVO, 1024, 1.f, nullptr, 0.f}; pg8::gemm_phase<EpiBf16, FormVO>(lds, 1024, 2048, 256, S, E, wave_s); }
    }
    SEAM(2);
    if (IN(3)) REPS(3) {
        for (int it = vcu; it < BATCH * 4 * 4; it += G) { const int bh = it >> 2, xq = it & 3, b = bh >> 2, h = bh & 3;
            mla::block(b, h, xq, Qb, KVb, KPE, Y, RSQ(ssq_mla), (char*)lds_raw, wave_s);
            mla::block(b, h, 7 - xq, Qb, KVb, KPE, Y, RSQ(ssq_mla), (char*)lds_raw, wave_s); }
    }
    SEAM(3);
    if (IN(5)) REPS(5) { pg8::TileOrder S; S.init(T, DM, G, bx, Y, DM, Wout_t, DM);
        EpiNormResMid E{nullptr, XN, nullptr, g_post_mix, rep ? (bf16_t*)PRE : XN, RSQ(ssq_h1), slots_p, ctl + CW_SEAM, ssq_lru, ssq_mla};
        pg8::gemm_phase<EpiNormResMid, pg8::TileOrder>(lds, DM, DM, DM, S, E, wave_s); }
    SEAM(5);
    if (IN(7)) REPS(7) { pg8::TileOrder S; S.init(T, DM, G, bx, XN, DM, WQK, DM, (size_t)DM * DM * 2); EpiSoftmax E{Pb, ssq_h1}; pg8::gemm_phase<EpiSoftmax, pg8::TileOrder>(lds, DM, DM, DM, S, E, wave_s); }
    SEAM(7);
    if (IN(8)) REPS(8) { pg8::TileOrder S; S.init(T, DM, G, bx, Pb, DM, WVO, DM, (size_t)DM * DM * 2); EpiNormRes E{nullptr, XN, nullptr, g_post_mem, rep ? (bf16_t*)PRE : XN, RSQ(ssq_h2), slots_p + (size_t)4 * T, ctl + CW_SEAM + SEAM_BANK, nullptr, nullptr};
        pg8::gemm_phase<EpiNormRes, pg8::TileOrder>(lds, DM, DM, DM, S, E, wave_s); }
    SEAM(8);
    if (IN(10)) REPS(10) { pg8::TileOrder S; S.init(T, 2 * DFF, G, bx, XN, DM, Wgu_t, DM); EpiSwiGLU E{Fb, ssq_h2}; pg8::gemm_phase<EpiSwiGLU, pg8::TileOrder, ALIGN_P10>(lds, DM, DM, DM, S, E, wave_s); }
    SEAM(10);
    if (IN(11)) REPS(11) { pg8::TileOrder S; S.init(T, DM, G, bx, Fb, DFF, Wdown_t, DFF); EpiNormRes E{nullptr, XN, rep ? PRE : out_p, g_post_ffn, nullptr, nullptr, slots_p + (size_t)8 * T, ctl + CW_SEAM + 2 * SEAM_BANK, nullptr, nullptr};
        pg8::gemm_phase<EpiNormRes, pg8::TileOrder>(lds, DFF, DFF, DFF, S, E, wave_s); }
#undef IN
#undef SEAM
}

#undef tid
#undef lane
#undef wave
#undef gw
#undef NGW
#undef x_in
#undef ssq_h1
#undef ssq_h2
#undef ssq_dummy
#undef ssq_x
#undef slots_p
#undef mem
#undef positions
#undef g_pre_mix
#undef w_in
#undef conv_w
#undef conv_b
#undef lru_wa
#undef lru_ba
#undef lru_wx
#undef lru_bx
#undef lru_lambda
#undef g_q_lat
#undef w_uq
#undef g_kv_lat
#undef w_ukv
#undef g_lru_out
#undef g_mla_out
#undef w_out
#undef g_post_mix
#undef g_pre_mem
#undef g_mem_kv
#undef w_mq
#undef w_mk
#undef w_mv
#undef w_mo
#undef g_post_mem
#undef g_pre_ffn
#undef w_gate
#undef w_up
#undef w_down
#undef g_post_ffn
#undef out_p
#undef ctl
#undef ssq_cq
#undef ssq_ckv
#undef ssq_lru
#undef ssq_mla
#undef cosT
#undef sinT
#undef Win_t
#undef Wuq_t
#undef Wukv_t
#undef Wout_t
#undef Wmq_b
#undef Wmkv_t
#undef Wmo_t
#undef Wgu_t
#undef Wdown_t
#undef MN
#undef MKV
#undef WQK
#undef WVO
#undef XN
#undef KPE
#undef Z
#undef Qb
#undef KVb
#undef Y
#undef PRE
#undef Pb
#undef Fb
#ifndef N_LAUNCHES
#define N_LAUNCHES 1
#endif
extern "C" void kernel_launch(void* const* d_in, const int* in_sizes, int n_in, void* d_out, int out_size, void* d_ws, size_t ws_size, hipStream_t stream) {
    static int grid = 0;
    if (grid == 0) {
        if (n_in != 32 || in_sizes[0] != T * DM || out_size != T * DM || ws_size < WS_END) { fprintf(stderr, "kernel_launch: unexpected shapes (n_in %d, in0 %d, out %d, ws %zu)\n", n_in, n_in > 0 ? in_sizes[0] : -1, out_size, ws_size); grid = -1; return; }
        int dev = 0, cus = 0, per_cu = 0;
        (void)hipGetDevice(&dev); (void)hipDeviceGetAttribute(&cus, hipDeviceAttributeMultiprocessorCount, dev);
        if (hipFuncSetAttribute((const void*)hymba_fwd, hipFuncAttributeMaxDynamicSharedMemorySize, LDS_BYTES) != hipSuccess) { fprintf(stderr, "kernel_launch: hipFuncSetAttribute failed\n"); grid = -1; return; }
        if (hipOccupancyMaxActiveBlocksPerMultiprocessor(&per_cu, (const void*)hymba_fwd, NWAVES * 64, LDS_BYTES) != hipSuccess || per_cu < 1) { fprintf(stderr, "kernel_launch: occupancy query says %d\n", per_cu); per_cu = 1; }
        (void)hipGetLastError();
        grid = cus > 0 ? cus : 256;
    }
    if (grid < 0) return;
    (void)hipMemsetAsync((char*)d_ws + WS_CTL, 0, CTL_ZERO_BYTES, stream);
    Args a{};
    for (int i = 0; i < 32; ++i) a.in[i] = d_in[i];
    a.out = (float*)d_out; a.ws = (unsigned char*)d_ws;
#if N_LAUNCHES == 1
    a.ph_lo = 0; a.ph_hi = NPHASE;
    void* kargs[] = {&a};
#ifdef PLAIN_LAUNCH
    (void)kargs; hipLaunchKernelGGL(hymba_fwd, dim3(grid), dim3(NWAVES * 64), LDS_BYTES, stream, a); hipError_t e = hipPeekAtLastError();
#else
    hipError_t e = hipLaunchCooperativeKernel((const void*)hymba_fwd, dim3(grid), dim3(NWAVES * 64), kargs, LDS_BYTES, stream);
#endif
    if (e != hipSuccess) fprintf(stderr, "kernel_launch: cooperative launch failed: %s (grid %d)\n", hipGetErrorString(e), grid);
#else
    for (int p = 0; p < NPHASE; ++p) { a.ph_lo = p; a.ph_hi = p + 1; hipLaunchKernelGGL(hymba_fwd, dim3(grid), dim3(NWAVES * 64), LDS_BYTES, stream, a); }
#endif
}
```

```cpp
#include <hip/hip_runtime.h>
#include <hip/hip_bf16.h>
#include <cstdio>
#include <cstdint>

#define LAS __attribute__((address_space(3)))
#define GAS __attribute__((address_space(1)))
typedef unsigned short bf16_t;
typedef short bf16x8 __attribute__((ext_vector_type(8)));
typedef short s16x4 __attribute__((ext_vector_type(4)));
typedef float f32x4 __attribute__((ext_vector_type(4)));
typedef float f32x2 __attribute__((ext_vector_type(2)));
typedef float f32x16 __attribute__((ext_vector_type(16)));
typedef unsigned u32x4 __attribute__((ext_vector_type(4)));
typedef unsigned u32x2 __attribute__((ext_vector_type(2)));

constexpr int BATCH = 16, SEQ = 2048, DM = 1024, T = BATCH * SEQ;
constexpr int NMEM = 256, TM = BATCH * NMEM;
constexpr int DLRU = 512, DINP = 1792, QLR = 384, KVLR = 256, DFF = 2816;
constexpr int OFF_GATE = 512, OFF_CQ = 1024, OFF_CKV = 1408, OFF_KPE = 1664;
constexpr float EPS = 1e-6f;
constexpr float LOG2E = 1.4426950408889634f;
constexpr float QSCALE = 0.07216878364870322f * LOG2E;
constexpr float MSCALE = 0.0625f * LOG2E;

constexpr size_t MiB = 1u << 20;
constexpr size_t WS_CTL = 0, CTL_ZERO_BYTES = 2 * MiB;
constexpr size_t WS_SSQ = 1 * MiB;
constexpr size_t WS_SLOTS = 2 * MiB;
constexpr int CW_SEAM = 65536, SEAM_BANK = 8192, CW_DONE = CW_SEAM + 3 * SEAM_BANK;
constexpr size_t WS_ROPE = 4 * MiB;
constexpr size_t WS_WIN = 12 * MiB, WS_WUQ = 16 * MiB, WS_WUKV = 17 * MiB, WS_WOUT = 18 * MiB, WS_WMQ = 20 * MiB, WS_WMKV = 22 * MiB,
                 WS_WMO = 26 * MiB, WS_WGU = 28 * MiB, WS_WDOWN = 39 * MiB;
constexpr size_t WS_MN = 46 * MiB, WS_MKV = 54 * MiB, WS_WQK = 70 * MiB, WS_WVO = 102 * MiB, WS_XN = 134 * MiB, WS_KPE = 198 * MiB;
constexpr size_t WS_Z = 202 * MiB, WS_Q = 314 * MiB, WS_KV = 362 * MiB, WS_Y = 426 * MiB;
constexpr size_t WS_PRE = 202 * MiB, WS_P = 330 * MiB, WS_F = 330 * MiB, WS_END = 506 * MiB;
constexpr int CW_BAR = 4096;

constexpr int RING_BYTES = 131072, EPI_OFF = RING_BYTES, EPI_BYTES = 16384, MISC_OFF = EPI_OFF + EPI_BYTES, LDS_BYTES = MISC_OFF + 1024;

__device__ __forceinline__ unsigned cvt_pk_bf16(float lo, float hi) { unsigned r; asm volatile("v_cvt_pk_bf16_f32 %0, %1, %2" : "=v"(r) : "v"(lo), "v"(hi)); return r; }
__device__ __forceinline__ float bf2f(unsigned short v) { return __uint_as_float((unsigned)v << 16); }
__device__ __forceinline__ float bflo(unsigned w) { return __uint_as_float(w << 16); }
__device__ __forceinline__ float bfhi(unsigned w) { return __uint_as_float(w & 0xffff0000u); }
__device__ __forceinline__ float wave_sum(float v) {
#pragma unroll
    for (int o = 1; o < 64; o <<= 1) v += __shfl_xor(v, o);
    return v;
}
__device__ __forceinline__ int lane_id() { int l; asm volatile("v_mbcnt_lo_u32_b32 %0, -1, 0\n\tv_mbcnt_hi_u32_b32 %0, -1, %0" : "=v"(l)); return l; }
#define LDS_WAIT() asm volatile("s_waitcnt lgkmcnt(0)" ::: "memory")
#define VM_WAIT() asm volatile("s_waitcnt vmcnt(0)" ::: "memory")

namespace pg8 {
constexpr int BM = 256, BK = 64, HALF = 128, HTB = HALF * BK * 2, STAGE_BYTES = 8 * HTB, NXCD = 8, WGM = 8;
__host__ __device__ __forceinline__ int lds_byte(int r, int c) { const int st = (r >> 4) * 2 + (c >> 5), rr = r & 15, cc = c & 31, ob = rr * 64 + cc * 2; return st * 1024 + (ob ^ (((ob >> 9) & 1) << 5)); }
__host__ __device__ __forceinline__ void stage_rc(int b, int& R, int& C) { const int st = b / 1024, sb = b % 1024, swz = sb ^ (((sb >> 9) & 1) << 5); R = (st >> 1) * 16 + swz / 64; C = (st & 1) * 32 + (swz % 64) / 2; }
__host__ __device__ __forceinline__ int perm32(int rho) { const int n = rho >> 4, i = rho & 15; return 8 * (i >> 2) + 4 * n + (i & 3); }

struct Unit { int pm, pn; const char* A; const char* B; long cofs; int job; unsigned* wait; unsigned* done; int lda, ldb, nt; };

struct TileOrder {
    int nM, nN, nwg, G, c; const char* A; const char* B; size_t tA, tB, bB;
    __device__ void init(int M, int N, int G_, int c_, const void* A_, int lda, const void* B_, int ldb, size_t batchB_bytes = 0) {
        nM = M / BM; nN = N / BM; nwg = nM * nN; G = G_; c = c_; A = (const char*)A_; B = (const char*)B_; tA = (size_t)BM * lda * 2; tB = (size_t)BM * ldb * 2; bB = batchB_bytes; }
    __device__ bool next(int i, Unit& u) const {
        const long L = (long)i * G + c; if (L >= nwg) return false;
        int wgid = (int)L; { const int q = nwg / NXCD, r = nwg % NXCD, xcd = wgid % NXCD, off = wgid / NXCD; wgid = (xcd < r ? xcd * (q + 1) : r * (q + 1) + (xcd - r) * q) + off; }
        const int nig = WGM * nN, gid = wgid / nig, fm = gid * WGM, gsz = (nM - fm) < WGM ? (nM - fm) : WGM;
        u.pm = fm + ((wgid % nig) % gsz); u.pn = (wgid % nig) / gsz; u.A = A + (size_t)u.pm * tA; u.B = B + (size_t)u.pn * tB + (size_t)(u.pm >> 3) * bB; u.cofs = 0; u.job = 0; u.wait = nullptr; u.done = nullptr; return true;
    }
};

__device__ __forceinline__ void chain_wait(const Unit& u) {
    if (u.wait) { unsigned sp = 0; while ((unsigned)__builtin_amdgcn_readfirstlane(__hip_atomic_load(u.wait, __ATOMIC_RELAXED, __HIP_MEMORY_SCOPE_AGENT)) < 4u) { __builtin_amdgcn_s_sleep(1); if (++sp > (1u << 22)) break; }
    }
}
__device__ __forceinline__ void chain_publish(const Unit& u, int wid) {
    if (u.done) { asm volatile("s_waitcnt vmcnt(0)\n\ts_barrier" ::: "memory");
        if (wid == 0 && lane_id() == 0) __hip_atomic_fetch_add(u.done, 1u, __ATOMIC_RELAXED, __HIP_MEMORY_SCOPE_AGENT); }
}
template <class Epi, class Sched, bool ALIGN_EPI = true, bool SP2 = true, bool CHAIN = false>
__device__ __forceinline__ void gemm_phase(LAS unsigned char* lds, const int lda, const int ldb, const int K, const Sched& S, const Epi& E, const int wv) {
    int lane = lane_id(); asm volatile("" : "+v"(lane));
    const int wid = wv, tid = wv * 64 + lane, wr = wid >> 2, wc = wid & 3, fr = lane & 15, fq = lane >> 4;
    const int nt = K / BK;
    unsigned voffA[2], voffB[2];
#pragma unroll
    for (int i = 0; i < 2; ++i) { int R, C; stage_rc(tid * 16 + i * 8192, R, C); const int Rb = Epi::PERM ? ((R & ~31) + perm32(R & 31)) : R;
        voffA[i] = (unsigned)(R * lda + C) * 2u; voffB[i] = (unsigned)(Rb * ldb + C) * 2u; }
    const size_t kstep = (size_t)(BK * 2);
    const size_t hstepA = (size_t)HALF * lda * 2, hstepB = (size_t)HALF * ldb * 2;
    const unsigned ldsw = (unsigned)wid * 1024u;
    const int aoff = lds_byte(wr * 64 + fr, fq * 8), boff = lds_byte(wc * 32 + fr, fq * 8);
#define PG8_SA(b, h) (((b) * 2 + (h)) * HTB)
#define PG8_SB(b, h) ((4 + (b) * 2 + (h)) * HTB)
#define PG8_STAGE_(bufoff, gbase, voff, AUX) do { _Pragma("unroll") for (int _i = 0; _i < 2; ++_i) \
        __builtin_amdgcn_global_load_lds((const unsigned*)((const char*)(gbase) + (voff)[_i]), (LAS unsigned*)(lds + (bufoff) + ldsw + _i * 8192), 16, 0, AUX); } while (0)
#define PG8_STAGE(bufoff, gbase, voff) PG8_STAGE_(bufoff, gbase, voff, 0)
#define PG8_STAGEA(bufoff, gbase, voff) do { if constexpr (CHAIN) PG8_STAGE_(bufoff, gbase, voff, 16); else PG8_STAGE_(bufoff, gbase, voff, 0); } while (0)
#define PG8_LDA(dst, b, h) do { _Pragma("unroll") for (int m = 0; m < 4; ++m) _Pragma("unroll") for (int k = 0; k < 2; ++k) dst[m][k] = *(const LAS bf16x8*)(lds + PG8_SA(b, h) + aoff + m * 2048 + k * 1024); } while (0)
#define PG8_LDB(dst, b, h) do { _Pragma("unroll") for (int n = 0; n < 2; ++n) _Pragma("unroll") for (int k = 0; k < 2; ++k) dst[n][k] = *(const LAS bf16x8*)(lds + PG8_SB(b, h) + boff + n * 2048 + k * 1024); } while (0)
#define PG8_MMA(ai, bj, At, Bt) do { __builtin_amdgcn_s_setprio(1); _Pragma("unroll") for (int m = 0; m < 4; ++m) _Pragma("unroll") for (int n = 0; n < 2; ++n) _Pragma("unroll") for (int k = 0; k < 2; ++k) \
        acc[ai][bj][m][n] = __builtin_amdgcn_mfma_f32_16x16x32_bf16(Bt[n][k], At[m][k], acc[ai][bj][m][n], 0, 0, 0); __builtin_amdgcn_s_setprio(0); } while (0)
#define PG8_WAIT_V(n) asm volatile("s_waitcnt vmcnt(" #n ")" ::: "memory")
#define PG8_WAIT_L(n) asm volatile("s_waitcnt lgkmcnt(" #n ")" ::: "memory")
#define PG8_BAR __builtin_amdgcn_s_barrier()
#define PG8_SCHED __builtin_amdgcn_sched_barrier(0)
    Unit cur, nxt; int ui = 0;
    if (!S.next(0, cur)) return;
    if constexpr (Epi::MIDK) { if (E.midk_on(cur)) E.prep(cur, lds, wid, 0); }
    if constexpr (CHAIN) chain_wait(cur);
    f32x4 acc[2][2][4][2];
#pragma unroll
    for (int a = 0; a < 2; ++a)
#pragma unroll
        for (int b = 0; b < 2; ++b)
#pragma unroll
            for (int m = 0; m < 4; ++m)
#pragma unroll
                for (int n = 0; n < 2; ++n) acc[a][b][m][n] = (f32x4){0.f, 0.f, 0.f, 0.f};
    bf16x8 At[4][2], B0[2][2], B1[2][2];
    const char* cA = cur.A; const char* cB = cur.B;
    static_assert(SP2, "only the SP2 loop is kept");
    PG8_STAGE(PG8_SB(0, 0), cB, voffB); PG8_STAGE(PG8_SB(0, 1), cB + hstepB, voffB); PG8_STAGEA(PG8_SA(0, 0), cA, voffA); PG8_STAGEA(PG8_SA(0, 1), cA + hstepA, voffA);
    if (wr == 1) PG8_BAR;
    PG8_WAIT_V(2); PG8_BAR;
    PG8_STAGE(PG8_SB(1, 0), cB + kstep, voffB); PG8_STAGEA(PG8_SA(1, 0), cA + kstep, voffA); PG8_STAGE(PG8_SB(1, 1), cB + hstepB + kstep, voffB);
    PG8_WAIT_V(6); PG8_BAR;
    for (;;) {
        const bool has_next = S.next(ui + 1, nxt);
        const char* nA = has_next ? nxt.A : cA; const char* nB = has_next ? nxt.B : cB;
        for (int t = 0; t < nt; t += 2) {
            if constexpr (Epi::MIDK) { if (t == Epi::TSPLIT && E.midk_on(cur)) E.midk(acc, lds, ui & 1, wr); }
            const bool last = (t == nt - 2);
            if constexpr (CHAIN) { if (last && has_next) chain_wait(nxt); }
            const char* a1 = cA + (size_t)(t + 1) * kstep;
            const char* a2 = last ? nA : cA + (size_t)(t + 2) * kstep; const char* b2 = last ? nB : cB + (size_t)(t + 2) * kstep;
            const char* a3 = a2 + kstep; const char* b3 = b2 + kstep;
            PG8_LDB(B0, 0, 0); PG8_LDB(B1, 0, 1); PG8_SCHED; PG8_LDA(At, 0, 0); PG8_STAGEA(PG8_SA(1, 1), a1 + hstepA, voffA);
            PG8_WAIT_V(8); PG8_WAIT_L(0); PG8_BAR; PG8_MMA(0, 0, At, B0); PG8_MMA(0, 1, At, B1); PG8_BAR; PG8_SCHED;
            PG8_LDA(At, 0, 1); PG8_STAGE(PG8_SB(0, 0), b2, voffB); PG8_STAGE(PG8_SB(0, 1), b2 + hstepB, voffB); PG8_STAGEA(PG8_SA(0, 0), a2, voffA);
            PG8_WAIT_V(8); PG8_WAIT_L(0); PG8_BAR; PG8_MMA(1, 0, At, B0); PG8_MMA(1, 1, At, B1); PG8_BAR; PG8_SCHED;
            PG8_LDB(B0, 1, 0); PG8_LDB(B1, 1, 1); PG8_SCHED; PG8_LDA(At, 1, 0); PG8_STAGEA(PG8_SA(0, 1), a2 + hstepA, voffA);
            PG8_WAIT_V(8); PG8_WAIT_L(0); PG8_BAR; PG8_MMA(0, 0, At, B0); PG8_MMA(0, 1, At, B1); PG8_BAR; PG8_SCHED;
            PG8_LDA(At, 1, 1); PG8_STAGE(PG8_SB(1, 0), b3, voffB); PG8_STAGE(PG8_SB(1, 1), b3 + hstepB, voffB); PG8_STAGEA(PG8_SA(1, 0), a3, voffA);
            PG8_WAIT_V(8); PG8_WAIT_L(0); PG8_BAR; PG8_MMA(1, 0, At, B0); PG8_MMA(1, 1, At, B1); PG8_BAR; PG8_SCHED;
        }
        if constexpr (ALIGN_EPI) { if (wr == 0) PG8_BAR; }
        E(acc, cur, wr, wc, fr, fq, lds, wid, ui & 1);
        if constexpr (CHAIN) chain_publish(cur, wid);
        if (!has_next) break;
        if constexpr (Epi::MIDK) { if (E.midk_on(nxt)) E.prep(nxt, lds, wid, (ui + 1) & 1); }
#pragma unroll
        for (int a = 0; a < 2; ++a)
#pragma unroll
            for (int b = 0; b < 2; ++b)
#pragma unroll
                for (int m = 0; m < 4; ++m)
#pragma unroll
                    for (int n = 0; n < 2; ++n) acc[a][b][m][n] = (f32x4){0.f, 0.f, 0.f, 0.f};
        cur = nxt; cA = nA; cB = nB; ++ui;
        if constexpr (ALIGN_EPI) { if (wr == 1) PG8_BAR; }
    }
    PG8_WAIT_V(0);
    if constexpr (!ALIGN_EPI) { if (wr == 0) PG8_BAR; }
    PG8_BAR;
#undef PG8_SA
#undef PG8_SB
#undef PG8_STAGE
#undef PG8_STAGE_
#undef PG8_STAGEA
#undef PG8_LDA
#undef PG8_LDB
#undef PG8_MMA
#undef PG8_WAIT_V
#undef PG8_WAIT_L
#undef PG8_BAR
#undef PG8_SCHED
}
template <class Epi, class Sched>
__device__ __forceinline__ void gemm_phase_v(LAS unsigned char* lds, const Sched& S, const Epi& E, const int wv) {
    constexpr bool ALIGN_EPI = true, SP2 = true, CHAIN = false;
    int lane = lane_id(); asm volatile("" : "+v"(lane));
    const int wid = wv, tid = wv * 64 + lane, wr = wid >> 2, wc = wid & 3, fr = lane & 15, fq = lane >> 4;
    unsigned RA2[2], RB2[2], C2[2];
#pragma unroll
    for (int i = 0; i < 2; ++i) { int R, C; stage_rc(tid * 16 + i * 8192, R, C); const int Rb = Epi::PERM ? ((R & ~31) + perm32(R & 31)) : R;
        RA2[i] = (unsigned)R * 2u; RB2[i] = (unsigned)Rb * 2u; C2[i] = (unsigned)C * 2u; }
    const size_t kstep = (size_t)(BK * 2);
    const unsigned ldsw = (unsigned)wid * 1024u;
    const int aoff = lds_byte(wr * 64 + fr, fq * 8), boff = lds_byte(wc * 32 + fr, fq * 8);
#define PG8_SA(b, h) (((b) * 2 + (h)) * HTB)
#define PG8_SB(b, h) ((4 + (b) * 2 + (h)) * HTB)
#define PG8_STAGE_(bufoff, gbase, voff, AUX) do { _Pragma("unroll") for (int _i = 0; _i < 2; ++_i) \
        __builtin_amdgcn_global_load_lds((const unsigned*)((const char*)(gbase) + (voff)[_i]), (LAS unsigned*)(lds + (bufoff) + ldsw + _i * 8192), 16, 0, AUX); } while (0)
#define PG8_STAGEV(bufoff, gbase, R2, ld) do { _Pragma("unroll") for (int _i = 0; _i < 2; ++_i) \
        __builtin_amdgcn_global_load_lds((const unsigned*)((const char*)(gbase) + ((R2)[_i] * (unsigned)(ld) + C2[_i])), (LAS unsigned*)(lds + (bufoff) + ldsw + _i * 8192), 16, 0, 0); } while (0)
#define PG8_LDA(dst, b, h) do { _Pragma("unroll") for (int m = 0; m < 4; ++m) _Pragma("unroll") for (int k = 0; k < 2; ++k) dst[m][k] = *(const LAS bf16x8*)(lds + PG8_SA(b, h) + aoff + m * 2048 + k * 1024); } while (0)
#define PG8_LDB(dst, b, h) do { _Pragma("unroll") for (int n = 0; n < 2; ++n) _Pragma("unroll") for (int k = 0; k < 2; ++k) dst[n][k] = *(const LAS bf16x8*)(lds + PG8_SB(b, h) + boff + n * 2048 + k * 1024); } while (0)
#define PG8_MMA(ai, bj, At, Bt) do { __builtin_amdgcn_s_setprio(1); _Pragma("unroll") for (int m = 0; m < 4; ++m) _Pragma("unroll") for (int n = 0; n < 2; ++n) _Pragma("unroll") for (int k = 0; k < 2; ++k) \
        acc[ai][bj][m][n] = __builtin_amdgcn_mfma_f32_16x16x32_bf16(Bt[n][k], At[m][k], acc[ai][bj][m][n], 0, 0, 0); __builtin_amdgcn_s_setprio(0); } while (0)
#define PG8_WAIT_V(n) asm volatile("s_waitcnt vmcnt(" #n ")" ::: "memory")
#define PG8_WAIT_L(n) asm volatile("s_waitcnt lgkmcnt(" #n ")" ::: "memory")
#define PG8_BAR __builtin_amdgcn_s_barrier()
#define PG8_SCHED __builtin_amdgcn_sched_barrier(0)
    Unit cur, nxt; int ui = 0;
    if (!S.next(0, cur)) return;
    if constexpr (Epi::MIDK) { if (E.midk_on(cur)) E.prep(cur, lds, wid, 0); }
    if constexpr (CHAIN) chain_wait(cur);
    f32x4 acc[2][2][4][2];
#pragma unroll
    for (int a = 0; a < 2; ++a)
#pragma unroll
        for (int b = 0; b < 2; ++b)
#pragma unroll
            for (int m = 0; m < 4; ++m)
#pragma unroll
                for (int n = 0; n < 2; ++n) acc[a][b][m][n] = (f32x4){0.f, 0.f, 0.f, 0.f};
    bf16x8 At[4][2], B0[2][2], B1[2][2];
    const char* cA = cur.A; const char* cB = cur.B; int clda = cur.lda, cldb = cur.ldb, nt = cur.nt;
    size_t hstepA = (size_t)HALF * clda * 2, hstepB = (size_t)HALF * cldb * 2;
    static_assert(SP2, "only the SP2 loop is kept");
    PG8_STAGEV(PG8_SB(0, 0), cB, RB2, cldb); PG8_STAGEV(PG8_SB(0, 1), cB + hstepB, RB2, cldb); PG8_STAGEV(PG8_SA(0, 0), cA, RA2, clda); PG8_STAGEV(PG8_SA(0, 1), cA + hstepA, RA2, clda);
    if (wr == 1) PG8_BAR;
    PG8_WAIT_V(2); PG8_BAR;
    PG8_STAGEV(PG8_SB(1, 0), cB + kstep, RB2, cldb); PG8_STAGEV(PG8_SA(1, 0), cA + kstep, RA2, clda); PG8_STAGEV(PG8_SB(1, 1), cB + hstepB + kstep, RB2, cldb);
    PG8_WAIT_V(6); PG8_BAR;
    for (;;) {
        const bool has_next = S.next(ui + 1, nxt);
        const char* nA = has_next ? nxt.A : cA; const char* nB = has_next ? nxt.B : cB; const int nlda = has_next ? nxt.lda : clda, nldb = has_next ? nxt.ldb : cldb;
        const size_t nhA = (size_t)HALF * nlda * 2, nhB = (size_t)HALF * nldb * 2;
        for (int t = 0; t < nt; t += 2) {
            if constexpr (Epi::MIDK) { if (t == Epi::TSPLIT && E.midk_on(cur)) E.midk(acc, lds, ui & 1, wr); }
            const bool last = (t == nt - 2);
            if constexpr (CHAIN) { if (last && has_next) chain_wait(nxt); }
            const char* a1 = cA + (size_t)(t + 1) * kstep;
            const char* a2 = last ? nA : cA + (size_t)(t + 2) * kstep; const char* b2 = last ? nB : cB + (size_t)(t + 2) * kstep;
            const char* a3 = a2 + kstep; const char* b3 = b2 + kstep;
            const int l2a = last ? nlda : clda, l2b = last ? nldb : cldb; const size_t h2A = last ? nhA : hstepA, h2B = last ? nhB : hstepB;
            PG8_LDB(B0, 0, 0); PG8_LDB(B1, 0, 1); PG8_SCHED; PG8_LDA(At, 0, 0); PG8_STAGEV(PG8_SA(1, 1), a1 + hstepA, RA2, clda);
            PG8_WAIT_V(8); PG8_WAIT_L(0); PG8_BAR; PG8_MMA(0, 0, At, B0); PG8_MMA(0, 1, At, B1); PG8_BAR; PG8_SCHED;
            PG8_LDA(At, 0, 1); PG8_STAGEV(PG8_SB(0, 0), b2, RB2, l2b); PG8_STAGEV(PG8_SB(0, 1), b2 + h2B, RB2, l2b); PG8_STAGEV(PG8_SA(0, 0), a2, RA2, l2a);
            PG8_WAIT_V(8); PG8_WAIT_L(0); PG8_BAR; PG8_MMA(1, 0, At, B0); PG8_MMA(1, 1, At, B1); PG8_BAR; PG8_SCHED;
            PG8_LDB(B0, 1, 0); PG8_LDB(B1, 1, 1); PG8_SCHED; PG8_LDA(At, 1, 0); PG8_STAGEV(PG8_SA(0, 1), a2 + h2A, RA2, l2a);
            PG8_WAIT_V(8); PG8_WAIT_L(0); PG8_BAR; PG8_MMA(0, 0, At, B0); PG8_MMA(0, 1, At, B1); PG8_BAR; PG8_SCHED;
            PG8_LDA(At, 1, 1); PG8_STAGEV(PG8_SB(1, 0), b3, RB2, l2b); PG8_STAGEV(PG8_SB(1, 1), b3 + h2B, RB2, l2b); PG8_STAGEV(PG8_SA(1, 0), a3, RA2, l2a);
            PG8_WAIT_V(8); PG8_WAIT_L(0); PG8_BAR; PG8_MMA(1, 0, At, B0); PG8_MMA(1, 1, At, B1); PG8_BAR; PG8_SCHED;
        }
        if constexpr (ALIGN_EPI) { if (wr == 0) PG8_BAR; }
        E(acc, cur, wr, wc, fr, fq, lds, wid, ui & 1);
        if constexpr (CHAIN) chain_publish(cur, wid);
        if (!has_next) break;
        if constexpr (Epi::MIDK) { if (E.midk_on(nxt)) E.prep(nxt, lds, wid, (ui + 1) & 1); }
#pragma unroll
        for (int a = 0; a < 2; ++a)
#pragma unroll
            for (int b = 0; b < 2; ++b)
#pragma unroll
                for (int m = 0; m < 4; ++m)
#pragma unroll
                    for (int n = 0; n < 2; ++n) acc[a][b][m][n] = (f32x4){0.f, 0.f, 0.f, 0.f};
        cur = nxt; cA = nA; cB = nB; ++ui; clda = nlda; cldb = nldb; hstepA = nhA; hstepB = nhB; nt = cur.nt;
        if constexpr (ALIGN_EPI) { if (wr == 1) PG8_BAR; }
    }
    PG8_WAIT_V(0);
    if constexpr (!ALIGN_EPI) { if (wr == 0) PG8_BAR; }
    PG8_BAR;
#undef PG8_SA
#undef PG8_SB
#undef PG8_STAGE_
#undef PG8_STAGEV
#undef PG8_LDA
#undef PG8_LDB
#undef PG8_MMA
#undef PG8_WAIT_V
#undef PG8_WAIT_L
#undef PG8_BAR
#undef PG8_SCHED
}
}

typedef f32x4 Acc[2][2][4][2];
__device__ __forceinline__ void store16(void* p, u32x4 v, bool wt) {
    if (wt) asm volatile("global_store_dwordx4 %0, %1, off sc1\n\ts_nop 1" :: "v"(p), "v"(v) : "memory"); else *(u32x4*)p = v;
}
__device__ __forceinline__ void ssq_rows_atomic(const Acc& acc, float* ssq, int row_base  , int bjmask, int fq, int lane) {
#pragma unroll
    for (int ai = 0; ai < 2; ++ai) {
        float s[4];
#pragma unroll
        for (int m = 0; m < 4; ++m) { float q = 0.f;
#pragma unroll
            for (int bj = 0; bj < 2; ++bj) if (bjmask & (1 << bj))
#pragma unroll
                for (int n = 0; n < 2; ++n) { const f32x4 x = acc[ai][bj][m][n]; q += (x[0] * x[0] + x[1] * x[1]) + (x[2] * x[2] + x[3] * x[3]); }
            q += __shfl_xor(q, 16); q += __shfl_xor(q, 32); s[m] = q; }
        const float v = fq == 0 ? s[0] : fq == 1 ? s[1] : fq == 2 ? s[2] : s[3];
        atomicAdd(ssq + row_base + ai * 128 + lane, v);
    }
}
struct EpiBf16 {
    static constexpr bool PERM = true, MIDK = false;
    bf16_t* O; int ldc; float scale; const float* ssq; float rdim_inv;
    __device__ __forceinline__ void operator()(const Acc& acc, const pg8::Unit& u, int wr, int wc, int fr, int fq, LAS unsigned char*, int, int) const {
        { const int ln_ = lane_id(); fr = ln_ & 15; fq = ln_ >> 4; }
        const int row0 = u.pm * 256 + wr * 64 + fr, col0 = u.pn * 256 + wc * 32 + 8 * fq;
#pragma unroll
        for (int ai = 0; ai < 2; ++ai)
#pragma unroll
            for (int m = 0; m < 4; ++m) { const int row = row0 + ai * 128 + m * 16; float sc = scale;
                if (ssq) sc *= __builtin_amdgcn_rsqf(ssq[row] * rdim_inv + EPS);
                bf16_t* rowp = O + u.cofs + (size_t)row * ldc + col0;
#pragma unroll
                for (int bj = 0; bj < 2; ++bj) { const f32x4 v0 = acc[ai][bj][m][0] * sc, v1 = acc[ai][bj][m][1] * sc;
                    u32x4 w; w.x = cvt_pk_bf16(v0[0], v0[1]); w.y = cvt_pk_bf16(v0[2], v0[3]); w.z = cvt_pk_bf16(v1[0], v1[1]); w.w = cvt_pk_bf16(v1[2], v1[3]);
                    *(u32x4*)(rowp + bj * 128) = w; } }
    }
};
__device__ __forceinline__ void rope8(f32x4& v0, f32x4& v1, const float* cosT, const float* sinT, int row, int i0) {
    const f32x4 c = *(const f32x4*)(cosT + (size_t)row * 32 + i0), s = *(const f32x4*)(sinT + (size_t)row * 32 + i0);
    const f32x4 a = v0, b = v1;
    v0[0] = a[0] * c[0] - a[1] * s[0]; v0[1] = a[1] * c[0] + a[0] * s[0]; v0[2] = a[2] * c[1] - a[3] * s[1]; v0[3] = a[3] * c[1] + a[2] * s[1];
    v1[0] = b[0] * c[2] - b[1] * s[2]; v1[1] = b[1] * c[2] + b[0] * s[2]; v1[2] = b[2] * c[3] - b[3] * s[3]; v1[3] = b[3] * c[3] + b[2] * s[3];
}
struct EpiZ {
    static constexpr bool PERM = true, MIDK = false;
    bf16_t* Z; bf16_t* KPE; float* ssq_cq; float* ssq_ckv; const float* cosT; const float* sinT; const float* ssq_x;
    __device__ __forceinline__ void operator()(Acc& acc, const pg8::Unit& u, int wr, int wc, int fr, int fq, LAS unsigned char*, int, int lane) const {
        { const int ln_ = lane_id(); fr = ln_ & 15; fq = ln_ >> 4; }
        const int row0 = u.pm * 256 + wr * 64 + fr, col0 = u.pn * 256 + wc * 32 + 8 * fq;
        const bool kpe_tile = (u.pn == 6);
#pragma unroll
        for (int ai = 0; ai < 2; ++ai)
#pragma unroll
            for (int m = 0; m < 4; ++m) { const float rsx = __builtin_amdgcn_rsqf(ssq_x[row0 + ai * 128 + m * 16] * (1.f / DM) + EPS);
#pragma unroll
                for (int bj = 0; bj < 2; ++bj)
#pragma unroll
                    for (int n = 0; n < 2; ++n) acc[ai][bj][m][n] = acc[ai][bj][m][n] * rsx; }
#pragma unroll
        for (int ai = 0; ai < 2; ++ai)
#pragma unroll
            for (int m = 0; m < 4; ++m) { const int row = row0 + ai * 128 + m * 16; bf16_t* rowp = Z + (size_t)row * DINP + col0;
#pragma unroll
                for (int bj = 0; bj < 2; ++bj) { f32x4 v0 = acc[ai][bj][m][0], v1 = acc[ai][bj][m][1];
                    if (kpe_tile && bj == 1) {
                        if (wc < 2) { rope8(v0, v1, cosT, sinT, row, 16 * (wc & 1) + 4 * fq);
                            u32x4 w; w.x = cvt_pk_bf16(v0[0], v0[1]); w.y = cvt_pk_bf16(v0[2], v0[3]); w.z = cvt_pk_bf16(v1[0], v1[1]); w.w = cvt_pk_bf16(v1[2], v1[3]);
                            *(u32x4*)(KPE + (size_t)row * 64 + wc * 32 + 8 * fq) = w; }
                    } else {
                        u32x4 w; w.x = cvt_pk_bf16(v0[0], v0[1]); w.y = cvt_pk_bf16(v0[2], v0[3]); w.z = cvt_pk_bf16(v1[0], v1[1]); w.w = cvt_pk_bf16(v1[2], v1[3]);
                        *(u32x4*)(rowp + bj * 128) = w; } } }
        const int rb = u.pm * 256 + wr * 64; lane = fq * 16 + fr;
        if (u.pn == 4) ssq_rows_atomic(acc, ssq_cq, rb, 3, fq, lane);
        else if (u.pn == 5) { ssq_rows_atomic(acc, ssq_cq, rb, 1, fq, lane); ssq_rows_atomic(acc, ssq_ckv, rb, 2, fq, lane); }
        else if (u.pn == 6) ssq_rows_atomic(acc, ssq_ckv, rb, 1, fq, lane);
    }
};
struct EpiQ {
    static constexpr bool PERM = true, MIDK = false;
    bf16_t* Q; const float* ssq; const float* cosT; const float* sinT;
    __device__ __forceinline__ void operator()(const Acc& acc, const pg8::Unit& u, int wr, int wc, int fr, int fq, LAS unsigned char*, int, int) const {
        { const int ln_ = lane_id(); fr = ln_ & 15; fq = ln_ >> 4; }
        const int row0 = u.pm * 256 + wr * 64 + fr, col0 = u.pn * 256 + wc * 32 + 8 * fq;
        const bool pe = (u.pn == 2);
#pragma unroll
        for (int ai = 0; ai < 2; ++ai)
#pragma unroll
            for (int m = 0; m < 4; ++m) { const int row = row0 + ai * 128 + m * 16;
                const float sc = QSCALE * __builtin_amdgcn_rsqf(ssq[row] * (1.f / QLR) + EPS);
                bf16_t* rowp = Q + (size_t)row * 768 + col0;
#pragma unroll
                for (int bj = 0; bj < 2; ++bj) { f32x4 v0 = acc[ai][bj][m][0] * sc, v1 = acc[ai][bj][m][1] * sc;
                    if (pe) rope8(v0, v1, cosT, sinT, row, 16 * (wc & 1) + 4 * fq);
                    u32x4 w; w.x = cvt_pk_bf16(v0[0], v0[1]); w.y = cvt_pk_bf16(v0[2], v0[3]); w.z = cvt_pk_bf16(v1[0], v1[1]); w.w = cvt_pk_bf16(v1[2], v1[3]);
                    *(u32x4*)(rowp + bj * 128) = w; } }
    }
};
struct EpiF32 {
    static constexpr bool PERM = false, MIDK = false;
    float* O; int ldc;
    __device__ __forceinline__ void operator()(const Acc& acc, const pg8::Unit& u, int wr, int wc, int fr, int fq, LAS unsigned char*, int, int) const {
        { const int ln_ = lane_id(); fr = ln_ & 15; fq = ln_ >> 4; }
        const int row0 = u.pm * 256 + wr * 64 + fr, col0 = u.pn * 256 + wc * 32 + 4 * fq;
#pragma unroll
        for (int ai = 0; ai < 2; ++ai)
#pragma unroll
            for (int m = 0; m < 4; ++m) { float* rowp = O + (size_t)(row0 + ai * 128 + m * 16) * ldc + col0;
#pragma unroll
                for (int bj = 0; bj < 2; ++bj)
#pragma unroll
                    for (int n = 0; n < 2; ++n) *(f32x4*)(rowp + bj * 128 + n * 16) = acc[ai][bj][m][n]; }
    }
};
struct EpiSwiGLU {
    static constexpr bool PERM = true, MIDK = false;
    bf16_t* F; const float* ssq;
    __device__ __forceinline__ void operator()(const Acc& acc, const pg8::Unit& u, int wr, int wc, int fr, int fq, LAS unsigned char*, int, int) const {
        { const int ln_ = lane_id(); fr = ln_ & 15; fq = ln_ >> 4; }
        const int row0 = u.pm * 256 + wr * 64 + fr, col0 = u.pn * 128 + wc * 32 + 8 * fq;
        float sq[2][4];
#pragma unroll
        for (int ai = 0; ai < 2; ++ai)
#pragma unroll
            for (int m = 0; m < 4; ++m) sq[ai][m] = ssq[row0 + ai * 128 + m * 16];
#pragma unroll
        for (int ai = 0; ai < 2; ++ai)
#pragma unroll
            for (int m = 0; m < 4; ++m) { bf16_t* rowp = F + (size_t)(row0 + ai * 128 + m * 16) * DFF + col0; float f[8];
                const float rsc = __builtin_amdgcn_rsqf(sq[ai][m] * (1.f / DM) + EPS);
#pragma unroll
                for (int n = 0; n < 2; ++n)
#pragma unroll
                    for (int e = 0; e < 4; ++e) { const float g = acc[ai][0][m][n][e] * rsc, up = acc[ai][1][m][n][e] * rsc;
                        f[n * 4 + e] = g * __builtin_amdgcn_rcpf(1.f + __builtin_amdgcn_exp2f(-g * LOG2E)) * up; }
                u32x4 w; w.x = cvt_pk_bf16(f[0], f[1]); w.y = cvt_pk_bf16(f[2], f[3]); w.z = cvt_pk_bf16(f[4], f[5]); w.w = cvt_pk_bf16(f[6], f[7]);
                *(u32x4*)rowp = w; }
    }
};
struct EpiSoftmax {
    static constexpr bool PERM = true, MIDK = false;
    bf16_t* P; const float* ssq; bool wt;
    __device__ __forceinline__ void operator()(Acc& acc, const pg8::Unit& u, int wr, int wc, int fr, int fq, LAS unsigned char* lds, int, int) const {
        { const int ln_ = lane_id(); fr = ln_ & 15; fq = ln_ >> 4; }
        LAS float* PM = (LAS float*)(lds + EPI_OFF);
        LAS float* PS = (LAS float*)(lds + EPI_OFF + 4096);
        float sq[2][4];
#pragma unroll
        for (int ai = 0; ai < 2; ++ai)
#pragma unroll
            for (int m = 0; m < 4; ++m) sq[ai][m] = ssq[u.pm * 256 + ai * 128 + wr * 64 + m * 16 + fr];
        float mxr[2][4];
#pragma unroll
        for (int ai = 0; ai < 2; ++ai)
#pragma unroll
            for (int m = 0; m < 4; ++m) { float q = -3.0e38f;
#pragma unroll
                for (int bj = 0; bj < 2; ++bj)
#pragma unroll
                    for (int n = 0; n < 2; ++n) { const f32x4 x = acc[ai][bj][m][n]; q = fmaxf(q, fmaxf(fmaxf(x[0], x[1]), fmaxf(x[2], x[3]))); }
                q = fmaxf(q, __shfl_xor(q, 16)); q = fmaxf(q, __shfl_xor(q, 32)); mxr[ai][m] = q; }
#pragma unroll
        for (int ai = 0; ai < 2; ++ai)
#pragma unroll
            for (int m = 0; m < 4; ++m) { sq[ai][m] = __builtin_amdgcn_rsqf(sq[ai][m] * (1.f / DM) + EPS);
                if (fq == 0) PM[(ai * 128 + wr * 64 + m * 16 + fr) * 4 + wc] = mxr[ai][m] * sq[ai][m]; }
        LDS_WAIT(); __builtin_amdgcn_s_barrier(); asm volatile("" ::: "memory");
#pragma unroll
        for (int ai = 0; ai < 2; ++ai)
#pragma unroll
            for (int m = 0; m < 4; ++m) { const f32x4 t = *(const LAS f32x4*)(PM + (ai * 128 + wr * 64 + m * 16 + fr) * 4);
                const float rm = fmaxf(fmaxf(t[0], t[1]), fmaxf(t[2], t[3])), rsc = sq[ai][m]; float s = 0.f;
#pragma unroll
                for (int bj = 0; bj < 2; ++bj)
#pragma unroll
                    for (int n = 0; n < 2; ++n) { f32x4 x = acc[ai][bj][m][n];
#pragma unroll
                        for (int e = 0; e < 4; ++e) { x[e] = __builtin_amdgcn_exp2f(fmaf(x[e], rsc, -rm)); s += x[e]; }
                        acc[ai][bj][m][n] = x; }
                s += __shfl_xor(s, 16); s += __shfl_xor(s, 32);
                if (fq == 0) PS[(ai * 128 + wr * 64 + m * 16 + fr) * 4 + wc] = s; }
        LDS_WAIT(); __builtin_amdgcn_s_barrier(); asm volatile("" ::: "memory");
        const int row0 = u.pm * 256 + wr * 64 + fr, col0 = u.pn * 256 + wc * 32 + 8 * fq;
#pragma unroll
        for (int ai = 0; ai < 2; ++ai)
#pragma unroll
            for (int m = 0; m < 4; ++m) { const f32x4 t = *(const LAS f32x4*)(PS + (ai * 128 + wr * 64 + m * 16 + fr) * 4);
                const float inv = __builtin_amdgcn_rcpf((t[0] + t[1]) + (t[2] + t[3]));
                bf16_t* rowp = P + (size_t)(row0 + ai * 128 + m * 16) * DM + col0;
#pragma unroll
                for (int bj = 0; bj < 2; ++bj) { const f32x4 v0 = acc[ai][bj][m][0] * inv, v1 = acc[ai][bj][m][1] * inv;
                    u32x4 w; w.x = cvt_pk_bf16(v0[0], v0[1]); w.y = cvt_pk_bf16(v0[2], v0[3]); w.z = cvt_pk_bf16(v1[0], v1[1]); w.w = cvt_pk_bf16(v1[2], v1[3]);
                    store16(rowp + bj * 128, w, wt); } }
    }
};

__device__ __forceinline__ unsigned ag_ld(const unsigned* p) { return __hip_atomic_load(p, __ATOMIC_RELAXED, __HIP_MEMORY_SCOPE_AGENT); }
template <bool MIDK_>
struct EpiNormResT {
    static constexpr bool PERM = true, MIDK = MIDK_; static constexpr int TSPLIT = 8;
    const float* hold_f; const bf16_t* hold_b; float* hout; const float* gpost; bf16_t* xn; float* ssq_next; float* slots; unsigned* cnt;
    bool wt;
    __device__ __forceinline__ bool midk_on(const pg8::Unit&) const { return MIDK_; }
    const float* ssq_a; const float* ssq_b;
    __device__ __forceinline__ void prep(const pg8::Unit& u, LAS unsigned char* lds, int wid, int par) const {
        if (wid < 4) { const int ln = lane_id(), row = wid * 64 + ln; const float sa = ssq_a[u.pm * 256 + row], sb = ssq_b[u.pm * 256 + row];
            const float ra = __builtin_amdgcn_rsqf(sa * (1.f / 512) + EPS), rb = __builtin_amdgcn_rsqf(sb * (1.f / 512) + EPS);
            ((LAS f32x2*)(lds + EPI_OFF + 5120))[par * 256 + row] = (f32x2){ra * __builtin_amdgcn_rcpf(rb), rb}; }
    }
    __device__ __forceinline__ void midk(Acc& acc, LAS unsigned char* lds, int par, int wr) const {
        const int ln = lane_id(), fr = ln & 15; const LAS f32x2* RT = (const LAS f32x2*)(lds + EPI_OFF + 5120) + par * 256;
#pragma unroll
        for (int ai = 0; ai < 2; ++ai)
#pragma unroll
            for (int m = 0; m < 4; ++m) { const float r = RT[ai * 128 + wr * 64 + m * 16 + fr].x;
#pragma unroll
                for (int bj = 0; bj < 2; ++bj)
#pragma unroll
                    for (int n = 0; n < 2; ++n) acc[ai][bj][m][n] = acc[ai][bj][m][n] * r; }
    }
    __device__ __forceinline__ void operator()(Acc& acc, const pg8::Unit& u, int wr, int wc, int fr, int fq, LAS unsigned char* lds, int wid, int par) const {
        const int ln = lane_id(); fr = ln & 15; fq = ln >> 4;
        if constexpr (MIDK_) { const LAS f32x2* RT = (const LAS f32x2*)(lds + EPI_OFF + 5120) + par * 256;
#pragma unroll
            for (int ai = 0; ai < 2; ++ai)
#pragma unroll
                for (int m = 0; m < 4; ++m) { const float r = RT[ai * 128 + wr * 64 + m * 16 + fr].y;
#pragma unroll
                    for (int bj = 0; bj < 2; ++bj)
#pragma unroll
                        for (int n = 0; n < 2; ++n) acc[ai][bj][m][n] = acc[ai][bj][m][n] * r; } }
        LAS float* PT = (LAS float*)(lds + EPI_OFF);
        LAS float* SR = (LAS float*)(lds + EPI_OFF + 4096);
        const int col0 = u.pn * 256 + wc * 32 + 8 * fq;
        f32x4 gv[2][2];
#pragma unroll
        for (int bj = 0; bj < 2; ++bj)
#pragma unroll
            for (int n = 0; n < 2; ++n) gv[bj][n] = *(const f32x4*)(gpost + col0 + bj * 128 + n * 4);
        u32x4 hb[2][4][2];
        if (!hold_f) {
#pragma unroll
            for (int ai = 0; ai < 2; ++ai)
#pragma unroll
                for (int m = 0; m < 4; ++m)
#pragma unroll
                    for (int bj = 0; bj < 2; ++bj) hb[ai][m][bj] = *(const u32x4*)(hold_b + (size_t)(u.pm * 256 + ai * 128 + wr * 64 + m * 16 + fr) * DM + col0 + bj * 128); }
#pragma unroll
        for (int ai = 0; ai < 2; ++ai)
#pragma unroll
            for (int m = 0; m < 4; ++m) { float q = 0.f;
#pragma unroll
                for (int bj = 0; bj < 2; ++bj)
#pragma unroll
                    for (int n = 0; n < 2; ++n) { const f32x4 x = acc[ai][bj][m][n]; q += (x[0] * x[0] + x[1] * x[1]) + (x[2] * x[2] + x[3] * x[3]); }
                q += __shfl_xor(q, 16); q += __shfl_xor(q, 32);
                if (fq == 0) PT[(ai * 128 + wr * 64 + m * 16 + fr) * 4 + wc] = q; }
        LDS_WAIT(); __builtin_amdgcn_s_barrier(); asm volatile("" ::: "memory");
        unsigned* c = cnt + 64 * u.pm;
        if (wid < 4) { const int row = wid * 64 + ln; const f32x4 t = *(const LAS f32x4*)(PT + row * 4); const float sq = (t[0] + t[1]) + (t[2] + t[3]);
            __hip_atomic_store((unsigned*)slots + ((size_t)(u.pm * 256 + row) * 4 + u.pn), __float_as_uint(sq), __ATOMIC_RELAXED, __HIP_MEMORY_SCOPE_AGENT);
            asm volatile("s_waitcnt vmcnt(0)" ::: "memory");
            if (ln == 0) __hip_atomic_fetch_add(c, 1u, __ATOMIC_RELAXED, __HIP_MEMORY_SCOPE_AGENT); }
        if (wid == 0) { unsigned sp = 0;
            while ((unsigned)__builtin_amdgcn_readfirstlane(ag_ld(c)) < 16u) { __builtin_amdgcn_s_sleep(2); if (++sp > (1u << 21)) break; }
            __builtin_amdgcn_fence(__ATOMIC_ACQUIRE, "agent"); }
        asm volatile("s_waitcnt vmcnt(0) lgkmcnt(0)" ::: "memory"); __builtin_amdgcn_s_barrier(); asm volatile("" ::: "memory");
        if (wid < 4) { const int row = wid * 64 + ln; const unsigned* sl = (const unsigned*)slots + (size_t)(u.pm * 256 + row) * 4;
            const float tot = (__uint_as_float(ag_ld(sl)) + __uint_as_float(ag_ld(sl + 1))) + (__uint_as_float(ag_ld(sl + 2)) + __uint_as_float(ag_ld(sl + 3)));
            SR[row] = __builtin_amdgcn_rsqf(tot * (1.f / DM) + EPS); }
        LDS_WAIT(); __builtin_amdgcn_s_barrier(); asm volatile("" ::: "memory");
#pragma unroll
        for (int ai = 0; ai < 2; ++ai) { float s[4];
#pragma unroll
            for (int m = 0; m < 4; ++m) { const int rl = ai * 128 + wr * 64 + m * 16 + fr; const float rs = SR[rl]; const size_t off = (size_t)(u.pm * 256 + rl) * DM + col0; float q = 0.f;
#pragma unroll
                for (int bj = 0; bj < 2; ++bj) { f32x4 h0, h1;
                    if (hold_f) { h0 = *(const f32x4*)(hold_f + off + bj * 128); h1 = *(const f32x4*)(hold_f + off + bj * 128 + 4); }
                    else { const u32x4 hv = hb[ai][m][bj]; h0 = (f32x4){bflo(hv.x), bfhi(hv.x), bflo(hv.y), bfhi(hv.y)}; h1 = (f32x4){bflo(hv.z), bfhi(hv.z), bflo(hv.w), bfhi(hv.w)}; }
                    const f32x4 v0 = h0 + acc[ai][bj][m][0] * rs * gv[bj][0], v1 = h1 + acc[ai][bj][m][1] * rs * gv[bj][1];
                    q += ((v0[0] * v0[0] + v0[1] * v0[1]) + (v0[2] * v0[2] + v0[3] * v0[3])) + ((v1[0] * v1[0] + v1[1] * v1[1]) + (v1[2] * v1[2] + v1[3] * v1[3]));
                    if (hout) { *(f32x4*)(hout + off + bj * 128) = v0; *(f32x4*)(hout + off + bj * 128 + 4) = v1; }
                    if (xn) { u32x4 w; w.x = cvt_pk_bf16(v0[0], v0[1]); w.y = cvt_pk_bf16(v0[2], v0[3]); w.z = cvt_pk_bf16(v1[0], v1[1]); w.w = cvt_pk_bf16(v1[2], v1[3]); store16(xn + off + bj * 128, w, wt); } }
                q += __shfl_xor(q, 16); q += __shfl_xor(q, 32); s[m] = q; }
            if (ssq_next) { const float v = fq == 0 ? s[0] : fq == 1 ? s[1] : fq == 2 ? s[2] : s[3]; atomicAdd(ssq_next + u.pm * 256 + wr * 64 + ai * 128 + ln, v); } }
    }
};
typedef EpiNormResT<false> EpiNormRes;
typedef EpiNormResT<true> EpiNormResMid;
struct ChainOrder {
    pg8::TileOrder o; unsigned* wt_base; unsigned* dn_base;
    __device__ bool next(int i, pg8::Unit& u) const { if (!o.next(i, u)) return false; u.wait = wt_base ? wt_base + 64 * u.pm : nullptr; u.done = dn_base ? dn_base + 64 * u.pm : nullptr; return true; }
};

struct EpiP2 { static constexpr bool PERM = true, MIDK = false; EpiQ eq; EpiBf16 ekv, eqk, evo;
    __device__ __forceinline__ void operator()(Acc& acc, const pg8::Unit& u, int wr, int wc, int fr, int fq, LAS unsigned char* l, int wid, int par) const {
        if (u.job == 0) eq(acc, u, wr, wc, fr, fq, l, wid, par); else if (u.job == 1) ekv(acc, u, wr, wc, fr, fq, l, wid, par);
        else if (u.job == 2) eqk(acc, u, wr, wc, fr, fq, l, wid, par); else evo(acc, u, wr, wc, fr, fq, l, wid, par); } };

struct EpiP1 { static constexpr bool PERM = true, MIDK = false; EpiZ ez; EpiBf16 eb;
    __device__ __forceinline__ void operator()(Acc& acc, const pg8::Unit& u, int wr, int wc, int fr, int fq, LAS unsigned char* l, int wid, int par) const {
        if (u.job == 0) ez(acc, u, wr, wc, fr, fq, l, wid, par); else eb(acc, u, wr, wc, fr, fq, l, wid, par); } };

#define XB_TMO      128
#define XB_XCNT(j)  (256  + 64 * (j))
#define XB_XSUB(j)  (1280 + 64 * (j))
#define XB_XGEN(j)  (2304 + 64 * (j))
#define XB_TOP      3328
#define XB_TOPGEN   3392
#define XCD_BAR_WORDS 3456
#define XB_SPIN_CAP (1u << 20)
__device__ __forceinline__ unsigned xb_ld(unsigned* p)              { return __hip_atomic_load(p, __ATOMIC_RELAXED, __HIP_MEMORY_SCOPE_AGENT); }
__device__ __forceinline__ unsigned xb_add(unsigned* p, unsigned v) { return __hip_atomic_fetch_add(p, v, __ATOMIC_RELAXED, __HIP_MEMORY_SCOPE_AGENT); }
__device__ __forceinline__ unsigned xb_xcc_id() { return (unsigned)__builtin_amdgcn_s_getreg((3 << 11) | 20) & 0xFu; }
#define XB_SPIN(cond, bar) do { unsigned _sp = 0; while (cond) { __builtin_amdgcn_s_sleep(1); \
    if ((++_sp & 255u) == 0u) { if (xb_ld(&(bar)[XB_TMO])) break; if (_sp > XB_SPIN_CAP) { atomicAdd(&(bar)[XB_TMO], 1u); break; } } } } while (0)
struct XcdBarrier { unsigned* bar; unsigned x; volatile LAS unsigned* st; unsigned G; };
__device__ __forceinline__ XcdBarrier xcd_barrier_post(unsigned* bar, volatile LAS unsigned* st, unsigned G) {
    XcdBarrier b; b.bar = bar; b.x = xb_xcc_id(); b.st = st; b.G = G;
    if (threadIdx.x == 0) (void)xb_add(&bar[XB_XCNT(b.x)], 1u);
    return b;
}
__device__ __forceinline__ void xcd_barrier_complete(unsigned* bar, unsigned x, unsigned& nloc, unsigned& nx, const unsigned G) {
    unsigned sum, cnt, mine, sp = 0u;
    for (;;) {
        sum = 0u; cnt = 0u; mine = 0u;
#pragma unroll
        for (unsigned j = 0; j < 16; ++j) { const unsigned c = xb_ld(&bar[XB_XCNT(j)]); sum += c; cnt += (c > 0u) ? 1u : 0u; mine = (j == x) ? c : mine; }
        if (sum == G) break;
        __builtin_amdgcn_s_sleep(1);
        if ((++sp & 255u) == 0u) { if (xb_ld(&bar[XB_TMO])) break; if (sp > XB_SPIN_CAP) { atomicAdd(&bar[XB_TMO], 1u); break; } }
    }
    nloc = mine > 0u ? mine : 1u; nx = cnt > 0u ? cnt : 1u;
}
__device__ __forceinline__ void xcd_barrier(const XcdBarrier& b, const int wv) {
    asm volatile("s_waitcnt vmcnt(0)" ::: "memory");
    __syncthreads();
    if (wv == 0 && lane_id() == 0) {
        unsigned* bar = b.bar;
        __builtin_amdgcn_s_waitcnt(0);
        unsigned nloc = b.st[0], nx = b.st[1];
        if (nloc == 0u) { xcd_barrier_complete(bar, b.x, nloc, nx, b.G); b.st[0] = nloc; b.st[1] = nx; }
        const unsigned old = xb_add(&bar[XB_XSUB(b.x)], 1u);
        const unsigned gen = old / nloc;
        if (old + 1u == (gen + 1u) * nloc) {
            __builtin_amdgcn_fence(__ATOMIC_RELEASE, "agent");
            asm volatile("s_waitcnt vmcnt(0)" ::: "memory");
            const unsigned og = xb_add(&bar[XB_TOP], 1u);
            const unsigned tg = og / nx;
            if (og + 1u == (tg + 1u) * nx) xb_add(&bar[XB_TOPGEN], 1u);
            else XB_SPIN(xb_ld(&bar[XB_TOPGEN]) == tg, bar);
            __builtin_amdgcn_fence(__ATOMIC_ACQUIRE, "agent");
            xb_add(&bar[XB_XGEN(b.x)], 1u);
            asm volatile("s_waitcnt vmcnt(0)" ::: "memory");
        } else {
            XB_SPIN(xb_ld(&bar[XB_XGEN(b.x)]) == gen, bar);
            __builtin_amdgcn_fence(__ATOMIC_ACQUIRE, "agent");
            asm volatile("s_waitcnt vmcnt(0)" ::: "memory");
        }
    }
    __syncthreads();
}

enum { MAP_ID = 0, MAP_WIN = 1, MAP_WUQ = 2, MAP_WUKV = 3, MAP_GATE = 4, MAP_UP = 5 };
__device__ __forceinline__ int map_n(int mode, int n) {
    switch (mode) {
    case MAP_WIN: { if (n < OFF_KPE) return n; const int j = n - OFF_KPE; return OFF_KPE + (j < 32 ? 2 * j : 2 * (j - 32) + 1); }
    case MAP_WUQ: { const int h = n / 192, d = n % 192; if (d < 128) return h * 128 + d; const int j = d - 128; return 512 + h * 64 + (j < 32 ? 2 * j : 2 * (j - 32) + 1); }
    case MAP_WUKV: { const int h = n / 256, d = n % 256; return d < 128 ? h * 128 + d : 512 + h * 128 + (d - 128); }
    case MAP_GATE: return (n >> 7) * 256 + (n & 127);
    case MAP_UP: return (n >> 7) * 256 + 128 + (n & 127);
    default: return n;
    }
}
__device__ __forceinline__ void p0_transpose_item(const float* W, int K, int N, bf16_t* WT, int row_off, int mode, const float* kscale, const float* kscale2, LAS float* scr, int item, int lane) {
    const int nblk = N / 64, kb = item / nblk, nb = item % nblk, k0 = 64 * kb, n0 = 64 * nb;
    float v[64];
#pragma unroll
    for (int i = 0; i < 64; ++i) v[i] = W[(size_t)(k0 + i) * N + n0 + lane];
    if (kscale) { const float* ks = (kscale2 && k0 >= 512) ? kscale2 - 512 : kscale;
#pragma unroll
        for (int i = 0; i < 64; ++i) v[i] *= ks[k0 + i]; }
#pragma unroll
    for (int i = 0; i < 64; ++i) scr[i * 65 + lane] = v[i];
    LDS_WAIT(); asm volatile("" ::: "memory");
    const int c = lane & 7;
#pragma unroll
    for (int j = 0; j < 8; ++j) { const int n = (lane >> 3) + 8 * j; const LAS float* sp = scr + (8 * c) * 65 + n;
        u32x4 o; o.x = cvt_pk_bf16(sp[0 * 65], sp[1 * 65]); o.y = cvt_pk_bf16(sp[2 * 65], sp[3 * 65]); o.z = cvt_pk_bf16(sp[4 * 65], sp[5 * 65]); o.w = cvt_pk_bf16(sp[6 * 65], sp[7 * 65]);
        *(u32x4*)(WT + (size_t)(row_off + map_n(mode, n0 + n)) * K + k0 + 8 * c) = o; }
    LDS_WAIT(); asm volatile("" ::: "memory");
}
template <int R, bool NORM>
__device__ __forceinline__ void rms_rows_to_bf16(const float* xrow, const float* g, bf16_t* orow, float* ssq_out, int lane) {
    f32x4 v[R][4]; float s[R];
#pragma unroll
    for (int r = 0; r < R; ++r)
#pragma unroll
        for (int j = 0; j < 4; ++j) v[r][j] = ((const f32x4*)(xrow + (size_t)r * DM) + lane)[64 * j];
    f32x4 gg[4];
#pragma unroll
    for (int j = 0; j < 4; ++j) gg[j] = ((const f32x4*)g + lane)[64 * j];
#pragma unroll
    for (int r = 0; r < R; ++r) { float q = 0.f;
#pragma unroll
        for (int j = 0; j < 4; ++j) q += (v[r][j].x * v[r][j].x + v[r][j].y * v[r][j].y) + (v[r][j].z * v[r][j].z + v[r][j].w * v[r][j].w);
        s[r] = q; }
#pragma unroll
    for (int o = 1; o < 64; o <<= 1)
#pragma unroll
        for (int r = 0; r < R; ++r) s[r] += __shfl_xor(s[r], o);
#pragma unroll
    for (int r = 0; r < R; ++r) { const float rs = NORM ? __builtin_amdgcn_rsqf(s[r] * (1.f / DM) + EPS) : 1.f; u32x2* o8 = (u32x2*)(orow + (size_t)r * DM) + lane;
        if (!NORM) { if (lane == 0) ssq_out[r] = s[r];
#pragma unroll
            for (int j = 0; j < 4; ++j) gg[j] = (f32x4){1.f, 1.f, 1.f, 1.f}; }
#pragma unroll
        for (int j = 0; j < 4; ++j) { u32x2 w; w.x = cvt_pk_bf16(v[r][j].x * rs * gg[j].x, v[r][j].y * rs * gg[j].y); w.y = cvt_pk_bf16(v[r][j].z * rs * gg[j].z, v[r][j].w * rs * gg[j].w); o8[64 * j] = w; } }
}
__device__ __forceinline__ void resid_row(const float* pre, const float* hold, const float* gpost, float* hout, const float* gnext, bf16_t* xn, int lane) {
    const f32x4* pr = (const f32x4*)pre + lane; const f32x4* hr = (const f32x4*)hold + lane; const f32x4* gp = (const f32x4*)gpost + lane;
    f32x4 v[4]; float s = 0.f;
#pragma unroll
    for (int j = 0; j < 4; ++j) { v[j] = pr[64 * j]; s += (v[j].x * v[j].x + v[j].y * v[j].y) + (v[j].z * v[j].z + v[j].w * v[j].w); }
    const float rs = __builtin_amdgcn_rsqf(wave_sum(s) * (1.f / DM) + EPS);
    float s2 = 0.f;
#pragma unroll
    for (int j = 0; j < 4; ++j) { const f32x4 h = hr[64 * j], g = gp[64 * j]; v[j] = h + v[j] * rs * g; s2 += (v[j].x * v[j].x + v[j].y * v[j].y) + (v[j].z * v[j].z + v[j].w * v[j].w); }
    f32x4* ho = (f32x4*)hout + lane;
#pragma unroll
    for (int j = 0; j < 4; ++j) ho[64 * j] = v[j];
    if (xn) { const float rs2 = __builtin_amdgcn_rsqf(wave_sum(s2) * (1.f / DM) + EPS); const f32x4* gn = (const f32x4*)gnext + lane; u32x2* o8 = (u32x2*)xn + lane;
#pragma unroll
        for (int j = 0; j < 4; ++j) { const f32x4 gg = gn[64 * j]; u32x2 w; w.x = cvt_pk_bf16(v[j].x * rs2 * gg.x, v[j].y * rs2 * gg.y); w.y = cvt_pk_bf16(v[j].z * rs2 * gg.z, v[j].w * rs2 * gg.w); o8[64 * j] = w; } }
}

namespace lru {
constexpr int TT = 128, NTILE = SEQ / TT, UP = 72;
constexpr int L_U = 0, L_UF = L_U + TT * UP * 2, L_WSEG = L_UF + TT * 33 * 4, L_CARRY = L_WSEG + 2 * 8 * 32 * 8, L_TSS = L_CARRY + 2 * 32 * 4, L_END = L_TSS + 2 * TT * 4;
static_assert(L_END <= RING_BYTES, "lru lds");
__device__ __forceinline__ float sigmoidf_(float x) { return __builtin_amdgcn_rcpf(1.f + __builtin_amdgcn_exp2f(-x * LOG2E)); }
__device__ __forceinline__ void unit(int b, int cb, const bf16_t* Z, bf16_t* Y, float* ssq_lru, const float* conv_w, const float* conv_b, const float* wa, const float* ba, const float* wx, const float* bx,
                                     const float* lam, LAS unsigned char* lds, const int wv) {
    const int lane = lane_id(), wid = wv, tid = wv * 64 + lane;
    const int hblk = cb >> 1, half = cb & 1, ib = hblk * 64, c0 = cb * 32;
    LAS bf16_t* U = (LAS bf16_t*)(lds + L_U); LAS float* UF = (LAS float*)(lds + L_UF); LAS f32x2* WSEG = (LAS f32x2*)(lds + L_WSEG);
    LAS float* CARRY = (LAS float*)(lds + L_CARRY); LAS float* TSS = (LAS float*)(lds + L_TSS);
    const int col = lane & 15, kq = lane >> 4;
    bf16x8 Bf[4][2];
#pragma unroll
    for (int nb = 0; nb < 4; ++nb)
#pragma unroll
        for (int ks = 0; ks < 2; ++ks) { const float* Wg = (nb < 2) ? wa : wx; const int oc = half * 32 + (nb & 1) * 16 + col; float w[8];
#pragma unroll
            for (int j = 0; j < 8; ++j) w[j] = Wg[((size_t)hblk * 64 + ks * 32 + 8 * kq + j) * 64 + oc];
            u32x4 p; p.x = cvt_pk_bf16(w[0], w[1]); p.y = cvt_pk_bf16(w[2], w[3]); p.z = cvt_pk_bf16(w[4], w[5]); p.w = cvt_pk_bf16(w[6], w[7]); Bf[nb][ks] = __builtin_bit_cast(bf16x8, p); }
    float cba[2], cbx[2], csp[2];
#pragma unroll
    for (int e = 0; e < 2; ++e) { const int ch = c0 + e * 16 + col; cba[e] = ba[ch]; cbx[e] = bx[ch]; const float l = lam[ch];
        csp[e] = 8.f * LOG2E * (fmaxf(-l, 0.f) + log1pf(expf(-fabsf(l)))); }
    const int cch = lane;
    const float cw0 = conv_w[0 * DLRU + ib + cch], cw1 = conv_w[1 * DLRU + ib + cch], cw2 = conv_w[2 * DLRU + ib + cch], cw3 = conv_w[3 * DLRU + ib + cch], cbb = conv_b[ib + cch];
    if (tid < 64) CARRY[tid] = 0.f;
    if (tid < 2 * TT) TSS[tid] = 0.f;
    const size_t rowb = (size_t)b * SEQ;
    const bf16_t* zx = Z + (rowb + wid * 16) * DINP + ib + cch;
    const bf16_t* zg = Z + (rowb + wid * 16 + kq * 4) * DINP + OFF_GATE + c0 + col;
    bf16_t* yp = Y + (rowb + wid * 16 + kq * 4) * DM + c0 + col;
    unsigned short xr[19], gr[8];
#define LRU_LOADX(t0_) do { _Pragma("unroll") for (int k = 0; k < 19; ++k) { const int tk = (t0_) + wid * 16 + k - 3; xr[k] = (tk >= 0) ? zx[(ptrdiff_t)((t0_) + k - 3) * DINP] : (unsigned short)0; } } while (0)
    LRU_LOADX(0);
    __syncthreads();
    for (int tile = 0; tile < NTILE; ++tile) {
        const int t0 = tile * TT, par = tile & 1;
        { float xm3 = bf2f(xr[0]), xm2 = bf2f(xr[1]), xm1 = bf2f(xr[2]);
#pragma unroll
          for (int k = 0; k < 16; ++k) { const float x0 = bf2f(xr[3 + k]); const float u = cbb + cw0 * xm3 + cw1 * xm2 + cw2 * xm1 + cw3 * x0; xm3 = xm2; xm2 = xm1; xm1 = x0;
              const int tl = wid * 16 + k; U[tl * UP + cch] = (bf16_t)(cvt_pk_bf16(u, 0.f) & 0xffffu);
              if ((cch >> 5) == half) UF[tl * 33 + (cch & 31)] = u; } }
#pragma unroll
        for (int e = 0; e < 2; ++e)
#pragma unroll
            for (int r = 0; r < 4; ++r) gr[e * 4 + r] = zg[(size_t)(t0 + r) * DINP + e * 16];
        if (tile + 1 < NTILE) LRU_LOADX(t0 + TT);
        LDS_WAIT();
        float av[2][4], uv[2][4], Ainc[2], Hinc[2];
        { f32x4 C[4];
#pragma unroll
          for (int nb = 0; nb < 4; ++nb) C[nb] = (f32x4){0.f, 0.f, 0.f, 0.f};
          const LAS bf16_t* ua = U + (wid * 16 + col) * UP + 8 * kq;
          const bf16x8 a0 = *(const LAS bf16x8*)ua, a1 = *(const LAS bf16x8*)(ua + 32);
#pragma unroll
          for (int nb = 0; nb < 4; ++nb) { C[nb] = __builtin_amdgcn_mfma_f32_16x16x32_bf16(a0, Bf[nb][0], C[nb], 0, 0, 0); C[nb] = __builtin_amdgcn_mfma_f32_16x16x32_bf16(a1, Bf[nb][1], C[nb], 0, 0, 0); }
#pragma unroll
          for (int e = 0; e < 2; ++e) { float Ap = 1.f, H = 0.f;
#pragma unroll
              for (int r = 0; r < 4; ++r) { const int tl = wid * 16 + kq * 4 + r, ch = e * 16 + col;
                  const float rg = sigmoidf_(C[e][r] + cba[e]), ig = sigmoidf_(C[e + 2][r] + cbx[e]);
                  const float a = __builtin_amdgcn_exp2f(-rg * csp[e]); const float mult = __builtin_amdgcn_sqrtf(fmaxf(1.f - a * a, 0.f));
                  const float uu = mult * ig * UF[tl * 33 + ch];
                  av[e][r] = a; uv[e][r] = uu; H = a * H + uu; Ap *= a; }
              { const float Ap1 = __shfl_up(Ap, 16), H1 = __shfl_up(H, 16); if (kq >= 1) { H = Ap * H1 + H; Ap = Ap * Ap1; } }
              { const float Ap2 = __shfl_up(Ap, 32), H2 = __shfl_up(H, 32); if (kq >= 2) { H = Ap * H2 + H; Ap = Ap * Ap2; } }
              Ainc[e] = Ap; Hinc[e] = H;
              if (kq == 3) WSEG[(par * 8 + wid) * 32 + e * 16 + col] = (f32x2){Ap, H}; } }
        __syncthreads();
        if (tid < TT) { const float v = TSS[(par ^ 1) * TT + tid]; if (tile > 0) atomicAdd(ssq_lru + rowb + t0 - TT + tid, v); }
        float qs[4] = {0.f, 0.f, 0.f, 0.f};
#pragma unroll
        for (int e = 0; e < 2; ++e) { const int ch = e * 16 + col;
            float h = CARRY[par * 32 + ch];
            for (int w2 = 0; w2 < wid; ++w2) { const f32x2 sg = WSEG[(par * 8 + w2) * 32 + ch]; h = sg.x * h + sg.y; }
            if (wid == 7 && kq == 0) { const f32x2 sg = WSEG[(par * 8 + 7) * 32 + ch]; CARRY[(par ^ 1) * 32 + ch] = sg.x * h + sg.y; }
            const float Ae = __shfl_up(Ainc[e], 16), He = __shfl_up(Hinc[e], 16);
            if (kq >= 1) h = Ae * h + He;
#pragma unroll
            for (int r = 0; r < 4; ++r) { h = av[e][r] * h + uv[e][r]; const float g = bf2f(gr[e * 4 + r]);
                const float ge = g * __builtin_amdgcn_rcpf(1.f + __builtin_amdgcn_exp2f(-1.5957691216057308f * LOG2E * (g + 0.044715f * g * g * g)));
                const float y = h * ge; yp[(size_t)(t0 + r) * DM + e * 16] = (bf16_t)(cvt_pk_bf16(y, 0.f) & 0xffffu); qs[r] += y * y; } }
#pragma unroll
        for (int r = 0; r < 4; ++r) { float q = qs[r]; q += __shfl_xor(q, 1); q += __shfl_xor(q, 2); q += __shfl_xor(q, 4); q += __shfl_xor(q, 8);
            if (col == 0) TSS[par * TT + wid * 16 + kq * 4 + r] = q; }
    }
    __syncthreads();
    if (tid < TT) atomicAdd(ssq_lru + rowb + (NTILE - 1) * TT + tid, TSS[((NTILE - 1) & 1) * TT + tid]);
    __syncthreads();
#undef LRU_LOADX
}
}

namespace mla {
constexpr int NW = 8, QBLK = 32, KVBLK = 64, QB = 256, KROW = 384, SHM_K = KVBLK * KROW, SHM_V = KVBLK * 128 * 2;
constexpr int L_V = 0, L_K = 2 * SHM_V, L_WS = L_K + 2 * SHM_K, L_END = L_WS + NW * 64 * 4;
static_assert(L_END <= RING_BYTES && NW * 8192 <= L_WS, "mla lds");
#define KSWZ(row, colB) ((row) * KROW + ((colB) ^ ((((row) >> 1) & 7) << 4)))
#define SBAR() __builtin_amdgcn_sched_barrier(0)
__device__ __forceinline__ int v_st(int k, int c) { const int kk = (k & ~0xC) | ((k & 4) << 1) | ((k & 8) >> 1); return ((kk >> 3) * 4 + (c >> 5)) * 512 + ((kk & 7) * 32 + (c & 31)) * 2; }
__device__ __forceinline__ int v_rd_base(int lane) { return ((lane & 3) << 3) | (((lane >> 2) & 3) << 6) | (((lane >> 4) & 1) << 5) | (((lane >> 5) & 1) << 8); }
constexpr int v_rd_off(int d0, int ks, int half) { return d0 * 512 + ks * 4096 + half * 2048; }
__device__ __forceinline__ int crow(int r, int hi) { return (r & 3) + 8 * (r >> 2) + 4 * hi; }
__device__ __forceinline__ void mask_tile(f32x16& p0, f32x16& p1, int dq) {
    const float NEG = -__builtin_inff();
#pragma unroll
    for (int r = 0; r < 16; ++r) { const int c = (r & 3) + 8 * (r >> 2); if (dq - c < 0) p0[r] = NEG; if (dq - c - 32 < 0) p1[r] = NEG; }
}
constexpr float THR2 = 8.f * LOG2E;
__device__ __forceinline__ void partialSM(f32x16& p0, f32x16& p1, float& m_reg, float& alpha) {
    float pmax = p0[0];
#pragma unroll
    for (int r = 1; r < 16; ++r) pmax = fmaxf(pmax, p0[r]);
#pragma unroll
    for (int r = 0; r < 16; ++r) pmax = fmaxf(pmax, p1[r]);
    { auto rr = __builtin_amdgcn_permlane32_swap(__float_as_uint(pmax), __float_as_uint(pmax), false, false); pmax = fmaxf(__uint_as_float(rr[0]), __uint_as_float(rr[1])); }
    float mn;
    if (__builtin_expect(__all((pmax - m_reg) <= THR2), 1)) { mn = m_reg; alpha = 1.f; }
    else { mn = fmaxf(m_reg, pmax); alpha = __builtin_amdgcn_exp2f(m_reg - mn); m_reg = mn; }
#pragma unroll
    for (int r = 0; r < 16; ++r) p0[r] = p0[r] - mn;
#pragma unroll
    for (int r = 0; r < 16; ++r) p1[r] = p1[r] - mn;
#pragma unroll
    for (int r = 0; r < 16; ++r) p0[r] = __builtin_amdgcn_exp2f(p0[r]);
}
__device__ __forceinline__ void finishSM(f32x16& p0, f32x16& p1, float alpha, float& l_reg, bf16x8& pa0, bf16x8& pa1, bf16x8& pa2, bf16x8& pa3) {
#pragma unroll
    for (int r = 0; r < 16; ++r) p1[r] = __builtin_amdgcn_exp2f(p1[r]);
    float ps = 0;
#pragma unroll
    for (int r = 0; r < 16; ++r) ps += p0[r];
#pragma unroll
    for (int r = 0; r < 16; ++r) ps += p1[r];
    { auto rr = __builtin_amdgcn_permlane32_swap(__float_as_uint(ps), __float_as_uint(ps), false, false); ps = __uint_as_float(rr[0]) + __uint_as_float(rr[1]); }
    l_reg = l_reg * alpha + ps;
#define PK4(P, B_, OUT) do { unsigned a0 = cvt_pk_bf16(P[B_+0], P[B_+1]), a1 = cvt_pk_bf16(P[B_+2], P[B_+3]);                          \
        unsigned b0 = cvt_pk_bf16(P[B_+4], P[B_+5]), b1 = cvt_pk_bf16(P[B_+6], P[B_+7]);                                             \
        auto r0 = __builtin_amdgcn_permlane32_swap(a0, b0, false, false); auto r1 = __builtin_amdgcn_permlane32_swap(a1, b1, false, false); \
        u32x4 w = {r0[0], r1[0], r0[1], r1[1]}; OUT = __builtin_bit_cast(bf16x8, w); } while (0)
    PK4(p0, 0, pa0); PK4(p0, 8, pa1); PK4(p1, 0, pa2); PK4(p1, 8, pa3);
#undef PK4
}
template <int KB>
__device__ __forceinline__ void qkt(f32x16& p0, f32x16& p1, const char* K_lds, int r32, int hi, const bf16x8* qr) {
    p0 = f32x16{}; p1 = f32x16{};
    unsigned kb[4];
#pragma unroll
    for (int dd = 0; dd < 4; ++dd) kb[dd] = (unsigned)(uintptr_t)(K_lds + KB * SHM_K + KSWZ(r32, (dd * 16 + hi * 8) * 2));
    bf16x8 fa[4], fb[4];
#define KRD(slot, d0) do { asm volatile("ds_read_b128 %0, %1 offset:%2" : "=v"(fa[slot]) : "v"(kb[(d0) & 3]), "i"(((d0) >> 2) * 128)); \
                           asm volatile("ds_read_b128 %0, %1 offset:%2" : "=v"(fb[slot]) : "v"(kb[(d0) & 3]), "i"(((d0) >> 2) * 128 + 32 * KROW)); } while (0)
#define KMM(slot, d0, N) do { asm volatile("s_waitcnt lgkmcnt(%0)" :: "i"(N) : "memory"); SBAR(); \
        p0 = __builtin_amdgcn_mfma_f32_32x32x16_bf16(fa[slot], qr[d0], p0, 0, 0, 0); p1 = __builtin_amdgcn_mfma_f32_32x32x16_bf16(fb[slot], qr[d0], p1, 0, 0, 0); SBAR(); } while (0)
    KRD(0, 0); KRD(1, 1); KRD(2, 2); KRD(3, 3);
    KMM(0, 0, 6); KRD(0, 4); KMM(1, 1, 6); KRD(1, 5); KMM(2, 2, 6); KRD(2, 6); KMM(3, 3, 6); KRD(3, 7);
    KMM(0, 4, 6); KRD(0, 8); KMM(1, 5, 6); KRD(1, 9); KMM(2, 6, 6); KRD(2, 10); KMM(3, 7, 6); KRD(3, 11);
    KMM(0, 8, 6); KMM(1, 9, 4); KMM(2, 10, 2); KMM(3, 11, 0);
#undef KRD
#undef KMM
}
template <int VB>
__device__ __forceinline__ void pv_tile(f32x16* o, int vb0, bf16x8 pa0, bf16x8 pa1, bf16x8 pa2, bf16x8 pa3) {
    s16x4 lo[2][4], hh[2][4];
#define TRRD(dst, off) asm volatile("ds_read_b64_tr_b16 %0, %1 offset:%2" : "=v"(dst) : "v"(vb0), "i"(off))
#define VRD(set, d0) do { constexpr int b_ = VB * SHM_V + v_rd_off(d0, 0, 0); \
        TRRD(lo[set][0], b_); TRRD(hh[set][0], b_ + 2048); TRRD(lo[set][1], b_ + 4096); TRRD(hh[set][1], b_ + 6144); \
        TRRD(lo[set][2], b_ + 8192); TRRD(hh[set][2], b_ + 10240); TRRD(lo[set][3], b_ + 12288); TRRD(hh[set][3], b_ + 14336); } while (0)
#define VFR(set, k) (bf16x8){lo[set][k][0], lo[set][k][1], lo[set][k][2], lo[set][k][3], hh[set][k][0], hh[set][k][1], hh[set][k][2], hh[set][k][3]}
#define VMM(set, d0, N) do { asm volatile("s_waitcnt lgkmcnt(%0)" :: "i"(N) : "memory"); SBAR(); \
        o[d0] = __builtin_amdgcn_mfma_f32_32x32x16_bf16(pa0, VFR(set, 0), o[d0], 0, 0, 0); o[d0] = __builtin_amdgcn_mfma_f32_32x32x16_bf16(pa1, VFR(set, 1), o[d0], 0, 0, 0); \
        o[d0] = __builtin_amdgcn_mfma_f32_32x32x16_bf16(pa2, VFR(set, 2), o[d0], 0, 0, 0); o[d0] = __builtin_amdgcn_mfma_f32_32x32x16_bf16(pa3, VFR(set, 3), o[d0], 0, 0, 0); SBAR(); } while (0)
    VRD(0, 0); VRD(1, 1);
    VMM(0, 0, 8); VRD(0, 2); VMM(1, 1, 8); VRD(1, 3); VMM(0, 2, 8); VMM(1, 3, 0);
#undef TRRD
#undef VRD
#undef VFR
#undef VMM
}
__device__ __forceinline__ void block(int b, int h, int qb, const bf16_t* Qb, const bf16_t* KVb, const bf16_t* KPE, bf16_t* Y, float* ssq_mla, char* lds, const int wv) {
    const int lane = lane_id(), wid = wv, tid = wv * 64 + lane, r32 = lane & 31, hi = lane >> 5;
    const size_t rowbase = (size_t)b * SEQ; const int q0 = qb * QB; const int NT = (q0 + QB) / KVBLK;
    const int qlo = q0 + wid * QBLK, qm = qlo + r32 - 4 * hi;
    char* V_lds = lds + L_V; char* K_lds = lds + L_K;
    float* ws = (float*)(lds + L_WS) + wid * 64; float* li_l = ws, * al_l = ws + 32;
    float m_reg = -1e30f, l_reg = 0; f32x16 o[4] = {};
    const int sr = tid >> 4, scc = (tid & 15) * 8, vst0 = v_st(sr, scc), vst1 = v_st(32 + sr, scc), kws = KSWZ(sr, (tid & 15) * 16);
    const int pr = tid >> 3, kws2 = KSWZ(pr, 256 + (tid & 7) * 16);
    const int vb0 = (int)(uintptr_t)V_lds + v_rd_base(lane);
    const bf16_t* Kn = KVb + rowbase * 1024 + h * 128 + scc;
    const bf16_t* Vn = KVb + rowbase * 1024 + 512 + h * 128 + scc;
    const bf16_t* Kp = KPE + rowbase * 64 + (tid & 7) * 8;
    bf16x8 qr[12];
    { const bf16_t* qp = Qb + (rowbase + q0 + wid * QBLK + r32) * 768;
#pragma unroll
      for (int d0 = 0; d0 < 8; ++d0) qr[d0] = *(const bf16x8*)(qp + h * 128 + d0 * 16 + hi * 8);
#pragma unroll
      for (int d0 = 0; d0 < 4; ++d0) qr[8 + d0] = *(const bf16x8*)(qp + 512 + h * 64 + d0 * 16 + hi * 8); }
    const int grp = wid >> 2;
    bf16x8 st_v0, st_v1, st_k0, st_k1, st_k2;
#define SLOADK(t) do { const size_t k0_ = (size_t)(t) * KVBLK; st_k0 = *(const bf16x8*)(Kn + (k0_ + sr) * 1024); st_k1 = *(const bf16x8*)(Kn + (k0_ + 32 + sr) * 1024); st_k2 = *(const bf16x8*)(Kp + (k0_ + pr) * 64); } while (0)
#define SLOADV(t) do { const size_t k0_ = (size_t)(t) * KVBLK; st_v0 = *(const bf16x8*)(Vn + (k0_ + sr) * 1024); st_v1 = *(const bf16x8*)(Vn + (k0_ + 32 + sr) * 1024); } while (0)
#define SWRITEK(off) do { *(bf16x8*)(K_lds + (off) + kws) = st_k0; *(bf16x8*)(K_lds + (off) + kws + 32 * KROW) = st_k1; *(bf16x8*)(K_lds + (off) + kws2) = st_k2; } while (0)
#define SWRITEV(off) do { *(bf16x8*)(V_lds + (off) + vst0) = st_v0; *(bf16x8*)(V_lds + (off) + vst1) = st_v1; } while (0)
#define BAR() asm volatile("s_waitcnt lgkmcnt(0)\n\ts_barrier" ::: "memory")
#define RESC(a) do { if (__any((a) < 1.f)) { if (hi == 0) al_l[r32] = (a); asm volatile("s_waitcnt lgkmcnt(0)" ::: "memory");              \
                     for (int d_ = 0; d_ < 4; ++d_) for (int r = 0; r < 16; ++r) o[d_][r] *= al_l[crow(r, hi)]; } } while (0)
#define MASKT(P0_, P1_, t) do { const int kb_ = (t) * KVBLK; if (kb_ + KVBLK - 1 > qlo) mask_tile(P0_, P1_, qm - kb_); } while (0)
#define ACT(t) ((t) * KVBLK <= qlo + QBLK - 1)
#define NEGALL() do { const float NEG_ = -__builtin_inff(); _Pragma("unroll") for (int r = 0; r < 16; ++r) { p0[r] = NEG_; p1[r] = NEG_; } } while (0)
    f32x16 p0, p1; float al; bf16x8 pa0, pa1, pa2, pa3;
    SLOADK(0); VM_WAIT(); SWRITEK(0);
    if (grp) { SLOADK(1); SLOADV(0); }
    BAR();
    if (grp) { VM_WAIT(); SWRITEK(SHM_K); SWRITEV(0); BAR(); }
#define SMSLOT(t, tk, tv) do { if ((tk) < NT || (tv) < NT) { VM_WAIT(); if ((tk) < NT) SWRITEK(((tk) & 1) * SHM_K); if ((tv) < NT) SWRITEV(((tv) & 1) * SHM_V); } \
        MASKT(p0, p1, (t)); partialSM(p0, p1, m_reg, al); RESC(al); finishSM(p0, p1, al, l_reg, pa0, pa1, pa2, pa3); SBAR(); } while (0)
    { const int tk = 1 + grp, tv = grp;
      SLOADK(tk); SLOADV(tv); SBAR(); qkt<0>(p0, p1, K_lds, r32, hi, qr); SBAR();
      BAR(); SMSLOT(0, tk, tv); BAR(); }
    for (int i = 0; i < NT; i += 2) {
        { const int tk = i + 2 + grp, tv = i + 1 + grp;
          if (tk < NT) SLOADK(tk); if (tv < NT) SLOADV(tv); SBAR();
          if (ACT(i + 1)) qkt<1>(p0, p1, K_lds, r32, hi, qr); else NEGALL(); SBAR(); if (ACT(i)) pv_tile<0>(o, vb0, pa0, pa1, pa2, pa3); SBAR();
          BAR(); SMSLOT(i + 1, tk, tv); BAR(); }
        { const int tk = i + 3 + grp, tv = i + 2 + grp;
          if (tk < NT) SLOADK(tk); if (tv < NT) SLOADV(tv); SBAR();
          if (i + 2 < NT) { if (ACT(i + 2)) qkt<0>(p0, p1, K_lds, r32, hi, qr); else NEGALL(); SBAR(); }
          if (ACT(i + 1)) pv_tile<1>(o, vb0, pa0, pa1, pa2, pa3); SBAR();
          BAR(); if (i + 2 < NT) SMSLOT(i + 2, tk, tv); BAR(); }
    }
    if (!grp) BAR();
#undef SMSLOT
#undef SLOADK
#undef SLOADV
#undef SWRITEK
#undef SWRITEV
#undef BAR
    if (hi == 0) li_l[r32] = l_reg; asm volatile("s_waitcnt lgkmcnt(0)" ::: "memory");
    float rli[16];
#pragma unroll
    for (int r = 0; r < 16; ++r) rli[r] = __builtin_amdgcn_rcpf(li_l[crow(r, hi)]);
    { bf16_t* stg = (bf16_t*)lds + wid * 4096;
#pragma unroll
      for (int r = 0; r < 16; ++r) { const int orow = crow(r, hi);
#pragma unroll
          for (int d0 = 0; d0 < 4; ++d0) stg[orow * 128 + d0 * 32 + r32] = (bf16_t)(cvt_pk_bf16(o[d0][r] * rli[r], 0.f) & 0xffffu); }
      asm volatile("s_waitcnt lgkmcnt(0)" ::: "memory");
      const int row = lane >> 1, hf = lane & 1; float q = 0.f;
      bf16_t* yp = Y + (rowbase + q0 + wid * QBLK + row) * DM + 512 + h * 128 + hf * 64;
#pragma unroll
      for (int j = 0; j < 8; ++j) { const u32x4 v = *(const u32x4*)(stg + row * 128 + hf * 64 + j * 8);
          q += bflo(v.x) * bflo(v.x) + bfhi(v.x) * bfhi(v.x) + bflo(v.y) * bflo(v.y) + bfhi(v.y) * bfhi(v.y) + bflo(v.z) * bflo(v.z) + bfhi(v.z) * bfhi(v.z) + bflo(v.w) * bflo(v.w) + bfhi(v.w) * bfhi(v.w);
          *(u32x4*)(yp + j * 8) = v; }
      q += __shfl_xor(q, 1);
      if (hf == 0) atomicAdd(ssq_mla + rowbase + q0 + wid * QBLK + row, q); }
    __syncthreads();
#undef RESC
#undef MASKT
#undef ACT
#undef NEGALL
}
#undef KSWZ
#undef SBAR
}

constexpr int NWAVES = 8, NPHASE = 13;
struct Args { const void* in[32]; float* out; unsigned char* ws; int ph_lo, ph_hi; };

__global__ void __launch_bounds__(NWAVES * 64, 2) hymba_fwd(Args args) {
    extern __shared__ __attribute__((aligned(16))) unsigned char lds_raw[];
    LAS unsigned char* lds = (LAS unsigned char*)lds_raw;
    volatile LAS unsigned* MISC = (volatile LAS unsigned*)(lds + MISC_OFF);
    const int G = gridDim.x, bx = blockIdx.x, vcu = (G % 8 == 0) ? (bx % 8) * (G / 8) + bx / 8 : bx;
    const int wave_s = __builtin_amdgcn_readfirstlane((int)threadIdx.x >> 6);
#define lane (lane_id())
#define tid (wave_s * 64 + lane)
#define wave (wave_s)
#define gw (vcu * NWAVES + wave)
#define NGW (G * NWAVES)
    unsigned char* ws = args.ws;
#define x_in ((const float*)args.in[0])
#define mem ((const float*)args.in[1])
#define positions ((const int*)args.in[2])
#define g_pre_mix ((const float*)args.in[3])
#define w_in ((const float*)args.in[4])
#define conv_w ((const float*)args.in[5])
#define conv_b ((const float*)args.in[6])
#define lru_wa ((const float*)args.in[7])
#define lru_ba ((const float*)args.in[8])
#define lru_wx ((const float*)args.in[9])
#define lru_bx ((const float*)args.in[10])
#define lru_lambda ((const float*)args.in[11])
#define g_q_lat ((const float*)args.in[12])
#define w_uq ((const float*)args.in[13])
#define g_kv_lat ((const float*)args.in[14])
#define w_ukv ((const float*)args.in[15])
#define g_lru_out ((const float*)args.in[16])
#define g_mla_out ((const float*)args.in[17])
#define w_out ((const float*)args.in[18])
#define g_post_mix ((const float*)args.in[19])
#define g_pre_mem ((const float*)args.in[20])
#define g_mem_kv ((const float*)args.in[21])
#define w_mq ((const float*)args.in[22])
#define w_mk ((const float*)args.in[23])
#define w_mv ((const float*)args.in[24])
#define w_mo ((const float*)args.in[25])
#define g_post_mem ((const float*)args.in[26])
#define g_pre_ffn ((const float*)args.in[27])
#define w_gate ((const float*)args.in[28])
#define w_up ((const float*)args.in[29])
#define w_down ((const float*)args.in[30])
#define g_post_ffn ((const float*)args.in[31])
#define out_p (args.out)
#define ctl ((unsigned*)(ws + WS_CTL))
#define ssq_cq ((float*)(ws + WS_SSQ))
#define ssq_ckv (ssq_cq + T)
#define ssq_lru (ssq_cq + 2 * T)
#define ssq_mla (ssq_cq + 3 * T)
#define ssq_h1 (ssq_cq + 4 * T)
#define ssq_h2 (ssq_cq + 5 * T)
#define ssq_x (ssq_cq + 6 * T)
#define ssq_dummy (ssq_cq + 7 * T)
#define slots_p ((float*)(ws + WS_SLOTS))
#define cosT ((float*)(ws + WS_ROPE))
#define sinT (cosT + (size_t)T * 32)
#define Win_t ((bf16_t*)(ws + WS_WIN))
#define Wuq_t ((bf16_t*)(ws + WS_WUQ))
#define Wukv_t ((bf16_t*)(ws + WS_WUKV))
#define Wout_t ((bf16_t*)(ws + WS_WOUT))
#define Wmq_b ((bf16_t*)(ws + WS_WMQ))
#define Wmkv_t ((bf16_t*)(ws + WS_WMKV))
#define Wmo_t ((bf16_t*)(ws + WS_WMO))
#define Wgu_t ((bf16_t*)(ws + WS_WGU))
#define Wdown_t ((bf16_t*)(ws + WS_WDOWN))
#define MN ((bf16_t*)(ws + WS_MN))
#define MKV ((bf16_t*)(ws + WS_MKV))
#define WQK ((bf16_t*)(ws + WS_WQK))
#define WVO ((bf16_t*)(ws + WS_WVO))
#define XN ((bf16_t*)(ws + WS_XN))
#define KPE ((bf16_t*)(ws + WS_KPE))
#define Z ((bf16_t*)(ws + WS_Z))
#define Qb ((bf16_t*)(ws + WS_Q))
#define KVb ((bf16_t*)(ws + WS_KV))
#define Y ((bf16_t*)(ws + WS_Y))
#define PRE ((float*)(ws + WS_PRE))
#define Pb ((bf16_t*)(ws + WS_P))
#define Fb ((bf16_t*)(ws + WS_F))
    for (int u = tid; u < 256; u += NWAVES * 64) ((LAS unsigned*)(lds + MISC_OFF))[u] = 0u;
    __syncthreads();
    XcdBarrier bar = xcd_barrier_post(ctl + CW_BAR, MISC + 8, (unsigned)G);
    const bool grouped = (G == 256);
    XcdBarrier gbar = grouped ? xcd_barrier_post(ctl + CW_BAR + XCD_BAR_WORDS * (1 + (bx & 7)), MISC + 10, (unsigned)(G >> 3)) : bar;
    const int lo = args.ph_lo, hi = args.ph_hi;
    unsigned long long ts0 = 0, ts1 = 0, tc0 = 0, tc1 = 0;
#define TS(k) do { if ((k) == (SPIN_LO)) { ts0 = __builtin_amdgcn_s_memrealtime(); tc0 = __builtin_amdgcn_s_memtime(); } } while (0)
#define TE(k) do { if ((k) == (SPIN_HI)) { ts1 = __builtin_amdgcn_s_memrealtime(); tc1 = __builtin_amdgcn_s_memtime(); } } while (0)
#ifndef REP_PHASE
#define REP_PHASE -1
#endif
#define REPS(k) for (int rep = 0; rep < ((REP_PHASE) == (k) ? 2 : 1); ++rep)
#define RSQ(p) (rep ? ssq_dummy : (p))
#ifndef PHASE_MASK
#define PHASE_MASK 0x1fff
#endif
#define IN(k) (((PHASE_MASK >> (k)) & 1) && lo <= (k) && (k) < hi)
#ifndef SPIN_LO
#define SPIN_LO -1
#define SPIN_HI -1
#endif
#ifndef ALIGN_P10
#define ALIGN_P10 true
#endif
#ifndef EXTRA_BAR
#define EXTRA_BAR 0
#endif
#define SEAM(k) do { if (IN(k) && IN((k) + 1)) { if ((k) == 0 || !grouped) xcd_barrier(bar, wave_s); else xcd_barrier(gbar, wave_s); } } while (0)

    TS(0); if (IN(0)) REPS(0) {
        LAS float* scr = (LAS float*)(lds + wave * 16640);
        constexpr int I_IN = 16 * 27, I_UQ = 6 * 12, I_UKV = 4 * 16, I_SQ = 16 * 16, I_GU = 16 * 44, I_DN = 44 * 16;
        int cum = 0;
#define P0_JOB(W, K_, N_, WT, ROFF, MODE, KS, KS2, CNT) do { for (int it = (gw + NGW - (cum % NGW)) % NGW; it < (CNT); it += NGW) p0_transpose_item(W, K_, N_, WT, ROFF, MODE, KS, KS2, scr, it, lane); cum += (CNT); } while (0)
        P0_JOB(w_in, DM, 1728, Win_t, 0, MAP_WIN, g_pre_mix, nullptr, I_IN);
        P0_JOB(w_uq, QLR, 768, Wuq_t, 0, MAP_WUQ, g_q_lat, nullptr, I_UQ);
        P0_JOB(w_ukv, KVLR, 1024, Wukv_t, 0, MAP_WUKV, g_kv_lat, nullptr, I_UKV);
        P0_JOB(w_out, DM, DM, Wout_t, 0, MAP_ID, g_lru_out, g_mla_out, I_SQ);
        P0_JOB(w_mk, DM, DM, Wmkv_t, 0, MAP_ID, nullptr, nullptr, I_SQ);
        P0_JOB(w_mv, DM, DM, Wmkv_t, 1024, MAP_ID, nullptr, nullptr, I_SQ);
        P0_JOB(w_mo, DM, DM, Wmo_t, 0, MAP_ID, nullptr, nullptr, I_SQ);
        P0_JOB(w_gate, DM, DFF, Wgu_t, 0, MAP_GATE, g_pre_ffn, nullptr, I_GU);
        P0_JOB(w_up, DM, DFF, Wgu_t, 0, MAP_UP, g_pre_ffn, nullptr, I_GU);
        P0_JOB(w_down, DFF, DM, Wdown_t, 0, MAP_ID, nullptr, nullptr, I_DN);
#undef P0_JOB
        const int gt = vcu * (NWAVES * 64) + tid, NGT = G * NWAVES * 64;
        for (int i = gt; i < 64 * 1024 / 8; i += NGT) *(u32x4*)(Win_t + (size_t)1728 * 1024 + (size_t)i * 8) = (u32x4){0u, 0u, 0u, 0u};
        for (int i = gt; i < DM * DM / 4; i += NGT) { const f32x4 v = *(const f32x4*)(w_mq + (size_t)i * 4) * g_pre_mem[i >> 8]; u32x2 w; w.x = cvt_pk_bf16(v.x, v.y); w.y = cvt_pk_bf16(v.z, v.w); *(u32x2*)(Wmq_b + (size_t)i * 4) = w; }
        for (int i = gt; i < T * 32; i += NGT) { const int row = i >> 5, k = i & 31; const double invf = exp2(-(double)k * (13.287712379549449 / 32.0));
            const double rev = (double)positions[row] * invf * 0.15915494309189535; const float fr_ = (float)(rev - rint(rev)); cosT[i] = __builtin_amdgcn_cosf(fr_); sinT[i] = __builtin_amdgcn_sinf(fr_); }
        { const int rpw = T / (G * NWAVES);
          for (int m = gw * rpw; m < (gw + 1) * rpw; m += 4) rms_rows_to_bf16<4, false>(x_in + (size_t)m * DM, g_pre_mix, XN + (size_t)m * DM, ssq_x + m, lane); }
        { const int rpw = TM / (G * NWAVES);
          for (int m = gw * rpw; m < (gw + 1) * rpw; m += 2) rms_rows_to_bf16<2, true>(mem + (size_t)m * DM, g_mem_kv, MN + (size_t)m * DM, nullptr, lane); }
    }
    SEAM(0); TE(0);
    TS(1); if (IN(1)) REPS(1) {
        {
          struct P1Order { pg8::TileOrder o; int nz, mu; const char* A2; const char* B2;
              __device__ bool next(int i, pg8::Unit& un) const { if (o.next(i, un)) return true; if (i != nz || mu < 0) return false;
                  un.pm = mu >> 3; un.pn = mu & 7; un.A = A2 + (size_t)un.pm * 256 * DM * 2; un.B = B2 + (size_t)un.pn * 256 * DM * 2; un.cofs = 0; un.job = 1; un.wait = nullptr; un.done = nullptr; return true; } };
          const int j = bx >> 3; P1Order S; S.o.init(T, DINP, G, bx, XN, DM, Win_t, DM);
          S.nz = (896 - bx + G - 1) / G;
          S.mu = (G == 256) ? (j >= 16 ? ((bx & 7) * 2 + ((j - 16) >> 3)) * 8 + ((j - 16) & 7) : -1) : (bx < 128 ? bx : -1); S.A2 = (const char*)MN; S.B2 = (const char*)Wmkv_t;
          EpiP1 E{EpiZ{Z, KPE, RSQ(ssq_cq), RSQ(ssq_ckv), cosT, sinT, ssq_x}, EpiBf16{MKV, 2048, 1.f, nullptr, 0.f}};
          pg8::gemm_phase<EpiP1, P1Order>(lds, DM, DM, DM, S, E, wave_s); }
    }
    SEAM(1); TE(1);
    TS(2); if (IN(2)) REPS(2) {
#ifndef P2SUB
#define P2SUB 31
#endif
#ifndef REP_P2SUB
#define REP_P2SUB 0
#endif
#define R2(i) for (int r2 = 0; r2 < (((REP_P2SUB) >> (i)) & 1) + 1; ++r2)
        if (P2SUB & 1) R2(0) for (int uidx = vcu; uidx < BATCH * 16; uidx += G) lru::unit(uidx >> 4, uidx & 15, Z, Y, (rep | r2) ? ssq_dummy : ssq_lru, conv_w, conv_b, lru_wa, lru_ba, lru_wx, lru_bx, lru_lambda, lds, wave_s);
#ifndef P2_MERGED
#define P2_MERGED 1
#endif
#if P2_MERGED
        { struct P2Order { pg8::TileOrder oq, okv; int nq, c, G; const bf16_t* mkv; const bf16_t* wmq; const bf16_t* wmo;
              __device__ bool next(int i, pg8::Unit& u) const {
                  if (i < nq) { oq.next(i, u); u.job = 0; u.lda = DINP; u.ldb = QLR; u.nt = QLR / 64; return true; }
                  i -= nq; if (i < 2) { okv.next(i, u); u.job = 1; u.lda = DINP; u.ldb = KVLR; u.nt = KVLR / 64; return true; }
                  i -= 2; if (i >= 2 || c >= 256) return false;
                  const int bh = c >> 2, q = c & 3, b = bh >> 2, h = bh & 3; u.wait = nullptr; u.done = nullptr; u.nt = 4;
                  if (i == 0) { u.pm = 0; u.pn = q; u.A = (const char*)(mkv + (size_t)(b * 256) * 2048 + h * 256); u.B = (const char*)(wmq + (size_t)(q * 256) * 1024 + h * 256); u.cofs = ((long)b * 1024 + h * 256) * 1024; u.job = 2; u.lda = 2048; u.ldb = 1024; }
                  else { u.pm = q; u.pn = 0; u.A = (const char*)(wmo + (size_t)(q * 256) * 1024 + h * 256); u.B = (const char*)(mkv + (size_t)(b * 256) * 2048 + 1024 + h * 256); u.cofs = (long)b * 1024 * 1024 + h * 256; u.job = 3; u.lda = 1024; u.ldb = 2048; }
                  return true; } };
          P2Order S; S.oq.init(T, 768, G, bx, Z + OFF_CQ, DINP, Wuq_t, QLR); S.okv.init(T, 1024, G, (bx + 128) % G, Z + OFF_CKV, DINP, Wukv_t, KVLR);
          S.nq = (384 - bx + G - 1) / G; S.c = vcu; S.G = G; S.mkv = MKV; S.wmq = Wmq_b; S.wmo = Wmo_t;
          EpiP2 E{EpiQ{Qb, ssq_cq, cosT, sinT}, EpiBf16{KVb, 1024, 1.f, ssq_ckv, 1.f / KVLR}, EpiBf16{WQK, 1024, MSCALE, nullptr, 0.f}, EpiBf16{WVO, 1024, 1.f, nullptr, 0.f}};
          pg8::gemm_phase_v<EpiP2, P2Order>(lds, S, E, wave_s); }
#else
        if (P2SUB & 2) R2(1) { pg8::TileOrder S; S.init(T, 768, G, bx, Z + OFF_CQ, DINP, Wuq_t, QLR); EpiQ E{Qb, ssq_cq, cosT, sinT};
          pg8::gemm_phase<EpiQ, pg8::TileOrder>(lds, DINP, QLR, QLR, S, E, wave_s); }
        if (P2SUB & 4) R2(2) { pg8::TileOrder S; S.init(T, 1024, G, (bx + 128) % G, Z + OFF_CKV, DINP, Wukv_t, KVLR); EpiBf16 E{KVb, 1024, 1.f, ssq_ckv, 1.f / KVLR};
          pg8::gemm_phase<EpiBf16, pg8::TileOrder>(lds, DINP, KVLR, KVLR, S, E, wave_s); }
        struct FormQK { int G, c; const bf16_t* mkv; const bf16_t* W;
            __device__ bool next(int i, pg8::Unit& u) const { const int L = i * G + c; if (L >= 256) return false; const int bh = L >> 2, q = L & 3, b = bh >> 2, h = bh & 3;
                u.pm = 0; u.pn = q; u.A = (const char*)(mkv + (size_t)(b * 256) * 2048 + h * 256); u.B = (const char*)(W + (size_t)(q * 256) * 1024 + h * 256); u.cofs = ((long)b * 1024 + h * 256) * 1024; u.job = 0; u.wait = nullptr; u.done = nullptr; return true; } };
        struct FormVO { int G, c; const bf16_t* mkv; const bf16_t* W;
            __device__ bool next(int i, pg8::Unit& u) const { const int L = i * G + c; if (L >= 256) return false; const int bh = L >> 2, q = L & 3, b = bh >> 2, h = bh & 3;
                u.pm = q; u.pn = 0; u.A = (const char*)(W + (size_t)(q * 256) * 1024 + h * 256); u.B = (const char*)(mkv + (size_t)(b * 256) * 2048 + 1024 + h * 256); u.cofs = (long)b * 1024 * 1024 + h * 256; u.job = 0; u.wait = nullptr; u.done = nullptr; return true; } };
        if (P2SUB & 8) R2(3) { FormQK S{G, vcu, MKV, Wmq_b}; EpiBf16 E{WQK, 1024, MSCALE, nullptr, 0.f}; pg8::gemm_phase<EpiBf16, FormQK>(lds, 2048, 1024, 256, S, E, wave_s); }
        if (P2SUB & 16) R2(3) { FormVO S{G, vcu, MKV, Wmo_t}; EpiBf16 E{WVO, 1024, 1.f, nullptr, 0.f}; pg8::gemm_phase<EpiBf16, FormVO>(lds, 1024, 2048, 256, S, E, wave_s); }
#endif
    }
    SEAM(2); TE(2);
    TS(3); if (IN(3)) REPS(3) {
        for (int it = vcu; it < BATCH * 4 * 4; it += G) { const int bh = it >> 2, xq = it & 3, b = bh >> 2, h = bh & 3;
            mla::block(b, h, xq, Qb, KVb, KPE, Y, RSQ(ssq_mla), (char*)lds_raw, wave_s);
            mla::block(b, h, 7 - xq, Qb, KVb, KPE, Y, RSQ(ssq_mla), (char*)lds_raw, wave_s); }
    }
    SEAM(3); TE(3);
#ifndef CHAIN_TAIL
#define CHAIN_TAIL 0
#endif
#if CHAIN_TAIL
    TS(5); if (IN(5)) {
        unsigned* dn = ctl + CW_DONE;
        { pg8::TileOrder S; S.init(T, DM, G, bx, Y, DM, Wout_t, DM);
          EpiNormResMid E{nullptr, XN, nullptr, g_post_mix, XN, ssq_h1, slots_p, ctl + CW_SEAM, false, ssq_lru, ssq_mla};
          pg8::gemm_phase<EpiNormResMid, pg8::TileOrder>(lds, DM, DM, DM, S, E, wave_s); }
        if (!grouped) xcd_barrier(bar, wave_s); else xcd_barrier(gbar, wave_s);
        { ChainOrder S; S.o.init(T, DM, G, bx, XN, DM, WQK, DM, (size_t)DM * DM * 2); S.wt_base = nullptr; S.dn_base = dn + SEAM_BANK;
          EpiSoftmax E{Pb, ssq_h1, true};
          pg8::gemm_phase<EpiSoftmax, ChainOrder, true, true, true>(lds, DM, DM, DM, S, E, wave_s); }
        { ChainOrder S; S.o.init(T, DM, G, bx, Pb, DM, WVO, DM, (size_t)DM * DM * 2); S.wt_base = dn + SEAM_BANK; S.dn_base = dn + 2 * SEAM_BANK;
          EpiNormRes E{nullptr, XN, nullptr, g_post_mem, XN, ssq_h2, slots_p + (size_t)4 * T, ctl + CW_SEAM + SEAM_BANK, true, nullptr, nullptr};
          pg8::gemm_phase<EpiNormRes, ChainOrder, true, true, true>(lds, DM, DM, DM, S, E, wave_s); }
        { ChainOrder S; S.o.init(T, 2 * DFF, G, bx, XN, DM, Wgu_t, DM); S.wt_base = dn + 2 * SEAM_BANK; S.dn_base = nullptr;
          EpiSwiGLU E{Fb, ssq_h2};
          pg8::gemm_phase<EpiSwiGLU, ChainOrder, true, true, true>(lds, DM, DM, DM, S, E, wave_s); } }
    if (IN(5) && IN(11)) { if (!grouped) xcd_barrier(bar, wave_s); else xcd_barrier(gbar, wave_s); } TE(5); TE(7); TE(8); TE(10);
#else
    TS(5); if (IN(5)) REPS(5) { pg8::TileOrder S; S.init(T, DM, G, bx, Y, DM, Wout_t, DM);
        EpiNormResMid E{nullptr, XN, nullptr, g_post_mix, rep ? (bf16_t*)PRE : XN, RSQ(ssq_h1), slots_p, ctl + CW_SEAM, false, ssq_lru, ssq_mla};
        pg8::gemm_phase<EpiNormResMid, pg8::TileOrder>(lds, DM, DM, DM, S, E, wave_s); }
    SEAM(5); TE(5);
    TS(7); if (IN(7)) REPS(7) { pg8::TileOrder S; S.init(T, DM, G, bx, XN, DM, WQK, DM, (size_t)DM * DM * 2); EpiSoftmax E{Pb, ssq_h1, false}; pg8::gemm_phase<EpiSoftmax, pg8::TileOrder>(lds, DM, DM, DM, S, E, wave_s); }
    SEAM(7); TE(7);
    TS(8); if (IN(8)) REPS(8) { pg8::TileOrder S; S.init(T, DM, G, bx, Pb, DM, WVO, DM, (size_t)DM * DM * 2); EpiNormRes E{nullptr, XN, nullptr, g_post_mem, rep ? (bf16_t*)PRE : XN, RSQ(ssq_h2), slots_p + (size_t)4 * T, ctl + CW_SEAM + SEAM_BANK, false, nullptr, nullptr};
        pg8::gemm_phase<EpiNormRes, pg8::TileOrder>(lds, DM, DM, DM, S, E, wave_s); }
    SEAM(8); TE(8);
#ifdef COLD10
    if (IN(10)) { for (int m = gw * 4; m < T; m += NGW * 4) rms_rows_to_bf16<4, true>(x_in + (size_t)m * DM, g_pre_mix, (bf16_t*)PRE + (size_t)m * DM, nullptr, lane);
                  for (int m = gw * 4; m < T; m += NGW * 4) rms_rows_to_bf16<4, true>(x_in + (size_t)m * DM, g_pre_mix, (bf16_t*)PRE + (size_t)(T + m) * DM, nullptr, lane); xcd_barrier(gbar, wave_s); }
#endif
    TS(10); if (IN(10)) REPS(10) { pg8::TileOrder S; S.init(T, 2 * DFF, G, bx, XN, DM, Wgu_t, DM); EpiSwiGLU E{Fb, ssq_h2}; pg8::gemm_phase<EpiSwiGLU, pg8::TileOrder, ALIGN_P10>(lds, DM, DM, DM, S, E, wave_s); }
    SEAM(10); TE(10);
#endif
    TS(11); if (IN(11)) REPS(11) { pg8::TileOrder S; S.init(T, DM, G, bx, Fb, DFF, Wdown_t, DFF); EpiNormRes E{nullptr, XN, rep ? PRE : out_p, g_post_ffn, nullptr, nullptr, slots_p + (size_t)8 * T, ctl + CW_SEAM + 2 * SEAM_BANK, false, nullptr, nullptr};
        pg8::gemm_phase<EpiNormRes, pg8::TileOrder>(lds, DFF, DFF, DFF, S, E, wave_s); }
    TE(11);
#ifdef CLKPROBE
    if ((SPIN_LO) >= 0) { const unsigned long long dt = ((tc1 - tc0) * 1000ull) / (ts1 - ts0), t2 = __builtin_amdgcn_s_memrealtime();
#else
    if ((SPIN_LO) >= 0) { const unsigned long long dt = ts1 - ts0, t2 = __builtin_amdgcn_s_memrealtime();
#endif
        while (__builtin_amdgcn_s_memrealtime() - t2 < dt) __builtin_amdgcn_s_sleep(8); }
#undef IN
#undef SEAM
}

#undef tid
#undef lane
#undef wave
#undef gw
#undef NGW
#undef x_in
#undef ssq_h1
#undef ssq_h2
#undef ssq_dummy
#undef ssq_x
#undef slots_p
#undef mem
#undef positions
#undef g_pre_mix
#undef w_in
#undef conv_w
#undef conv_b
#undef lru_wa
#undef lru_ba
#undef lru_wx
#undef lru_bx
#undef lru_lambda
#undef g_q_lat
#undef w_uq
#undef g_kv_lat
#undef w_ukv
#undef g_lru_out
#undef g_mla_out
#undef w_out
#undef g_post_mix
#undef g_pre_mem
#undef g_mem_kv
#undef w_mq
#undef w_mk
#undef w_mv
#undef w_mo
#undef g_post_mem
#undef g_pre_ffn
#undef w_gate
#undef w_up
#undef w_down
#undef g_post_ffn
#undef out_p
#undef ctl
#undef ssq_cq
#undef ssq_ckv
#undef ssq_lru
#undef ssq_mla
#undef cosT
#undef sinT
#undef Win_t
#undef Wuq_t
#undef Wukv_t
#undef Wout_t
#undef Wmq_b
#undef Wmkv_t
#undef Wmo_t
#undef Wgu_t
#undef Wdown_t
#undef MN
#undef MKV
#undef WQK
#undef WVO
#undef XN
#undef KPE
#undef Z
#undef Qb
#undef KVb
#undef Y
#undef PRE
#undef Pb
#undef Fb
#ifndef N_LAUNCHES
#define N_LAUNCHES 1
#endif
extern "C" void kernel_launch(void* const* d_in, const int* in_sizes, int n_in, void* d_out, int out_size, void* d_ws, size_t ws_size, hipStream_t stream) {
    static int grid = 0;
    if (grid == 0) {
        if (n_in != 32 || in_sizes[0] != T * DM || out_size != T * DM || ws_size < WS_END) { fprintf(stderr, "kernel_launch: unexpected shapes (n_in %d, in0 %d, out %d, ws %zu)\n", n_in, n_in > 0 ? in_sizes[0] : -1, out_size, ws_size); grid = -1; return; }
        int dev = 0, cus = 0, per_cu = 0;
        (void)hipGetDevice(&dev); (void)hipDeviceGetAttribute(&cus, hipDeviceAttributeMultiprocessorCount, dev);
        if (hipFuncSetAttribute((const void*)hymba_fwd, hipFuncAttributeMaxDynamicSharedMemorySize, LDS_BYTES) != hipSuccess) { fprintf(stderr, "kernel_launch: hipFuncSetAttribute failed\n"); grid = -1; return; }
        if (hipOccupancyMaxActiveBlocksPerMultiprocessor(&per_cu, (const void*)hymba_fwd, NWAVES * 64, LDS_BYTES) != hipSuccess || per_cu < 1) { fprintf(stderr, "kernel_launch: occupancy query says %d\n", per_cu); per_cu = 1; }
        (void)hipGetLastError();
        grid = cus > 0 ? cus : 256;
    }
    if (grid < 0) return;
    (void)hipMemsetAsync((char*)d_ws + WS_CTL, 0, CTL_ZERO_BYTES, stream);
    Args a{};
    for (int i = 0; i < 32; ++i) a.in[i] = d_in[i];
    a.out = (float*)d_out; a.ws = (unsigned char*)d_ws;
#if N_LAUNCHES == 1
    a.ph_lo = 0; a.ph_hi = NPHASE;
    void* kargs[] = {&a};
#ifdef PLAIN_LAUNCH
    (void)kargs; hipLaunchKernelGGL(hymba_fwd, dim3(grid), dim3(NWAVES * 64), LDS_BYTES, stream, a); hipError_t e = hipPeekAtLastError();
#else
    hipError_t e = hipLaunchCooperativeKernel((const void*)hymba_fwd, dim3(grid), dim3(NWAVES * 64), kargs, LDS_BYTES, stream);
#endif
    if (e != hipSuccess) fprintf(stderr, "kernel_launch: cooperative launch failed: %s (grid %d)\n", hipGetErrorString(e), grid);
#else
    for (int p = 0; p < NPHASE; ++p) { a.ph_lo = p; a.ph_hi = p + 1; hipLaunchKernelGGL(hymba_fwd, dim3(grid), dim3(NWAVES * 64), LDS_BYTES, stream, a); }
#endif
}
```

```cpp
#include <hip/hip_runtime.h>
#include <hip/hip_bf16.h>
#include <cstdio>
#include <cstdint>

#define LAS __attribute__((address_space(3)))
#define GAS __attribute__((address_space(1)))
typedef unsigned short bf16_t;
typedef short bf16x8 __attribute__((ext_vector_type(8)));
typedef short s16x4 __attribute__((ext_vector_type(4)));
typedef float f32x4 __attribute__((ext_vector_type(4)));
typedef float f32x2 __attribute__((ext_vector_type(2)));
typedef float f32x16 __attribute__((ext_vector_type(16)));
typedef unsigned u32x4 __attribute__((ext_vector_type(4)));
typedef unsigned u32x2 __attribute__((ext_vector_type(2)));

constexpr int BATCH = 16, SEQ = 2048, DM = 1024, T = BATCH * SEQ;
constexpr int NMEM = 256, TM = BATCH * NMEM;
constexpr int DLRU = 512, DINP = 1792, QLR = 384, KVLR = 256, DFF = 2816;
constexpr int OFF_GATE = 512, OFF_CQ = 1024, OFF_CKV = 1408, OFF_KPE = 1664;
constexpr float EPS = 1e-6f;
constexpr float LOG2E = 1.4426950408889634f;
constexpr float QSCALE = 0.07216878364870322f * LOG2E;
constexpr float MSCALE = 0.0625f * LOG2E;

constexpr size_t MiB = 1u << 20;
constexpr size_t WS_CTL = 0, CTL_ZERO_BYTES = 2 * MiB;
constexpr size_t WS_SSQ = 1 * MiB;
constexpr size_t WS_SLOTS = 2 * MiB;
constexpr int CW_SEAM = 65536, SEAM_BANK = 8192, CW_DONE = CW_SEAM + 3 * SEAM_BANK;
constexpr size_t WS_ROPE = 4 * MiB;
constexpr size_t WS_WIN = 12 * MiB, WS_WUQ = 16 * MiB, WS_WUKV = 17 * MiB, WS_WOUT = 18 * MiB, WS_WMQ = 20 * MiB, WS_WMKV = 22 * MiB,
                 WS_WMO = 26 * MiB, WS_WGU = 28 * MiB, WS_WDOWN = 39 * MiB;
constexpr size_t WS_MN = 46 * MiB, WS_MKV = 54 * MiB, WS_WQK = 70 * MiB, WS_WVO = 102 * MiB, WS_XN = 134 * MiB, WS_KPE = 198 * MiB;
constexpr size_t WS_Z = 202 * MiB, WS_Q = 314 * MiB, WS_KV = 362 * MiB, WS_Y = 426 * MiB;
constexpr size_t WS_PRE = 202 * MiB, WS_P = 330 * MiB, WS_F = 330 * MiB, WS_END = 506 * MiB;
constexpr int CW_BAR = 4096;

constexpr int RING_BYTES = 131072, EPI_OFF = RING_BYTES, EPI_BYTES = 16384, MISC_OFF = EPI_OFF + EPI_BYTES, LDS_BYTES = MISC_OFF + 1024;

__device__ __forceinline__ unsigned cvt_pk_bf16(float lo, float hi) { unsigned r; asm volatile("v_cvt_pk_bf16_f32 %0, %1, %2" : "=v"(r) : "v"(lo), "v"(hi)); return r; }
__device__ __forceinline__ float bf2f(unsigned short v) { return __uint_as_float((unsigned)v << 16); }
__device__ __forceinline__ float bflo(unsigned w) { return __uint_as_float(w << 16); }
__device__ __forceinline__ float bfhi(unsigned w) { return __uint_as_float(w & 0xffff0000u); }
__device__ __forceinline__ float wave_sum(float v) {
#pragma unroll
    for (int o = 1; o < 64; o <<= 1) v += __shfl_xor(v, o);
    return v;
}
__device__ __forceinline__ int lane_id() { int l; asm volatile("v_mbcnt_lo_u32_b32 %0, -1, 0\n\tv_mbcnt_hi_u32_b32 %0, -1, %0" : "=v"(l)); return l; }
#define LDS_WAIT() asm volatile("s_waitcnt lgkmcnt(0)" ::: "memory")
#define VM_WAIT() asm volatile("s_waitcnt vmcnt(0)" ::: "memory")

namespace pg8 {
constexpr int BM = 256, BK = 64, HALF = 128, HTB = HALF * BK * 2, STAGE_BYTES = 8 * HTB, NXCD = 8, WGM = 8;
__host__ __device__ __forceinline__ int lds_byte(int r, int c) { const int st = (r >> 4) * 2 + (c >> 5), rr = r & 15, cc = c & 31, ob = rr * 64 + cc * 2; return st * 1024 + (ob ^ (((ob >> 9) & 1) << 5)); }
__host__ __device__ __forceinline__ void stage_rc(int b, int& R, int& C) { const int st = b / 1024, sb = b % 1024, swz = sb ^ (((sb >> 9) & 1) << 5); R = (st >> 1) * 16 + swz / 64; C = (st & 1) * 32 + (swz % 64) / 2; }
__host__ __device__ __forceinline__ int perm32(int rho) { const int n = rho >> 4, i = rho & 15; return 8 * (i >> 2) + 4 * n + (i & 3); }

struct Unit { int pm, pn; const char* A; const char* B; long cofs; int job; unsigned* wait; unsigned* done; int lda, ldb, nt; };

struct TileOrder {
    int nM, nN, nwg, G, c; const char* A; const char* B; size_t tA, tB, bB;
    __device__ void init(int M, int N, int G_, int c_, const void* A_, int lda, const void* B_, int ldb, size_t batchB_bytes = 0) {
        nM = M / BM; nN = N / BM; nwg = nM * nN; G = G_; c = c_; A = (const char*)A_; B = (const char*)B_; tA = (size_t)BM * lda * 2; tB = (size_t)BM * ldb * 2; bB = batchB_bytes; }
    __device__ bool next(int i, Unit& u) const {
        const long L = (long)i * G + c; if (L >= nwg) return false;
        int wgid = (int)L; { const int q = nwg / NXCD, r = nwg % NXCD, xcd = wgid % NXCD, off = wgid / NXCD; wgid = (xcd < r ? xcd * (q + 1) : r * (q + 1) + (xcd - r) * q) + off; }
        const int nig = WGM * nN, gid = wgid / nig, fm = gid * WGM, gsz = (nM - fm) < WGM ? (nM - fm) : WGM;
        u.pm = fm + ((wgid % nig) % gsz); u.pn = (wgid % nig) / gsz; u.A = A + (size_t)u.pm * tA; u.B = B + (size_t)u.pn * tB + (size_t)(u.pm >> 3) * bB; u.cofs = 0; u.job = 0; u.wait = nullptr; u.done = nullptr; return true;
    }
};

__device__ __forceinline__ void chain_wait(const Unit& u) {
    if (u.wait) { unsigned sp = 0; while ((unsigned)__builtin_amdgcn_readfirstlane(__hip_atomic_load(u.wait, __ATOMIC_RELAXED, __HIP_MEMORY_SCOPE_AGENT)) < 4u) { __builtin_amdgcn_s_sleep(1); if (++sp > (1u << 22)) break; }
    }
}
__device__ __forceinline__ void chain_publish(const Unit& u, int wid) {
    if (u.done) { asm volatile("s_waitcnt vmcnt(0)\n\ts_barrier" ::: "memory");
        if (wid == 0 && lane_id() == 0) __hip_atomic_fetch_add(u.done, 1u, __ATOMIC_RELAXED, __HIP_MEMORY_SCOPE_AGENT); }
}
template <class Epi, class Sched, bool ALIGN_EPI = true, bool SP2 = true, bool CHAIN = false>
__device__ __forceinline__ void gemm_phase(LAS unsigned char* lds, const int lda, const int ldb, const int K, const Sched& S, const Epi& E, const int wv) {
    int lane = lane_id(); asm volatile("" : "+v"(lane));
    const int wid = wv, tid = wv * 64 + lane, wr = wid >> 2, wc = wid & 3, fr = lane & 15, fq = lane >> 4;
    const int nt = K / BK;
    unsigned voffA[2], voffB[2];
#pragma unroll
    for (int i = 0; i < 2; ++i) { int R, C; stage_rc(tid * 16 + i * 8192, R, C); const int Rb = Epi::PERM ? ((R & ~31) + perm32(R & 31)) : R;
        voffA[i] = (unsigned)(R * lda + C) * 2u; voffB[i] = (unsigned)(Rb * ldb + C) * 2u; }
    const size_t kstep = (size_t)(BK * 2);
    const size_t hstepA = (size_t)HALF * lda * 2, hstepB = (size_t)HALF * ldb * 2;
    const unsigned ldsw = (unsigned)wid * 1024u;
    const int aoff = lds_byte(wr * 64 + fr, fq * 8), boff = lds_byte(wc * 32 + fr, fq * 8);
#define PG8_SA(b, h) (((b) * 2 + (h)) * HTB)
#define PG8_SB(b, h) ((4 + (b) * 2 + (h)) * HTB)
#define PG8_STAGE_(bufoff, gbase, voff, AUX) do { _Pragma("unroll") for (int _i = 0; _i < 2; ++_i) \
        __builtin_amdgcn_global_load_lds((const unsigned*)((const char*)(gbase) + (voff)[_i]), (LAS unsigned*)(lds + (bufoff) + ldsw + _i * 8192), 16, 0, AUX); } while (0)
#define PG8_STAGE(bufoff, gbase, voff) PG8_STAGE_(bufoff, gbase, voff, 0)
#define PG8_STAGEA(bufoff, gbase, voff) do { if constexpr (CHAIN) PG8_STAGE_(bufoff, gbase, voff, 16); else PG8_STAGE_(bufoff, gbase, voff, 0); } while (0)
#define PG8_LDA(dst, b, h) do { _Pragma("unroll") for (int m = 0; m < 4; ++m) _Pragma("unroll") for (int k = 0; k < 2; ++k) dst[m][k] = *(const LAS bf16x8*)(lds + PG8_SA(b, h) + aoff + m * 2048 + k * 1024); } while (0)
#define PG8_LDB(dst, b, h) do { _Pragma("unroll") for (int n = 0; n < 2; ++n) _Pragma("unroll") for (int k = 0; k < 2; ++k) dst[n][k] = *(const LAS bf16x8*)(lds + PG8_SB(b, h) + boff + n * 2048 + k * 1024); } while (0)
#define PG8_MMA(ai, bj, At, Bt) do { __builtin_amdgcn_s_setprio(1); _Pragma("unroll") for (int m = 0; m < 4; ++m) _Pragma("unroll") for (int n = 0; n < 2; ++n) _Pragma("unroll") for (int k = 0; k < 2; ++k) \
        acc[ai][bj][m][n] = __builtin_amdgcn_mfma_f32_16x16x32_bf16(Bt[n][k], At[m][k], acc[ai][bj][m][n], 0, 0, 0); __builtin_amdgcn_s_setprio(0); } while (0)
#define PG8_WAIT_V(n) asm volatile("s_waitcnt vmcnt(" #n ")" ::: "memory")
#define PG8_WAIT_L(n) asm volatile("s_waitcnt lgkmcnt(" #n ")" ::: "memory")
#define PG8_BAR __builtin_amdgcn_s_barrier()
#define PG8_SCHED __builtin_amdgcn_sched_barrier(0)
    Unit cur, nxt; int ui = 0;
    if (!S.next(0, cur)) return;
    if constexpr (Epi::MIDK) { if (E.midk_on(cur)) E.prep(cur, lds, wid, 0); }
    if constexpr (CHAIN) chain_wait(cur);
    f32x4 acc[2][2][4][2];
#pragma unroll
    for (int a = 0; a < 2; ++a)
#pragma unroll
        for (int b = 0; b < 2; ++b)
#pragma unroll
            for (int m = 0; m < 4; ++m)
#pragma unroll
                for (int n = 0; n < 2; ++n) acc[a][b][m][n] = (f32x4){0.f, 0.f, 0.f, 0.f};
    bf16x8 At[4][2], B0[2][2], B1[2][2];
    const char* cA = cur.A; const char* cB = cur.B;
    static_assert(SP2, "only the SP2 loop is kept");
    PG8_STAGE(PG8_SB(0, 0), cB, voffB); PG8_STAGE(PG8_SB(0, 1), cB + hstepB, voffB); PG8_STAGEA(PG8_SA(0, 0), cA, voffA); PG8_STAGEA(PG8_SA(0, 1), cA + hstepA, voffA);
    if (wr == 1) PG8_BAR;
    PG8_WAIT_V(2); PG8_BAR;
    PG8_STAGE(PG8_SB(1, 0), cB + kstep, voffB); PG8_STAGEA(PG8_SA(1, 0), cA + kstep, voffA); PG8_STAGE(PG8_SB(1, 1), cB + hstepB + kstep, voffB);
    PG8_WAIT_V(6); PG8_BAR;
    for (;;) {
        const bool has_next = S.next(ui + 1, nxt);
        const char* nA = has_next ? nxt.A : cA; const char* nB = has_next ? nxt.B : cB;
        for (int t = 0; t < nt; t += 2) {
            if constexpr (Epi::MIDK) { if (t == Epi::TSPLIT && E.midk_on(cur)) E.midk(acc, lds, ui & 1, wr); }
            const bool last = (t == nt - 2);
            if constexpr (CHAIN) { if (last && has_next) chain_wait(nxt); }
            const char* a1 = cA + (size_t)(t + 1) * kstep;
            const char* a2 = last ? nA : cA + (size_t)(t + 2) * kstep; const char* b2 = last ? nB : cB + (size_t)(t + 2) * kstep;
            const char* a3 = a2 + kstep; const char* b3 = b2 + kstep;
            PG8_LDB(B0, 0, 0); PG8_LDB(B1, 0, 1); PG8_SCHED; PG8_LDA(At, 0, 0); PG8_STAGEA(PG8_SA(1, 1), a1 + hstepA, voffA);
            PG8_WAIT_V(8); PG8_WAIT_L(0); PG8_BAR; PG8_MMA(0, 0, At, B0); PG8_MMA(0, 1, At, B1); PG8_BAR; PG8_SCHED;
            PG8_LDA(At, 0, 1); PG8_STAGE(PG8_SB(0, 0), b2, voffB); PG8_STAGE(PG8_SB(0, 1), b2 + hstepB, voffB); PG8_STAGEA(PG8_SA(0, 0), a2, voffA);
            PG8_WAIT_V(8); PG8_WAIT_L(0); PG8_BAR; PG8_MMA(1, 0, At, B0); PG8_MMA(1, 1, At, B1); PG8_BAR; PG8_SCHED;
            PG8_LDB(B0, 1, 0); PG8_LDB(B1, 1, 1); PG8_SCHED; PG8_LDA(At, 1, 0); PG8_STAGEA(PG8_SA(0, 1), a2 + hstepA, voffA);
            PG8_WAIT_V(8); PG8_WAIT_L(0); PG8_BAR; PG8_MMA(0, 0, At, B0); PG8_MMA(0, 1, At, B1); PG8_BAR; PG8_SCHED;
            PG8_LDA(At, 1, 1); PG8_STAGE(PG8_SB(1, 0), b3, voffB); PG8_STAGE(PG8_SB(1, 1), b3 + hstepB, voffB); PG8_STAGEA(PG8_SA(1, 0), a3, voffA);
            PG8_WAIT_V(8); PG8_WAIT_L(0); PG8_BAR; PG8_MMA(1, 0, At, B0); PG8_MMA(1, 1, At, B1); PG8_BAR; PG8_SCHED;
        }
        if constexpr (ALIGN_EPI) { if (wr == 0) PG8_BAR; }
        E(acc, cur, wr, wc, fr, fq, lds, wid, ui & 1);
        if constexpr (CHAIN) chain_publish(cur, wid);
        if (!has_next) break;
        if constexpr (Epi::MIDK) { if (E.midk_on(nxt)) E.prep(nxt, lds, wid, (ui + 1) & 1); }
#pragma unroll
        for (int a = 0; a < 2; ++a)
#pragma unroll
            for (int b = 0; b < 2; ++b)
#pragma unroll
                for (int m = 0; m < 4; ++m)
#pragma unroll
                    for (int n = 0; n < 2; ++n) acc[a][b][m][n] = (f32x4){0.f, 0.f, 0.f, 0.f};
        cur = nxt; cA = nA; cB = nB; ++ui;
        if constexpr (ALIGN_EPI) { if (wr == 1) PG8_BAR; }
    }
    PG8_WAIT_V(0);
    if constexpr (!ALIGN_EPI) { if (wr == 0) PG8_BAR; }
    PG8_BAR;
#undef PG8_SA
#undef PG8_SB
#undef PG8_STAGE
#undef PG8_STAGE_
#undef PG8_STAGEA
#undef PG8_LDA
#undef PG8_LDB
#undef PG8_MMA
#undef PG8_WAIT_V
#undef PG8_WAIT_L
#undef PG8_BAR
#undef PG8_SCHED
}
template <class Epi, class Sched>
__device__ __forceinline__ void gemm_phase_v(LAS unsigned char* lds, const Sched& S, const Epi& E, const int wv) {
    constexpr bool ALIGN_EPI = true, SP2 = true, CHAIN = false;
    int lane = lane_id(); asm volatile("" : "+v"(lane));
    const int wid = wv, tid = wv * 64 + lane, wr = wid >> 2, wc = wid & 3, fr = lane & 15, fq = lane >> 4;
    unsigned RA2[2], RB2[2], C2[2];
#pragma unroll
    for (int i = 0; i < 2; ++i) { int R, C; stage_rc(tid * 16 + i * 8192, R, C); const int Rb = Epi::PERM ? ((R & ~31) + perm32(R & 31)) : R;
        RA2[i] = (unsigned)R * 2u; RB2[i] = (unsigned)Rb * 2u; C2[i] = (unsigned)C * 2u; }
    const size_t kstep = (size_t)(BK * 2);
    const unsigned ldsw = (unsigned)wid * 1024u;
    const int aoff = lds_byte(wr * 64 + fr, fq * 8), boff = lds_byte(wc * 32 + fr, fq * 8);
#define PG8_SA(b, h) (((b) * 2 + (h)) * HTB)
#define PG8_SB(b, h) ((4 + (b) * 2 + (h)) * HTB)
#define PG8_STAGE_(bufoff, gbase, voff, AUX) do { _Pragma("unroll") for (int _i = 0; _i < 2; ++_i) \
        __builtin_amdgcn_global_load_lds((const unsigned*)((const char*)(gbase) + (voff)[_i]), (LAS unsigned*)(lds + (bufoff) + ldsw + _i * 8192), 16, 0, AUX); } while (0)
#define PG8_STAGEV(bufoff, gbase, R2, ld) do { _Pragma("unroll") for (int _i = 0; _i < 2; ++_i) \
        __builtin_amdgcn_global_load_lds((const unsigned*)((const char*)(gbase) + ((R2)[_i] * (unsigned)(ld) + C2[_i])), (LAS unsigned*)(lds + (bufoff) + ldsw + _i * 8192), 16, 0, 0); } while (0)
#define PG8_LDA(dst, b, h) do { _Pragma("unroll") for (int m = 0; m < 4; ++m) _Pragma("unroll") for (int k = 0; k < 2; ++k) dst[m][k] = *(const LAS bf16x8*)(lds + PG8_SA(b, h) + aoff + m * 2048 + k * 1024); } while (0)
#define PG8_LDB(dst, b, h) do { _Pragma("unroll") for (int n = 0; n < 2; ++n) _Pragma("unroll") for (int k = 0; k < 2; ++k) dst[n][k] = *(const LAS bf16x8*)(lds + PG8_SB(b, h) + boff + n * 2048 + k * 1024); } while (0)
#define PG8_MMA(ai, bj, At, Bt) do { __builtin_amdgcn_s_setprio(1); _Pragma("unroll") for (int m = 0; m < 4; ++m) _Pragma("unroll") for (int n = 0; n < 2; ++n) _Pragma("unroll") for (int k = 0; k < 2; ++k) \
        acc[ai][bj][m][n] = __builtin_amdgcn_mfma_f32_16x16x32_bf16(Bt[n][k], At[m][k], acc[ai][bj][m][n], 0, 0, 0); __builtin_amdgcn_s_setprio(0); } while (0)
#define PG8_WAIT_V(n) asm volatile("s_waitcnt vmcnt(" #n ")" ::: "memory")
#define PG8_WAIT_L(n) asm volatile("s_waitcnt lgkmcnt(" #n ")" ::: "memory")
#define PG8_BAR __builtin_amdgcn_s_barrier()
#define PG8_SCHED __builtin_amdgcn_sched_barrier(0)
    Unit cur, nxt; int ui = 0;
    if (!S.next(0, cur)) return;
    if constexpr (Epi::MIDK) { if (E.midk_on(cur)) E.prep(cur, lds, wid, 0); }
    if constexpr (CHAIN) chain_wait(cur);
    f32x4 acc[2][2][4][2];
#pragma unroll
    for (int a = 0; a < 2; ++a)
#pragma unroll
        for (int b = 0; b < 2; ++b)
#pragma unroll
            for (int m = 0; m < 4; ++m)
#pragma unroll
                for (int n = 0; n < 2; ++n) acc[a][b][m][n] = (f32x4){0.f, 0.f, 0.f, 0.f};
    bf16x8 At[4][2], B0[2][2], B1[2][2];
    const char* cA = cur.A; const char* cB = cur.B; int clda = cur.lda, cldb = cur.ldb, nt = cur.nt;
    size_t hstepA = (size_t)HALF * clda * 2, hstepB = (size_t)HALF * cldb * 2;
    static_assert(SP2, "only the SP2 loop is kept");
    PG8_STAGEV(PG8_SB(0, 0), cB, RB2, cldb); PG8_STAGEV(PG8_SB(0, 1), cB + hstepB, RB2, cldb); PG8_STAGEV(PG8_SA(0, 0), cA, RA2, clda); PG8_STAGEV(PG8_SA(0, 1), cA + hstepA, RA2, clda);
    if (wr == 1) PG8_BAR;
    PG8_WAIT_V(2); PG8_BAR;
    PG8_STAGEV(PG8_SB(1, 0), cB + kstep, RB2, cldb); PG8_STAGEV(PG8_SA(1, 0), cA + kstep, RA2, clda); PG8_STAGEV(PG8_SB(1, 1), cB + hstepB + kstep, RB2, cldb);
    PG8_WAIT_V(6); PG8_BAR;
    for (;;) {
        const bool has_next = S.next(ui + 1, nxt);
        const char* nA = has_next ? nxt.A : cA; const char* nB = has_next ? nxt.B : cB; const int nlda = has_next ? nxt.lda : clda, nldb = has_next ? nxt.ldb : cldb;
        const size_t nhA = (size_t)HALF * nlda * 2, nhB = (size_t)HALF * nldb * 2;
        for (int t = 0; t < nt; t += 2) {
            if constexpr (Epi::MIDK) { if (t == Epi::TSPLIT && E.midk_on(cur)) E.midk(acc, lds, ui & 1, wr); }
            const bool last = (t == nt - 2);
            if constexpr (CHAIN) { if (last && has_next) chain_wait(nxt); }
            const char* a1 = cA + (size_t)(t + 1) * kstep;
            const char* a2 = last ? nA : cA + (size_t)(t + 2) * kstep; const char* b2 = last ? nB : cB + (size_t)(t + 2) * kstep;
            const char* a3 = a2 + kstep; const char* b3 = b2 + kstep;
            const int l2a = last ? nlda : clda, l2b = last ? nldb : cldb; const size_t h2A = last ? nhA : hstepA, h2B = last ? nhB : hstepB;
            PG8_LDB(B0, 0, 0); PG8_LDB(B1, 0, 1); PG8_SCHED; PG8_LDA(At, 0, 0); PG8_STAGEV(PG8_SA(1, 1), a1 + hstepA, RA2, clda);
            PG8_WAIT_V(8); PG8_WAIT_L(0); PG8_BAR; PG8_MMA(0, 0, At, B0); PG8_MMA(0, 1, At, B1); PG8_BAR; PG8_SCHED;
            PG8_LDA(At, 0, 1); PG8_STAGEV(PG8_SB(0, 0), b2, RB2, l2b); PG8_STAGEV(PG8_SB(0, 1), b2 + h2B, RB2, l2b); PG8_STAGEV(PG8_SA(0, 0), a2, RA2, l2a);
            PG8_WAIT_V(8); PG8_WAIT_L(0); PG8_BAR; PG8_MMA(1, 0, At, B0); PG8_MMA(1, 1, At, B1); PG8_BAR; PG8_SCHED;
            PG8_LDB(B0, 1, 0); PG8_LDB(B1, 1, 1); PG8_SCHED; PG8_LDA(At, 1, 0); PG8_STAGEV(PG8_SA(0, 1), a2 + h2A, RA2, l2a);
            PG8_WAIT_V(8); PG8_WAIT_L(0); PG8_BAR; PG8_MMA(0, 0, At, B0); PG8_MMA(0, 1, At, B1); PG8_BAR; PG8_SCHED;
            PG8_LDA(At, 1, 1); PG8_STAGEV(PG8_SB(1, 0), b3, RB2, l2b); PG8_STAGEV(PG8_SB(1, 1), b3 + h2B, RB2, l2b); PG8_STAGEV(PG8_SA(1, 0), a3, RA2, l2a);
            PG8_WAIT_V(8); PG8_WAIT_L(0); PG8_BAR; PG8_MMA(1, 0, At, B0); PG8_MMA(1, 1, At, B1); PG8_BAR; PG8_SCHED;
        }
        if constexpr (ALIGN_EPI) { if (wr == 0) PG8_BAR; }
        E(acc, cur, wr, wc, fr, fq, lds, wid, ui & 1);
        if constexpr (CHAIN) chain_publish(cur, wid);
        if (!has_next) break;
        if constexpr (Epi::MIDK) { if (E.midk_on(nxt)) E.prep(nxt, lds, wid, (ui + 1) & 1); }
#pragma unroll
        for (int a = 0; a < 2; ++a)
#pragma unroll
            for (int b = 0; b < 2; ++b)
#pragma unroll
                for (int m = 0; m < 4; ++m)
#pragma unroll
                    for (int n = 0; n < 2; ++n) acc[a][b][m][n] = (f32x4){0.f, 0.f, 0.f, 0.f};
        cur = nxt; cA = nA; cB = nB; ++ui; clda = nlda; cldb = nldb; hstepA = nhA; hstepB = nhB; nt = cur.nt;
        if constexpr (ALIGN_EPI) { if (wr == 1) PG8_BAR; }
    }
    PG8_WAIT_V(0);
    if constexpr (!ALIGN_EPI) { if (wr == 0) PG8_BAR; }
    PG8_BAR;
#undef PG8_SA
#undef PG8_SB
#undef PG8_STAGE_
#undef PG8_STAGEV
#undef PG8_LDA
#undef PG8_LDB
#undef PG8_MMA
#undef PG8_WAIT_V
#undef PG8_WAIT_L
#undef PG8_BAR
#undef PG8_SCHED
}
}

typedef f32x4 Acc[2][2][4][2];
__device__ __forceinline__ void store16(void* p, u32x4 v, bool wt) {
    if (wt) asm volatile("global_store_dwordx4 %0, %1, off sc1\n\ts_nop 1" :: "v"(p), "v"(v) : "memory"); else *(u32x4*)p = v;
}
__device__ __forceinline__ void ssq_rows_atomic(const Acc& acc, float* ssq, int row_base  , int bjmask, int fq, int lane) {
#pragma unroll
    for (int ai = 0; ai < 2; ++ai) {
        float s[4];
#pragma unroll
        for (int m = 0; m < 4; ++m) { float q = 0.f;
#pragma unroll
            for (int bj = 0; bj < 2; ++bj) if (bjmask & (1 << bj))
#pragma unroll
                for (int n = 0; n < 2; ++n) { const f32x4 x = acc[ai][bj][m][n]; q += (x[0] * x[0] + x[1] * x[1]) + (x[2] * x[2] + x[3] * x[3]); }
            q += __shfl_xor(q, 16); q += __shfl_xor(q, 32); s[m] = q; }
        const float v = fq == 0 ? s[0] : fq == 1 ? s[1] : fq == 2 ? s[2] : s[3];
        atomicAdd(ssq + row_base + ai * 128 + lane, v);
    }
}
struct EpiBf16 {
    static constexpr bool PERM = true, MIDK = false;
    bf16_t* O; int ldc; float scale; const float* ssq; float rdim_inv;
    __device__ __forceinline__ void operator()(const Acc& acc, const pg8::Unit& u, int wr, int wc, int fr, int fq, LAS unsigned char*, int, int) const {
        { const int ln_ = lane_id(); fr = ln_ & 15; fq = ln_ >> 4; }
        const int row0 = u.pm * 256 + wr * 64 + fr, col0 = u.pn * 256 + wc * 32 + 8 * fq;
#pragma unroll
        for (int ai = 0; ai < 2; ++ai)
#pragma unroll
            for (int m = 0; m < 4; ++m) { const int row = row0 + ai * 128 + m * 16; float sc = scale;
                if (ssq) sc *= __builtin_amdgcn_rsqf(ssq[row] * rdim_inv + EPS);
                bf16_t* rowp = O + u.cofs + (size_t)row * ldc + col0;
#pragma unroll
                for (int bj = 0; bj < 2; ++bj) { const f32x4 v0 = acc[ai][bj][m][0] * sc, v1 = acc[ai][bj][m][1] * sc;
                    u32x4 w; w.x = cvt_pk_bf16(v0[0], v0[1]); w.y = cvt_pk_bf16(v0[2], v0[3]); w.z = cvt_pk_bf16(v1[0], v1[1]); w.w = cvt_pk_bf16(v1[2], v1[3]);
                    *(u32x4*)(rowp + bj * 128) = w; } }
    }
};
__device__ __forceinline__ void rope8(f32x4& v0, f32x4& v1, const float* cosT, const float* sinT, int row, int i0) {
    const f32x4 c = *(const f32x4*)(cosT + (size_t)row * 32 + i0), s = *(const f32x4*)(sinT + (size_t)row * 32 + i0);
    const f32x4 a = v0, b = v1;
    v0[0] = a[0] * c[0] - a[1] * s[0]; v0[1] = a[1] * c[0] + a[0] * s[0]; v0[2] = a[2] * c[1] - a[3] * s[1]; v0[3] = a[3] * c[1] + a[2] * s[1];
    v1[0] = b[0] * c[2] - b[1] * s[2]; v1[1] = b[1] * c[2] + b[0] * s[2]; v1[2] = b[2] * c[3] - b[3] * s[3]; v1[3] = b[3] * c[3] + b[2] * s[3];
}
struct EpiZ {
    static constexpr bool PERM = true, MIDK = false;
    bf16_t* Z; bf16_t* KPE; float* ssq_cq; float* ssq_ckv; const float* cosT; const float* sinT; const float* ssq_x;
    __device__ __forceinline__ void operator()(Acc& acc, const pg8::Unit& u, int wr, int wc, int fr, int fq, LAS unsigned char*, int, int lane) const {
        { const int ln_ = lane_id(); fr = ln_ & 15; fq = ln_ >> 4; }
        const int row0 = u.pm * 256 + wr * 64 + fr, col0 = u.pn * 256 + wc * 32 + 8 * fq;
        const bool kpe_tile = (u.pn == 6);
#pragma unroll
        for (int ai = 0; ai < 2; ++ai)
#pragma unroll
            for (int m = 0; m < 4; ++m) { const float rsx = __builtin_amdgcn_rsqf(ssq_x[row0 + ai * 128 + m * 16] * (1.f / DM) + EPS);
#pragma unroll
                for (int bj = 0; bj < 2; ++bj)
#pragma unroll
                    for (int n = 0; n < 2; ++n) acc[ai][bj][m][n] = acc[ai][bj][m][n] * rsx; }
#pragma unroll
        for (int ai = 0; ai < 2; ++ai)
#pragma unroll
            for (int m = 0; m < 4; ++m) { const int row = row0 + ai * 128 + m * 16; bf16_t* rowp = Z + (size_t)row * DINP + col0;
#pragma unroll
                for (int bj = 0; bj < 2; ++bj) { f32x4 v0 = acc[ai][bj][m][0], v1 = acc[ai][bj][m][1];
                    if (kpe_tile && bj == 1) {
                        if (wc < 2) { rope8(v0, v1, cosT, sinT, row, 16 * (wc & 1) + 4 * fq);
                            u32x4 w; w.x = cvt_pk_bf16(v0[0], v0[1]); w.y = cvt_pk_bf16(v0[2], v0[3]); w.z = cvt_pk_bf16(v1[0], v1[1]); w.w = cvt_pk_bf16(v1[2], v1[3]);
                            *(u32x4*)(KPE + (size_t)row * 64 + wc * 32 + 8 * fq) = w; }
                    } else {
                        u32x4 w; w.x = cvt_pk_bf16(v0[0], v0[1]); w.y = cvt_pk_bf16(v0[2], v0[3]); w.z = cvt_pk_bf16(v1[0], v1[1]); w.w = cvt_pk_bf16(v1[2], v1[3]);
                        *(u32x4*)(rowp + bj * 128) = w; } } }
        const int rb = u.pm * 256 + wr * 64; lane = fq * 16 + fr;
        if (u.pn == 4) ssq_rows_atomic(acc, ssq_cq, rb, 3, fq, lane);
        else if (u.pn == 5) { ssq_rows_atomic(acc, ssq_cq, rb, 1, fq, lane); ssq_rows_atomic(acc, ssq_ckv, rb, 2, fq, lane); }
        else if (u.pn == 6) ssq_rows_atomic(acc, ssq_ckv, rb, 1, fq, lane);
    }
};
struct EpiQ {
    static constexpr bool PERM = true, MIDK = false;
    bf16_t* Q; const float* ssq; const float* cosT; const float* sinT;
    __device__ __forceinline__ void operator()(const Acc& acc, const pg8::Unit& u, int wr, int wc, int fr, int fq, LAS unsigned char*, int, int) const {
        { const int ln_ = lane_id(); fr = ln_ & 15; fq = ln_ >> 4; }
        const int row0 = u.pm * 256 + wr * 64 + fr, col0 = u.pn * 256 + wc * 32 + 8 * fq;
        const bool pe = (u.pn == 2);
#pragma unroll
        for (int ai = 0; ai < 2; ++ai)
#pragma unroll
            for (int m = 0; m < 4; ++m) { const int row = row0 + ai * 128 + m * 16;
                const float sc = QSCALE * __builtin_amdgcn_rsqf(ssq[row] * (1.f / QLR) + EPS);
                bf16_t* rowp = Q + (size_t)row * 768 + col0;
#pragma unroll
                for (int bj = 0; bj < 2; ++bj) { f32x4 v0 = acc[ai][bj][m][0] * sc, v1 = acc[ai][bj][m][1] * sc;
                    if (pe) rope8(v0, v1, cosT, sinT, row, 16 * (wc & 1) + 4 * fq);
                    u32x4 w; w.x = cvt_pk_bf16(v0[0], v0[1]); w.y = cvt_pk_bf16(v0[2], v0[3]); w.z = cvt_pk_bf16(v1[0], v1[1]); w.w = cvt_pk_bf16(v1[2], v1[3]);
                    *(u32x4*)(rowp + bj * 128) = w; } }
    }
};
struct EpiF32 {
    static constexpr bool PERM = false, MIDK = false;
    float* O; int ldc;
    __device__ __forceinline__ void operator()(const Acc& acc, const pg8::Unit& u, int wr, int wc, int fr, int fq, LAS unsigned char*, int, int) const {
        { const int ln_ = lane_id(); fr = ln_ & 15; fq = ln_ >> 4; }
        const int row0 = u.pm * 256 + wr * 64 + fr, col0 = u.pn * 256 + wc * 32 + 4 * fq;
#pragma unroll
        for (int ai = 0; ai < 2; ++ai)
#pragma unroll
            for (int m = 0; m < 4; ++m) { float* rowp = O + (size_t)(row0 + ai * 128 + m * 16) * ldc + col0;
#pragma unroll
                for (int bj = 0; bj < 2; ++bj)
#pragma unroll
                    for (int n = 0; n < 2; ++n) *(f32x4*)(rowp + bj * 128 + n * 16) = acc[ai][bj][m][n]; }
    }
};
struct EpiSwiGLU {
    static constexpr bool PERM = true, MIDK = false;
    bf16_t* F; const float* ssq;
    __device__ __forceinline__ void operator()(const Acc& acc, const pg8::Unit& u, int wr, int wc, int fr, int fq, LAS unsigned char*, int, int) const {
        { const int ln_ = lane_id(); fr = ln_ & 15; fq = ln_ >> 4; }
        const int row0 = u.pm * 256 + wr * 64 + fr, col0 = u.pn * 128 + wc * 32 + 8 * fq;
        float sq[2][4];
#pragma unroll
        for (int ai = 0; ai < 2; ++ai)
#pragma unroll
            for (int m = 0; m < 4; ++m) sq[ai][m] = ssq[row0 + ai * 128 + m * 16];
#pragma unroll
        for (int ai = 0; ai < 2; ++ai)
#pragma unroll
            for (int m = 0; m < 4; ++m) { bf16_t* rowp = F + (size_t)(row0 + ai * 128 + m * 16) * DFF + col0; float f[8];
                const float rsc = __builtin_amdgcn_rsqf(sq[ai][m] * (1.f / DM) + EPS);
#pragma unroll
                for (int n = 0; n < 2; ++n)
#pragma unroll
                    for (int e = 0; e < 4; ++e) { const float g = acc[ai][0][m][n][e] * rsc, up = acc[ai][1][m][n][e] * rsc;
                        f[n * 4 + e] = g * __builtin_amdgcn_rcpf(1.f + __builtin_amdgcn_exp2f(-g * LOG2E)) * up; }
                u32x4 w; w.x = cvt_pk_bf16(f[0], f[1]); w.y = cvt_pk_bf16(f[2], f[3]); w.z = cvt_pk_bf16(f[4], f[5]); w.w = cvt_pk_bf16(f[6], f[7]);
                *(u32x4*)rowp = w; }
    }
};
struct EpiSoftmax {
    static constexpr bool PERM = true, MIDK = false;
    bf16_t* P; const float* ssq; bool wt;
    __device__ __forceinline__ void operator()(Acc& acc, const pg8::Unit& u, int wr, int wc, int fr, int fq, LAS unsigned char* lds, int, int) const {
        { const int ln_ = lane_id(); fr = ln_ & 15; fq = ln_ >> 4; }
        LAS float* PM = (LAS float*)(lds + EPI_OFF);
        LAS float* PS = (LAS float*)(lds + EPI_OFF + 4096);
        float sq[2][4];
#pragma unroll
        for (int ai = 0; ai < 2; ++ai)
#pragma unroll
            for (int m = 0; m < 4; ++m) sq[ai][m] = ssq[u.pm * 256 + ai * 128 + wr * 64 + m * 16 + fr];
        float mxr[2][4];
#pragma unroll
        for (int ai = 0; ai < 2; ++ai)
#pragma unroll
            for (int m = 0; m < 4; ++m) { float q = -3.0e38f;
#pragma unroll
                for (int bj = 0; bj < 2; ++bj)
#pragma unroll
                    for (int n = 0; n < 2; ++n) { const f32x4 x = acc[ai][bj][m][n]; q = fmaxf(q, fmaxf(fmaxf(x[0], x[1]), fmaxf(x[2], x[3]))); }
                q = fmaxf(q, __shfl_xor(q, 16)); q = fmaxf(q, __shfl_xor(q, 32)); mxr[ai][m] = q; }
#pragma unroll
        for (int ai = 0; ai < 2; ++ai)
#pragma unroll
            for (int m = 0; m < 4; ++m) { sq[ai][m] = __builtin_amdgcn_rsqf(sq[ai][m] * (1.f / DM) + EPS);
                if (fq == 0) PM[(ai * 128 + wr * 64 + m * 16 + fr) * 4 + wc] = mxr[ai][m] * sq[ai][m]; }
        LDS_WAIT(); __builtin_amdgcn_s_barrier(); asm volatile("" ::: "memory");
#pragma unroll
        for (int ai = 0; ai < 2; ++ai)
#pragma unroll
            for (int m = 0; m < 4; ++m) { const f32x4 t = *(const LAS f32x4*)(PM + (ai * 128 + wr * 64 + m * 16 + fr) * 4);
                const float rm = fmaxf(fmaxf(t[0], t[1]), fmaxf(t[2], t[3])), rsc = sq[ai][m]; float s = 0.f;
#pragma unroll
                for (int bj = 0; bj < 2; ++bj)
#pragma unroll
                    for (int n = 0; n < 2; ++n) { f32x4 x = acc[ai][bj][m][n];
#pragma unroll
                        for (int e = 0; e < 4; ++e) { x[e] = __builtin_amdgcn_exp2f(fmaf(x[e], rsc, -rm)); s += x[e]; }
                        acc[ai][bj][m][n] = x; }
                s += __shfl_xor(s, 16); s += __shfl_xor(s, 32);
                if (fq == 0) PS[(ai * 128 + wr * 64 + m * 16 + fr) * 4 + wc] = s; }
        LDS_WAIT(); __builtin_amdgcn_s_barrier(); asm volatile("" ::: "memory");
        const int row0 = u.pm * 256 + wr * 64 + fr, col0 = u.pn * 256 + wc * 32 + 8 * fq;
#pragma unroll
        for (int ai = 0; ai < 2; ++ai)
#pragma unroll
            for (int m = 0; m < 4; ++m) { const f32x4 t = *(const LAS f32x4*)(PS + (ai * 128 + wr * 64 + m * 16 + fr) * 4);
                const float inv = __builtin_amdgcn_rcpf((t[0] + t[1]) + (t[2] + t[3]));
                bf16_t* rowp = P + (size_t)(row0 + ai * 128 + m * 16) * DM + col0;
#pragma unroll
                for (int bj = 0; bj < 2; ++bj) { const f32x4 v0 = acc[ai][bj][m][0] * inv, v1 = acc[ai][bj][m][1] * inv;
                    u32x4 w; w.x = cvt_pk_bf16(v0[0], v0[1]); w.y = cvt_pk_bf16(v0[2], v0[3]); w.z = cvt_pk_bf16(v1[0], v1[1]); w.w = cvt_pk_bf16(v1[2], v1[3]);
                    store16(rowp + bj * 128, w, wt); } }
    }
};

__device__ __forceinline__ unsigned ag_ld(const unsigned* p) { return __hip_atomic_load(p, __ATOMIC_RELAXED, __HIP_MEMORY_SCOPE_AGENT); }
template <bool MIDK_>
struct EpiNormResT {
    static constexpr bool PERM = true, MIDK = MIDK_; static constexpr int TSPLIT = 8;
    const float* hold_f; const bf16_t* hold_b; float* hout; const float* gpost; bf16_t* xn; float* ssq_next; float* slots; unsigned* cnt;
    bool wt;
    __device__ __forceinline__ bool midk_on(const pg8::Unit&) const { return MIDK_; }
    const float* ssq_a; const float* ssq_b;
    __device__ __forceinline__ void prep(const pg8::Unit& u, LAS unsigned char* lds, int wid, int par) const {
        if (wid < 4) { const int ln = lane_id(), row = wid * 64 + ln; const float sa = ssq_a[u.pm * 256 + row], sb = ssq_b[u.pm * 256 + row];
            const float ra = __builtin_amdgcn_rsqf(sa * (1.f / 512) + EPS), rb = __builtin_amdgcn_rsqf(sb * (1.f / 512) + EPS);
            ((LAS f32x2*)(lds + EPI_OFF + 5120))[par * 256 + row] = (f32x2){ra * __builtin_amdgcn_rcpf(rb), rb}; }
    }
    __device__ __forceinline__ void midk(Acc& acc, LAS unsigned char* lds, int par, int wr) const {
        const int ln = lane_id(), fr = ln & 15; const LAS f32x2* RT = (const LAS f32x2*)(lds + EPI_OFF + 5120) + par * 256;
#pragma unroll
        for (int ai = 0; ai < 2; ++ai)
#pragma unroll
            for (int m = 0; m < 4; ++m) { const float r = RT[ai * 128 + wr * 64 + m * 16 + fr].x;
#pragma unroll
                for (int bj = 0; bj < 2; ++bj)
#pragma unroll
                    for (int n = 0; n < 2; ++n) acc[ai][bj][m][n] = acc[ai][bj][m][n] * r; }
    }
    __device__ __forceinline__ void operator()(Acc& acc, const pg8::Unit& u, int wr, int wc, int fr, int fq, LAS unsigned char* lds, int wid, int par) const {
        const int ln = lane_id(); fr = ln & 15; fq = ln >> 4;
        if constexpr (MIDK_) { const LAS f32x2* RT = (const LAS f32x2*)(lds + EPI_OFF + 5120) + par * 256;
#pragma unroll
            for (int ai = 0; ai < 2; ++ai)
#pragma unroll
                for (int m = 0; m < 4; ++m) { const float r = RT[ai * 128 + wr * 64 + m * 16 + fr].y;
#pragma unroll
                    for (int bj = 0; bj < 2; ++bj)
#pragma unroll
                        for (int n = 0; n < 2; ++n) acc[ai][bj][m][n] = acc[ai][bj][m][n] * r; } }
        LAS float* PT = (LAS float*)(lds + EPI_OFF);
        LAS float* SR = (LAS float*)(lds + EPI_OFF + 4096);
        const int col0 = u.pn * 256 + wc * 32 + 8 * fq;
        f32x4 gv[2][2];
#pragma unroll
        for (int bj = 0; bj < 2; ++bj)
#pragma unroll
            for (int n = 0; n < 2; ++n) gv[bj][n] = *(const f32x4*)(gpost + col0 + bj * 128 + n * 4);
        u32x4 hb[2][4][2];
        if (!hold_f) {
#pragma unroll
            for (int ai = 0; ai < 2; ++ai)
#pragma unroll
                for (int m = 0; m < 4; ++m)
#pragma unroll
                    for (int bj = 0; bj < 2; ++bj) hb[ai][m][bj] = *(const u32x4*)(hold_b + (size_t)(u.pm * 256 + ai * 128 + wr * 64 + m * 16 + fr) * DM + col0 + bj * 128); }
#pragma unroll
        for (int ai = 0; ai < 2; ++ai)
#pragma unroll
            for (int m = 0; m < 4; ++m) { float q = 0.f;
#pragma unroll
                for (int bj = 0; bj < 2; ++bj)
#pragma unroll
                    for (int n = 0; n < 2; ++n) { const f32x4 x = acc[ai][bj][m][n]; q += (x[0] * x[0] + x[1] * x[1]) + (x[2] * x[2] + x[3] * x[3]); }
                q += __shfl_xor(q, 16); q += __shfl_xor(q, 32);
                if (fq == 0) PT[(ai * 128 + wr * 64 + m * 16 + fr) * 4 + wc] = q; }
        LDS_WAIT(); __builtin_amdgcn_s_barrier(); asm volatile("" ::: "memory");
        unsigned* c = cnt + 64 * u.pm;
        if (wid < 4) { const int row = wid * 64 + ln; const f32x4 t = *(const LAS f32x4*)(PT + row * 4); const float sq = (t[0] + t[1]) + (t[2] + t[3]);
            __hip_atomic_store((unsigned*)slots + ((size_t)(u.pm * 256 + row) * 4 + u.pn), __float_as_uint(sq), __ATOMIC_RELAXED, __HIP_MEMORY_SCOPE_AGENT);
            asm volatile("s_waitcnt vmcnt(0)" ::: "memory");
            if (ln == 0) __hip_atomic_fetch_add(c, 1u, __ATOMIC_RELAXED, __HIP_MEMORY_SCOPE_AGENT); }
        if (wid == 0) { unsigned sp = 0;
            while ((unsigned)__builtin_amdgcn_readfirstlane(ag_ld(c)) < 16u) { __builtin_amdgcn_s_sleep(2); if (++sp > (1u << 21)) break; }
            __builtin_amdgcn_fence(__ATOMIC_ACQUIRE, "agent"); }
        asm volatile("s_waitcnt vmcnt(0) lgkmcnt(0)" ::: "memory"); __builtin_amdgcn_s_barrier(); asm volatile("" ::: "memory");
        if (wid < 4) { const int row = wid * 64 + ln; const unsigned* sl = (const unsigned*)slots + (size_t)(u.pm * 256 + row) * 4;
            const float tot = (__uint_as_float(ag_ld(sl)) + __uint_as_float(ag_ld(sl + 1))) + (__uint_as_float(ag_ld(sl + 2)) + __uint_as_float(ag_ld(sl + 3)));
            SR[row] = __builtin_amdgcn_rsqf(tot * (1.f / DM) + EPS); }
        LDS_WAIT(); __builtin_amdgcn_s_barrier(); asm volatile("" ::: "memory");
#pragma unroll
        for (int ai = 0; ai < 2; ++ai) { float s[4];
#pragma unroll
            for (int m = 0; m < 4; ++m) { const int rl = ai * 128 + wr * 64 + m * 16 + fr; const float rs = SR[rl]; const size_t off = (size_t)(u.pm * 256 + rl) * DM + col0; float q = 0.f;
#pragma unroll
                for (int bj = 0; bj < 2; ++bj) { f32x4 h0, h1;
                    if (hold_f) { h0 = *(const f32x4*)(hold_f + off + bj * 128); h1 = *(const f32x4*)(hold_f + off + bj * 128 + 4); }
                    else { const u32x4 hv = hb[ai][m][bj]; h0 = (f32x4){bflo(hv.x), bfhi(hv.x), bflo(hv.y), bfhi(hv.y)}; h1 = (f32x4){bflo(hv.z), bfhi(hv.z), bflo(hv.w), bfhi(hv.w)}; }
                    const f32x4 v0 = h0 + acc[ai][bj][m][0] * rs * gv[bj][0], v1 = h1 + acc[ai][bj][m][1] * rs * gv[bj][1];
                    q += ((v0[0] * v0[0] + v0[1] * v0[1]) + (v0[2] * v0[2] + v0[3] * v0[3])) + ((v1[0] * v1[0] + v1[1] * v1[1]) + (v1[2] * v1[2] + v1[3] * v1[3]));
                    if (hout) { *(f32x4*)(hout + off + bj * 128) = v0; *(f32x4*)(hout + off + bj * 128 + 4) = v1; }
                    if (xn) { u32x4 w; w.x = cvt_pk_bf16(v0[0], v0[1]); w.y = cvt_pk_bf16(v0[2], v0[3]); w.z = cvt_pk_bf16(v1[0], v1[1]); w.w = cvt_pk_bf16(v1[2], v1[3]); store16(xn + off + bj * 128, w, wt); } }
                q += __shfl_xor(q, 16); q += __shfl_xor(q, 32); s[m] = q; }
            if (ssq_next) { const float v = fq == 0 ? s[0] : fq == 1 ? s[1] : fq == 2 ? s[2] : s[3]; atomicAdd(ssq_next + u.pm * 256 + wr * 64 + ai * 128 + ln, v); } }
    }
};
typedef EpiNormResT<false> EpiNormRes;
typedef EpiNormResT<true> EpiNormResMid;
struct ChainOrder {
    pg8::TileOrder o; unsigned* wt_base; unsigned* dn_base;
    __device__ bool next(int i, pg8::Unit& u) const { if (!o.next(i, u)) return false; u.wait = wt_base ? wt_base + 64 * u.pm : nullptr; u.done = dn_base ? dn_base + 64 * u.pm : nullptr; return true; }
};

struct EpiP2 { static constexpr bool PERM = true, MIDK = false; EpiQ eq; EpiBf16 ekv, eqk, evo;
    __device__ __forceinline__ void operator()(Acc& acc, const pg8::Unit& u, int wr, int wc, int fr, int fq, LAS unsigned char* l, int wid, int par) const {
        if (u.job == 0) eq(acc, u, wr, wc, fr, fq, l, wid, par); else if (u.job == 1) ekv(acc, u, wr, wc, fr, fq, l, wid, par);
        else if (u.job == 2) eqk(acc, u, wr, wc, fr, fq, l, wid, par); else evo(acc, u, wr, wc, fr, fq, l, wid, par); } };

struct EpiP1 { static constexpr bool PERM = true, MIDK = false; EpiZ ez; EpiBf16 eb;
    __device__ __forceinline__ void operator()(Acc& acc, const pg8::Unit& u, int wr, int wc, int fr, int fq, LAS unsigned char* l, int wid, int par) const {
        if (u.job == 0) ez(acc, u, wr, wc, fr, fq, l, wid, par); else eb(acc, u, wr, wc, fr, fq, l, wid, par); } };

#define XB_TMO      128
#define XB_XCNT(j)  (256  + 64 * (j))
#define XB_XSUB(j)  (1280 + 64 * (j))
#define XB_XGEN(j)  (2304 + 64 * (j))
#define XB_TOP      3328
#define XB_TOPGEN   3392
#define XCD_BAR_WORDS 3456
#define XB_SPIN_CAP (1u << 20)
__device__ __forceinline__ unsigned xb_ld(unsigned* p)              { return __hip_atomic_load(p, __ATOMIC_RELAXED, __HIP_MEMORY_SCOPE_AGENT); }
__device__ __forceinline__ unsigned xb_add(unsigned* p, unsigned v) { return __hip_atomic_fetch_add(p, v, __ATOMIC_RELAXED, __HIP_MEMORY_SCOPE_AGENT); }
__device__ __forceinline__ unsigned xb_xcc_id() { return (unsigned)__builtin_amdgcn_s_getreg((3 << 11) | 20) & 0xFu; }
#define XB_SPIN(cond, bar) do { unsigned _sp = 0; while (cond) { __builtin_amdgcn_s_sleep(1); \
    if ((++_sp & 255u) == 0u) { if (xb_ld(&(bar)[XB_TMO])) break; if (_sp > XB_SPIN_CAP) { atomicAdd(&(bar)[XB_TMO], 1u); break; } } } } while (0)
struct XcdBarrier { unsigned* bar; unsigned x; volatile LAS unsigned* st; unsigned G; };
__device__ __forceinline__ XcdBarrier xcd_barrier_post(unsigned* bar, volatile LAS unsigned* st, unsigned G) {
    XcdBarrier b; b.bar = bar; b.x = xb_xcc_id(); b.st = st; b.G = G;
    if (threadIdx.x == 0) (void)xb_add(&bar[XB_XCNT(b.x)], 1u);
    return b;
}
__device__ __forceinline__ void xcd_barrier_complete(unsigned* bar, unsigned x, unsigned& nloc, unsigned& nx, const unsigned G) {
    unsigned sum, cnt, mine, sp = 0u;
    for (;;) {
        sum = 0u; cnt = 0u; mine = 0u;
#pragma unroll
        for (unsigned j = 0; j < 16; ++j) { const unsigned c = xb_ld(&bar[XB_XCNT(j)]); sum += c; cnt += (c > 0u) ? 1u : 0u; mine = (j == x) ? c : mine; }
        if (sum == G) break;
        __builtin_amdgcn_s_sleep(1);
        if ((++sp & 255u) == 0u) { if (xb_ld(&bar[XB_TMO])) break; if (sp > XB_SPIN_CAP) { atomicAdd(&bar[XB_TMO], 1u); break; } }
    }
    nloc = mine > 0u ? mine : 1u; nx = cnt > 0u ? cnt : 1u;
}
__device__ __forceinline__ void xcd_barrier(const XcdBarrier& b, const int wv) {
    asm volatile("s_waitcnt vmcnt(0)" ::: "memory");
    __syncthreads();
    if (wv == 0 && lane_id() == 0) {
        unsigned* bar = b.bar;
        __builtin_amdgcn_s_waitcnt(0);
        unsigned nloc = b.st[0], nx = b.st[1];
        if (nloc == 0u) { xcd_barrier_complete(bar, b.x, nloc, nx, b.G); b.st[0] = nloc; b.st[1] = nx; }
        const unsigned old = xb_add(&bar[XB_XSUB(b.x)], 1u);
        const unsigned gen = old / nloc;
        if (old + 1u == (gen + 1u) * nloc) {
            __builtin_amdgcn_fence(__ATOMIC_RELEASE, "agent");
            asm volatile("s_waitcnt vmcnt(0)" ::: "memory");
            const unsigned og = xb_add(&bar[XB_TOP], 1u);
            const unsigned tg = og / nx;
            if (og + 1u == (tg + 1u) * nx) xb_add(&bar[XB_TOPGEN], 1u);
            else XB_SPIN(xb_ld(&bar[XB_TOPGEN]) == tg, bar);
            __builtin_amdgcn_fence(__ATOMIC_ACQUIRE, "agent");
            xb_add(&bar[XB_XGEN(b.x)], 1u);
            asm volatile("s_waitcnt vmcnt(0)" ::: "memory");
        } else {
            XB_SPIN(xb_ld(&bar[XB_XGEN(b.x)]) == gen, bar);
            __builtin_amdgcn_fence(__ATOMIC_ACQUIRE, "agent");
            asm volatile("s_waitcnt vmcnt(0)" ::: "memory");
        }
    }
    __syncthreads();
}

enum { MAP_ID = 0, MAP_WIN = 1, MAP_WUQ = 2, MAP_WUKV = 3, MAP_GATE = 4, MAP_UP = 5 };
__device__ __forceinline__ int map_n(int mode, int n) {
    switch (mode) {
    case MAP_WIN: { if (n < OFF_KPE) return n; const int j = n - OFF_KPE; return OFF_KPE + (j < 32 ? 2 * j : 2 * (j - 32) + 1); }
    case MAP_WUQ: { const int h = n / 192, d = n % 192; if (d < 128) return h * 128 + d; const int j = d - 128; return 512 + h * 64 + (j < 32 ? 2 * j : 2 * (j - 32) + 1); }
    case MAP_WUKV: { const int h = n / 256, d = n % 256; return d < 128 ? h * 128 + d : 512 + h * 128 + (d - 128); }
    case MAP_GATE: return (n >> 7) * 256 + (n & 127);
    case MAP_UP: return (n >> 7) * 256 + 128 + (n & 127);
    default: return n;
    }
}
__device__ __forceinline__ void p0_transpose_item(const float* W, int K, int N, bf16_t* WT, int row_off, int mode, const float* kscale, const float* kscale2, LAS float* scr, int item, int lane) {
    const int nblk = N / 64, kb = item / nblk, nb = item % nblk, k0 = 64 * kb, n0 = 64 * nb;
    float v[64];
#pragma unroll
    for (int i = 0; i < 64; ++i) v[i] = __builtin_nontemporal_load(W + (size_t)(k0 + i) * N + n0 + lane);
    if (kscale) { const float* ks = (kscale2 && k0 >= 512) ? kscale2 - 512 : kscale;
#pragma unroll
        for (int i = 0; i < 64; ++i) v[i] *= ks[k0 + i]; }
#pragma unroll
    for (int i = 0; i < 64; ++i) scr[i * 65 + lane] = v[i];
    LDS_WAIT(); asm volatile("" ::: "memory");
    const int c = lane & 7;
#pragma unroll
    for (int j = 0; j < 8; ++j) { const int n = (lane >> 3) + 8 * j; const LAS float* sp = scr + (8 * c) * 65 + n;
        u32x4 o; o.x = cvt_pk_bf16(sp[0 * 65], sp[1 * 65]); o.y = cvt_pk_bf16(sp[2 * 65], sp[3 * 65]); o.z = cvt_pk_bf16(sp[4 * 65], sp[5 * 65]); o.w = cvt_pk_bf16(sp[6 * 65], sp[7 * 65]);
        *(u32x4*)(WT + (size_t)(row_off + map_n(mode, n0 + n)) * K + k0 + 8 * c) = o; }
    LDS_WAIT(); asm volatile("" ::: "memory");
}
template <int R, bool NORM>
__device__ __forceinline__ void rms_rows_to_bf16(const float* xrow, const float* g, bf16_t* orow, float* ssq_out, int lane) {
    f32x4 v[R][4]; float s[R];
#pragma unroll
    for (int r = 0; r < R; ++r)
#pragma unroll
        for (int j = 0; j < 4; ++j) v[r][j] = __builtin_nontemporal_load((const f32x4*)(xrow + (size_t)r * DM) + lane + 64 * j);
    f32x4 gg[4];
#pragma unroll
    for (int j = 0; j < 4; ++j) gg[j] = ((const f32x4*)g + lane)[64 * j];
#pragma unroll
    for (int r = 0; r < R; ++r) { float q = 0.f;
#pragma unroll
        for (int j = 0; j < 4; ++j) q += (v[r][j].x * v[r][j].x + v[r][j].y * v[r][j].y) + (v[r][j].z * v[r][j].z + v[r][j].w * v[r][j].w);
        s[r] = q; }
#pragma unroll
    for (int o = 1; o < 64; o <<= 1)
#pragma unroll
        for (int r = 0; r < R; ++r) s[r] += __shfl_xor(s[r], o);
#pragma unroll
    for (int r = 0; r < R; ++r) { const float rs = NORM ? __builtin_amdgcn_rsqf(s[r] * (1.f / DM) + EPS) : 1.f; u32x2* o8 = (u32x2*)(orow + (size_t)r * DM) + lane;
        if (!NORM) { if (lane == 0) ssq_out[r] = s[r];
#pragma unroll
            for (int j = 0; j < 4; ++j) gg[j] = (f32x4){1.f, 1.f, 1.f, 1.f}; }
#pragma unroll
        for (int j = 0; j < 4; ++j) { u32x2 w; w.x = cvt_pk_bf16(v[r][j].x * rs * gg[j].x, v[r][j].y * rs * gg[j].y); w.y = cvt_pk_bf16(v[r][j].z * rs * gg[j].z, v[r][j].w * rs * gg[j].w); o8[64 * j] = w; } }
}
__device__ __forceinline__ void resid_row(const float* pre, const float* hold, const float* gpost, float* hout, const float* gnext, bf16_t* xn, int lane) {
    const f32x4* pr = (const f32x4*)pre + lane; const f32x4* hr = (const f32x4*)hold + lane; const f32x4* gp = (const f32x4*)gpost + lane;
    f32x4 v[4]; float s = 0.f;
#pragma unroll
    for (int j = 0; j < 4; ++j) { v[j] = pr[64 * j]; s += (v[j].x * v[j].x + v[j].y * v[j].y) + (v[j].z * v[j].z + v[j].w * v[j].w); }
    const float rs = __builtin_amdgcn_rsqf(wave_sum(s) * (1.f / DM) + EPS);
    float s2 = 0.f;
#pragma unroll
    for (int j = 0; j < 4; ++j) { const f32x4 h = hr[64 * j], g = gp[64 * j]; v[j] = h + v[j] * rs * g; s2 += (v[j].x * v[j].x + v[j].y * v[j].y) + (v[j].z * v[j].z + v[j].w * v[j].w); }
    f32x4* ho = (f32x4*)hout + lane;
#pragma unroll
    for (int j = 0; j < 4; ++j) ho[64 * j] = v[j];
    if (xn) { const float rs2 = __builtin_amdgcn_rsqf(wave_sum(s2) * (1.f / DM) + EPS); const f32x4* gn = (const f32x4*)gnext + lane; u32x2* o8 = (u32x2*)xn + lane;
#pragma unroll
        for (int j = 0; j < 4; ++j) { const f32x4 gg = gn[64 * j]; u32x2 w; w.x = cvt_pk_bf16(v[j].x * rs2 * gg.x, v[j].y * rs2 * gg.y); w.y = cvt_pk_bf16(v[j].z * rs2 * gg.z, v[j].w * rs2 * gg.w); o8[64 * j] = w; } }
}

namespace lru {
constexpr int TT = 128, NTILE = SEQ / TT, UP = 72;
constexpr int L_U = 0, L_UF = L_U + TT * UP * 2, L_WSEG = L_UF + TT * 33 * 4, L_CARRY = L_WSEG + 2 * 8 * 32 * 8, L_TSS = L_CARRY + 2 * 32 * 4, L_END = L_TSS + 2 * TT * 4;
static_assert(L_END <= RING_BYTES, "lru lds");
__device__ __forceinline__ float sigmoidf_(float x) { return __builtin_amdgcn_rcpf(1.f + __builtin_amdgcn_exp2f(-x * LOG2E)); }
__device__ __forceinline__ void unit(int b, int cb, const bf16_t* Z, bf16_t* Y, float* ssq_lru, const float* conv_w, const float* conv_b, const float* wa, const float* ba, const float* wx, const float* bx,
                                     const float* lam, LAS unsigned char* lds, const int wv) {
    const int lane = lane_id(), wid = wv, tid = wv * 64 + lane;
    const int hblk = cb >> 1, half = cb & 1, ib = hblk * 64, c0 = cb * 32;
    LAS bf16_t* U = (LAS bf16_t*)(lds + L_U); LAS float* UF = (LAS float*)(lds + L_UF); LAS f32x2* WSEG = (LAS f32x2*)(lds + L_WSEG);
    LAS float* CARRY = (LAS float*)(lds + L_CARRY); LAS float* TSS = (LAS float*)(lds + L_TSS);
    const int col = lane & 15, kq = lane >> 4;
    bf16x8 Bf[4][2];
#pragma unroll
    for (int nb = 0; nb < 4; ++nb)
#pragma unroll
        for (int ks = 0; ks < 2; ++ks) { const float* Wg = (nb < 2) ? wa : wx; const int oc = half * 32 + (nb & 1) * 16 + col; float w[8];
#pragma unroll
            for (int j = 0; j < 8; ++j) w[j] = Wg[((size_t)hblk * 64 + ks * 32 + 8 * kq + j) * 64 + oc];
            u32x4 p; p.x = cvt_pk_bf16(w[0], w[1]); p.y = cvt_pk_bf16(w[2], w[3]); p.z = cvt_pk_bf16(w[4], w[5]); p.w = cvt_pk_bf16(w[6], w[7]); Bf[nb][ks] = __builtin_bit_cast(bf16x8, p); }
    float cba[2], cbx[2], csp[2];
#pragma unroll
    for (int e = 0; e < 2; ++e) { const int ch = c0 + e * 16 + col; cba[e] = ba[ch]; cbx[e] = bx[ch]; const float l = lam[ch];
        csp[e] = 8.f * LOG2E * (fmaxf(-l, 0.f) + log1pf(expf(-fabsf(l)))); }
    const int cch = lane;
    const float cw0 = conv_w[0 * DLRU + ib + cch], cw1 = conv_w[1 * DLRU + ib + cch], cw2 = conv_w[2 * DLRU + ib + cch], cw3 = conv_w[3 * DLRU + ib + cch], cbb = conv_b[ib + cch];
    if (tid < 64) CARRY[tid] = 0.f;
    if (tid < 2 * TT) TSS[tid] = 0.f;
    const size_t rowb = (size_t)b * SEQ;
    const bf16_t* zx = Z + (rowb + wid * 16) * DINP + ib + cch;
    const bf16_t* zg = Z + (rowb + wid * 16 + kq * 4) * DINP + OFF_GATE + c0 + col;
    bf16_t* yp = Y + (rowb + wid * 16 + kq * 4) * DM + c0 + col;
    unsigned short xr[19], gr[8];
#define LRU_LOADX(t0_) do { _Pragma("unroll") for (int k = 0; k < 19; ++k) { const int tk = (t0_) + wid * 16 + k - 3; xr[k] = (tk >= 0) ? zx[(ptrdiff_t)((t0_) + k - 3) * DINP] : (unsigned short)0; } } while (0)
    LRU_LOADX(0);
    __syncthreads();
    for (int tile = 0; tile < NTILE; ++tile) {
        const int t0 = tile * TT, par = tile & 1;
        { float xm3 = bf2f(xr[0]), xm2 = bf2f(xr[1]), xm1 = bf2f(xr[2]);
#pragma unroll
          for (int k = 0; k < 16; ++k) { const float x0 = bf2f(xr[3 + k]); const float u = cbb + cw0 * xm3 + cw1 * xm2 + cw2 * xm1 + cw3 * x0; xm3 = xm2; xm2 = xm1; xm1 = x0;
              const int tl = wid * 16 + k; U[tl * UP + cch] = (bf16_t)(cvt_pk_bf16(u, 0.f) & 0xffffu);
              if ((cch >> 5) == half) UF[tl * 33 + (cch & 31)] = u; } }
#pragma unroll
        for (int e = 0; e < 2; ++e)
#pragma unroll
            for (int r = 0; r < 4; ++r) gr[e * 4 + r] = zg[(size_t)(t0 + r) * DINP + e * 16];
        if (tile + 1 < NTILE) LRU_LOADX(t0 + TT);
        LDS_WAIT();
        float av[2][4], uv[2][4], Ainc[2], Hinc[2];
        { f32x4 C[4];
#pragma unroll
          for (int nb = 0; nb < 4; ++nb) C[nb] = (f32x4){0.f, 0.f, 0.f, 0.f};
          const LAS bf16_t* ua = U + (wid * 16 + col) * UP + 8 * kq;
          const bf16x8 a0 = *(const LAS bf16x8*)ua, a1 = *(const LAS bf16x8*)(ua + 32);
#pragma unroll
          for (int nb = 0; nb < 4; ++nb) { C[nb] = __builtin_amdgcn_mfma_f32_16x16x32_bf16(a0, Bf[nb][0], C[nb], 0, 0, 0); C[nb] = __builtin_amdgcn_mfma_f32_16x16x32_bf16(a1, Bf[nb][1], C[nb], 0, 0, 0); }
#pragma unroll
          for (int e = 0; e < 2; ++e) { float Ap = 1.f, H = 0.f;
#pragma unroll
              for (int r = 0; r < 4; ++r) { const int tl = wid * 16 + kq * 4 + r, ch = e * 16 + col;
                  const float rg = sigmoidf_(C[e][r] + cba[e]), ig = sigmoidf_(C[e + 2][r] + cbx[e]);
                  const float a = __builtin_amdgcn_exp2f(-rg * csp[e]); const float mult = __builtin_amdgcn_sqrtf(fmaxf(1.f - a * a, 0.f));
                  const float uu = mult * ig * UF[tl * 33 + ch];
                  av[e][r] = a; uv[e][r] = uu; H = a * H + uu; Ap *= a; }
              { const float Ap1 = __shfl_up(Ap, 16), H1 = __shfl_up(H, 16); if (kq >= 1) { H = Ap * H1 + H; Ap = Ap * Ap1; } }
              { const float Ap2 = __shfl_up(Ap, 32), H2 = __shfl_up(H, 32); if (kq >= 2) { H = Ap * H2 + H; Ap = Ap * Ap2; } }
              Ainc[e] = Ap; Hinc[e] = H;
              if (kq == 3) WSEG[(par * 8 + wid) * 32 + e * 16 + col] = (f32x2){Ap, H}; } }
        __syncthreads();
        if (tid < TT) { const float v = TSS[(par ^ 1) * TT + tid]; if (tile > 0) atomicAdd(ssq_lru + rowb + t0 - TT + tid, v); }
        float qs[4] = {0.f, 0.f, 0.f, 0.f};
#pragma unroll
        for (int e = 0; e < 2; ++e) { const int ch = e * 16 + col;
            float h = CARRY[par * 32 + ch];
            for (int w2 = 0; w2 < wid; ++w2) { const f32x2 sg = WSEG[(par * 8 + w2) * 32 + ch]; h = sg.x * h + sg.y; }
            if (wid == 7 && kq == 0) { const f32x2 sg = WSEG[(par * 8 + 7) * 32 + ch]; CARRY[(par ^ 1) * 32 + ch] = sg.x * h + sg.y; }
            const float Ae = __shfl_up(Ainc[e], 16), He = __shfl_up(Hinc[e], 16);
            if (kq >= 1) h = Ae * h + He;
#pragma unroll
            for (int r = 0; r < 4; ++r) { h = av[e][r] * h + uv[e][r]; const float g = bf2f(gr[e * 4 + r]);
                const float ge = g * __builtin_amdgcn_rcpf(1.f + __builtin_amdgcn_exp2f(-1.5957691216057308f * LOG2E * (g + 0.044715f * g * g * g)));
                const float y = h * ge; yp[(size_t)(t0 + r) * DM + e * 16] = (bf16_t)(cvt_pk_bf16(y, 0.f) & 0xffffu); qs[r] += y * y; } }
#pragma unroll
        for (int r = 0; r < 4; ++r) { float q = qs[r]; q += __shfl_xor(q, 1); q += __shfl_xor(q, 2); q += __shfl_xor(q, 4); q += __shfl_xor(q, 8);
            if (col == 0) TSS[par * TT + wid * 16 + kq * 4 + r] = q; }
    }
    __syncthreads();
    if (tid < TT) atomicAdd(ssq_lru + rowb + (NTILE - 1) * TT + tid, TSS[((NTILE - 1) & 1) * TT + tid]);
    __syncthreads();
#undef LRU_LOADX
}
}

namespace mla {
constexpr int NW = 8, QBLK = 32, KVBLK = 64, QB = 256, KROW = 384, SHM_K = KVBLK * KROW, SHM_V = KVBLK * 128 * 2;
constexpr int L_V = 0, L_K = 2 * SHM_V, L_WS = L_K + 2 * SHM_K, L_END = L_WS + NW * 64 * 4;
static_assert(L_END <= RING_BYTES && NW * 8192 <= L_WS, "mla lds");
#define KSWZ(row, colB) ((row) * KROW + ((colB) ^ ((((row) >> 1) & 7) << 4)))
#define SBAR() __builtin_amdgcn_sched_barrier(0)
__device__ __forceinline__ int v_st(int k, int c) { const int kk = (k & ~0xC) | ((k & 4) << 1) | ((k & 8) >> 1); return ((kk >> 3) * 4 + (c >> 5)) * 512 + ((kk & 7) * 32 + (c & 31)) * 2; }
__device__ __forceinline__ int v_rd_base(int lane) { return ((lane & 3) << 3) | (((lane >> 2) & 3) << 6) | (((lane >> 4) & 1) << 5) | (((lane >> 5) & 1) << 8); }
constexpr int v_rd_off(int d0, int ks, int half) { return d0 * 512 + ks * 4096 + half * 2048; }
__device__ __forceinline__ int crow(int r, int hi) { return (r & 3) + 8 * (r >> 2) + 4 * hi; }
__device__ __forceinline__ void mask_tile(f32x16& p0, f32x16& p1, int dq) {
    const float NEG = -__builtin_inff();
#pragma unroll
    for (int r = 0; r < 16; ++r) { const int c = (r & 3) + 8 * (r >> 2); if (dq - c < 0) p0[r] = NEG; if (dq - c - 32 < 0) p1[r] = NEG; }
}
constexpr float THR2 = 8.f * LOG2E;
__device__ __forceinline__ void partialSM(f32x16& p0, f32x16& p1, float& m_reg, float& alpha) {
    float pmax = p0[0];
#pragma unroll
    for (int r = 1; r < 16; ++r) pmax = fmaxf(pmax, p0[r]);
#pragma unroll
    for (int r = 0; r < 16; ++r) pmax = fmaxf(pmax, p1[r]);
    { auto rr = __builtin_amdgcn_permlane32_swap(__float_as_uint(pmax), __float_as_uint(pmax), false, false); pmax = fmaxf(__uint_as_float(rr[0]), __uint_as_float(rr[1])); }
    float mn;
    if (__builtin_expect(__all((pmax - m_reg) <= THR2), 1)) { mn = m_reg; alpha = 1.f; }
    else { mn = fmaxf(m_reg, pmax); alpha = __builtin_amdgcn_exp2f(m_reg - mn); m_reg = mn; }
#pragma unroll
    for (int r = 0; r < 16; ++r) p0[r] = p0[r] - mn;
#pragma unroll
    for (int r = 0; r < 16; ++r) p1[r] = p1[r] - mn;
#pragma unroll
    for (int r = 0; r < 16; ++r) p0[r] = __builtin_amdgcn_exp2f(p0[r]);
}
__device__ __forceinline__ void finishSM(f32x16& p0, f32x16& p1, float alpha, float& l_reg, bf16x8& pa0, bf16x8& pa1, bf16x8& pa2, bf16x8& pa3) {
#pragma unroll
    for (int r = 0; r < 16; ++r) p1[r] = __builtin_amdgcn_exp2f(p1[r]);
    float ps = 0;
#pragma unroll
    for (int r = 0; r < 16; ++r) ps += p0[r];
#pragma unroll
    for (int r = 0; r < 16; ++r) ps += p1[r];
    { auto rr = __builtin_amdgcn_permlane32_swap(__float_as_uint(ps), __float_as_uint(ps), false, false); ps = __uint_as_float(rr[0]) + __uint_as_float(rr[1]); }
    l_reg = l_reg * alpha + ps;
#define PK4(P, B_, OUT) do { unsigned a0 = cvt_pk_bf16(P[B_+0], P[B_+1]), a1 = cvt_pk_bf16(P[B_+2], P[B_+3]);                          \
        unsigned b0 = cvt_pk_bf16(P[B_+4], P[B_+5]), b1 = cvt_pk_bf16(P[B_+6], P[B_+7]);                                             \
        auto r0 = __builtin_amdgcn_permlane32_swap(a0, b0, false, false); auto r1 = __builtin_amdgcn_permlane32_swap(a1, b1, false, false); \
        u32x4 w = {r0[0], r1[0], r0[1], r1[1]}; OUT = __builtin_bit_cast(bf16x8, w); } while (0)
    PK4(p0, 0, pa0); PK4(p0, 8, pa1); PK4(p1, 0, pa2); PK4(p1, 8, pa3);
#undef PK4
}
template <int KB>
__device__ __forceinline__ void qkt(f32x16& p0, f32x16& p1, const char* K_lds, int r32, int hi, const bf16x8* qr) {
    p0 = f32x16{}; p1 = f32x16{};
    unsigned kb[4];
#pragma unroll
    for (int dd = 0; dd < 4; ++dd) kb[dd] = (unsigned)(uintptr_t)(K_lds + KB * SHM_K + KSWZ(r32, (dd * 16 + hi * 8) * 2));
    bf16x8 fa[4], fb[4];
#define KRD(slot, d0) do { asm volatile("ds_read_b128 %0, %1 offset:%2" : "=v"(fa[slot]) : "v"(kb[(d0) & 3]), "i"(((d0) >> 2) * 128)); \
                           asm volatile("ds_read_b128 %0, %1 offset:%2" : "=v"(fb[slot]) : "v"(kb[(d0) & 3]), "i"(((d0) >> 2) * 128 + 32 * KROW)); } while (0)
#define KMM(slot, d0, N) do { asm volatile("s_waitcnt lgkmcnt(%0)" :: "i"(N) : "memory"); SBAR(); \
        p0 = __builtin_amdgcn_mfma_f32_32x32x16_bf16(fa[slot], qr[d0], p0, 0, 0, 0); p1 = __builtin_amdgcn_mfma_f32_32x32x16_bf16(fb[slot], qr[d0], p1, 0, 0, 0); SBAR(); } while (0)
    KRD(0, 0); KRD(1, 1); KRD(2, 2); KRD(3, 3);
    KMM(0, 0, 6); KRD(0, 4); KMM(1, 1, 6); KRD(1, 5); KMM(2, 2, 6); KRD(2, 6); KMM(3, 3, 6); KRD(3, 7);
    KMM(0, 4, 6); KRD(0, 8); KMM(1, 5, 6); KRD(1, 9); KMM(2, 6, 6); KRD(2, 10); KMM(3, 7, 6); KRD(3, 11);
    KMM(0, 8, 6); KMM(1, 9, 4); KMM(2, 10, 2); KMM(3, 11, 0);
#undef KRD
#undef KMM
}
template <int VB>
__device__ __forceinline__ void pv_tile(f32x16* o, int vb0, bf16x8 pa0, bf16x8 pa1, bf16x8 pa2, bf16x8 pa3) {
    s16x4 lo[2][4], hh[2][4];
#define TRRD(dst, off) asm volatile("ds_read_b64_tr_b16 %0, %1 offset:%2" : "=v"(dst) : "v"(vb0), "i"(off))
#define VRD(set, d0) do { constexpr int b_ = VB * SHM_V + v_rd_off(d0, 0, 0); \
        TRRD(lo[set][0], b_); TRRD(hh[set][0], b_ + 2048); TRRD(lo[set][1], b_ + 4096); TRRD(hh[set][1], b_ + 6144); \
        TRRD(lo[set][2], b_ + 8192); TRRD(hh[set][2], b_ + 10240); TRRD(lo[set][3], b_ + 12288); TRRD(hh[set][3], b_ + 14336); } while (0)
#define VFR(set, k) (bf16x8){lo[set][k][0], lo[set][k][1], lo[set][k][2], lo[set][k][3], hh[set][k][0], hh[set][k][1], hh[set][k][2], hh[set][k][3]}
#define VMM(set, d0, N) do { asm volatile("s_waitcnt lgkmcnt(%0)" :: "i"(N) : "memory"); SBAR(); \
        o[d0] = __builtin_amdgcn_mfma_f32_32x32x16_bf16(pa0, VFR(set, 0), o[d0], 0, 0, 0); o[d0] = __builtin_amdgcn_mfma_f32_32x32x16_bf16(pa1, VFR(set, 1), o[d0], 0, 0, 0); \
        o[d0] = __builtin_amdgcn_mfma_f32_32x32x16_bf16(pa2, VFR(set, 2), o[d0], 0, 0, 0); o[d0] = __builtin_amdgcn_mfma_f32_32x32x16_bf16(pa3, VFR(set, 3), o[d0], 0, 0, 0); SBAR(); } while (0)
    VRD(0, 0); VRD(1, 1);
    VMM(0, 0, 8); VRD(0, 2); VMM(1, 1, 8); VRD(1, 3); VMM(0, 2, 8); VMM(1, 3, 0);
#undef TRRD
#undef VRD
#undef VFR
#undef VMM
}
__device__ __forceinline__ void block(int b, int h, int qb, const bf16_t* Qb, const bf16_t* KVb, const bf16_t* KPE, bf16_t* Y, float* ssq_mla, char* lds, const int wv) {
    const int lane = lane_id(), wid = wv, tid = wv * 64 + lane, r32 = lane & 31, hi = lane >> 5;
    const size_t rowbase = (size_t)b * SEQ; const int q0 = qb * QB; const int NT = (q0 + QB) / KVBLK;
    const int qlo = q0 + wid * QBLK, qm = qlo + r32 - 4 * hi;
    char* V_lds = lds + L_V; char* K_lds = lds + L_K;
    float* ws = (float*)(lds + L_WS) + wid * 64; float* li_l = ws, * al_l = ws + 32;
    float m_reg = -1e30f, l_reg = 0; f32x16 o[4] = {};
    const int sr = tid >> 4, scc = (tid & 15) * 8, vst0 = v_st(sr, scc), vst1 = v_st(32 + sr, scc), kws = KSWZ(sr, (tid & 15) * 16);
    const int pr = tid >> 3, kws2 = KSWZ(pr, 256 + (tid & 7) * 16);
    const int vb0 = (int)(uintptr_t)V_lds + v_rd_base(lane);
    const bf16_t* Kn = KVb + rowbase * 1024 + h * 128 + scc;
    const bf16_t* Vn = KVb + rowbase * 1024 + 512 + h * 128 + scc;
    const bf16_t* Kp = KPE + rowbase * 64 + (tid & 7) * 8;
    bf16x8 qr[12];
    { const bf16_t* qp = Qb + (rowbase + q0 + wid * QBLK + r32) * 768;
#pragma unroll
      for (int d0 = 0; d0 < 8; ++d0) qr[d0] = *(const bf16x8*)(qp + h * 128 + d0 * 16 + hi * 8);
#pragma unroll
      for (int d0 = 0; d0 < 4; ++d0) qr[8 + d0] = *(const bf16x8*)(qp + 512 + h * 64 + d0 * 16 + hi * 8); }
    const int grp = wid >> 2;
    bf16x8 st_v0, st_v1, st_k0, st_k1, st_k2;
#define SLOADK(t) do { const size_t k0_ = (size_t)(t) * KVBLK; st_k0 = *(const bf16x8*)(Kn + (k0_ + sr) * 1024); st_k1 = *(const bf16x8*)(Kn + (k0_ + 32 + sr) * 1024); st_k2 = *(const bf16x8*)(Kp + (k0_ + pr) * 64); } while (0)
#define SLOADV(t) do { const size_t k0_ = (size_t)(t) * KVBLK; st_v0 = *(const bf16x8*)(Vn + (k0_ + sr) * 1024); st_v1 = *(const bf16x8*)(Vn + (k0_ + 32 + sr) * 1024); } while (0)
#define SWRITEK(off) do { *(bf16x8*)(K_lds + (off) + kws) = st_k0; *(bf16x8*)(K_lds + (off) + kws + 32 * KROW) = st_k1; *(bf16x8*)(K_lds + (off) + kws2) = st_k2; } while (0)
#define SWRITEV(off) do { *(bf16x8*)(V_lds + (off) + vst0) = st_v0; *(bf16x8*)(V_lds + (off) + vst1) = st_v1; } while (0)
#define BAR() asm volatile("s_waitcnt lgkmcnt(0)\n\ts_barrier" ::: "memory")
#define RESC(a) do { if (__any((a) < 1.f)) { if (hi == 0) al_l[r32] = (a); asm volatile("s_waitcnt lgkmcnt(0)" ::: "memory");              \
                     for (int d_ = 0; d_ < 4; ++d_) for (int r = 0; r < 16; ++r) o[d_][r] *= al_l[crow(r, hi)]; } } while (0)
#define MASKT(P0_, P1_, t) do { const int kb_ = (t) * KVBLK; if (kb_ + KVBLK - 1 > qlo) mask_tile(P0_, P1_, qm - kb_); } while (0)
#define ACT(t) ((t) * KVBLK <= qlo + QBLK - 1)
#define NEGALL() do { const float NEG_ = -__builtin_inff(); _Pragma("unroll") for (int r = 0; r < 16; ++r) { p0[r] = NEG_; p1[r] = NEG_; } } while (0)
    f32x16 p0, p1; float al; bf16x8 pa0, pa1, pa2, pa3;
    SLOADK(0); VM_WAIT(); SWRITEK(0);
    if (grp) { SLOADK(1); SLOADV(0); }
    BAR();
    if (grp) { VM_WAIT(); SWRITEK(SHM_K); SWRITEV(0); BAR(); }
#define SMSLOT(t, tk, tv) do { if ((tk) < NT || (tv) < NT) { VM_WAIT(); if ((tk) < NT) SWRITEK(((tk) & 1) * SHM_K); if ((tv) < NT) SWRITEV(((tv) & 1) * SHM_V); } \
        MASKT(p0, p1, (t)); partialSM(p0, p1, m_reg, al); RESC(al); finishSM(p0, p1, al, l_reg, pa0, pa1, pa2, pa3); SBAR(); } while (0)
    { const int tk = 1 + grp, tv = grp;
      SLOADK(tk); SLOADV(tv); SBAR(); qkt<0>(p0, p1, K_lds, r32, hi, qr); SBAR();
      BAR(); SMSLOT(0, tk, tv); BAR(); }
    for (int i = 0; i < NT; i += 2) {
        { const int tk = i + 2 + grp, tv = i + 1 + grp;
          if (tk < NT) SLOADK(tk); if (tv < NT) SLOADV(tv); SBAR();
          if (ACT(i + 1)) qkt<1>(p0, p1, K_lds, r32, hi, qr); else NEGALL(); SBAR(); if (ACT(i)) pv_tile<0>(o, vb0, pa0, pa1, pa2, pa3); SBAR();
          BAR(); SMSLOT(i + 1, tk, tv); BAR(); }
        { const int tk = i + 3 + grp, tv = i + 2 + grp;
          if (tk < NT) SLOADK(tk); if (tv < NT) SLOADV(tv); SBAR();
          if (i + 2 < NT) { if (ACT(i + 2)) qkt<0>(p0, p1, K_lds, r32, hi, qr); else NEGALL(); SBAR(); }
          if (ACT(i + 1)) pv_tile<1>(o, vb0, pa0, pa1, pa2, pa3); SBAR();
          BAR(); if (i + 2 < NT) SMSLOT(i + 2, tk, tv); BAR(); }
    }
    if (!grp) BAR();
#undef SMSLOT
#undef SLOADK
#undef SLOADV
#undef SWRITEK
#undef SWRITEV
#undef BAR
    if (hi == 0) li_l[r32] = l_reg; asm volatile("s_waitcnt lgkmcnt(0)" ::: "memory");
    float rli[16];
#pragma unroll
    for (int r = 0; r < 16; ++r) rli[r] = __builtin_amdgcn_rcpf(li_l[crow(r, hi)]);
    { bf16_t* stg = (bf16_t*)lds + wid * 4096;
#pragma unroll
      for (int r = 0; r < 16; ++r) { const int orow = crow(r, hi);
#pragma unroll
          for (int d0 = 0; d0 < 4; ++d0) stg[orow * 128 + d0 * 32 + r32] = (bf16_t)(cvt_pk_bf16(o[d0][r] * rli[r], 0.f) & 0xffffu); }
      asm volatile("s_waitcnt lgkmcnt(0)" ::: "memory");
      const int row = lane >> 1, hf = lane & 1; float q = 0.f;
      bf16_t* yp = Y + (rowbase + q0 + wid * QBLK + row) * DM + 512 + h * 128 + hf * 64;
#pragma unroll
      for (int j = 0; j < 8; ++j) { const u32x4 v = *(const u32x4*)(stg + row * 128 + hf * 64 + j * 8);
          q += bflo(v.x) * bflo(v.x) + bfhi(v.x) * bfhi(v.x) + bflo(v.y) * bflo(v.y) + bfhi(v.y) * bfhi(v.y) + bflo(v.z) * bflo(v.z) + bfhi(v.z) * bfhi(v.z) + bflo(v.w) * bflo(v.w) + bfhi(v.w) * bfhi(v.w);
          *(u32x4*)(yp + j * 8) = v; }
      q += __shfl_xor(q, 1);
      if (hf == 0) atomicAdd(ssq_mla + rowbase + q0 + wid * QBLK + row, q); }
    __syncthreads();
#undef RESC
#undef MASKT
#undef ACT
#undef NEGALL
}
#undef KSWZ
#undef SBAR
}

constexpr int NWAVES = 8, NPHASE = 13;
struct Args { const void* in[32]; float* out; unsigned char* ws; int ph_lo, ph_hi; };

__global__ void __launch_bounds__(NWAVES * 64, 2) hymba_fwd(Args args) {
    extern __shared__ __attribute__((aligned(16))) unsigned char lds_raw[];
    LAS unsigned char* lds = (LAS unsigned char*)lds_raw;
    volatile LAS unsigned* MISC = (volatile LAS unsigned*)(lds + MISC_OFF);
    const int G = gridDim.x, bx = blockIdx.x, vcu = (G % 8 == 0) ? (bx % 8) * (G / 8) + bx / 8 : bx;
    const int wave_s = __builtin_amdgcn_readfirstlane((int)threadIdx.x >> 6);
#define lane (lane_id())
#define tid (wave_s * 64 + lane)
#define wave (wave_s)
#define gw (vcu * NWAVES + wave)
#define NGW (G * NWAVES)
    unsigned char* ws = args.ws;
#define x_in ((const float*)args.in[0])
#define mem ((const float*)args.in[1])
#define positions ((const int*)args.in[2])
#define g_pre_mix ((const float*)args.in[3])
#define w_in ((const float*)args.in[4])
#define conv_w ((const float*)args.in[5])
#define conv_b ((const float*)args.in[6])
#define lru_wa ((const float*)args.in[7])
#define lru_ba ((const float*)args.in[8])
#define lru_wx ((const float*)args.in[9])
#define lru_bx ((const float*)args.in[10])
#define lru_lambda ((const float*)args.in[11])
#define g_q_lat ((const float*)args.in[12])
#define w_uq ((const float*)args.in[13])
#define g_kv_lat ((const float*)args.in[14])
#define w_ukv ((const float*)args.in[15])
#define g_lru_out ((const float*)args.in[16])
#define g_mla_out ((const float*)args.in[17])
#define w_out ((const float*)args.in[18])
#define g_post_mix ((const float*)args.in[19])
#define g_pre_mem ((const float*)args.in[20])
#define g_mem_kv ((const float*)args.in[21])
#define w_mq ((const float*)args.in[22])
#define w_mk ((const float*)args.in[23])
#define w_mv ((const float*)args.in[24])
#define w_mo ((const float*)args.in[25])
#define g_post_mem ((const float*)args.in[26])
#define g_pre_ffn ((const float*)args.in[27])
#define w_gate ((const float*)args.in[28])
#define w_up ((const float*)args.in[29])
#define w_down ((const float*)args.in[30])
#define g_post_ffn ((const float*)args.in[31])
#define out_p (args.out)
#define ctl ((unsigned*)(ws + WS_CTL))
#define ssq_cq ((float*)(ws + WS_SSQ))
#define ssq_ckv (ssq_cq + T)
#define ssq_lru (ssq_cq + 2 * T)
#define ssq_mla (ssq_cq + 3 * T)
#define ssq_h1 (ssq_cq + 4 * T)
#define ssq_h2 (ssq_cq + 5 * T)
#define ssq_x (ssq_cq + 6 * T)
#define ssq_dummy (ssq_cq + 7 * T)
#define slots_p ((float*)(ws + WS_SLOTS))
#define cosT ((float*)(ws + WS_ROPE))
#define sinT (cosT + (size_t)T * 32)
#define Win_t ((bf16_t*)(ws + WS_WIN))
#define Wuq_t ((bf16_t*)(ws + WS_WUQ))
#define Wukv_t ((bf16_t*)(ws + WS_WUKV))
#define Wout_t ((bf16_t*)(ws + WS_WOUT))
#define Wmq_b ((bf16_t*)(ws + WS_WMQ))
#define Wmkv_t ((bf16_t*)(ws + WS_WMKV))
#define Wmo_t ((bf16_t*)(ws + WS_WMO))
#define Wgu_t ((bf16_t*)(ws + WS_WGU))
#define Wdown_t ((bf16_t*)(ws + WS_WDOWN))
#define MN ((bf16_t*)(ws + WS_MN))
#define MKV ((bf16_t*)(ws + WS_MKV))
#define WQK ((bf16_t*)(ws + WS_WQK))
#define WVO ((bf16_t*)(ws + WS_WVO))
#define XN ((bf16_t*)(ws + WS_XN))
#define KPE ((bf16_t*)(ws + WS_KPE))
#define Z ((bf16_t*)(ws + WS_Z))
#define Qb ((bf16_t*)(ws + WS_Q))
#define KVb ((bf16_t*)(ws + WS_KV))
#define Y ((bf16_t*)(ws + WS_Y))
#define PRE ((float*)(ws + WS_PRE))
#define Pb ((bf16_t*)(ws + WS_P))
#define Fb ((bf16_t*)(ws + WS_F))
    for (int u = tid; u < 256; u += NWAVES * 64) ((LAS unsigned*)(lds + MISC_OFF))[u] = 0u;
    __syncthreads();
    XcdBarrier bar = xcd_barrier_post(ctl + CW_BAR, MISC + 8, (unsigned)G);
    const bool grouped = (G == 256);
    XcdBarrier gbar = grouped ? xcd_barrier_post(ctl + CW_BAR + XCD_BAR_WORDS * (1 + (bx & 7)), MISC + 10, (unsigned)(G >> 3)) : bar;
    const int lo = args.ph_lo, hi = args.ph_hi;
    unsigned long long ts0 = 0, ts1 = 0, tc0 = 0, tc1 = 0;
#define TS(k) do { if ((k) == (SPIN_LO)) { ts0 = __builtin_amdgcn_s_memrealtime(); tc0 = __builtin_amdgcn_s_memtime(); } } while (0)
#define TE(k) do { if ((k) == (SPIN_HI)) { ts1 = __builtin_amdgcn_s_memrealtime(); tc1 = __builtin_amdgcn_s_memtime(); } } while (0)
#ifndef REP_PHASE
#define REP_PHASE -1
#endif
#define REPS(k) for (int rep = 0; rep < ((REP_PHASE) == (k) ? 2 : 1); ++rep)
#define RSQ(p) (rep ? ssq_dummy : (p))
#ifndef PHASE_MASK
#define PHASE_MASK 0x1fff
#endif
#define IN(k) (((PHASE_MASK >> (k)) & 1) && lo <= (k) && (k) < hi)
#ifndef SPIN_LO
#define SPIN_LO -1
#define SPIN_HI -1
#endif
#ifndef ALIGN_P10
#define ALIGN_P10 true
#endif
#ifndef EXTRA_BAR
#define EXTRA_BAR 0
#endif
#define SEAM(k) do { if (IN(k) && IN((k) + 1)) { if ((k) == 0 || !grouped) xcd_barrier(bar, wave_s); else xcd_barrier(gbar, wave_s); } } while (0)

    TS(0); if (IN(0)) REPS(0) {
        LAS float* scr = (LAS float*)(lds + wave * 16640);
        constexpr int I_IN = 16 * 27, I_UQ = 6 * 12, I_UKV = 4 * 16, I_SQ = 16 * 16, I_GU = 16 * 44, I_DN = 44 * 16;
        int cum = 0;
#define P0_JOB(W, K_, N_, WT, ROFF, MODE, KS, KS2, CNT) do { for (int it = (gw + NGW - (cum % NGW)) % NGW; it < (CNT); it += NGW) p0_transpose_item(W, K_, N_, WT, ROFF, MODE, KS, KS2, scr, it, lane); cum += (CNT); } while (0)
        P0_JOB(w_in, DM, 1728, Win_t, 0, MAP_WIN, g_pre_mix, nullptr, I_IN);
        P0_JOB(w_uq, QLR, 768, Wuq_t, 0, MAP_WUQ, g_q_lat, nullptr, I_UQ);
        P0_JOB(w_ukv, KVLR, 1024, Wukv_t, 0, MAP_WUKV, g_kv_lat, nullptr, I_UKV);
        P0_JOB(w_out, DM, DM, Wout_t, 0, MAP_ID, g_lru_out, g_mla_out, I_SQ);
        P0_JOB(w_mk, DM, DM, Wmkv_t, 0, MAP_ID, nullptr, nullptr, I_SQ);
        P0_JOB(w_mv, DM, DM, Wmkv_t, 1024, MAP_ID, nullptr, nullptr, I_SQ);
        P0_JOB(w_mo, DM, DM, Wmo_t, 0, MAP_ID, nullptr, nullptr, I_SQ);
        P0_JOB(w_gate, DM, DFF, Wgu_t, 0, MAP_GATE, g_pre_ffn, nullptr, I_GU);
        P0_JOB(w_up, DM, DFF, Wgu_t, 0, MAP_UP, g_pre_ffn, nullptr, I_GU);
        P0_JOB(w_down, DFF, DM, Wdown_t, 0, MAP_ID, nullptr, nullptr, I_DN);
#undef P0_JOB
        const int gt = vcu * (NWAVES * 64) + tid, NGT = G * NWAVES * 64;
        for (int i = gt; i < 64 * 1024 / 8; i += NGT) *(u32x4*)(Win_t + (size_t)1728 * 1024 + (size_t)i * 8) = (u32x4){0u, 0u, 0u, 0u};
        for (int i = gt; i < DM * DM / 4; i += NGT) { const f32x4 v = *(const f32x4*)(w_mq + (size_t)i * 4) * g_pre_mem[i >> 8]; u32x2 w; w.x = cvt_pk_bf16(v.x, v.y); w.y = cvt_pk_bf16(v.z, v.w); *(u32x2*)(Wmq_b + (size_t)i * 4) = w; }
        for (int i = gt; i < T * 32; i += NGT) { const int row = i >> 5, k = i & 31; const double invf = exp2(-(double)k * (13.287712379549449 / 32.0));
            const double rev = (double)positions[row] * invf * 0.15915494309189535; const float fr_ = (float)(rev - rint(rev)); cosT[i] = __builtin_amdgcn_cosf(fr_); sinT[i] = __builtin_amdgcn_sinf(fr_); }
        { const int rpw = T / (G * NWAVES);
          for (int m = gw * rpw; m < (gw + 1) * rpw; m += 4) rms_rows_to_bf16<4, false>(x_in + (size_t)m * DM, g_pre_mix, XN + (size_t)m * DM, ssq_x + m, lane); }
        { const int rpw = TM / (G * NWAVES);
          for (int m = gw * rpw; m < (gw + 1) * rpw; m += 2) rms_rows_to_bf16<2, true>(mem + (size_t)m * DM, g_mem_kv, MN + (size_t)m * DM, nullptr, lane); }
    }
    SEAM(0); TE(0);
    TS(1); if (IN(1)) REPS(1) {
        {
          struct P1Order { pg8::TileOrder o; int nz, mu; const char* A2; const char* B2;
              __device__ bool next(int i, pg8::Unit& un) const { if (o.next(i, un)) return true; if (i != nz || mu < 0) return false;
                  un.pm = mu >> 3; un.pn = mu & 7; un.A = A2 + (size_t)un.pm * 256 * DM * 2; un.B = B2 + (size_t)un.pn * 256 * DM * 2; un.cofs = 0; un.job = 1; un.wait = nullptr; un.done = nullptr; return true; } };
          const int j = bx >> 3; P1Order S; S.o.init(T, DINP, G, bx, XN, DM, Win_t, DM);
          S.nz = (896 - bx + G - 1) / G;
          S.mu = (G == 256) ? (j >= 16 ? ((bx & 7) * 2 + ((j - 16) >> 3)) * 8 + ((j - 16) & 7) : -1) : (bx < 128 ? bx : -1); S.A2 = (const char*)MN; S.B2 = (const char*)Wmkv_t;
          EpiP1 E{EpiZ{Z, KPE, RSQ(ssq_cq), RSQ(ssq_ckv), cosT, sinT, ssq_x}, EpiBf16{MKV, 2048, 1.f, nullptr, 0.f}};
          pg8::gemm_phase<EpiP1, P1Order>(lds, DM, DM, DM, S, E, wave_s); }
    }
    SEAM(1); TE(1);
    TS(2); if (IN(2)) REPS(2) {
#ifndef P2SUB
#define P2SUB 31
#endif
#ifndef REP_P2SUB
#define REP_P2SUB 0
#endif
#define R2(i) for (int r2 = 0; r2 < (((REP_P2SUB) >> (i)) & 1) + 1; ++r2)
        if (P2SUB & 1) R2(0) for (int uidx = vcu; uidx < BATCH * 16; uidx += G) lru::unit(uidx >> 4, uidx & 15, Z, Y, (rep | r2) ? ssq_dummy : ssq_lru, conv_w, conv_b, lru_wa, lru_ba, lru_wx, lru_bx, lru_lambda, lds, wave_s);
#ifndef P2_MERGED
#define P2_MERGED 1
#endif
#if P2_MERGED
        { struct P2Order { pg8::TileOrder oq, okv; int nq, c, G; const bf16_t* mkv; const bf16_t* wmq; const bf16_t* wmo;
              __device__ bool next(int i, pg8::Unit& u) const {
                  if (i < nq) { oq.next(i, u); u.job = 0; u.lda = DINP; u.ldb = QLR; u.nt = QLR / 64; return true; }
                  i -= nq; if (i < 2) { okv.next(i, u); u.job = 1; u.lda = DINP; u.ldb = KVLR; u.nt = KVLR / 64; return true; }
                  i -= 2; if (i >= 2 || c >= 256) return false;
                  const int bh = c >> 2, q = c & 3, b = bh >> 2, h = bh & 3; u.wait = nullptr; u.done = nullptr; u.nt = 4;
                  if (i == 0) { u.pm = 0; u.pn = q; u.A = (const char*)(mkv + (size_t)(b * 256) * 2048 + h * 256); u.B = (const char*)(wmq + (size_t)(q * 256) * 1024 + h * 256); u.cofs = ((long)b * 1024 + h * 256) * 1024; u.job = 2; u.lda = 2048; u.ldb = 1024; }
                  else { u.pm = q; u.pn = 0; u.A = (const char*)(wmo + (size_t)(q * 256) * 1024 + h * 256); u.B = (const char*)(mkv + (size_t)(b * 256) * 2048 + 1024 + h * 256); u.cofs = (long)b * 1024 * 1024 + h * 256; u.job = 3; u.lda = 1024; u.ldb = 2048; }
                  return true; } };
          P2Order S; S.oq.init(T, 768, G, bx, Z + OFF_CQ, DINP, Wuq_t, QLR); S.okv.init(T, 1024, G, (bx + 128) % G, Z + OFF_CKV, DINP, Wukv_t, KVLR);
          S.nq = (384 - bx + G - 1) / G; S.c = vcu; S.G = G; S.mkv = MKV; S.wmq = Wmq_b; S.wmo = Wmo_t;
          EpiP2 E{EpiQ{Qb, ssq_cq, cosT, sinT}, EpiBf16{KVb, 1024, 1.f, ssq_ckv, 1.f / KVLR}, EpiBf16{WQK, 1024, MSCALE, nullptr, 0.f}, EpiBf16{WVO, 1024, 1.f, nullptr, 0.f}};
          pg8::gemm_phase_v<EpiP2, P2Order>(lds, S, E, wave_s); }
#else
        if (P2SUB & 2) R2(1) { pg8::TileOrder S; S.init(T, 768, G, bx, Z + OFF_CQ, DINP, Wuq_t, QLR); EpiQ E{Qb, ssq_cq, cosT, sinT};
          pg8::gemm_phase<EpiQ, pg8::TileOrder>(lds, DINP, QLR, QLR, S, E, wave_s); }
        if (P2SUB & 4) R2(2) { pg8::TileOrder S; S.init(T, 1024, G, (bx + 128) % G, Z + OFF_CKV, DINP, Wukv_t, KVLR); EpiBf16 E{KVb, 1024, 1.f, ssq_ckv, 1.f / KVLR};
          pg8::gemm_phase<EpiBf16, pg8::TileOrder>(lds, DINP, KVLR, KVLR, S, E, wave_s); }
        struct FormQK { int G, c; const bf16_t* mkv; const bf16_t* W;
            __device__ bool next(int i, pg8::Unit& u) const { const int L = i * G + c; if (L >= 256) return false; const int bh = L >> 2, q = L & 3, b = bh >> 2, h = bh & 3;
                u.pm = 0; u.pn = q; u.A = (const char*)(mkv + (size_t)(b * 256) * 2048 + h * 256); u.B = (const char*)(W + (size_t)(q * 256) * 1024 + h * 256); u.cofs = ((long)b * 1024 + h * 256) * 1024; u.job = 0; u.wait = nullptr; u.done = nullptr; return true; } };
        struct FormVO { int G, c; const bf16_t* mkv; const bf16_t* W;
            __device__ bool next(int i, pg8::Unit& u) const { const int L = i * G + c; if (L >= 256) return false; const int bh = L >> 2, q = L & 3, b = bh >> 2, h = bh & 3;
                u.pm = q; u.pn = 0; u.A = (const char*)(W + (size_t)(q * 256) * 1024 + h * 256); u.B = (const char*)(mkv + (size_t)(b * 256) * 2048 + 1024 + h * 256); u.cofs = (long)b * 1024 * 1024 + h * 256; u.job = 0; u.wait = nullptr; u.done = nullptr; return true; } };
        if (P2SUB & 8) R2(3) { FormQK S{G, vcu, MKV, Wmq_b}; EpiBf16 E{WQK, 1024, MSCALE, nullptr, 0.f}; pg8::gemm_phase<EpiBf16, FormQK>(lds, 2048, 1024, 256, S, E, wave_s); }
        if (P2SUB & 16) R2(3) { FormVO S{G, vcu, MKV, Wmo_t}; EpiBf16 E{WVO, 1024, 1.f, nullptr, 0.f}; pg8::gemm_phase<EpiBf16, FormVO>(lds, 1024, 2048, 256, S, E, wave_s); }
#endif
    }
    SEAM(2); TE(2);
    TS(3); if (IN(3)) REPS(3) {
        for (int it = vcu; it < BATCH * 4 * 4; it += G) { const int bh = it >> 2, xq = it & 3, b = bh >> 2, h = bh & 3;
            mla::block(b, h, xq, Qb, KVb, KPE, Y, RSQ(ssq_mla), (char*)lds_raw, wave_s);
            mla::block(b, h, 7 - xq, Qb, KVb, KPE, Y, RSQ(ssq_mla), (char*)lds_raw, wave_s); }
    }
    SEAM(3); TE(3);
#ifndef CHAIN_TAIL
#define CHAIN_TAIL 0
#endif
#if CHAIN_TAIL
    TS(5); if (IN(5)) {
        unsigned* dn = ctl + CW_DONE;
        { pg8::TileOrder S; S.init(T, DM, G, bx, Y, DM, Wout_t, DM);
          EpiNormResMid E{nullptr, XN, nullptr, g_post_mix, XN, ssq_h1, slots_p, ctl + CW_SEAM, false, ssq_lru, ssq_mla};
          pg8::gemm_phase<EpiNormResMid, pg8::TileOrder>(lds, DM, DM, DM, S, E, wave_s); }
        if (!grouped) xcd_barrier(bar, wave_s); else xcd_barrier(gbar, wave_s);
        { ChainOrder S; S.o.init(T, DM, G, bx, XN, DM, WQK, DM, (size_t)DM * DM * 2); S.wt_base = nullptr; S.dn_base = dn + SEAM_BANK;
          EpiSoftmax E{Pb, ssq_h1, true};
          pg8::gemm_phase<EpiSoftmax, ChainOrder, true, true, true>(lds, DM, DM, DM, S, E, wave_s); }
        { ChainOrder S; S.o.init(T, DM, G, bx, Pb, DM, WVO, DM, (size_t)DM * DM * 2); S.wt_base = dn + SEAM_BANK; S.dn_base = dn + 2 * SEAM_BANK;
          EpiNormRes E{nullptr, XN, nullptr, g_post_mem, XN, ssq_h2, slots_p + (size_t)4 * T, ctl + CW_SEAM + SEAM_BANK, true, nullptr, nullptr};
          pg8::gemm_phase<EpiNormRes, ChainOrder, true, true, true>(lds, DM, DM, DM, S, E, wave_s); }
        { ChainOrder S; S.o.init(T, 2 * DFF, G, bx, XN, DM, Wgu_t, DM); S.wt_base = dn + 2 * SEAM_BANK; S.dn_base = nullptr;
          EpiSwiGLU E{Fb, ssq_h2};
          pg8::gemm_phase<EpiSwiGLU, ChainOrder, true, true, true>(lds, DM, DM, DM, S, E, wave_s); } }
    if (IN(5) && IN(11)) { if (!grouped) xcd_barrier(bar, wave_s); else xcd_barrier(gbar, wave_s); } TE(5); TE(7); TE(8); TE(10);
#else
    TS(5); if (IN(5)) REPS(5) { pg8::TileOrder S; S.init(T, DM, G, bx, Y, DM, Wout_t, DM);
        EpiNormResMid E{nullptr, XN, nullptr, g_post_mix, rep ? (bf16_t*)PRE : XN, RSQ(ssq_h1), slots_p, ctl + CW_SEAM, false, ssq_lru, ssq_mla};
        pg8::gemm_phase<EpiNormResMid, pg8::TileOrder>(lds, DM, DM, DM, S, E, wave_s); }
    SEAM(5); TE(5);
    TS(7); if (IN(7)) REPS(7) { pg8::TileOrder S; S.init(T, DM, G, bx, XN, DM, WQK, DM, (size_t)DM * DM * 2); EpiSoftmax E{Pb, ssq_h1, false}; pg8::gemm_phase<EpiSoftmax, pg8::TileOrder>(lds, DM, DM, DM, S, E, wave_s); }
    SEAM(7); TE(7);
    TS(8); if (IN(8)) REPS(8) { pg8::TileOrder S; S.init(T, DM, G, bx, Pb, DM, WVO, DM, (size_t)DM * DM * 2); EpiNormRes E{nullptr, XN, nullptr, g_post_mem, rep ? (bf16_t*)PRE : XN, RSQ(ssq_h2), slots_p + (size_t)4 * T, ctl + CW_SEAM + SEAM_BANK, false, nullptr, nullptr};
        pg8::gemm_phase<EpiNormRes, pg8::TileOrder>(lds, DM, DM, DM, S, E, wave_s); }
    SEAM(8); TE(8);
#ifdef COLD10
    if (IN(10)) { for (int m = gw * 4; m < T; m += NGW * 4) rms_rows_to_bf16<4, true>(x_in + (size_t)m * DM, g_pre_mix, (bf16_t*)PRE + (size_t)m * DM, nullptr, lane);
                  for (int m = gw * 4; m < T; m += NGW * 4) rms_rows_to_bf16<4, true>(x_in + (size_t)m * DM, g_pre_mix, (bf16_t*)PRE + (size_t)(T + m) * DM, nullptr, lane); xcd_barrier(gbar, wave_s); }
#endif
    TS(10); if (IN(10)) REPS(10) { pg8::TileOrder S; S.init(T, 2 * DFF, G, bx, XN, DM, Wgu_t, DM); EpiSwiGLU E{Fb, ssq_h2}; pg8::gemm_phase<EpiSwiGLU, pg8::TileOrder, ALIGN_P10>(lds, DM, DM, DM, S, E, wave_s); }
    SEAM(10); TE(10);
#endif
    TS(11); if (IN(11)) REPS(11) { pg8::TileOrder S; S.init(T, DM, G, bx, Fb, DFF, Wdown_t, DFF); EpiNormRes E{nullptr, XN, rep ? PRE : out_p, g_post_ffn, nullptr, nullptr, slots_p + (size_t)8 * T, ctl + CW_SEAM + 2 * SEAM_BANK, false, nullptr, nullptr};
        pg8::gemm_phase<EpiNormRes, pg8::TileOrder>(lds, DFF, DFF, DFF, S, E, wave_s); }
    TE(11);
#ifdef CLKPROBE
    if ((SPIN_LO) >= 0) { const unsigned long long dt = ((tc1 - tc0) * 1000ull) / (ts1 - ts0), t2 = __builtin_amdgcn_s_memrealtime();
#else
    if ((SPIN_LO) >= 0) { const unsigned long long dt = ts1 - ts0, t2 = __builtin_amdgcn_s_memrealtime();
#endif
        while (__builtin_amdgcn_s_memrealtime() - t2 < dt) __builtin_amdgcn_s_sleep(8); }
#undef IN
#undef SEAM
}

#undef tid
#undef lane
#undef wave
#undef gw
#undef NGW
#undef x_in
#undef ssq_h1
#undef ssq_h2
#undef ssq_dummy
#undef ssq_x
#undef slots_p
#undef mem
#undef positions
#undef g_pre_mix
#undef w_in
#undef conv_w
#undef conv_b
#undef lru_wa
#undef lru_ba
#undef lru_wx
#undef lru_bx
#undef lru_lambda
#undef g_q_lat
#undef w_uq
#undef g_kv_lat
#undef w_ukv
#undef g_lru_out
#undef g_mla_out
#undef w_out
#undef g_post_mix
#undef g_pre_mem
#undef g_mem_kv
#undef w_mq
#undef w_mk
#undef w_mv
#undef w_mo
#undef g_post_mem
#undef g_pre_ffn
#undef w_gate
#undef w_up
#undef w_down
#undef g_post_ffn
#undef out_p
#undef ctl
#undef ssq_cq
#undef ssq_ckv
#undef ssq_lru
#undef ssq_mla
#undef cosT
#undef sinT
#undef Win_t
#undef Wuq_t
#undef Wukv_t
#undef Wout_t
#undef Wmq_b
#undef Wmkv_t
#undef Wmo_t
#undef Wgu_t
#undef Wdown_t
#undef MN
#undef MKV
#undef WQK
#undef WVO
#undef XN
#undef KPE
#undef Z
#undef Qb
#undef KVb
#undef Y
#undef PRE
#undef Pb
#undef Fb
#ifndef N_LAUNCHES
#define N_LAUNCHES 1
#endif
extern "C" void kernel_launch(void* const* d_in, const int* in_sizes, int n_in, void* d_out, int out_size, void* d_ws, size_t ws_size, hipStream_t stream) {
    static int grid = 0;
    if (grid == 0) {
        if (n_in != 32 || in_sizes[0] != T * DM || out_size != T * DM || ws_size < WS_END) { fprintf(stderr, "kernel_launch: unexpected shapes (n_in %d, in0 %d, out %d, ws %zu)\n", n_in, n_in > 0 ? in_sizes[0] : -1, out_size, ws_size); grid = -1; return; }
        int dev = 0, cus = 0, per_cu = 0;
        (void)hipGetDevice(&dev); (void)hipDeviceGetAttribute(&cus, hipDeviceAttributeMultiprocessorCount, dev);
        if (hipFuncSetAttribute((const void*)hymba_fwd, hipFuncAttributeMaxDynamicSharedMemorySize, LDS_BYTES) != hipSuccess) { fprintf(stderr, "kernel_launch: hipFuncSetAttribute failed\n"); grid = -1; return; }
        if (hipOccupancyMaxActiveBlocksPerMultiprocessor(&per_cu, (const void*)hymba_fwd, NWAVES * 64, LDS_BYTES) != hipSuccess || per_cu < 1) { fprintf(stderr, "kernel_launch: occupancy query says %d\n", per_cu); per_cu = 1; }
        (void)hipGetLastError();
        grid = cus > 0 ? cus : 256;
    }
    if (grid < 0) return;
    (void)hipMemsetAsync((char*)d_ws + WS_CTL, 0, CTL_ZERO_BYTES, stream);
    Args a{};
    for (int i = 0; i < 32; ++i) a.in[i] = d_in[i];
    a.out = (float*)d_out; a.ws = (unsigned char*)d_ws;
#if N_LAUNCHES == 1
    a.ph_lo = 0; a.ph_hi = NPHASE;
    void* kargs[] = {&a};
#ifdef PLAIN_LAUNCH
    (void)kargs; hipLaunchKernelGGL(hymba_fwd, dim3(grid), dim3(NWAVES * 64), LDS_BYTES, stream, a); hipError_t e = hipPeekAtLastError();
#else
    hipError_t e = hipLaunchCooperativeKernel((const void*)hymba_fwd, dim3(grid), dim3(NWAVES * 64), kargs, LDS_BYTES, stream);
#endif
    if (e != hipSuccess) fprintf(stderr, "kernel_launch: cooperative launch failed: %s (grid %d)\n", hipGetErrorString(e), grid);
#else
    for (int p = 0; p < NPHASE; ++p) { a.ph_lo = p; a.ph_hi = p + 1; hipLaunchKernelGGL(hymba_fwd, dim3(grid), dim3(NWAVES * 64), LDS_BYTES, stream, a); }
#endif
}
```

```cpp
#include <hip/hip_runtime.h>
#include <hip/hip_bf16.h>
#include <cstdio>
#include <cstdint>

#define LAS __attribute__((address_space(3)))
#define GAS __attribute__((address_space(1)))
typedef unsigned short bf16_t;
typedef short bf16x8 __attribute__((ext_vector_type(8)));
typedef short s16x4 __attribute__((ext_vector_type(4)));
typedef float f32x4 __attribute__((ext_vector_type(4)));
typedef float f32x2 __attribute__((ext_vector_type(2)));
typedef float f32x16 __attribute__((ext_vector_type(16)));
typedef unsigned u32x4 __attribute__((ext_vector_type(4)));
typedef unsigned u32x2 __attribute__((ext_vector_type(2)));

constexpr int BATCH = 16, SEQ = 2048, DM = 1024, T = BATCH * SEQ;
constexpr int NMEM = 256, TM = BATCH * NMEM;
constexpr int DLRU = 512, DINP = 1792, QLR = 384, KVLR = 256, DFF = 2816;
constexpr int OFF_GATE = 512, OFF_CQ = 1024, OFF_CKV = 1408, OFF_KPE = 1664;
constexpr float EPS = 1e-6f;
constexpr float LOG2E = 1.4426950408889634f;
constexpr float QSCALE = 0.07216878364870322f * LOG2E;
constexpr float MSCALE = 0.0625f * LOG2E;

constexpr size_t MiB = 1u << 20;
constexpr size_t WS_CTL = 0, CTL_ZERO_BYTES = 2 * MiB;
constexpr size_t WS_SSQ = 1 * MiB;
constexpr size_t WS_SLOTS = 2 * MiB;
constexpr int CW_SEAM = 65536, SEAM_BANK = 8192, CW_DONE = CW_SEAM + 3 * SEAM_BANK;
constexpr size_t WS_ROPE = 4 * MiB;
constexpr size_t WS_WIN = 12 * MiB, WS_WUQ = 16 * MiB, WS_WUKV = 17 * MiB, WS_WOUT = 18 * MiB, WS_WMQ = 20 * MiB, WS_WMKV = 22 * MiB,
                 WS_WMO = 26 * MiB, WS_WGU = 28 * MiB, WS_WDOWN = 39 * MiB;
constexpr size_t WS_MN = 46 * MiB, WS_MKV = 54 * MiB, WS_WQK = 70 * MiB, WS_WVO = 102 * MiB, WS_XN = 134 * MiB, WS_KPE = 198 * MiB;
constexpr size_t WS_Z = 202 * MiB, WS_Q = 314 * MiB, WS_KV = 362 * MiB, WS_Y = 426 * MiB;
constexpr size_t WS_PRE = 202 * MiB, WS_P = 330 * MiB, WS_F = 330 * MiB, WS_END = 506 * MiB;
constexpr int CW_BAR = 4096;

constexpr int RING_BYTES = 131072, EPI_OFF = RING_BYTES, EPI_BYTES = 16384, MISC_OFF = EPI_OFF + EPI_BYTES, LDS_BYTES = MISC_OFF + 1024;

__device__ __forceinline__ unsigned cvt_pk_bf16(float lo, float hi) { unsigned r; asm volatile("v_cvt_pk_bf16_f32 %0, %1, %2" : "=v"(r) : "v"(lo), "v"(hi)); return r; }
__device__ __forceinline__ float bf2f(unsigned short v) { return __uint_as_float((unsigned)v << 16); }
__device__ __forceinline__ float bflo(unsigned w) { return __uint_as_float(w << 16); }
__device__ __forceinline__ float bfhi(unsigned w) { return __uint_as_float(w & 0xffff0000u); }
__device__ __forceinline__ float wave_sum(float v) {
#pragma unroll
    for (int o = 1; o < 64; o <<= 1) v += __shfl_xor(v, o);
    return v;
}
__device__ __forceinline__ int lane_id() { int l; asm volatile("v_mbcnt_lo_u32_b32 %0, -1, 0\n\tv_mbcnt_hi_u32_b32 %0, -1, %0" : "=v"(l)); return l; }
#define LDS_WAIT() asm volatile("s_waitcnt lgkmcnt(0)" ::: "memory")
#define VM_WAIT() asm volatile("s_waitcnt vmcnt(0)" ::: "memory")

namespace pg8 {
constexpr int BM = 256, BK = 64, HALF = 128, HTB = HALF * BK * 2, STAGE_BYTES = 8 * HTB, NXCD = 8, WGM = 8;
__host__ __device__ __forceinline__ int lds_byte(int r, int c) { const int st = (r >> 4) * 2 + (c >> 5), rr = r & 15, cc = c & 31, ob = rr * 64 + cc * 2; return st * 1024 + (ob ^ (((ob >> 9) & 1) << 5)); }
__host__ __device__ __forceinline__ void stage_rc(int b, int& R, int& C) { const int st = b / 1024, sb = b % 1024, swz = sb ^ (((sb >> 9) & 1) << 5); R = (st >> 1) * 16 + swz / 64; C = (st & 1) * 32 + (swz % 64) / 2; }
__host__ __device__ __forceinline__ int perm32(int rho) { const int n = rho >> 4, i = rho & 15; return 8 * (i >> 2) + 4 * n + (i & 3); }

struct Unit { int pm, pn; const char* A; const char* B; long cofs; int job; unsigned* wait; unsigned* done; int lda, ldb, nt; };

struct TileOrder {
    int nM, nN, nwg, G, c; const char* A; const char* B; size_t tA, tB, bB;
    __device__ void init(int M, int N, int G_, int c_, const void* A_, int lda, const void* B_, int ldb, size_t batchB_bytes = 0) {
        nM = M / BM; nN = N / BM; nwg = nM * nN; G = G_; c = c_; A = (const char*)A_; B = (const char*)B_; tA = (size_t)BM * lda * 2; tB = (size_t)BM * ldb * 2; bB = batchB_bytes; }
    __device__ bool next(int i, Unit& u) const {
        const long L = (long)i * G + c; if (L >= nwg) return false;
        int wgid = (int)L; { const int q = nwg / NXCD, r = nwg % NXCD, xcd = wgid % NXCD, off = wgid / NXCD; wgid = (xcd < r ? xcd * (q + 1) : r * (q + 1) + (xcd - r) * q) + off; }
        const int nig = WGM * nN, gid = wgid / nig, fm = gid * WGM, gsz = (nM - fm) < WGM ? (nM - fm) : WGM;
        u.pm = fm + ((wgid % nig) % gsz); u.pn = (wgid % nig) / gsz; u.A = A + (size_t)u.pm * tA; u.B = B + (size_t)u.pn * tB + (size_t)(u.pm >> 3) * bB; u.cofs = 0; u.job = 0; u.wait = nullptr; u.done = nullptr; return true;
    }
};

__device__ __forceinline__ void chain_wait(const Unit& u) {
    if (u.wait) { unsigned sp = 0; while ((unsigned)__builtin_amdgcn_readfirstlane(__hip_atomic_load(u.wait, __ATOMIC_RELAXED, __HIP_MEMORY_SCOPE_AGENT)) < 4u) { __builtin_amdgcn_s_sleep(1); if (++sp > (1u << 22)) break; }
    }
}
__device__ __forceinline__ void chain_publish(const Unit& u, int wid) {
    if (u.done) { asm volatile("s_waitcnt vmcnt(0)\n\ts_barrier" ::: "memory");
        if (wid == 0 && lane_id() == 0) __hip_atomic_fetch_add(u.done, 1u, __ATOMIC_RELAXED, __HIP_MEMORY_SCOPE_AGENT); }
}
template <class Epi, class Sched, bool ALIGN_EPI = true, bool SP2 = true, bool CHAIN = false>
__device__ __forceinline__ void gemm_phase(LAS unsigned char* lds, const int lda, const int ldb, const int K, const Sched& S, const Epi& E, const int wv) {
    int lane = lane_id(); asm volatile("" : "+v"(lane));
    const int wid = wv, tid = wv * 64 + lane, wr = wid >> 2, wc = wid & 3, fr = lane & 15, fq = lane >> 4;
    const int nt = K / BK;
    unsigned voffA[2], voffB[2];
#pragma unroll
    for (int i = 0; i < 2; ++i) { int R, C; stage_rc(tid * 16 + i * 8192, R, C); const int Rb = Epi::PERM ? ((R & ~31) + perm32(R & 31)) : R;
        voffA[i] = (unsigned)(R * lda + C) * 2u; voffB[i] = (unsigned)(Rb * ldb + C) * 2u; }
    const size_t kstep = (size_t)(BK * 2);
    const size_t hstepA = (size_t)HALF * lda * 2, hstepB = (size_t)HALF * ldb * 2;
    const unsigned ldsw = (unsigned)wid * 1024u;
    const int aoff = lds_byte(wr * 64 + fr, fq * 8), boff = lds_byte(wc * 32 + fr, fq * 8);
#define PG8_SA(b, h) (((b) * 2 + (h)) * HTB)
#define PG8_SB(b, h) ((4 + (b) * 2 + (h)) * HTB)
#define PG8_STAGE_(bufoff, gbase, voff, AUX) do { _Pragma("unroll") for (int _i = 0; _i < 2; ++_i) \
        __builtin_amdgcn_global_load_lds((const unsigned*)((const char*)(gbase) + (voff)[_i]), (LAS unsigned*)(lds + (bufoff) + ldsw + _i * 8192), 16, 0, AUX); } while (0)
#define PG8_STAGE(bufoff, gbase, voff) PG8_STAGE_(bufoff, gbase, voff, 0)
#define PG8_STAGEA(bufoff, gbase, voff) do { if constexpr (CHAIN) PG8_STAGE_(bufoff, gbase, voff, 16); else PG8_STAGE_(bufoff, gbase, voff, 0); } while (0)
#define PG8_LDA(dst, b, h) do { _Pragma("unroll") for (int m = 0; m < 4; ++m) _Pragma("unroll") for (int k = 0; k < 2; ++k) dst[m][k] = *(const LAS bf16x8*)(lds + PG8_SA(b, h) + aoff + m * 2048 + k * 1024); } while (0)
#define PG8_LDB(dst, b, h) do { _Pragma("unroll") for (int n = 0; n < 2; ++n) _Pragma("unroll") for (int k = 0; k < 2; ++k) dst[n][k] = *(const LAS bf16x8*)(lds + PG8_SB(b, h) + boff + n * 2048 + k * 1024); } while (0)
#define PG8_MMA(ai, bj, At, Bt) do { __builtin_amdgcn_s_setprio(1); _Pragma("unroll") for (int m = 0; m < 4; ++m) _Pragma("unroll") for (int n = 0; n < 2; ++n) _Pragma("unroll") for (int k = 0; k < 2; ++k) \
        acc[ai][bj][m][n] = __builtin_amdgcn_mfma_f32_16x16x32_bf16(Bt[n][k], At[m][k], acc[ai][bj][m][n], 0, 0, 0); __builtin_amdgcn_s_setprio(0); } while (0)
#define PG8_WAIT_V(n) asm volatile("s_waitcnt vmcnt(" #n ")" ::: "memory")
#define PG8_WAIT_L(n) asm volatile("s_waitcnt lgkmcnt(" #n ")" ::: "memory")
#define PG8_BAR __builtin_amdgcn_s_barrier()
#define PG8_SCHED __builtin_amdgcn_sched_barrier(0)
    Unit cur, nxt; int ui = 0;
    if (!S.next(0, cur)) return;
    if constexpr (Epi::MIDK) { if (E.midk_on(cur)) E.prep(cur, lds, wid, 0); }
    if constexpr (CHAIN) chain_wait(cur);
    f32x4 acc[2][2][4][2];
#pragma unroll
    for (int a = 0; a < 2; ++a)
#pragma unroll
        for (int b = 0; b < 2; ++b)
#pragma unroll
            for (int m = 0; m < 4; ++m)
#pragma unroll
                for (int n = 0; n < 2; ++n) acc[a][b][m][n] = (f32x4){0.f, 0.f, 0.f, 0.f};
    bf16x8 At[4][2], B0[2][2], B1[2][2];
    const char* cA = cur.A; const char* cB = cur.B;
    static_assert(SP2, "only the SP2 loop is kept");
    PG8_STAGE(PG8_SB(0, 0), cB, voffB); PG8_STAGE(PG8_SB(0, 1), cB + hstepB, voffB); PG8_STAGEA(PG8_SA(0, 0), cA, voffA); PG8_STAGEA(PG8_SA(0, 1), cA + hstepA, voffA);
    if (wr == 1) PG8_BAR;
    PG8_WAIT_V(2); PG8_BAR;
    PG8_STAGE(PG8_SB(1, 0), cB + kstep, voffB); PG8_STAGEA(PG8_SA(1, 0), cA + kstep, voffA); PG8_STAGE(PG8_SB(1, 1), cB + hstepB + kstep, voffB);
    PG8_WAIT_V(6); PG8_BAR;
    for (;;) {
        const bool has_next = S.next(ui + 1, nxt);
        const char* nA = has_next ? nxt.A : cA; const char* nB = has_next ? nxt.B : cB;
        for (int t = 0; t < nt; t += 2) {
            if constexpr (Epi::MIDK) { if (t == Epi::TSPLIT && E.midk_on(cur)) E.midk(acc, lds, ui & 1, wr); }
            const bool last = (t == nt - 2);
            if constexpr (CHAIN) { if (last && has_next) chain_wait(nxt); }
            const char* a1 = cA + (size_t)(t + 1) * kstep;
            const char* a2 = last ? nA : cA + (size_t)(t + 2) * kstep; const char* b2 = last ? nB : cB + (size_t)(t + 2) * kstep;
            const char* a3 = a2 + kstep; const char* b3 = b2 + kstep;
            PG8_LDB(B0, 0, 0); PG8_LDB(B1, 0, 1); PG8_SCHED; PG8_LDA(At, 0, 0); PG8_STAGEA(PG8_SA(1, 1), a1 + hstepA, voffA);
            PG8_WAIT_V(8); PG8_WAIT_L(0); PG8_BAR; PG8_MMA(0, 0, At, B0); PG8_MMA(0, 1, At, B1); PG8_BAR; PG8_SCHED;
            PG8_LDA(At, 0, 1); PG8_STAGE(PG8_SB(0, 0), b2, voffB); PG8_STAGE(PG8_SB(0, 1), b2 + hstepB, voffB); PG8_STAGEA(PG8_SA(0, 0), a2, voffA);
            PG8_WAIT_V(8); PG8_WAIT_L(0); PG8_BAR; PG8_MMA(1, 0, At, B0); PG8_MMA(1, 1, At, B1); PG8_BAR; PG8_SCHED;
            PG8_LDB(B0, 1, 0); PG8_LDB(B1, 1, 1); PG8_SCHED; PG8_LDA(At, 1, 0); PG8_STAGEA(PG8_SA(0, 1), a2 + hstepA, voffA);
            PG8_WAIT_V(8); PG8_WAIT_L(0); PG8_BAR; PG8_MMA(0, 0, At, B0); PG8_MMA(0, 1, At, B1); PG8_BAR; PG8_SCHED;
            PG8_LDA(At, 1, 1); PG8_STAGE(PG8_SB(1, 0), b3, voffB); PG8_STAGE(PG8_SB(1, 1), b3 + hstepB, voffB); PG8_STAGEA(PG8_SA(1, 0), a3, voffA);
            PG8_WAIT_V(8); PG8_WAIT_L(0); PG8_BAR; PG8_MMA(1, 0, At, B0); PG8_MMA(1, 1, At, B1); PG8_BAR; PG8_SCHED;
        }
        if constexpr (ALIGN_EPI) { if (wr == 0) PG8_BAR; }
        E(acc, cur, wr, wc, fr, fq, lds, wid, ui & 1);
        if constexpr (CHAIN) chain_publish(cur, wid);
        if (!has_next) break;
        if constexpr (Epi::MIDK) { if (E.midk_on(nxt)) E.prep(nxt, lds, wid, (ui + 1) & 1); }
#pragma unroll
        for (int a = 0; a < 2; ++a)
#pragma unroll
            for (int b = 0; b < 2; ++b)
#pragma unroll
                for (int m = 0; m < 4; ++m)
#pragma unroll
                    for (int n = 0; n < 2; ++n) acc[a][b][m][n] = (f32x4){0.f, 0.f, 0.f, 0.f};
        cur = nxt; cA = nA; cB = nB; ++ui;
        if constexpr (ALIGN_EPI) { if (wr == 1) PG8_BAR; }
    }
    PG8_WAIT_V(0);
    if constexpr (!ALIGN_EPI) { if (wr == 0) PG8_BAR; }
    PG8_BAR;
#undef PG8_SA
#undef PG8_SB
#undef PG8_STAGE
#undef PG8_STAGE_
#undef PG8_STAGEA
#undef PG8_LDA
#undef PG8_LDB
#undef PG8_MMA
#undef PG8_WAIT_V
#undef PG8_WAIT_L
#undef PG8_BAR
#undef PG8_SCHED
}
template <class Epi, class Sched>
__device__ __forceinline__ void gemm_phase_v(LAS unsigned char* lds, const Sched& S, const Epi& E, const int wv) {
    constexpr bool ALIGN_EPI = true, SP2 = true, CHAIN = false;
    int lane = lane_id(); asm volatile("" : "+v"(lane));
    const int wid = wv, tid = wv * 64 + lane, wr = wid >> 2, wc = wid & 3, fr = lane & 15, fq = lane >> 4;
    unsigned RA2[2], RB2[2], C2[2];
#pragma unroll
    for (int i = 0; i < 2; ++i) { int R, C; stage_rc(tid * 16 + i * 8192, R, C); const int Rb = Epi::PERM ? ((R & ~31) + perm32(R & 31)) : R;
        RA2[i] = (unsigned)R * 2u; RB2[i] = (unsigned)Rb * 2u; C2[i] = (unsigned)C * 2u; }
    const size_t kstep = (size_t)(BK * 2);
    const unsigned ldsw = (unsigned)wid * 1024u;
    const int aoff = lds_byte(wr * 64 + fr, fq * 8), boff = lds_byte(wc * 32 + fr, fq * 8);
#define PG8_SA(b, h) (((b) * 2 + (h)) * HTB)
#define PG8_SB(b, h) ((4 + (b) * 2 + (h)) * HTB)
#define PG8_STAGE_(bufoff, gbase, voff, AUX) do { _Pragma("unroll") for (int _i = 0; _i < 2; ++_i) \
        __builtin_amdgcn_global_load_lds((const unsigned*)((const char*)(gbase) + (voff)[_i]), (LAS unsigned*)(lds + (bufoff) + ldsw + _i * 8192), 16, 0, AUX); } while (0)
#define PG8_STAGEV(bufoff, gbase, R2, ld) do { _Pragma("unroll") for (int _i = 0; _i < 2; ++_i) \
        __builtin_amdgcn_global_load_lds((const unsigned*)((const char*)(gbase) + ((R2)[_i] * (unsigned)(ld) + C2[_i])), (LAS unsigned*)(lds + (bufoff) + ldsw + _i * 8192), 16, 0, 0); } while (0)
#define PG8_LDA(dst, b, h) do { _Pragma("unroll") for (int m = 0; m < 4; ++m) _Pragma("unroll") for (int k = 0; k < 2; ++k) dst[m][k] = *(const LAS bf16x8*)(lds + PG8_SA(b, h) + aoff + m * 2048 + k * 1024); } while (0)
#define PG8_LDB(dst, b, h) do { _Pragma("unroll") for (int n = 0; n < 2; ++n) _Pragma("unroll") for (int k = 0; k < 2; ++k) dst[n][k] = *(const LAS bf16x8*)(lds + PG8_SB(b, h) + boff + n * 2048 + k * 1024); } while (0)
#define PG8_MMA(ai, bj, At, Bt) do { __builtin_amdgcn_s_setprio(1); _Pragma("unroll") for (int m = 0; m < 4; ++m) _Pragma("unroll") for (int n = 0; n < 2; ++n) _Pragma("unroll") for (int k = 0; k < 2; ++k) \
        acc[ai][bj][m][n] = __builtin_amdgcn_mfma_f32_16x16x32_bf16(Bt[n][k], At[m][k], acc[ai][bj][m][n], 0, 0, 0); __builtin_amdgcn_s_setprio(0); } while (0)
#define PG8_WAIT_V(n) asm volatile("s_waitcnt vmcnt(" #n ")" ::: "memory")
#define PG8_WAIT_L(n) asm volatile("s_waitcnt lgkmcnt(" #n ")" ::: "memory")
#define PG8_BAR __builtin_amdgcn_s_barrier()
#define PG8_SCHED __builtin_amdgcn_sched_barrier(0)
    Unit cur, nxt; int ui = 0;
    if (!S.next(0, cur)) return;
    if constexpr (Epi::MIDK) { if (E.midk_on(cur)) E.prep(cur, lds, wid, 0); }
    if constexpr (CHAIN) chain_wait(cur);
    f32x4 acc[2][2][4][2];
#pragma unroll
    for (int a = 0; a < 2; ++a)
#pragma unroll
        for (int b = 0; b < 2; ++b)
#pragma unroll
            for (int m = 0; m < 4; ++m)
#pragma unroll
                for (int n = 0; n < 2; ++n) acc[a][b][m][n] = (f32x4){0.f, 0.f, 0.f, 0.f};
    bf16x8 At[4][2], B0[2][2], B1[2][2];
    const char* cA = cur.A; const char* cB = cur.B; int clda = cur.lda, cldb = cur.ldb, nt = cur.nt;
    size_t hstepA = (size_t)HALF * clda * 2, hstepB = (size_t)HALF * cldb * 2;
    static_assert(SP2, "only the SP2 loop is kept");
    PG8_STAGEV(PG8_SB(0, 0), cB, RB2, cldb); PG8_STAGEV(PG8_SB(0, 1), cB + hstepB, RB2, cldb); PG8_STAGEV(PG8_SA(0, 0), cA, RA2, clda); PG8_STAGEV(PG8_SA(0, 1), cA + hstepA, RA2, clda);
    if (wr == 1) PG8_BAR;
    PG8_WAIT_V(2); PG8_BAR;
    PG8_STAGEV(PG8_SB(1, 0), cB + kstep, RB2, cldb); PG8_STAGEV(PG8_SA(1, 0), cA + kstep, RA2, clda); PG8_STAGEV(PG8_SB(1, 1), cB + hstepB + kstep, RB2, cldb);
    PG8_WAIT_V(6); PG8_BAR;
    for (;;) {
        const bool has_next = S.next(ui + 1, nxt);
        const char* nA = has_next ? nxt.A : cA; const char* nB = has_next ? nxt.B : cB; const int nlda = has_next ? nxt.lda : clda, nldb = has_next ? nxt.ldb : cldb;
        const size_t nhA = (size_t)HALF * nlda * 2, nhB = (size_t)HALF * nldb * 2;
        for (int t = 0; t < nt; t += 2) {
            if constexpr (Epi::MIDK) { if (t == Epi::TSPLIT && E.midk_on(cur)) E.midk(acc, lds, ui & 1, wr); }
            const bool last = (t == nt - 2);
            if constexpr (CHAIN) { if (last && has_next) chain_wait(nxt); }
            const char* a1 = cA + (size_t)(t + 1) * kstep;
            const char* a2 = last ? nA : cA + (size_t)(t + 2) * kstep; const char* b2 = last ? nB : cB + (size_t)(t + 2) * kstep;
            const char* a3 = a2 + kstep; const char* b3 = b2 + kstep;
            const int l2a = last ? nlda : clda, l2b = last ? nldb : cldb; const size_t h2A = last ? nhA : hstepA, h2B = last ? nhB : hstepB;
            PG8_LDB(B0, 0, 0); PG8_LDB(B1, 0, 1); PG8_SCHED; PG8_LDA(At, 0, 0); PG8_STAGEV(PG8_SA(1, 1), a1 + hstepA, RA2, clda);
            PG8_WAIT_V(8); PG8_WAIT_L(0); PG8_BAR; PG8_MMA(0, 0, At, B0); PG8_MMA(0, 1, At, B1); PG8_BAR; PG8_SCHED;
            PG8_LDA(At, 0, 1); PG8_STAGEV(PG8_SB(0, 0), b2, RB2, l2b); PG8_STAGEV(PG8_SB(0, 1), b2 + h2B, RB2, l2b); PG8_STAGEV(PG8_SA(0, 0), a2, RA2, l2a);
            PG8_WAIT_V(8); PG8_WAIT_L(0); PG8_BAR; PG8_MMA(1, 0, At, B0); PG8_MMA(1, 1, At, B1); PG8_BAR; PG8_SCHED;
            PG8_LDB(B0, 1, 0); PG8_LDB(B1, 1, 1); PG8_SCHED; PG8_LDA(At, 1, 0); PG8_STAGEV(PG8_SA(0, 1), a2 + h2A, RA2, l2a);
            PG8_WAIT_V(8); PG8_WAIT_L(0); PG8_BAR; PG8_MMA(0, 0, At, B0); PG8_MMA(0, 1, At, B1); PG8_BAR; PG8_SCHED;
            PG8_LDA(At, 1, 1); PG8_STAGEV(PG8_SB(1, 0), b3, RB2, l2b); PG8_STAGEV(PG8_SB(1, 1), b3 + h2B, RB2, l2b); PG8_STAGEV(PG8_SA(1, 0), a3, RA2, l2a);
            PG8_WAIT_V(8); PG8_WAIT_L(0); PG8_BAR; PG8_MMA(1, 0, At, B0); PG8_MMA(1, 1, At, B1); PG8_BAR; PG8_SCHED;
        }
        if constexpr (ALIGN_EPI) { if (wr == 0) PG8_BAR; }
        E(acc, cur, wr, wc, fr, fq, lds, wid, ui & 1);
        if constexpr (CHAIN) chain_publish(cur, wid);
        if (!has_next) break;
        if constexpr (Epi::MIDK) { if (E.midk_on(nxt)) E.prep(nxt, lds, wid, (ui + 1) & 1); }
#pragma unroll
        for (int a = 0; a < 2; ++a)
#pragma unroll
            for (int b = 0; b < 2; ++b)
#pragma unroll
                for (int m = 0; m < 4; ++m)
#pragma unroll
                    for (int n = 0; n < 2; ++n) acc[a][b][m][n] = (f32x4){0.f, 0.f, 0.f, 0.f};
        cur = nxt; cA = nA; cB = nB; ++ui; clda = nlda; cldb = nldb; hstepA = nhA; hstepB = nhB; nt = cur.nt;
        if constexpr (ALIGN_EPI) { if (wr == 1) PG8_BAR; }
    }
    PG8_WAIT_V(0);
    if constexpr (!ALIGN_EPI) { if (wr == 0) PG8_BAR; }
    PG8_BAR;
#undef PG8_SA
#undef PG8_SB
#undef PG8_STAGE_
#undef PG8_STAGEV
#undef PG8_LDA
#undef PG8_LDB
#undef PG8_MMA
#undef PG8_WAIT_V
#undef PG8_WAIT_L
#undef PG8_BAR
#undef PG8_SCHED
}
}

typedef f32x4 Acc[2][2][4][2];
__device__ __forceinline__ void store16(void* p, u32x4 v, bool wt) {
    if (wt) asm volatile("global_store_dwordx4 %0, %1, off sc1\n\ts_nop 1" :: "v"(p), "v"(v) : "memory"); else *(u32x4*)p = v;
}
__device__ __forceinline__ void ssq_rows_atomic(const Acc& acc, float* ssq, int row_base  , int bjmask, int fq, int lane) {
#pragma unroll
    for (int ai = 0; ai < 2; ++ai) {
        float s[4];
#pragma unroll
        for (int m = 0; m < 4; ++m) { float q = 0.f;
#pragma unroll
            for (int bj = 0; bj < 2; ++bj) if (bjmask & (1 << bj))
#pragma unroll
                for (int n = 0; n < 2; ++n) { const f32x4 x = acc[ai][bj][m][n]; q += (x[0] * x[0] + x[1] * x[1]) + (x[2] * x[2] + x[3] * x[3]); }
            q += __shfl_xor(q, 16); q += __shfl_xor(q, 32); s[m] = q; }
        const float v = fq == 0 ? s[0] : fq == 1 ? s[1] : fq == 2 ? s[2] : s[3];
        atomicAdd(ssq + row_base + ai * 128 + lane, v);
    }
}
struct EpiBf16 {
    static constexpr bool PERM = true, MIDK = false;
    bf16_t* O; int ldc; float scale; const float* ssq; float rdim_inv;
    __device__ __forceinline__ void operator()(const Acc& acc, const pg8::Unit& u, int wr, int wc, int fr, int fq, LAS unsigned char*, int, int) const {
        { const int ln_ = lane_id(); fr = ln_ & 15; fq = ln_ >> 4; }
        const int row0 = u.pm * 256 + wr * 64 + fr, col0 = u.pn * 256 + wc * 32 + 8 * fq;
#pragma unroll
        for (int ai = 0; ai < 2; ++ai)
#pragma unroll
            for (int m = 0; m < 4; ++m) { const int row = row0 + ai * 128 + m * 16; float sc = scale;
                if (ssq) sc *= __builtin_amdgcn_rsqf(ssq[row] * rdim_inv + EPS);
                bf16_t* rowp = O + u.cofs + (size_t)row * ldc + col0;
#pragma unroll
                for (int bj = 0; bj < 2; ++bj) { const f32x4 v0 = acc[ai][bj][m][0] * sc, v1 = acc[ai][bj][m][1] * sc;
                    u32x4 w; w.x = cvt_pk_bf16(v0[0], v0[1]); w.y = cvt_pk_bf16(v0[2], v0[3]); w.z = cvt_pk_bf16(v1[0], v1[1]); w.w = cvt_pk_bf16(v1[2], v1[3]);
                    *(u32x4*)(rowp + bj * 128) = w; } }
    }
};
__device__ __forceinline__ void rope8(f32x4& v0, f32x4& v1, const float* cosT, const float* sinT, int row, int i0) {
    const f32x4 c = *(const f32x4*)(cosT + (size_t)row * 32 + i0), s = *(const f32x4*)(sinT + (size_t)row * 32 + i0);
    const f32x4 a = v0, b = v1;
    v0[0] = a[0] * c[0] - a[1] * s[0]; v0[1] = a[1] * c[0] + a[0] * s[0]; v0[2] = a[2] * c[1] - a[3] * s[1]; v0[3] = a[3] * c[1] + a[2] * s[1];
    v1[0] = b[0] * c[2] - b[1] * s[2]; v1[1] = b[1] * c[2] + b[0] * s[2]; v1[2] = b[2] * c[3] - b[3] * s[3]; v1[3] = b[3] * c[3] + b[2] * s[3];
}
struct EpiZ {
    static constexpr bool PERM = true, MIDK = false;
    bf16_t* Z; bf16_t* KPE; float* ssq_cq; float* ssq_ckv; const float* cosT; const float* sinT; const float* ssq_x;
    __device__ __forceinline__ void operator()(Acc& acc, const pg8::Unit& u, int wr, int wc, int fr, int fq, LAS unsigned char*, int, int lane) const {
        { const int ln_ = lane_id(); fr = ln_ & 15; fq = ln_ >> 4; }
        const int row0 = u.pm * 256 + wr * 64 + fr, col0 = u.pn * 256 + wc * 32 + 8 * fq;
        const bool kpe_tile = (u.pn == 6);
#pragma unroll
        for (int ai = 0; ai < 2; ++ai)
#pragma unroll
            for (int m = 0; m < 4; ++m) { const float rsx = __builtin_amdgcn_rsqf(ssq_x[row0 + ai * 128 + m * 16] * (1.f / DM) + EPS);
#pragma unroll
                for (int bj = 0; bj < 2; ++bj)
#pragma unroll
                    for (int n = 0; n < 2; ++n) acc[ai][bj][m][n] = acc[ai][bj][m][n] * rsx; }
#pragma unroll
        for (int ai = 0; ai < 2; ++ai)
#pragma unroll
            for (int m = 0; m < 4; ++m) { const int row = row0 + ai * 128 + m * 16; bf16_t* rowp = Z + (size_t)row * DINP + col0;
#pragma unroll
                for (int bj = 0; bj < 2; ++bj) { f32x4 v0 = acc[ai][bj][m][0], v1 = acc[ai][bj][m][1];
                    if (kpe_tile && bj == 1) {
                        if (wc < 2) { rope8(v0, v1, cosT, sinT, row, 16 * (wc & 1) + 4 * fq);
                            u32x4 w; w.x = cvt_pk_bf16(v0[0], v0[1]); w.y = cvt_pk_bf16(v0[2], v0[3]); w.z = cvt_pk_bf16(v1[0], v1[1]); w.w = cvt_pk_bf16(v1[2], v1[3]);
                            *(u32x4*)(KPE + (size_t)row * 64 + wc * 32 + 8 * fq) = w; }
                    } else {
                        u32x4 w; w.x = cvt_pk_bf16(v0[0], v0[1]); w.y = cvt_pk_bf16(v0[2], v0[3]); w.z = cvt_pk_bf16(v1[0], v1[1]); w.w = cvt_pk_bf16(v1[2], v1[3]);
                        *(u32x4*)(rowp + bj * 128) = w; } } }
        const int rb = u.pm * 256 + wr * 64; lane = fq * 16 + fr;
        if (u.pn == 4) ssq_rows_atomic(acc, ssq_cq, rb, 3, fq, lane);
        else if (u.pn == 5) { ssq_rows_atomic(acc, ssq_cq, rb, 1, fq, lane); ssq_rows_atomic(acc, ssq_ckv, rb, 2, fq, lane); }
        else if (u.pn == 6) ssq_rows_atomic(acc, ssq_ckv, rb, 1, fq, lane);
    }
};
struct EpiQ {
    static constexpr bool PERM = true, MIDK = false;
    bf16_t* Q; const float* ssq; const float* cosT; const float* sinT;
    __device__ __forceinline__ void operator()(const Acc& acc, const pg8::Unit& u, int wr, int wc, int fr, int fq, LAS unsigned char*, int, int) const {
        { const int ln_ = lane_id(); fr = ln_ & 15; fq = ln_ >> 4; }
        const int row0 = u.pm * 256 + wr * 64 + fr, col0 = u.pn * 256 + wc * 32 + 8 * fq;
        const bool pe = (u.pn == 2);
#pragma unroll
        for (int ai = 0; ai < 2; ++ai)
#pragma unroll
            for (int m = 0; m < 4; ++m) { const int row = row0 + ai * 128 + m * 16;
                const float sc = QSCALE * __builtin_amdgcn_rsqf(ssq[row] * (1.f / QLR) + EPS);
                bf16_t* rowp = Q + (size_t)row * 768 + col0;
#pragma unroll
                for (int bj = 0; bj < 2; ++bj) { f32x4 v0 = acc[ai][bj][m][0] * sc, v1 = acc[ai][bj][m][1] * sc;
                    if (pe) rope8(v0, v1, cosT, sinT, row, 16 * (wc & 1) + 4 * fq);
                    u32x4 w; w.x = cvt_pk_bf16(v0[0], v0[1]); w.y = cvt_pk_bf16(v0[2], v0[3]); w.z = cvt_pk_bf16(v1[0], v1[1]); w.w = cvt_pk_bf16(v1[2], v1[3]);
                    *(u32x4*)(rowp + bj * 128) = w; } }
    }
};
struct EpiF32 {
    static constexpr bool PERM = false, MIDK = false;
    float* O; int ldc;
    __device__ __forceinline__ void operator()(const Acc& acc, const pg8::Unit& u, int wr, int wc, int fr, int fq, LAS unsigned char*, int, int) const {
        { const int ln_ = lane_id(); fr = ln_ & 15; fq = ln_ >> 4; }
        const int row0 = u.pm * 256 + wr * 64 + fr, col0 = u.pn * 256 + wc * 32 + 4 * fq;
#pragma unroll
        for (int ai = 0; ai < 2; ++ai)
#pragma unroll
            for (int m = 0; m < 4; ++m) { float* rowp = O + (size_t)(row0 + ai * 128 + m * 16) * ldc + col0;
#pragma unroll
                for (int bj = 0; bj < 2; ++bj)
#pragma unroll
                    for (int n = 0; n < 2; ++n) *(f32x4*)(rowp + bj * 128 + n * 16) = acc[ai][bj][m][n]; }
    }
};
struct EpiSwiGLU {
    static constexpr bool PERM = true, MIDK = false;
    bf16_t* F; const float* ssq;
    __device__ __forceinline__ void operator()(const Acc& acc, const pg8::Unit& u, int wr, int wc, int fr, int fq, LAS unsigned char*, int, int) const {
        { const int ln_ = lane_id(); fr = ln_ & 15; fq = ln_ >> 4; }
        const int row0 = u.pm * 256 + wr * 64 + fr, col0 = u.pn * 128 + wc * 32 + 8 * fq;
        float sq[2][4];
#pragma unroll
        for (int ai = 0; ai < 2; ++ai)
#pragma unroll
            for (int m = 0; m < 4; ++m) sq[ai][m] = ssq[row0 + ai * 128 + m * 16];
#pragma unroll
        for (int ai = 0; ai < 2; ++ai)
#pragma unroll
            for (int m = 0; m < 4; ++m) { bf16_t* rowp = F + (size_t)(row0 + ai * 128 + m * 16) * DFF + col0; float f[8];
                const float rsc = __builtin_amdgcn_rsqf(sq[ai][m] * (1.f / DM) + EPS);
#pragma unroll
                for (int n = 0; n < 2; ++n)
#pragma unroll
                    for (int e = 0; e < 4; ++e) { const float g = acc[ai][0][m][n][e] * rsc, up = acc[ai][1][m][n][e] * rsc;
                        f[n * 4 + e] = g * __builtin_amdgcn_rcpf(1.f + __builtin_amdgcn_exp2f(-g * LOG2E)) * up; }
                u32x4 w; w.x = cvt_pk_bf16(f[0], f[1]); w.y = cvt_pk_bf16(f[2], f[3]); w.z = cvt_pk_bf16(f[4], f[5]); w.w = cvt_pk_bf16(f[6], f[7]);
                *(u32x4*)rowp = w; }
    }
};
struct EpiSoftmax {
    static constexpr bool PERM = true, MIDK = false;
    bf16_t* P; const float* ssq; bool wt;
    __device__ __forceinline__ void operator()(Acc& acc, const pg8::Unit& u, int wr, int wc, int fr, int fq, LAS unsigned char* lds, int, int) const {
        { const int ln_ = lane_id(); fr = ln_ & 15; fq = ln_ >> 4; }
        LAS float* PM = (LAS float*)(lds + EPI_OFF);
        LAS float* PS = (LAS float*)(lds + EPI_OFF + 4096);
        float sq[2][4];
#pragma unroll
        for (int ai = 0; ai < 2; ++ai)
#pragma unroll
            for (int m = 0; m < 4; ++m) sq[ai][m] = ssq[u.pm * 256 + ai * 128 + wr * 64 + m * 16 + fr];
        float mxr[2][4];
#pragma unroll
        for (int ai = 0; ai < 2; ++ai)
#pragma unroll
            for (int m = 0; m < 4; ++m) { float q = -3.0e38f;
#pragma unroll
                for (int bj = 0; bj < 2; ++bj)
#pragma unroll
                    for (int n = 0; n < 2; ++n) { const f32x4 x = acc[ai][bj][m][n]; q = fmaxf(q, fmaxf(fmaxf(x[0], x[1]), fmaxf(x[2], x[3]))); }
                q = fmaxf(q, __shfl_xor(q, 16)); q = fmaxf(q, __shfl_xor(q, 32)); mxr[ai][m] = q; }
#pragma unroll
        for (int ai = 0; ai < 2; ++ai)
#pragma unroll
            for (int m = 0; m < 4; ++m) { sq[ai][m] = __builtin_amdgcn_rsqf(sq[ai][m] * (1.f / DM) + EPS);
                if (fq == 0) PM[(ai * 128 + wr * 64 + m * 16 + fr) * 4 + wc] = mxr[ai][m] * sq[ai][m]; }
        LDS_WAIT(); __builtin_amdgcn_s_barrier(); asm volatile("" ::: "memory");
#pragma unroll
        for (int ai = 0; ai < 2; ++ai)
#pragma unroll
            for (int m = 0; m < 4; ++m) { const f32x4 t = *(const LAS f32x4*)(PM + (ai * 128 + wr * 64 + m * 16 + fr) * 4);
                const float rm = fmaxf(fmaxf(t[0], t[1]), fmaxf(t[2], t[3])), rsc = sq[ai][m]; float s = 0.f;
#pragma unroll
                for (int bj = 0; bj < 2; ++bj)
#pragma unroll
                    for (int n = 0; n < 2; ++n) { f32x4 x = acc[ai][bj][m][n];
#pragma unroll
                        for (int e = 0; e < 4; ++e) { x[e] = __builtin_amdgcn_exp2f(fmaf(x[e], rsc, -rm)); s += x[e]; }
                        acc[ai][bj][m][n] = x; }
                s += __shfl_xor(s, 16); s += __shfl_xor(s, 32);
                if (fq == 0) PS[(ai * 128 + wr * 64 + m * 16 + fr) * 4 + wc] = s; }
        LDS_WAIT(); __builtin_amdgcn_s_barrier(); asm volatile("" ::: "memory");
        const int row0 = u.pm * 256 + wr * 64 + fr, col0 = u.pn * 256 + wc * 32 + 8 * fq;
#pragma unroll
        for (int ai = 0; ai < 2; ++ai)
#pragma unroll
            for (int m = 0; m < 4; ++m) { const f32x4 t = *(const LAS f32x4*)(PS + (ai * 128 + wr * 64 + m * 16 + fr) * 4);
                const float inv = __builtin_amdgcn_rcpf((t[0] + t[1]) + (t[2] + t[3]));
                bf16_t* rowp = P + (size_t)(row0 + ai * 128 + m * 16) * DM + col0;
#pragma unroll
                for (int bj = 0; bj < 2; ++bj) { const f32x4 v0 = acc[ai][bj][m][0] * inv, v1 = acc[ai][bj][m][1] * inv;
                    u32x4 w; w.x = cvt_pk_bf16(v0[0], v0[1]); w.y = cvt_pk_bf16(v0[2], v0[3]); w.z = cvt_pk_bf16(v1[0], v1[1]); w.w = cvt_pk_bf16(v1[2], v1[3]);
                    store16(rowp + bj * 128, w, wt); } }
    }
};

__device__ __forceinline__ unsigned ag_ld(const unsigned* p) { return __hip_atomic_load(p, __ATOMIC_RELAXED, __HIP_MEMORY_SCOPE_AGENT); }
template <bool MIDK_>
struct EpiNormResT {
    static constexpr bool PERM = true, MIDK = MIDK_; static constexpr int TSPLIT = 8;
    const float* hold_f; const bf16_t* hold_b; float* hout; const float* gpost; bf16_t* xn; float* ssq_next; float* slots; unsigned* cnt;
    bool wt;
    __device__ __forceinline__ bool midk_on(const pg8::Unit&) const { return MIDK_; }
    const float* ssq_a; const float* ssq_b;
    __device__ __forceinline__ void prep(const pg8::Unit& u, LAS unsigned char* lds, int wid, int par) const {
        if (wid < 4) { const int ln = lane_id(), row = wid * 64 + ln; const float sa = ssq_a[u.pm * 256 + row], sb = ssq_b[u.pm * 256 + row];
            const float ra = __builtin_amdgcn_rsqf(sa * (1.f / 512) + EPS), rb = __builtin_amdgcn_rsqf(sb * (1.f / 512) + EPS);
            ((LAS f32x2*)(lds + EPI_OFF + 5120))[par * 256 + row] = (f32x2){ra * __builtin_amdgcn_rcpf(rb), rb}; }
    }
    __device__ __forceinline__ void midk(Acc& acc, LAS unsigned char* lds, int par, int wr) const {
        const int ln = lane_id(), fr = ln & 15; const LAS f32x2* RT = (const LAS f32x2*)(lds + EPI_OFF + 5120) + par * 256;
#pragma unroll
        for (int ai = 0; ai < 2; ++ai)
#pragma unroll
            for (int m = 0; m < 4; ++m) { const float r = RT[ai * 128 + wr * 64 + m * 16 + fr].x;
#pragma unroll
                for (int bj = 0; bj < 2; ++bj)
#pragma unroll
                    for (int n = 0; n < 2; ++n) acc[ai][bj][m][n] = acc[ai][bj][m][n] * r; }
    }
    __device__ __forceinline__ void operator()(Acc& acc, const pg8::Unit& u, int wr, int wc, int fr, int fq, LAS unsigned char* lds, int wid, int par) const {
        const int ln = lane_id(); fr = ln & 15; fq = ln >> 4;
        if constexpr (MIDK_) { const LAS f32x2* RT = (const LAS f32x2*)(lds + EPI_OFF + 5120) + par * 256;
#pragma unroll
            for (int ai = 0; ai < 2; ++ai)
#pragma unroll
                for (int m = 0; m < 4; ++m) { const float r = RT[ai * 128 + wr * 64 + m * 16 + fr].y;
#pragma unroll
                    for (int bj = 0; bj < 2; ++bj)
#pragma unroll
                        for (int n = 0; n < 2; ++n) acc[ai][bj][m][n] = acc[ai][bj][m][n] * r; } }
        LAS float* PT = (LAS float*)(lds + EPI_OFF);
        LAS float* SR = (LAS float*)(lds + EPI_OFF + 4096);
        const int col0 = u.pn * 256 + wc * 32 + 8 * fq;
        f32x4 gv[2][2];
#pragma unroll
        for (int bj = 0; bj < 2; ++bj)
#pragma unroll
            for (int n = 0; n < 2; ++n) gv[bj][n] = *(const f32x4*)(gpost + col0 + bj * 128 + n * 4);
        u32x4 hb[2][4][2];
        if (!hold_f) {
#pragma unroll
            for (int ai = 0; ai < 2; ++ai)
#pragma unroll
                for (int m = 0; m < 4; ++m)
#pragma unroll
                    for (int bj = 0; bj < 2; ++bj) hb[ai][m][bj] = __builtin_nontemporal_load((const u32x4*)(hold_b + (size_t)(u.pm * 256 + ai * 128 + wr * 64 + m * 16 + fr) * DM + col0 + bj * 128)); }
#pragma unroll
        for (int ai = 0; ai < 2; ++ai)
#pragma unroll
            for (int m = 0; m < 4; ++m) { float q = 0.f;
#pragma unroll
                for (int bj = 0; bj < 2; ++bj)
#pragma unroll
                    for (int n = 0; n < 2; ++n) { const f32x4 x = acc[ai][bj][m][n]; q += (x[0] * x[0] + x[1] * x[1]) + (x[2] * x[2] + x[3] * x[3]); }
                q += __shfl_xor(q, 16); q += __shfl_xor(q, 32);
                if (fq == 0) PT[(ai * 128 + wr * 64 + m * 16 + fr) * 4 + wc] = q; }
        LDS_WAIT(); __builtin_amdgcn_s_barrier(); asm volatile("" ::: "memory");
        unsigned* c = cnt + 64 * u.pm;
        if (wid < 4) { const int row = wid * 64 + ln; const f32x4 t = *(const LAS f32x4*)(PT + row * 4); const float sq = (t[0] + t[1]) + (t[2] + t[3]);
            __hip_atomic_store((unsigned*)slots + ((size_t)(u.pm * 256 + row) * 4 + u.pn), __float_as_uint(sq), __ATOMIC_RELAXED, __HIP_MEMORY_SCOPE_AGENT);
            asm volatile("s_waitcnt vmcnt(0)" ::: "memory");
            if (ln == 0) __hip_atomic_fetch_add(c, 1u, __ATOMIC_RELAXED, __HIP_MEMORY_SCOPE_AGENT); }
        if (wid == 0) { unsigned sp = 0;
            while ((unsigned)__builtin_amdgcn_readfirstlane(ag_ld(c)) < 16u) { __builtin_amdgcn_s_sleep(2); if (++sp > (1u << 21)) break; }
            __builtin_amdgcn_fence(__ATOMIC_ACQUIRE, "agent"); }
        asm volatile("s_waitcnt vmcnt(0) lgkmcnt(0)" ::: "memory"); __builtin_amdgcn_s_barrier(); asm volatile("" ::: "memory");
        if (wid < 4) { const int row = wid * 64 + ln; const unsigned* sl = (const unsigned*)slots + (size_t)(u.pm * 256 + row) * 4;
            const float tot = (__uint_as_float(ag_ld(sl)) + __uint_as_float(ag_ld(sl + 1))) + (__uint_as_float(ag_ld(sl + 2)) + __uint_as_float(ag_ld(sl + 3)));
            SR[row] = __builtin_amdgcn_rsqf(tot * (1.f / DM) + EPS); }
        LDS_WAIT(); __builtin_amdgcn_s_barrier(); asm volatile("" ::: "memory");
#pragma unroll
        for (int ai = 0; ai < 2; ++ai) { float s[4];
#pragma unroll
            for (int m = 0; m < 4; ++m) { const int rl = ai * 128 + wr * 64 + m * 16 + fr; const float rs = SR[rl]; const size_t off = (size_t)(u.pm * 256 + rl) * DM + col0; float q = 0.f;
#pragma unroll
                for (int bj = 0; bj < 2; ++bj) { f32x4 h0, h1;
                    if (hold_f) { h0 = *(const f32x4*)(hold_f + off + bj * 128); h1 = *(const f32x4*)(hold_f + off + bj * 128 + 4); }
                    else { const u32x4 hv = hb[ai][m][bj]; h0 = (f32x4){bflo(hv.x), bfhi(hv.x), bflo(hv.y), bfhi(hv.y)}; h1 = (f32x4){bflo(hv.z), bfhi(hv.z), bflo(hv.w), bfhi(hv.w)}; }
                    const f32x4 v0 = h0 + acc[ai][bj][m][0] * rs * gv[bj][0], v1 = h1 + acc[ai][bj][m][1] * rs * gv[bj][1];
                    q += ((v0[0] * v0[0] + v0[1] * v0[1]) + (v0[2] * v0[2] + v0[3] * v0[3])) + ((v1[0] * v1[0] + v1[1] * v1[1]) + (v1[2] * v1[2] + v1[3] * v1[3]));
                    if (hout) { __builtin_nontemporal_store(v0, (f32x4*)(hout + off + bj * 128)); __builtin_nontemporal_store(v1, (f32x4*)(hout + off + bj * 128 + 4)); }
                    if (xn) { u32x4 w; w.x = cvt_pk_bf16(v0[0], v0[1]); w.y = cvt_pk_bf16(v0[2], v0[3]); w.z = cvt_pk_bf16(v1[0], v1[1]); w.w = cvt_pk_bf16(v1[2], v1[3]); store16(xn + off + bj * 128, w, wt); } }
                q += __shfl_xor(q, 16); q += __shfl_xor(q, 32); s[m] = q; }
            if (ssq_next) { const float v = fq == 0 ? s[0] : fq == 1 ? s[1] : fq == 2 ? s[2] : s[3]; atomicAdd(ssq_next + u.pm * 256 + wr * 64 + ai * 128 + ln, v); } }
    }
};
typedef EpiNormResT<false> EpiNormRes;
typedef EpiNormResT<true> EpiNormResMid;
struct ChainOrder {
    pg8::TileOrder o; unsigned* wt_base; unsigned* dn_base;
    __device__ bool next(int i, pg8::Unit& u) const { if (!o.next(i, u)) return false; u.wait = wt_base ? wt_base + 64 * u.pm : nullptr; u.done = dn_base ? dn_base + 64 * u.pm : nullptr; return true; }
};

struct EpiP2 { static constexpr bool PERM = true, MIDK = false; EpiQ eq; EpiBf16 ekv, eqk, evo;
    __device__ __forceinline__ void operator()(Acc& acc, const pg8::Unit& u, int wr, int wc, int fr, int fq, LAS unsigned char* l, int wid, int par) const {
        if (u.job == 0) eq(acc, u, wr, wc, fr, fq, l, wid, par); else if (u.job == 1) ekv(acc, u, wr, wc, fr, fq, l, wid, par);
        else if (u.job == 2) eqk(acc, u, wr, wc, fr, fq, l, wid, par); else evo(acc, u, wr, wc, fr, fq, l, wid, par); } };

struct EpiP1 { static constexpr bool PERM = true, MIDK = false; EpiZ ez; EpiBf16 eb;
    __device__ __forceinline__ void operator()(Acc& acc, const pg8::Unit& u, int wr, int wc, int fr, int fq, LAS unsigned char* l, int wid, int par) const {
        if (u.job == 0) ez(acc, u, wr, wc, fr, fq, l, wid, par); else eb(acc, u, wr, wc, fr, fq, l, wid, par); } };

#define XB_TMO      128
#define XB_XCNT(j)  (256  + 64 * (j))
#define XB_XSUB(j)  (1280 + 64 * (j))
#define XB_XGEN(j)  (2304 + 64 * (j))
#define XB_TOP      3328
#define XB_TOPGEN   3392
#define XCD_BAR_WORDS 3456
#define XB_SPIN_CAP (1u << 20)
__device__ __forceinline__ unsigned xb_ld(unsigned* p)              { return __hip_atomic_load(p, __ATOMIC_RELAXED, __HIP_MEMORY_SCOPE_AGENT); }
__device__ __forceinline__ unsigned xb_add(unsigned* p, unsigned v) { return __hip_atomic_fetch_add(p, v, __ATOMIC_RELAXED, __HIP_MEMORY_SCOPE_AGENT); }
__device__ __forceinline__ unsigned xb_xcc_id() { return (unsigned)__builtin_amdgcn_s_getreg((3 << 11) | 20) & 0xFu; }
#define XB_SPIN(cond, bar) do { unsigned _sp = 0; while (cond) { __builtin_amdgcn_s_sleep(1); \
    if ((++_sp & 255u) == 0u) { if (xb_ld(&(bar)[XB_TMO])) break; if (_sp > XB_SPIN_CAP) { atomicAdd(&(bar)[XB_TMO], 1u); break; } } } } while (0)
struct XcdBarrier { unsigned* bar; unsigned x; volatile LAS unsigned* st; unsigned G; };
__device__ __forceinline__ XcdBarrier xcd_barrier_post(unsigned* bar, volatile LAS unsigned* st, unsigned G) {
    XcdBarrier b; b.bar = bar; b.x = xb_xcc_id(); b.st = st; b.G = G;
    if (threadIdx.x == 0) (void)xb_add(&bar[XB_XCNT(b.x)], 1u);
    return b;
}
__device__ __forceinline__ void xcd_barrier_complete(unsigned* bar, unsigned x, unsigned& nloc, unsigned& nx, const unsigned G) {
    unsigned sum, cnt, mine, sp = 0u;
    for (;;) {
        sum = 0u; cnt = 0u; mine = 0u;
#pragma unroll
        for (unsigned j = 0; j < 16; ++j) { const unsigned c = xb_ld(&bar[XB_XCNT(j)]); sum += c; cnt += (c > 0u) ? 1u : 0u; mine = (j == x) ? c : mine; }
        if (sum == G) break;
        __builtin_amdgcn_s_sleep(1);
        if ((++sp & 255u) == 0u) { if (xb_ld(&bar[XB_TMO])) break; if (sp > XB_SPIN_CAP) { atomicAdd(&bar[XB_TMO], 1u); break; } }
    }
    nloc = mine > 0u ? mine : 1u; nx = cnt > 0u ? cnt : 1u;
}
__device__ __forceinline__ void xcd_barrier(const XcdBarrier& b, const int wv) {
    asm volatile("s_waitcnt vmcnt(0)" ::: "memory");
    __syncthreads();
    if (wv == 0 && lane_id() == 0) {
        unsigned* bar = b.bar;
        __builtin_amdgcn_s_waitcnt(0);
        unsigned nloc = b.st[0], nx = b.st[1];
        if (nloc == 0u) { xcd_barrier_complete(bar, b.x, nloc, nx, b.G); b.st[0] = nloc; b.st[1] = nx; }
        const unsigned old = xb_add(&bar[XB_XSUB(b.x)], 1u);
        const unsigned gen = old / nloc;
        if (old + 1u == (gen + 1u) * nloc) {
            __builtin_amdgcn_fence(__ATOMIC_RELEASE, "agent");
            asm volatile("s_waitcnt vmcnt(0)" ::: "memory");
            const unsigned og = xb_add(&bar[XB_TOP], 1u);
            const unsigned tg = og / nx;
            if (og + 1u == (tg + 1u) * nx) xb_add(&bar[XB_TOPGEN], 1u);
            else XB_SPIN(xb_ld(&bar[XB_TOPGEN]) == tg, bar);
            __builtin_amdgcn_fence(__ATOMIC_ACQUIRE, "agent");
            xb_add(&bar[XB_XGEN(b.x)], 1u);
            asm volatile("s_waitcnt vmcnt(0)" ::: "memory");
        } else {
            XB_SPIN(xb_ld(&bar[XB_XGEN(b.x)]) == gen, bar);
            __builtin_amdgcn_fence(__ATOMIC_ACQUIRE, "agent");
            asm volatile("s_waitcnt vmcnt(0)" ::: "memory");
        }
    }
    __syncthreads();
}

enum { MAP_ID = 0, MAP_WIN = 1, MAP_WUQ = 2, MAP_WUKV = 3, MAP_GATE = 4, MAP_UP = 5 };
__device__ __forceinline__ int map_n(int mode, int n) {
    switch (mode) {
    case MAP_WIN: { if (n < OFF_KPE) return n; const int j = n - OFF_KPE; return OFF_KPE + (j < 32 ? 2 * j : 2 * (j - 32) + 1); }
    case MAP_WUQ: { const int h = n / 192, d = n % 192; if (d < 128) return h * 128 + d; const int j = d - 128; return 512 + h * 64 + (j < 32 ? 2 * j : 2 * (j - 32) + 1); }
    case MAP_WUKV: { const int h = n / 256, d = n % 256; return d < 128 ? h * 128 + d : 512 + h * 128 + (d - 128); }
    case MAP_GATE: return (n >> 7) * 256 + (n & 127);
    case MAP_UP: return (n >> 7) * 256 + 128 + (n & 127);
    default: return n;
    }
}
__device__ __forceinline__ void p0_transpose_item(const float* W, int K, int N, bf16_t* WT, int row_off, int mode, const float* kscale, const float* kscale2, LAS float* scr, int item, int lane) {
    const int nblk = N / 64, kb = item / nblk, nb = item % nblk, k0 = 64 * kb, n0 = 64 * nb;
    float v[64];
#pragma unroll
    for (int i = 0; i < 64; ++i) v[i] = __builtin_nontemporal_load(W + (size_t)(k0 + i) * N + n0 + lane);
    if (kscale) { const float* ks = (kscale2 && k0 >= 512) ? kscale2 - 512 : kscale;
#pragma unroll
        for (int i = 0; i < 64; ++i) v[i] *= ks[k0 + i]; }
#pragma unroll
    for (int i = 0; i < 64; ++i) scr[i * 65 + lane] = v[i];
    LDS_WAIT(); asm volatile("" ::: "memory");
    const int c = lane & 7;
#pragma unroll
    for (int j = 0; j < 8; ++j) { const int n = (lane >> 3) + 8 * j; const LAS float* sp = scr + (8 * c) * 65 + n;
        u32x4 o; o.x = cvt_pk_bf16(sp[0 * 65], sp[1 * 65]); o.y = cvt_pk_bf16(sp[2 * 65], sp[3 * 65]); o.z = cvt_pk_bf16(sp[4 * 65], sp[5 * 65]); o.w = cvt_pk_bf16(sp[6 * 65], sp[7 * 65]);
        *(u32x4*)(WT + (size_t)(row_off + map_n(mode, n0 + n)) * K + k0 + 8 * c) = o; }
    LDS_WAIT(); asm volatile("" ::: "memory");
}
template <int R, bool NORM>
__device__ __forceinline__ void rms_rows_to_bf16(const float* xrow, const float* g, bf16_t* orow, float* ssq_out, int lane) {
    f32x4 v[R][4]; float s[R];
#pragma unroll
    for (int r = 0; r < R; ++r)
#pragma unroll
        for (int j = 0; j < 4; ++j) v[r][j] = __builtin_nontemporal_load((const f32x4*)(xrow + (size_t)r * DM) + lane + 64 * j);
    f32x4 gg[4];
#pragma unroll
    for (int j = 0; j < 4; ++j) gg[j] = ((const f32x4*)g + lane)[64 * j];
#pragma unroll
    for (int r = 0; r < R; ++r) { float q = 0.f;
#pragma unroll
        for (int j = 0; j < 4; ++j) q += (v[r][j].x * v[r][j].x + v[r][j].y * v[r][j].y) + (v[r][j].z * v[r][j].z + v[r][j].w * v[r][j].w);
        s[r] = q; }
#pragma unroll
    for (int o = 1; o < 64; o <<= 1)
#pragma unroll
        for (int r = 0; r < R; ++r) s[r] += __shfl_xor(s[r], o);
#pragma unroll
    for (int r = 0; r < R; ++r) { const float rs = NORM ? __builtin_amdgcn_rsqf(s[r] * (1.f / DM) + EPS) : 1.f; u32x2* o8 = (u32x2*)(orow + (size_t)r * DM) + lane;
        if (!NORM) { if (lane == 0) ssq_out[r] = s[r];
#pragma unroll
            for (int j = 0; j < 4; ++j) gg[j] = (f32x4){1.f, 1.f, 1.f, 1.f}; }
#pragma unroll
        for (int j = 0; j < 4; ++j) { u32x2 w; w.x = cvt_pk_bf16(v[r][j].x * rs * gg[j].x, v[r][j].y * rs * gg[j].y); w.y = cvt_pk_bf16(v[r][j].z * rs * gg[j].z, v[r][j].w * rs * gg[j].w); o8[64 * j] = w; } }
}
__device__ __forceinline__ void resid_row(const float* pre, const float* hold, const float* gpost, float* hout, const float* gnext, bf16_t* xn, int lane) {
    const f32x4* pr = (const f32x4*)pre + lane; const f32x4* hr = (const f32x4*)hold + lane; const f32x4* gp = (const f32x4*)gpost + lane;
    f32x4 v[4]; float s = 0.f;
#pragma unroll
    for (int j = 0; j < 4; ++j) { v[j] = pr[64 * j]; s += (v[j].x * v[j].x + v[j].y * v[j].y) + (v[j].z * v[j].z + v[j].w * v[j].w); }
    const float rs = __builtin_amdgcn_rsqf(wave_sum(s) * (1.f / DM) + EPS);
    float s2 = 0.f;
#pragma unroll
    for (int j = 0; j < 4; ++j) { const f32x4 h = hr[64 * j], g = gp[64 * j]; v[j] = h + v[j] * rs * g; s2 += (v[j].x * v[j].x + v[j].y * v[j].y) + (v[j].z * v[j].z + v[j].w * v[j].w); }
    f32x4* ho = (f32x4*)hout + lane;
#pragma unroll
    for (int j = 0; j < 4; ++j) ho[64 * j] = v[j];
    if (xn) { const float rs2 = __builtin_amdgcn_rsqf(wave_sum(s2) * (1.f / DM) + EPS); const f32x4* gn = (const f32x4*)gnext + lane; u32x2* o8 = (u32x2*)xn + lane;
#pragma unroll
        for (int j = 0; j < 4; ++j) { const f32x4 gg = gn[64 * j]; u32x2 w; w.x = cvt_pk_bf16(v[j].x * rs2 * gg.x, v[j].y * rs2 * gg.y); w.y = cvt_pk_bf16(v[j].z * rs2 * gg.z, v[j].w * rs2 * gg.w); o8[64 * j] = w; } }
}


__device__ __forceinline__ float row16_sum(float v) {
    v += __builtin_bit_cast(float, __builtin_amdgcn_update_dpp(0, __builtin_bit_cast(int, v), 0xB1, 0xF, 0xF, true));
    v += __builtin_bit_cast(float, __builtin_amdgcn_update_dpp(0, __builtin_bit_cast(int, v), 0x4E, 0xF, 0xF, true));
    v += __builtin_bit_cast(float, __builtin_amdgcn_update_dpp(0, __builtin_bit_cast(int, v), 0x141, 0xF, 0xF, true));
    v += __builtin_bit_cast(float, __builtin_amdgcn_update_dpp(0, __builtin_bit_cast(int, v), 0x140, 0xF, 0xF, true));
    return v;
}
__device__ __forceinline__ void row_swap16(float x, float& from_other) { auto r = __builtin_amdgcn_permlane16_swap(__float_as_uint(x), __float_as_uint(x), false, false); const int row = (lane_id() >> 4) & 1; from_other = __uint_as_float(row ? r[0] : r[1]); }
namespace lru {
constexpr int TT = 128, NTILE = SEQ / TT, UP = 72;
constexpr int L_U = 0, L_UF = L_U + TT * UP * 2, L_WSEG = L_UF + TT * 33 * 4, L_CARRY = L_WSEG + 2 * 8 * 32 * 8, L_TSS = L_CARRY + 2 * 32 * 4, L_END = L_TSS + 2 * TT * 4;
static_assert(L_END <= RING_BYTES, "lru lds");
__device__ __forceinline__ float sigmoidf_(float x) { return __builtin_amdgcn_rcpf(1.f + __builtin_amdgcn_exp2f(-x * LOG2E)); }
__device__ __forceinline__ void unit(int b, int cb, const bf16_t* Z, bf16_t* Y, float* ssq_lru, const float* conv_w, const float* conv_b, const float* wa, const float* ba, const float* wx, const float* bx,
                                     const float* lam, LAS unsigned char* lds, const int wv) {
    const int lane = lane_id(), wid = wv, tid = wv * 64 + lane;
    const int hblk = cb >> 1, half = cb & 1, ib = hblk * 64, c0 = cb * 32;
    LAS bf16_t* U = (LAS bf16_t*)(lds + L_U); LAS float* UF = (LAS float*)(lds + L_UF); LAS f32x2* WSEG = (LAS f32x2*)(lds + L_WSEG);
    LAS float* CARRY = (LAS float*)(lds + L_CARRY); LAS float* TSS = (LAS float*)(lds + L_TSS);
    const int col = lane & 15, kq = lane >> 4;
    bf16x8 Bf[4][2];
#pragma unroll
    for (int nb = 0; nb < 4; ++nb)
#pragma unroll
        for (int ks = 0; ks < 2; ++ks) { const float* Wg = (nb < 2) ? wa : wx; const int oc = half * 32 + (nb & 1) * 16 + col; float w[8];
#pragma unroll
            for (int j = 0; j < 8; ++j) w[j] = Wg[((size_t)hblk * 64 + ks * 32 + 8 * kq + j) * 64 + oc];
            u32x4 p; p.x = cvt_pk_bf16(w[0], w[1]); p.y = cvt_pk_bf16(w[2], w[3]); p.z = cvt_pk_bf16(w[4], w[5]); p.w = cvt_pk_bf16(w[6], w[7]); Bf[nb][ks] = __builtin_bit_cast(bf16x8, p); }
    float cba[2], cbx[2], csp[2];
#pragma unroll
    for (int e = 0; e < 2; ++e) { const int ch = c0 + e * 16 + col; cba[e] = ba[ch]; cbx[e] = bx[ch]; const float l = lam[ch];
        csp[e] = 8.f * LOG2E * (fmaxf(-l, 0.f) + log1pf(expf(-fabsf(l)))); }
    const int cch = lane;
    const float cw0 = conv_w[0 * DLRU + ib + cch], cw1 = conv_w[1 * DLRU + ib + cch], cw2 = conv_w[2 * DLRU + ib + cch], cw3 = conv_w[3 * DLRU + ib + cch], cbb = conv_b[ib + cch];
    if (tid < 64) CARRY[tid] = 0.f;
    if (tid < 2 * TT) TSS[tid] = 0.f;
    const size_t rowb = (size_t)b * SEQ;
    const bf16_t* zx = Z + (rowb + wid * 16) * DINP + ib + cch;
    const bf16_t* zg = Z + (rowb + wid * 16 + kq * 4) * DINP + OFF_GATE + c0 + col;
    bf16_t* yp = Y + (rowb + wid * 16 + kq * 4) * DM + c0 + col;
    unsigned short xr[19], gr[8];
#define LRU_LOADX(t0_) do { _Pragma("unroll") for (int k = 0; k < 19; ++k) { const int tk = (t0_) + wid * 16 + k - 3; xr[k] = (tk >= 0) ? __builtin_nontemporal_load(zx + (ptrdiff_t)((t0_) + k - 3) * DINP) : (unsigned short)0; } } while (0)
    LRU_LOADX(0);
    __syncthreads();
    for (int tile = 0; tile < NTILE; ++tile) {
        const int t0 = tile * TT, par = tile & 1;
        { float xm3 = bf2f(xr[0]), xm2 = bf2f(xr[1]), xm1 = bf2f(xr[2]);
#pragma unroll
          for (int k = 0; k < 16; ++k) { const float x0 = bf2f(xr[3 + k]); const float u = cbb + cw0 * xm3 + cw1 * xm2 + cw2 * xm1 + cw3 * x0; xm3 = xm2; xm2 = xm1; xm1 = x0;
              const int tl = wid * 16 + k; U[tl * UP + cch] = (bf16_t)(cvt_pk_bf16(u, 0.f) & 0xffffu);
              if ((cch >> 5) == half) UF[tl * 33 + (cch & 31)] = u; } }
#pragma unroll
        for (int e = 0; e < 2; ++e)
#pragma unroll
            for (int r = 0; r < 4; ++r) gr[e * 4 + r] = __builtin_nontemporal_load(zg + (size_t)(t0 + r) * DINP + e * 16);
        if (tile + 1 < NTILE) LRU_LOADX(t0 + TT);
        LDS_WAIT();
        float av[2][4], uv[2][4], Ainc[2], Hinc[2];
        { f32x4 C[4];
#pragma unroll
          for (int nb = 0; nb < 4; ++nb) C[nb] = (f32x4){0.f, 0.f, 0.f, 0.f};
          const LAS bf16_t* ua = U + (wid * 16 + col) * UP + 8 * kq;
          const bf16x8 a0 = *(const LAS bf16x8*)ua, a1 = *(const LAS bf16x8*)(ua + 32);
#pragma unroll
          for (int nb = 0; nb < 4; ++nb) { C[nb] = __builtin_amdgcn_mfma_f32_16x16x32_bf16(a0, Bf[nb][0], C[nb], 0, 0, 0); C[nb] = __builtin_amdgcn_mfma_f32_16x16x32_bf16(a1, Bf[nb][1], C[nb], 0, 0, 0); }
#pragma unroll
          for (int e = 0; e < 2; ++e) { float Ap = 1.f, H = 0.f;
#pragma unroll
              for (int r = 0; r < 4; ++r) { const int tl = wid * 16 + kq * 4 + r, ch = e * 16 + col;
                  const float rg = sigmoidf_(C[e][r] + cba[e]), ig = sigmoidf_(C[e + 2][r] + cbx[e]);
                  const float a = __builtin_amdgcn_exp2f(-rg * csp[e]); const float mult = __builtin_amdgcn_sqrtf(fmaxf(1.f - a * a, 0.f));
                  const float uu = mult * ig * UF[tl * 33 + ch];
                  av[e][r] = a; uv[e][r] = uu; H = a * H + uu; Ap *= a; }
              { const float Ap1 = __shfl_up(Ap, 16), H1 = __shfl_up(H, 16); if (kq >= 1) { H = Ap * H1 + H; Ap = Ap * Ap1; } }
              { const float Ap2 = __shfl_up(Ap, 32), H2 = __shfl_up(H, 32); if (kq >= 2) { H = Ap * H2 + H; Ap = Ap * Ap2; } }
              Ainc[e] = Ap; Hinc[e] = H;
              if (kq == 3) WSEG[(par * 8 + wid) * 32 + e * 16 + col] = (f32x2){Ap, H}; } }
        __syncthreads();
        if (tid < TT) { const float v = TSS[(par ^ 1) * TT + tid]; if (tile > 0) atomicAdd(ssq_lru + rowb + t0 - TT + tid, v); }
        float qs[4] = {0.f, 0.f, 0.f, 0.f};
#pragma unroll
        for (int e = 0; e < 2; ++e) { const int ch = e * 16 + col;
            float h = CARRY[par * 32 + ch]; f32x2 sg[8];
#pragma unroll
            for (int w2 = 0; w2 < 8; ++w2) sg[w2] = WSEG[(par * 8 + w2) * 32 + ch];
#pragma unroll
            for (int w2 = 0; w2 < 7; ++w2) if (w2 < wid) h = sg[w2].x * h + sg[w2].y;
            if (wid == 7 && kq == 0) CARRY[(par ^ 1) * 32 + ch] = sg[7].x * h + sg[7].y;
            const float Ae = __shfl_up(Ainc[e], 16), He = __shfl_up(Hinc[e], 16);
            if (kq >= 1) h = Ae * h + He;
#pragma unroll
            for (int r = 0; r < 4; ++r) { h = av[e][r] * h + uv[e][r]; const float g = bf2f(gr[e * 4 + r]);
                const float ge = g * __builtin_amdgcn_rcpf(1.f + __builtin_amdgcn_exp2f(-1.5957691216057308f * LOG2E * (g + 0.044715f * g * g * g)));
                const float y = h * ge; yp[(size_t)(t0 + r) * DM + e * 16] = (bf16_t)(cvt_pk_bf16(y, 0.f) & 0xffffu); qs[r] += y * y; } }
#pragma unroll
        for (int r = 0; r < 4; ++r) { const float q = row16_sum(qs[r]);
            if (col == 0) TSS[par * TT + wid * 16 + kq * 4 + r] = q; }
    }
    __syncthreads();
    if (tid < TT) atomicAdd(ssq_lru + rowb + (NTILE - 1) * TT + tid, TSS[((NTILE - 1) & 1) * TT + tid]);
    __syncthreads();
#undef LRU_LOADX
}
}

namespace mla {
constexpr int NW = 8, QBLK = 32, KVBLK = 64, QB = 256, KROW = 384, SHM_K = KVBLK * KROW, SHM_V = KVBLK * 128 * 2;
constexpr int L_V = 0, L_K = 2 * SHM_V, L_WS = L_K + 2 * SHM_K, L_END = L_WS + NW * 64 * 4;
static_assert(L_END <= RING_BYTES && NW * 8192 <= L_WS, "mla lds");
#define KSWZ(row, colB) ((row) * KROW + ((colB) ^ ((((row) >> 1) & 7) << 4)))
#define SBAR() __builtin_amdgcn_sched_barrier(0)
__device__ __forceinline__ int v_st(int k, int c) { const int kk = (k & ~0xC) | ((k & 4) << 1) | ((k & 8) >> 1); return ((kk >> 3) * 4 + (c >> 5)) * 512 + ((kk & 7) * 32 + (c & 31)) * 2; }
__device__ __forceinline__ int v_rd_base(int lane) { return ((lane & 3) << 3) | (((lane >> 2) & 3) << 6) | (((lane >> 4) & 1) << 5) | (((lane >> 5) & 1) << 8); }
constexpr int v_rd_off(int d0, int ks, int half) { return d0 * 512 + ks * 4096 + half * 2048; }
__device__ __forceinline__ int crow(int r, int hi) { return (r & 3) + 8 * (r >> 2) + 4 * hi; }
__device__ __forceinline__ void mask_tile(f32x16& p0, f32x16& p1, int dq) {
    const float NEG = -__builtin_inff();
#pragma unroll
    for (int r = 0; r < 16; ++r) { const int c = (r & 3) + 8 * (r >> 2); if (dq - c < 0) p0[r] = NEG; if (dq - c - 32 < 0) p1[r] = NEG; }
}
constexpr float THR2 = 8.f * LOG2E;
__device__ __forceinline__ void partialSM(f32x16& p0, f32x16& p1, float& m_reg, float& alpha) {
    float pmax = p0[0];
#pragma unroll
    for (int r = 1; r < 16; ++r) pmax = fmaxf(pmax, p0[r]);
#pragma unroll
    for (int r = 0; r < 16; ++r) pmax = fmaxf(pmax, p1[r]);
    { auto rr = __builtin_amdgcn_permlane32_swap(__float_as_uint(pmax), __float_as_uint(pmax), false, false); pmax = fmaxf(__uint_as_float(rr[0]), __uint_as_float(rr[1])); }
    float mn;
    if (__builtin_expect(__all((pmax - m_reg) <= THR2), 1)) { mn = m_reg; alpha = 1.f; }
    else { mn = fmaxf(m_reg, pmax); alpha = __builtin_amdgcn_exp2f(m_reg - mn); m_reg = mn; }
#pragma unroll
    for (int r = 0; r < 16; ++r) p0[r] = p0[r] - mn;
#pragma unroll
    for (int r = 0; r < 16; ++r) p1[r] = p1[r] - mn;
#pragma unroll
    for (int r = 0; r < 16; ++r) p0[r] = __builtin_amdgcn_exp2f(p0[r]);
}
__device__ __forceinline__ void finishSM(f32x16& p0, f32x16& p1, float alpha, float& l_reg, bf16x8& pa0, bf16x8& pa1, bf16x8& pa2, bf16x8& pa3) {
#pragma unroll
    for (int r = 0; r < 16; ++r) p1[r] = __builtin_amdgcn_exp2f(p1[r]);
    float ps = 0;
#pragma unroll
    for (int r = 0; r < 16; ++r) ps += p0[r];
#pragma unroll
    for (int r = 0; r < 16; ++r) ps += p1[r];
    { auto rr = __builtin_amdgcn_permlane32_swap(__float_as_uint(ps), __float_as_uint(ps), false, false); ps = __uint_as_float(rr[0]) + __uint_as_float(rr[1]); }
    l_reg = l_reg * alpha + ps;
#define PK4(P, B_, OUT) do { unsigned a0 = cvt_pk_bf16(P[B_+0], P[B_+1]), a1 = cvt_pk_bf16(P[B_+2], P[B_+3]);                          \
        unsigned b0 = cvt_pk_bf16(P[B_+4], P[B_+5]), b1 = cvt_pk_bf16(P[B_+6], P[B_+7]);                                             \
        auto r0 = __builtin_amdgcn_permlane32_swap(a0, b0, false, false); auto r1 = __builtin_amdgcn_permlane32_swap(a1, b1, false, false); \
        u32x4 w = {r0[0], r1[0], r0[1], r1[1]}; OUT = __builtin_bit_cast(bf16x8, w); } while (0)
    PK4(p0, 0, pa0); PK4(p0, 8, pa1); PK4(p1, 0, pa2); PK4(p1, 8, pa3);
#undef PK4
}
template <int KB>
__device__ __forceinline__ void qkt(f32x16& p0, f32x16& p1, const char* K_lds, int r32, int hi, const bf16x8* qr) {
    p0 = f32x16{}; p1 = f32x16{};
    unsigned kb[4];
#pragma unroll
    for (int dd = 0; dd < 4; ++dd) kb[dd] = (unsigned)(uintptr_t)(K_lds + KB * SHM_K + KSWZ(r32, (dd * 16 + hi * 8) * 2));
    bf16x8 fa[4], fb[4];
#define KRD(slot, d0) do { asm volatile("ds_read_b128 %0, %1 offset:%2" : "=v"(fa[slot]) : "v"(kb[(d0) & 3]), "i"(((d0) >> 2) * 128)); \
                           asm volatile("ds_read_b128 %0, %1 offset:%2" : "=v"(fb[slot]) : "v"(kb[(d0) & 3]), "i"(((d0) >> 2) * 128 + 32 * KROW)); } while (0)
#define KMM(slot, d0, N) do { asm volatile("s_waitcnt lgkmcnt(%0)" :: "i"(N) : "memory"); SBAR(); \
        p0 = __builtin_amdgcn_mfma_f32_32x32x16_bf16(fa[slot], qr[d0], p0, 0, 0, 0); p1 = __builtin_amdgcn_mfma_f32_32x32x16_bf16(fb[slot], qr[d0], p1, 0, 0, 0); SBAR(); } while (0)
    KRD(0, 0); KRD(1, 1); KRD(2, 2); KRD(3, 3);
    KMM(0, 0, 6); KRD(0, 4); KMM(1, 1, 6); KRD(1, 5); KMM(2, 2, 6); KRD(2, 6); KMM(3, 3, 6); KRD(3, 7);
    KMM(0, 4, 6); KRD(0, 8); KMM(1, 5, 6); KRD(1, 9); KMM(2, 6, 6); KRD(2, 10); KMM(3, 7, 6); KRD(3, 11);
    KMM(0, 8, 6); KMM(1, 9, 4); KMM(2, 10, 2); KMM(3, 11, 0);
#undef KRD
#undef KMM
}
template <int VB>
__device__ __forceinline__ void pv_tile(f32x16* o, int vb0, bf16x8 pa0, bf16x8 pa1, bf16x8 pa2, bf16x8 pa3) {
    s16x4 lo[2][4], hh[2][4];
#define TRRD(dst, off) asm volatile("ds_read_b64_tr_b16 %0, %1 offset:%2" : "=v"(dst) : "v"(vb0), "i"(off))
#define VRD(set, d0) do { constexpr int b_ = VB * SHM_V + v_rd_off(d0, 0, 0); \
        TRRD(lo[set][0], b_); TRRD(hh[set][0], b_ + 2048); TRRD(lo[set][1], b_ + 4096); TRRD(hh[set][1], b_ + 6144); \
        TRRD(lo[set][2], b_ + 8192); TRRD(hh[set][2], b_ + 10240); TRRD(lo[set][3], b_ + 12288); TRRD(hh[set][3], b_ + 14336); } while (0)
#define VFR(set, k) (bf16x8){lo[set][k][0], lo[set][k][1], lo[set][k][2], lo[set][k][3], hh[set][k][0], hh[set][k][1], hh[set][k][2], hh[set][k][3]}
#define VMM(set, d0, N) do { asm volatile("s_waitcnt lgkmcnt(%0)" :: "i"(N) : "memory"); SBAR(); \
        o[d0] = __builtin_amdgcn_mfma_f32_32x32x16_bf16(pa0, VFR(set, 0), o[d0], 0, 0, 0); o[d0] = __builtin_amdgcn_mfma_f32_32x32x16_bf16(pa1, VFR(set, 1), o[d0], 0, 0, 0); \
        o[d0] = __builtin_amdgcn_mfma_f32_32x32x16_bf16(pa2, VFR(set, 2), o[d0], 0, 0, 0); o[d0] = __builtin_amdgcn_mfma_f32_32x32x16_bf16(pa3, VFR(set, 3), o[d0], 0, 0, 0); SBAR(); } while (0)
    VRD(0, 0); VRD(1, 1);
    VMM(0, 0, 8); VRD(0, 2); VMM(1, 1, 8); VRD(1, 3); VMM(0, 2, 8); VMM(1, 3, 0);
#undef TRRD
#undef VRD
#undef VFR
#undef VMM
}
__device__ __forceinline__ void block(int b, int h, int qb, const bf16_t* Qb, const bf16_t* KVb, const bf16_t* KPE, bf16_t* Y, float* ssq_mla, char* lds, const int wv) {
    const int lane = lane_id(), wid = wv, tid = wv * 64 + lane, r32 = lane & 31, hi = lane >> 5;
    const size_t rowbase = (size_t)b * SEQ; const int q0 = qb * QB; const int NT = (q0 + QB) / KVBLK;
    const int qlo = q0 + wid * QBLK, qm = qlo + r32 - 4 * hi;
    char* V_lds = lds + L_V; char* K_lds = lds + L_K;
    float* ws = (float*)(lds + L_WS) + wid * 64; float* li_l = ws, * al_l = ws + 32;
    float m_reg = -1e30f, l_reg = 0; f32x16 o[4] = {};
    const int sr = tid >> 4, scc = (tid & 15) * 8, vst0 = v_st(sr, scc), vst1 = v_st(32 + sr, scc), kws = KSWZ(sr, (tid & 15) * 16);
    const int pr = tid >> 3, kws2 = KSWZ(pr, 256 + (tid & 7) * 16);
    const int vb0 = (int)(uintptr_t)V_lds + v_rd_base(lane);
    const bf16_t* Kn = KVb + rowbase * 1024 + h * 128 + scc;
    const bf16_t* Vn = KVb + rowbase * 1024 + 512 + h * 128 + scc;
    const bf16_t* Kp = KPE + rowbase * 64 + (tid & 7) * 8;
    bf16x8 qr[12];
    { const bf16_t* qp = Qb + (rowbase + q0 + wid * QBLK + r32) * 768;
#pragma unroll
      for (int d0 = 0; d0 < 8; ++d0) qr[d0] = *(const bf16x8*)(qp + h * 128 + d0 * 16 + hi * 8);
#pragma unroll
      for (int d0 = 0; d0 < 4; ++d0) qr[8 + d0] = *(const bf16x8*)(qp + 512 + h * 64 + d0 * 16 + hi * 8); }
    const int grp = wid >> 2;
    bf16x8 st_v0, st_v1, st_k0, st_k1, st_k2;
#define SLOADK(t) do { const size_t k0_ = (size_t)(t) * KVBLK; st_k0 = *(const bf16x8*)(Kn + (k0_ + sr) * 1024); st_k1 = *(const bf16x8*)(Kn + (k0_ + 32 + sr) * 1024); st_k2 = *(const bf16x8*)(Kp + (k0_ + pr) * 64); } while (0)
#define SLOADV(t) do { const size_t k0_ = (size_t)(t) * KVBLK; st_v0 = *(const bf16x8*)(Vn + (k0_ + sr) * 1024); st_v1 = *(const bf16x8*)(Vn + (k0_ + 32 + sr) * 1024); } while (0)
#define SWRITEK(off) do { *(bf16x8*)(K_lds + (off) + kws) = st_k0; *(bf16x8*)(K_lds + (off) + kws + 32 * KROW) = st_k1; *(bf16x8*)(K_lds + (off) + kws2) = st_k2; } while (0)
#define SWRITEV(off) do { *(bf16x8*)(V_lds + (off) + vst0) = st_v0; *(bf16x8*)(V_lds + (off) + vst1) = st_v1; } while (0)
#define BAR() asm volatile("s_waitcnt lgkmcnt(0)\n\ts_barrier" ::: "memory")
#define RESC(a) do { if (__any((a) < 1.f)) { if (hi == 0) al_l[r32] = (a); asm volatile("s_waitcnt lgkmcnt(0)" ::: "memory");              \
                     for (int d_ = 0; d_ < 4; ++d_) for (int r = 0; r < 16; ++r) o[d_][r] *= al_l[crow(r, hi)]; } } while (0)
#define MASKT(P0_, P1_, t) do { const int kb_ = (t) * KVBLK; if (kb_ + KVBLK - 1 > qlo) mask_tile(P0_, P1_, qm - kb_); } while (0)
#define ACT(t) ((t) * KVBLK <= qlo + QBLK - 1)
#define NEGALL() do { const float NEG_ = -__builtin_inff(); _Pragma("unroll") for (int r = 0; r < 16; ++r) { p0[r] = NEG_; p1[r] = NEG_; } } while (0)
    f32x16 p0, p1; float al; bf16x8 pa0, pa1, pa2, pa3;
    SLOADK(0); VM_WAIT(); SWRITEK(0);
    if (grp) { SLOADK(1); SLOADV(0); }
    BAR();
    if (grp) { VM_WAIT(); SWRITEK(SHM_K); SWRITEV(0); BAR(); }
#define SMSLOT(t, tk, tv) do { if ((tk) < NT || (tv) < NT) { VM_WAIT(); if ((tk) < NT) SWRITEK(((tk) & 1) * SHM_K); if ((tv) < NT) SWRITEV(((tv) & 1) * SHM_V); } \
        MASKT(p0, p1, (t)); partialSM(p0, p1, m_reg, al); RESC(al); finishSM(p0, p1, al, l_reg, pa0, pa1, pa2, pa3); SBAR(); } while (0)
    { const int tk = 1 + grp, tv = grp;
      SLOADK(tk); SLOADV(tv); SBAR(); qkt<0>(p0, p1, K_lds, r32, hi, qr); SBAR();
      BAR(); SMSLOT(0, tk, tv); BAR(); }
    for (int i = 0; i < NT; i += 2) {
        { const int tk = i + 2 + grp, tv = i + 1 + grp;
          if (tk < NT) SLOADK(tk); if (tv < NT) SLOADV(tv); SBAR();
          if (ACT(i + 1)) qkt<1>(p0, p1, K_lds, r32, hi, qr); else NEGALL(); SBAR(); if (ACT(i)) pv_tile<0>(o, vb0, pa0, pa1, pa2, pa3); SBAR();
          BAR(); SMSLOT(i + 1, tk, tv); BAR(); }
        { const int tk = i + 3 + grp, tv = i + 2 + grp;
          if (tk < NT) SLOADK(tk); if (tv < NT) SLOADV(tv); SBAR();
          if (i + 2 < NT) { if (ACT(i + 2)) qkt<0>(p0, p1, K_lds, r32, hi, qr); else NEGALL(); SBAR(); }
          if (ACT(i + 1)) pv_tile<1>(o, vb0, pa0, pa1, pa2, pa3); SBAR();
          BAR(); if (i + 2 < NT) SMSLOT(i + 2, tk, tv); BAR(); }
    }
    if (!grp) BAR();
#undef SMSLOT
#undef SLOADK
#undef SLOADV
#undef SWRITEK
#undef SWRITEV
#undef BAR
    if (hi == 0) li_l[r32] = l_reg; asm volatile("s_waitcnt lgkmcnt(0)" ::: "memory");
    float rli[16];
#pragma unroll
    for (int r = 0; r < 16; ++r) rli[r] = __builtin_amdgcn_rcpf(li_l[crow(r, hi)]);
    { bf16_t* stg = (bf16_t*)lds + wid * 4096;
#pragma unroll
      for (int r = 0; r < 16; ++r) { const int orow = crow(r, hi);
#pragma unroll
          for (int d0 = 0; d0 < 4; ++d0) stg[orow * 128 + d0 * 32 + r32] = (bf16_t)(cvt_pk_bf16(o[d0][r] * rli[r], 0.f) & 0xffffu); }
      asm volatile("s_waitcnt lgkmcnt(0)" ::: "memory");
      const int row = lane >> 1, hf = lane & 1; float q = 0.f;
      bf16_t* yp = Y + (rowbase + q0 + wid * QBLK + row) * DM + 512 + h * 128 + hf * 64;
#pragma unroll
      for (int j = 0; j < 8; ++j) { const u32x4 v = *(const u32x4*)(stg + row * 128 + hf * 64 + j * 8);
          q += bflo(v.x) * bflo(v.x) + bfhi(v.x) * bfhi(v.x) + bflo(v.y) * bflo(v.y) + bfhi(v.y) * bfhi(v.y) + bflo(v.z) * bflo(v.z) + bfhi(v.z) * bfhi(v.z) + bflo(v.w) * bflo(v.w) + bfhi(v.w) * bfhi(v.w);
          *(u32x4*)(yp + j * 8) = v; }
      q += __shfl_xor(q, 1);
      if (hf == 0) atomicAdd(ssq_mla + rowbase + q0 + wid * QBLK + row, q); }
    __syncthreads();
#undef RESC
#undef MASKT
#undef ACT
#undef NEGALL
}
#undef KSWZ
#undef SBAR
}

constexpr int NWAVES = 8, NPHASE = 13;
struct Args { const void* in[32]; float* out; unsigned char* ws; int ph_lo, ph_hi; };

__global__ void __launch_bounds__(NWAVES * 64, 2) hymba_fwd(Args args) {
    extern __shared__ __attribute__((aligned(16))) unsigned char lds_raw[];
    LAS unsigned char* lds = (LAS unsigned char*)lds_raw;
    volatile LAS unsigned* MISC = (volatile LAS unsigned*)(lds + MISC_OFF);
    const int G = gridDim.x, bx = blockIdx.x, vcu = (G % 8 == 0) ? (bx % 8) * (G / 8) + bx / 8 : bx;
    const int wave_s = __builtin_amdgcn_readfirstlane((int)threadIdx.x >> 6);
#define lane (lane_id())
#define tid (wave_s * 64 + lane)
#define wave (wave_s)
#define gw (vcu * NWAVES + wave)
#define NGW (G * NWAVES)
    unsigned char* ws = args.ws;
#define x_in ((const float*)args.in[0])
#define mem ((const float*)args.in[1])
#define positions ((const int*)args.in[2])
#define g_pre_mix ((const float*)args.in[3])
#define w_in ((const float*)args.in[4])
#define conv_w ((const float*)args.in[5])
#define conv_b ((const float*)args.in[6])
#define lru_wa ((const float*)args.in[7])
#define lru_ba ((const float*)args.in[8])
#define lru_wx ((const float*)args.in[9])
#define lru_bx ((const float*)args.in[10])
#define lru_lambda ((const float*)args.in[11])
#define g_q_lat ((const float*)args.in[12])
#define w_uq ((const float*)args.in[13])
#define g_kv_lat ((const float*)args.in[14])
#define w_ukv ((const float*)args.in[15])
#define g_lru_out ((const float*)args.in[16])
#define g_mla_out ((const float*)args.in[17])
#define w_out ((const float*)args.in[18])
#define g_post_mix ((const float*)args.in[19])
#define g_pre_mem ((const float*)args.in[20])
#define g_mem_kv ((const float*)args.in[21])
#define w_mq ((const float*)args.in[22])
#define w_mk ((const float*)args.in[23])
#define w_mv ((const float*)args.in[24])
#define w_mo ((const float*)args.in[25])
#define g_post_mem ((const float*)args.in[26])
#define g_pre_ffn ((const float*)args.in[27])
#define w_gate ((const float*)args.in[28])
#define w_up ((const float*)args.in[29])
#define w_down ((const float*)args.in[30])
#define g_post_ffn ((const float*)args.in[31])
#define out_p (args.out)
#define ctl ((unsigned*)(ws + WS_CTL))
#define ssq_cq ((float*)(ws + WS_SSQ))
#define ssq_ckv (ssq_cq + T)
#define ssq_lru (ssq_cq + 2 * T)
#define ssq_mla (ssq_cq + 3 * T)
#define ssq_h1 (ssq_cq + 4 * T)
#define ssq_h2 (ssq_cq + 5 * T)
#define ssq_x (ssq_cq + 6 * T)
#define ssq_dummy (ssq_cq + 7 * T)
#define slots_p ((float*)(ws + WS_SLOTS))
#define cosT ((float*)(ws + WS_ROPE))
#define sinT (cosT + (size_t)T * 32)
#define Win_t ((bf16_t*)(ws + WS_WIN))
#define Wuq_t ((bf16_t*)(ws + WS_WUQ))
#define Wukv_t ((bf16_t*)(ws + WS_WUKV))
#define Wout_t ((bf16_t*)(ws + WS_WOUT))
#define Wmq_b ((bf16_t*)(ws + WS_WMQ))
#define Wmkv_t ((bf16_t*)(ws + WS_WMKV))
#define Wmo_t ((bf16_t*)(ws + WS_WMO))
#define Wgu_t ((bf16_t*)(ws + WS_WGU))
#define Wdown_t ((bf16_t*)(ws + WS_WDOWN))
#define MN ((bf16_t*)(ws + WS_MN))
#define MKV ((bf16_t*)(ws + WS_MKV))
#define WQK ((bf16_t*)(ws + WS_WQK))
#define WVO ((bf16_t*)(ws + WS_WVO))
#define XN ((bf16_t*)(ws + WS_XN))
#define KPE ((bf16_t*)(ws + WS_KPE))
#define Z ((bf16_t*)(ws + WS_Z))
#define Qb ((bf16_t*)(ws + WS_Q))
#define KVb ((bf16_t*)(ws + WS_KV))
#define Y ((bf16_t*)(ws + WS_Y))
#define PRE ((float*)(ws + WS_PRE))
#define Pb ((bf16_t*)(ws + WS_P))
#define Fb ((bf16_t*)(ws + WS_F))
    for (int u = tid; u < 256; u += NWAVES * 64) ((LAS unsigned*)(lds + MISC_OFF))[u] = 0u;
    __syncthreads();
    XcdBarrier bar = xcd_barrier_post(ctl + CW_BAR, MISC + 8, (unsigned)G);
    const bool grouped = (G == 256);
    XcdBarrier gbar = grouped ? xcd_barrier_post(ctl + CW_BAR + XCD_BAR_WORDS * (1 + (bx & 7)), MISC + 10, (unsigned)(G >> 3)) : bar;
    const int lo = args.ph_lo, hi = args.ph_hi;
    unsigned long long ts0 = 0, ts1 = 0, tc0 = 0, tc1 = 0;
#define TS(k) do { if ((k) == (SPIN_LO)) { ts0 = __builtin_amdgcn_s_memrealtime(); tc0 = __builtin_amdgcn_s_memtime(); } } while (0)
#define TE(k) do { if ((k) == (SPIN_HI)) { ts1 = __builtin_amdgcn_s_memrealtime(); tc1 = __builtin_amdgcn_s_memtime(); } } while (0)
#ifndef REP_PHASE
#define REP_PHASE -1
#endif
#define REPS(k) for (int rep = 0; rep < ((REP_PHASE) == (k) ? 2 : 1); ++rep)
#define RSQ(p) (rep ? ssq_dummy : (p))
#ifndef PHASE_MASK
#define PHASE_MASK 0x1fff
#endif
#define IN(k) (((PHASE_MASK >> (k)) & 1) && lo <= (k) && (k) < hi)
#ifndef SPIN_LO
#define SPIN_LO -1
#define SPIN_HI -1
#endif
#ifndef ALIGN_P10
#define ALIGN_P10 true
#endif
#ifndef EXTRA_BAR
#define EXTRA_BAR 0
#endif
#define SEAM(k) do { if (IN(k) && IN((k) + 1)) { if ((k) == 0 || !grouped) xcd_barrier(bar, wave_s); else xcd_barrier(gbar, wave_s); } } while (0)

    TS(0); if (IN(0)) REPS(0) {
        LAS float* scr = (LAS float*)(lds + wave * 16640);
        constexpr int I_IN = 16 * 27, I_UQ = 6 * 12, I_UKV = 4 * 16, I_SQ = 16 * 16, I_GU = 16 * 44, I_DN = 44 * 16;
        int cum = 0;
#define P0_JOB(W, K_, N_, WT, ROFF, MODE, KS, KS2, CNT) do { for (int it = (gw + NGW - (cum % NGW)) % NGW; it < (CNT); it += NGW) p0_transpose_item(W, K_, N_, WT, ROFF, MODE, KS, KS2, scr, it, lane); cum += (CNT); } while (0)
        P0_JOB(w_in, DM, 1728, Win_t, 0, MAP_WIN, g_pre_mix, nullptr, I_IN);
        P0_JOB(w_uq, QLR, 768, Wuq_t, 0, MAP_WUQ, g_q_lat, nullptr, I_UQ);
        P0_JOB(w_ukv, KVLR, 1024, Wukv_t, 0, MAP_WUKV, g_kv_lat, nullptr, I_UKV);
        P0_JOB(w_out, DM, DM, Wout_t, 0, MAP_ID, g_lru_out, g_mla_out, I_SQ);
        P0_JOB(w_mk, DM, DM, Wmkv_t, 0, MAP_ID, nullptr, nullptr, I_SQ);
        P0_JOB(w_mv, DM, DM, Wmkv_t, 1024, MAP_ID, nullptr, nullptr, I_SQ);
        P0_JOB(w_mo, DM, DM, Wmo_t, 0, MAP_ID, nullptr, nullptr, I_SQ);
        P0_JOB(w_gate, DM, DFF, Wgu_t, 0, MAP_GATE, g_pre_ffn, nullptr, I_GU);
        P0_JOB(w_up, DM, DFF, Wgu_t, 0, MAP_UP, g_pre_ffn, nullptr, I_GU);
        P0_JOB(w_down, DFF, DM, Wdown_t, 0, MAP_ID, nullptr, nullptr, I_DN);
#undef P0_JOB
        const int gt = vcu * (NWAVES * 64) + tid, NGT = G * NWAVES * 64;
        for (int i = gt; i < 64 * 1024 / 8; i += NGT) *(u32x4*)(Win_t + (size_t)1728 * 1024 + (size_t)i * 8) = (u32x4){0u, 0u, 0u, 0u};
        for (int i = gt; i < DM * DM / 4; i += NGT) { const f32x4 v = __builtin_nontemporal_load((const f32x4*)(w_mq + (size_t)i * 4)) * g_pre_mem[i >> 8]; u32x2 w; w.x = cvt_pk_bf16(v.x, v.y); w.y = cvt_pk_bf16(v.z, v.w); *(u32x2*)(Wmq_b + (size_t)i * 4) = w; }
        for (int i = gt; i < T * 32; i += NGT) { const int row = i >> 5, k = i & 31; const double invf = exp2(-(double)k * (13.287712379549449 / 32.0));
            const double rev = (double)positions[row] * invf * 0.15915494309189535; const float fr_ = (float)(rev - rint(rev)); cosT[i] = __builtin_amdgcn_cosf(fr_); sinT[i] = __builtin_amdgcn_sinf(fr_); }
        { const int rpw = T / (G * NWAVES);
          for (int m = gw * rpw; m < (gw + 1) * rpw; m += 4) rms_rows_to_bf16<4, false>(x_in + (size_t)m * DM, g_pre_mix, XN + (size_t)m * DM, ssq_x + m, lane); }
        { const int rpw = TM / (G * NWAVES);
          for (int m = gw * rpw; m < (gw + 1) * rpw; m += 2) rms_rows_to_bf16<2, true>(mem + (size_t)m * DM, g_mem_kv, MN + (size_t)m * DM, nullptr, lane); }
    }
    SEAM(0); TE(0);
    TS(1); if (IN(1)) REPS(1) {
        {
          struct P1Order { pg8::TileOrder o; int nz, mu; const char* A2; const char* B2;
              __device__ bool next(int i, pg8::Unit& un) const { if (o.next(i, un)) return true; if (i != nz || mu < 0) return false;
                  un.pm = mu >> 3; un.pn = mu & 7; un.A = A2 + (size_t)un.pm * 256 * DM * 2; un.B = B2 + (size_t)un.pn * 256 * DM * 2; un.cofs = 0; un.job = 1; un.wait = nullptr; un.done = nullptr; return true; } };
          const int j = bx >> 3; P1Order S; S.o.init(T, DINP, G, bx, XN, DM, Win_t, DM);
          S.nz = (896 - bx + G - 1) / G;
          S.mu = (G == 256) ? (j >= 16 ? ((bx & 7) * 2 + ((j - 16) >> 3)) * 8 + ((j - 16) & 7) : -1) : (bx < 128 ? bx : -1); S.A2 = (const char*)MN; S.B2 = (const char*)Wmkv_t;
          EpiP1 E{EpiZ{Z, KPE, RSQ(ssq_cq), RSQ(ssq_ckv), cosT, sinT, ssq_x}, EpiBf16{MKV, 2048, 1.f, nullptr, 0.f}};
          pg8::gemm_phase<EpiP1, P1Order>(lds, DM, DM, DM, S, E, wave_s); }
    }
    SEAM(1); TE(1);
    TS(2); if (IN(2)) REPS(2) {
#ifndef P2SUB
#define P2SUB 31
#endif
#ifndef REP_P2SUB
#define REP_P2SUB 0
#endif
#define R2(i) for (int r2 = 0; r2 < (((REP_P2SUB) >> (i)) & 1) + 1; ++r2)
        if (P2SUB & 1) R2(0) for (int uidx = vcu; uidx < BATCH * 16; uidx += G) lru::unit(uidx >> 4, uidx & 15, Z, Y, (rep | r2) ? ssq_dummy : ssq_lru, conv_w, conv_b, lru_wa, lru_ba, lru_wx, lru_bx, lru_lambda, lds, wave_s);
#ifndef P2_MERGED
#define P2_MERGED 1
#endif
#if P2_MERGED
        { struct P2Order { pg8::TileOrder oq, okv; int nq, c, G; const bf16_t* mkv; const bf16_t* wmq; const bf16_t* wmo;
              __device__ bool next(int i, pg8::Unit& u) const {
                  if (i < nq) { oq.next(i, u); u.job = 0; u.lda = DINP; u.ldb = QLR; u.nt = QLR / 64; return true; }
                  i -= nq; if (i < 2) { okv.next(i, u); u.job = 1; u.lda = DINP; u.ldb = KVLR; u.nt = KVLR / 64; return true; }
                  i -= 2; if (i >= 2 || c >= 256) return false;
                  const int bh = c >> 2, q = c & 3, b = bh >> 2, h = bh & 3; u.wait = nullptr; u.done = nullptr; u.nt = 4;
                  if (i == 0) { u.pm = 0; u.pn = q; u.A = (const char*)(mkv + (size_t)(b * 256) * 2048 + h * 256); u.B = (const char*)(wmq + (size_t)(q * 256) * 1024 + h * 256); u.cofs = ((long)b * 1024 + h * 256) * 1024; u.job = 2; u.lda = 2048; u.ldb = 1024; }
                  else { u.pm = q; u.pn = 0; u.A = (const char*)(wmo + (size_t)(q * 256) * 1024 + h * 256); u.B = (const char*)(mkv + (size_t)(b * 256) * 2048 + 1024 + h * 256); u.cofs = (long)b * 1024 * 1024 + h * 256; u.job = 3; u.lda = 1024; u.ldb = 2048; }
                  return true; } };
          P2Order S; S.oq.init(T, 768, G, bx, Z + OFF_CQ, DINP, Wuq_t, QLR); S.okv.init(T, 1024, G, (bx + 128) % G, Z + OFF_CKV, DINP, Wukv_t, KVLR);
          S.nq = (384 - bx + G - 1) / G; S.c = vcu; S.G = G; S.mkv = MKV; S.wmq = Wmq_b; S.wmo = Wmo_t;
          EpiP2 E{EpiQ{Qb, ssq_cq, cosT, sinT}, EpiBf16{KVb, 1024, 1.f, ssq_ckv, 1.f / KVLR}, EpiBf16{WQK, 1024, MSCALE, nullptr, 0.f}, EpiBf16{WVO, 1024, 1.f, nullptr, 0.f}};
          pg8::gemm_phase_v<EpiP2, P2Order>(lds, S, E, wave_s); }
#else
        if (P2SUB & 2) R2(1) { pg8::TileOrder S; S.init(T, 768, G, bx, Z + OFF_CQ, DINP, Wuq_t, QLR); EpiQ E{Qb, ssq_cq, cosT, sinT};
          pg8::gemm_phase<EpiQ, pg8::TileOrder>(lds, DINP, QLR, QLR, S, E, wave_s); }
        if (P2SUB & 4) R2(2) { pg8::TileOrder S; S.init(T, 1024, G, (bx + 128) % G, Z + OFF_CKV, DINP, Wukv_t, KVLR); EpiBf16 E{KVb, 1024, 1.f, ssq_ckv, 1.f / KVLR};
          pg8::gemm_phase<EpiBf16, pg8::TileOrder>(lds, DINP, KVLR, KVLR, S, E, wave_s); }
        struct FormQK { int G, c; const bf16_t* mkv; const bf16_t* W;
            __device__ bool next(int i, pg8::Unit& u) const { const int L = i * G + c; if (L >= 256) return false; const int bh = L >> 2, q = L & 3, b = bh >> 2, h = bh & 3;
                u.pm = 0; u.pn = q; u.A = (const char*)(mkv + (size_t)(b * 256) * 2048 + h * 256); u.B = (const char*)(W + (size_t)(q * 256) * 1024 + h * 256); u.cofs = ((long)b * 1024 + h * 256) * 1024; u.job = 0; u.wait = nullptr; u.done = nullptr; return true; } };
        struct FormVO { int G, c; const bf16_t* mkv; const bf16_t* W;
            __device__ bool next(int i, pg8::Unit& u) const { const int L = i * G + c; if (L >= 256) return false; const int bh = L >> 2, q = L & 3, b = bh >> 2, h = bh & 3;
                u.pm = q; u.pn = 0; u.A = (const char*)(W + (size_t)(q * 256) * 1024 + h * 256); u.B = (const char*)(mkv + (size_t)(b * 256) * 2048 + 1024 + h * 256); u.cofs = (long)b * 1024 * 1024 + h * 256; u.job = 0; u.wait = nullptr; u.done = nullptr; return true; } };
        if (P2SUB & 8) R2(3) { FormQK S{G, vcu, MKV, Wmq_b}; EpiBf16 E{WQK, 1024, MSCALE, nullptr, 0.f}; pg8::gemm_phase<EpiBf16, FormQK>(lds, 2048, 1024, 256, S, E, wave_s); }
        if (P2SUB & 16) R2(3) { FormVO S{G, vcu, MKV, Wmo_t}; EpiBf16 E{WVO, 1024, 1.f, nullptr, 0.f}; pg8::gemm_phase<EpiBf16, FormVO>(lds, 1024, 2048, 256, S, E, wave_s); }
#endif
    }
    SEAM(2); TE(2);
    TS(3); if (IN(3)) REPS(3) {
        for (int it = vcu; it < BATCH * 4 * 4; it += G) { const int bh = it >> 2, xq = it & 3, b = bh >> 2, h = bh & 3;
            mla::block(b, h, xq, Qb, KVb, KPE, Y, RSQ(ssq_mla), (char*)lds_raw, wave_s);
            mla::block(b, h, 7 - xq, Qb, KVb, KPE, Y, RSQ(ssq_mla), (char*)lds_raw, wave_s); }
    }
    SEAM(3); TE(3);
#ifndef CHAIN_TAIL
#define CHAIN_TAIL 0
#endif
#if CHAIN_TAIL
    TS(5); if (IN(5)) {
        unsigned* dn = ctl + CW_DONE;
        { pg8::TileOrder S; S.init(T, DM, G, bx, Y, DM, Wout_t, DM);
          EpiNormResMid E{nullptr, XN, nullptr, g_post_mix, XN, ssq_h1, slots_p, ctl + CW_SEAM, false, ssq_lru, ssq_mla};
          pg8::gemm_phase<EpiNormResMid, pg8::TileOrder>(lds, DM, DM, DM, S, E, wave_s); }
        if (!grouped) xcd_barrier(bar, wave_s); else xcd_barrier(gbar, wave_s);
        { ChainOrder S; S.o.init(T, DM, G, bx, XN, DM, WQK, DM, (size_t)DM * DM * 2); S.wt_base = nullptr; S.dn_base = dn + SEAM_BANK;
          EpiSoftmax E{Pb, ssq_h1, true};
          pg8::gemm_phase<EpiSoftmax, ChainOrder, true, true, true>(lds, DM, DM, DM, S, E, wave_s); }
        { ChainOrder S; S.o.init(T, DM, G, bx, Pb, DM, WVO, DM, (size_t)DM * DM * 2); S.wt_base = dn + SEAM_BANK; S.dn_base = dn + 2 * SEAM_BANK;
          EpiNormRes E{nullptr, XN, nullptr, g_post_mem, XN, ssq_h2, slots_p + (size_t)4 * T, ctl + CW_SEAM + SEAM_BANK, true, nullptr, nullptr};
          pg8::gemm_phase<EpiNormRes, ChainOrder, true, true, true>(lds, DM, DM, DM, S, E, wave_s); }
        { ChainOrder S; S.o.init(T, 2 * DFF, G, bx, XN, DM, Wgu_t, DM); S.wt_base = dn + 2 * SEAM_BANK; S.dn_base = nullptr;
          EpiSwiGLU E{Fb, ssq_h2};
          pg8::gemm_phase<EpiSwiGLU, ChainOrder, true, true, true>(lds, DM, DM, DM, S, E, wave_s); } }
    if (IN(5) && IN(11)) { if (!grouped) xcd_barrier(bar, wave_s); else xcd_barrier(gbar, wave_s); } TE(5); TE(7); TE(8); TE(10);
#else
    TS(5); if (IN(5)) REPS(5) { pg8::TileOrder S; S.init(T, DM, G, bx, Y, DM, Wout_t, DM);
        EpiNormResMid E{nullptr, XN, nullptr, g_post_mix, rep ? (bf16_t*)PRE : XN, RSQ(ssq_h1), slots_p, ctl + CW_SEAM, false, ssq_lru, ssq_mla};
        pg8::gemm_phase<EpiNormResMid, pg8::TileOrder>(lds, DM, DM, DM, S, E, wave_s); }
    SEAM(5); TE(5);
    TS(7); if (IN(7)) REPS(7) { pg8::TileOrder S; S.init(T, DM, G, bx, XN, DM, WQK, DM, (size_t)DM * DM * 2); EpiSoftmax E{Pb, ssq_h1, false}; pg8::gemm_phase<EpiSoftmax, pg8::TileOrder>(lds, DM, DM, DM, S, E, wave_s); }
    SEAM(7); TE(7);
    TS(8); if (IN(8)) REPS(8) { pg8::TileOrder S; S.init(T, DM, G, bx, Pb, DM, WVO, DM, (size_t)DM * DM * 2); EpiNormRes E{nullptr, XN, nullptr, g_post_mem, rep ? (bf16_t*)PRE : XN, RSQ(ssq_h2), slots_p + (size_t)4 * T, ctl + CW_SEAM + SEAM_BANK, false, nullptr, nullptr};
        pg8::gemm_phase<EpiNormRes, pg8::TileOrder>(lds, DM, DM, DM, S, E, wave_s); }
    SEAM(8); TE(8);
#ifdef COLD10
    if (IN(10)) { for (int m = gw * 4; m < T; m += NGW * 4) rms_rows_to_bf16<4, true>(x_in + (size_t)m * DM, g_pre_mix, (bf16_t*)PRE + (size_t)m * DM, nullptr, lane);
                  for (int m = gw * 4; m < T; m += NGW * 4) rms_rows_to_bf16<4, true>(x_in + (size_t)m * DM, g_pre_mix, (bf16_t*)PRE + (size_t)(T + m) * DM, nullptr, lane); xcd_barrier(gbar, wave_s); }
#endif
    TS(10); if (IN(10)) REPS(10) { pg8::TileOrder S; S.init(T, 2 * DFF, G, bx, XN, DM, Wgu_t, DM); EpiSwiGLU E{Fb, ssq_h2}; pg8::gemm_phase<EpiSwiGLU, pg8::TileOrder, ALIGN_P10>(lds, DM, DM, DM, S, E, wave_s); }
    SEAM(10); TE(10);
#endif
    TS(11); if (IN(11)) REPS(11) { pg8::TileOrder S; S.init(T, DM, G, bx, Fb, DFF, Wdown_t, DFF); EpiNormRes E{nullptr, XN, rep ? PRE : out_p, g_post_ffn, nullptr, nullptr, slots_p + (size_t)8 * T, ctl + CW_SEAM + 2 * SEAM_BANK, false, nullptr, nullptr};
        pg8::gemm_phase<EpiNormRes, pg8::TileOrder>(lds, DFF, DFF, DFF, S, E, wave_s); }
    TE(11);
#ifdef CLKPROBE
    if ((SPIN_LO) >= 0) { const unsigned long long dt = ((tc1 - tc0) * 1000ull) / (ts1 - ts0), t2 = __builtin_amdgcn_s_memrealtime();
#else
    if ((SPIN_LO) >= 0) { const unsigned long long dt = ts1 - ts0, t2 = __builtin_amdgcn_s_memrealtime();
#endif
        while (__builtin_amdgcn_s_memrealtime() - t2 < dt) __builtin_amdgcn_s_sleep(8); }
#undef IN
#undef SEAM
}

#undef tid
#undef lane
#undef wave
#undef gw
#undef NGW
#undef x_in
#undef ssq_h1
#undef ssq_h2
#undef ssq_dummy
#undef ssq_x
#undef slots_p
#undef mem
#undef positions
#undef g_pre_mix
#undef w_in
#undef conv_w
#undef conv_b
#undef lru_wa
#undef lru_ba
#undef lru_wx
#undef lru_bx
#undef lru_lambda
#undef g_q_lat
#undef w_uq
#undef g_kv_lat
#undef w_ukv
#undef g_lru_out
#undef g_mla_out
#undef w_out
#undef g_post_mix
#undef g_pre_mem
#undef g_mem_kv
#undef w_mq
#undef w_mk
#undef w_mv
#undef w_mo
#undef g_post_mem
#undef g_pre_ffn
#undef w_gate
#undef w_up
#undef w_down
#undef g_post_ffn
#undef out_p
#undef ctl
#undef ssq_cq
#undef ssq_ckv
#undef ssq_lru
#undef ssq_mla
#undef cosT
#undef sinT
#undef Win_t
#undef Wuq_t
#undef Wukv_t
#undef Wout_t
#undef Wmq_b
#undef Wmkv_t
#undef Wmo_t
#undef Wgu_t
#undef Wdown_t
#undef MN
#undef MKV
#undef WQK
#undef WVO
#undef XN
#undef KPE
#undef Z
#undef Qb
#undef KVb
#undef Y
#undef PRE
#undef Pb
#undef Fb
#ifndef N_LAUNCHES
#define N_LAUNCHES 1
#endif
extern "C" void kernel_launch(void* const* d_in, const int* in_sizes, int n_in, void* d_out, int out_size, void* d_ws, size_t ws_size, hipStream_t stream) {
    static int grid = 0;
    if (grid == 0) {
        if (n_in != 32 || in_sizes[0] != T * DM || out_size != T * DM || ws_size < WS_END) { fprintf(stderr, "kernel_launch: unexpected shapes (n_in %d, in0 %d, out %d, ws %zu)\n", n_in, n_in > 0 ? in_sizes[0] : -1, out_size, ws_size); grid = -1; return; }
        int dev = 0, cus = 0, per_cu = 0;
        (void)hipGetDevice(&dev); (void)hipDeviceGetAttribute(&cus, hipDeviceAttributeMultiprocessorCount, dev);
        if (hipFuncSetAttribute((const void*)hymba_fwd, hipFuncAttributeMaxDynamicSharedMemorySize, LDS_BYTES) != hipSuccess) { fprintf(stderr, "kernel_launch: hipFuncSetAttribute failed\n"); grid = -1; return; }
        if (hipOccupancyMaxActiveBlocksPerMultiprocessor(&per_cu, (const void*)hymba_fwd, NWAVES * 64, LDS_BYTES) != hipSuccess || per_cu < 1) { fprintf(stderr, "kernel_launch: occupancy query says %d\n", per_cu); per_cu = 1; }
        (void)hipGetLastError();
        grid = cus > 0 ? cus : 256;
    }
    if (grid < 0) return;
    (void)hipMemsetAsync((char*)d_ws + WS_CTL, 0, CTL_ZERO_BYTES, stream);
    Args a{};
    for (int i = 0; i < 32; ++i) a.in[i] = d_in[i];
    a.out = (float*)d_out; a.ws = (unsigned char*)d_ws;
#if N_LAUNCHES == 1
    a.ph_lo = 0; a.ph_hi = NPHASE;
    void* kargs[] = {&a};
#ifdef PLAIN_LAUNCH
    (void)kargs; hipLaunchKernelGGL(hymba_fwd, dim3(grid), dim3(NWAVES * 64), LDS_BYTES, stream, a); hipError_t e = hipPeekAtLastError();
#else
    hipError_t e = hipLaunchCooperativeKernel((const void*)hymba_fwd, dim3(grid), dim3(NWAVES * 64), kargs, LDS_BYTES, stream);
#endif
    if (e != hipSuccess) fprintf(stderr, "kernel_launch: cooperative launch failed: %s (grid %d)\n", hipGetErrorString(e), grid);
#else
    for (int p = 0; p < NPHASE; ++p) { a.ph_lo = p; a.ph_hi = p + 1; hipLaunchKernelGGL(hymba_fwd, dim3(grid), dim3(NWAVES * 64), LDS_BYTES, stream, a); }
#endif
}
```

```cpp
#include <hip/hip_runtime.h>
#include <hip/hip_bf16.h>
#include <cstdio>
#include <cstdint>

#define LAS __attribute__((address_space(3)))
#define GAS __attribute__((address_space(1)))
typedef unsigned short bf16_t;
typedef short bf16x8 __attribute__((ext_vector_type(8)));
typedef short s16x4 __attribute__((ext_vector_type(4)));
typedef float f32x4 __attribute__((ext_vector_type(4)));
typedef float f32x2 __attribute__((ext_vector_type(2)));
typedef float f32x16 __attribute__((ext_vector_type(16)));
typedef unsigned u32x4 __attribute__((ext_vector_type(4)));
typedef unsigned u32x2 __attribute__((ext_vector_type(2)));

constexpr int BATCH = 16, SEQ = 2048, DM = 1024, T = BATCH * SEQ;
constexpr int NMEM = 256, TM = BATCH * NMEM;
constexpr int DLRU = 512, DINP = 1792, QLR = 384, KVLR = 256, DFF = 2816;
constexpr int OFF_GATE = 512, OFF_CQ = 1024, OFF_CKV = 1408, OFF_KPE = 1664;
constexpr float EPS = 1e-6f;
constexpr float LOG2E = 1.4426950408889634f;
constexpr float QSCALE = 0.07216878364870322f * LOG2E;
constexpr float MSCALE = 0.0625f * LOG2E;

constexpr size_t MiB = 1u << 20;
constexpr size_t WS_CTL = 0, CTL_ZERO_BYTES = 2 * MiB;
constexpr size_t WS_SSQ = 1 * MiB;
constexpr size_t WS_SLOTS = 2 * MiB;
constexpr int CW_SEAM = 65536, SEAM_BANK = 8192, CW_DONE = CW_SEAM + 3 * SEAM_BANK;
constexpr size_t WS_ROPE = 4 * MiB;
constexpr size_t WS_WIN = 12 * MiB, WS_WUQ = 16 * MiB, WS_WUKV = 17 * MiB, WS_WOUT = 18 * MiB, WS_WMQ = 20 * MiB, WS_WMKV = 22 * MiB,
                 WS_WMO = 26 * MiB, WS_WGU = 28 * MiB, WS_WDOWN = 39 * MiB;
constexpr size_t WS_MN = 46 * MiB, WS_MKV = 54 * MiB, WS_WQK = 70 * MiB, WS_WVO = 102 * MiB, WS_XN = 134 * MiB, WS_KPE = 198 * MiB;
constexpr size_t WS_Z = 202 * MiB, WS_Q = 314 * MiB, WS_KV = 362 * MiB, WS_Y = 426 * MiB;
constexpr size_t WS_PRE = 202 * MiB, WS_P = 330 * MiB, WS_F = 330 * MiB, WS_END = 506 * MiB;
constexpr int CW_BAR = 4096;

constexpr int RING_BYTES = 131072, EPI_OFF = RING_BYTES, EPI_BYTES = 16384, MISC_OFF = EPI_OFF + EPI_BYTES, LDS_BYTES = MISC_OFF + 1024;

__device__ __forceinline__ unsigned cvt_pk_bf16(float lo, float hi) { unsigned r; asm volatile("v_cvt_pk_bf16_f32 %0, %1, %2" : "=v"(r) : "v"(lo), "v"(hi)); return r; }
__device__ __forceinline__ float bf2f(unsigned short v) { return __uint_as_float((unsigned)v << 16); }
__device__ __forceinline__ float bflo(unsigned w) { return __uint_as_float(w << 16); }
__device__ __forceinline__ float bfhi(unsigned w) { return __uint_as_float(w & 0xffff0000u); }
__device__ __forceinline__ float wave_sum(float v) {
#pragma unroll
    for (int o = 1; o < 64; o <<= 1) v += __shfl_xor(v, o);
    return v;
}
__device__ __forceinline__ int lane_id() { int l; asm volatile("v_mbcnt_lo_u32_b32 %0, -1, 0\n\tv_mbcnt_hi_u32_b32 %0, -1, %0" : "=v"(l)); return l; }
#define LDS_WAIT() asm volatile("s_waitcnt lgkmcnt(0)" ::: "memory")
#define VM_WAIT() asm volatile("s_waitcnt vmcnt(0)" ::: "memory")

namespace pg8 {
constexpr int BM = 256, BK = 64, HALF = 128, HTB = HALF * BK * 2, STAGE_BYTES = 8 * HTB, NXCD = 8, WGM = 8;
__host__ __device__ __forceinline__ int lds_byte(int r, int c) { const int st = (r >> 4) * 2 + (c >> 5), rr = r & 15, cc = c & 31, ob = rr * 64 + cc * 2; return st * 1024 + (ob ^ (((ob >> 9) & 1) << 5)); }
__host__ __device__ __forceinline__ void stage_rc(int b, int& R, int& C) { const int st = b / 1024, sb = b % 1024, swz = sb ^ (((sb >> 9) & 1) << 5); R = (st >> 1) * 16 + swz / 64; C = (st & 1) * 32 + (swz % 64) / 2; }
__host__ __device__ __forceinline__ int perm32(int rho) { const int n = rho >> 4, i = rho & 15; return 8 * (i >> 2) + 4 * n + (i & 3); }

struct Unit { int pm, pn; const char* A; const char* B; long cofs; int job; unsigned* wait; unsigned* done; int lda, ldb, nt; };

struct TileOrder {
    int nM, nN, nwg, G, c; const char* A; const char* B; size_t tA, tB, bB;
    __device__ void init(int M, int N, int G_, int c_, const void* A_, int lda, const void* B_, int ldb, size_t batchB_bytes = 0) {
        nM = M / BM; nN = N / BM; nwg = nM * nN; G = G_; c = c_; A = (const char*)A_; B = (const char*)B_; tA = (size_t)BM * lda * 2; tB = (size_t)BM * ldb * 2; bB = batchB_bytes; }
    __device__ bool next(int i, Unit& u) const {
        const long L = (long)i * G + c; if (L >= nwg) return false;
        int wgid = (int)L; { const int q = nwg / NXCD, r = nwg % NXCD, xcd = wgid % NXCD, off = wgid / NXCD; wgid = (xcd < r ? xcd * (q + 1) : r * (q + 1) + (xcd - r) * q) + off; }
        const int nig = WGM * nN, gid = wgid / nig, fm = gid * WGM, gsz = (nM - fm) < WGM ? (nM - fm) : WGM;
        u.pm = fm + ((wgid % nig) % gsz); u.pn = (wgid % nig) / gsz; u.A = A + (size_t)u.pm * tA; u.B = B + (size_t)u.pn * tB + (size_t)(u.pm >> 3) * bB; u.cofs = 0; u.job = 0; u.wait = nullptr; u.done = nullptr; return true;
    }
};

__device__ __forceinline__ void chain_wait(const Unit& u) {
    if (u.wait) { unsigned sp = 0; while ((unsigned)__builtin_amdgcn_readfirstlane(__hip_atomic_load(u.wait, __ATOMIC_RELAXED, __HIP_MEMORY_SCOPE_AGENT)) < 4u) { __builtin_amdgcn_s_sleep(1); if (++sp > (1u << 22)) break; }
    }
}
__device__ __forceinline__ void chain_publish(const Unit& u, int wid) {
    if (u.done) { asm volatile("s_waitcnt vmcnt(0)\n\ts_barrier" ::: "memory");
        if (wid == 0 && lane_id() == 0) __hip_atomic_fetch_add(u.done, 1u, __ATOMIC_RELAXED, __HIP_MEMORY_SCOPE_AGENT); }
}
template <class Epi, class Sched, bool ALIGN_EPI = true, bool SP2 = true, bool CHAIN = false>
__device__ __forceinline__ void gemm_phase(LAS unsigned char* lds, const int lda, const int ldb, const int K, const Sched& S, const Epi& E, const int wv) {
    int lane = lane_id(); asm volatile("" : "+v"(lane));
    const int wid = wv, tid = wv * 64 + lane, wr = wid >> 2, wc = wid & 3, fr = lane & 15, fq = lane >> 4;
    const int nt = K / BK;
    unsigned voffA[2], voffB[2];
#pragma unroll
    for (int i = 0; i < 2; ++i) { int R, C; stage_rc(tid * 16 + i * 8192, R, C); const int Rb = Epi::PERM ? ((R & ~31) + perm32(R & 31)) : R;
        voffA[i] = (unsigned)(R * lda + C) * 2u; voffB[i] = (unsigned)(Rb * ldb + C) * 2u; }
    const size_t kstep = (size_t)(BK * 2);
    const size_t hstepA = (size_t)HALF * lda * 2, hstepB = (size_t)HALF * ldb * 2;
    const unsigned ldsw = (unsigned)wid * 1024u;
    const int aoff = lds_byte(wr * 64 + fr, fq * 8), boff = lds_byte(wc * 32 + fr, fq * 8);
#define PG8_SA(b, h) (((b) * 2 + (h)) * HTB)
#define PG8_SB(b, h) ((4 + (b) * 2 + (h)) * HTB)
#define PG8_STAGE_(bufoff, gbase, voff, AUX) do { _Pragma("unroll") for (int _i = 0; _i < 2; ++_i) \
        __builtin_amdgcn_global_load_lds((const unsigned*)((const char*)(gbase) + (voff)[_i]), (LAS unsigned*)(lds + (bufoff) + ldsw + _i * 8192), 16, 0, AUX); } while (0)
#define PG8_STAGE(bufoff, gbase, voff) PG8_STAGE_(bufoff, gbase, voff, 0)
#define PG8_STAGEA(bufoff, gbase, voff) do { if constexpr (CHAIN) PG8_STAGE_(bufoff, gbase, voff, 16); else PG8_STAGE_(bufoff, gbase, voff, 0); } while (0)
#define PG8_LDA(dst, b, h) do { _Pragma("unroll") for (int m = 0; m < 4; ++m) _Pragma("unroll") for (int k = 0; k < 2; ++k) dst[m][k] = *(const LAS bf16x8*)(lds + PG8_SA(b, h) + aoff + m * 2048 + k * 1024); } while (0)
#define PG8_LDB(dst, b, h) do { _Pragma("unroll") for (int n = 0; n < 2; ++n) _Pragma("unroll") for (int k = 0; k < 2; ++k) dst[n][k] = *(const LAS bf16x8*)(lds + PG8_SB(b, h) + boff + n * 2048 + k * 1024); } while (0)
#define PG8_MMA(ai, bj, At, Bt) do { __builtin_amdgcn_s_setprio(1); _Pragma("unroll") for (int m = 0; m < 4; ++m) _Pragma("unroll") for (int n = 0; n < 2; ++n) _Pragma("unroll") for (int k = 0; k < 2; ++k) \
        acc[ai][bj][m][n] = __builtin_amdgcn_mfma_f32_16x16x32_bf16(Bt[n][k], At[m][k], acc[ai][bj][m][n], 0, 0, 0); __builtin_amdgcn_s_setprio(0); } while (0)
#define PG8_WAIT_V(n) asm volatile("s_waitcnt vmcnt(" #n ")" ::: "memory")
#define PG8_WAIT_L(n) asm volatile("s_waitcnt lgkmcnt(" #n ")" ::: "memory")
#define PG8_BAR __builtin_amdgcn_s_barrier()
#define PG8_SCHED __builtin_amdgcn_sched_barrier(0)
    Unit cur, nxt; int ui = 0;
    if (!S.next(0, cur)) return;
    if constexpr (Epi::MIDK) { if (E.midk_on(cur)) E.prep(cur, lds, wid, 0); }
    if constexpr (CHAIN) chain_wait(cur);
    f32x4 acc[2][2][4][2];
#pragma unroll
    for (int a = 0; a < 2; ++a)
#pragma unroll
        for (int b = 0; b < 2; ++b)
#pragma unroll
            for (int m = 0; m < 4; ++m)
#pragma unroll
                for (int n = 0; n < 2; ++n) acc[a][b][m][n] = (f32x4){0.f, 0.f, 0.f, 0.f};
    bf16x8 At[4][2], B0[2][2], B1[2][2];
    const char* cA = cur.A; const char* cB = cur.B;
    static_assert(SP2, "only the SP2 loop is kept");
    PG8_STAGE(PG8_SB(0, 0), cB, voffB); PG8_STAGE(PG8_SB(0, 1), cB + hstepB, voffB); PG8_STAGEA(PG8_SA(0, 0), cA, voffA); PG8_STAGEA(PG8_SA(0, 1), cA + hstepA, voffA);
    if (wr == 1) PG8_BAR;
    PG8_WAIT_V(2); PG8_BAR;
    PG8_STAGE(PG8_SB(1, 0), cB + kstep, voffB); PG8_STAGEA(PG8_SA(1, 0), cA + kstep, voffA); PG8_STAGE(PG8_SB(1, 1), cB + hstepB + kstep, voffB);
    PG8_WAIT_V(6); PG8_BAR;
    for (;;) {
        const bool has_next = S.next(ui + 1, nxt);
        const char* nA = has_next ? nxt.A : cA; const char* nB = has_next ? nxt.B : cB;
        for (int t = 0; t < nt; t += 2) {
            if constexpr (Epi::MIDK) { if (t == Epi::TSPLIT && E.midk_on(cur)) E.midk(acc, lds, ui & 1, wr); }
            const bool last = (t == nt - 2);
            if constexpr (CHAIN) { if (last && has_next) chain_wait(nxt); }
            const char* a1 = cA + (size_t)(t + 1) * kstep;
            const char* a2 = last ? nA : cA + (size_t)(t + 2) * kstep; const char* b2 = last ? nB : cB + (size_t)(t + 2) * kstep;
            const char* a3 = a2 + kstep; const char* b3 = b2 + kstep;
            PG8_LDB(B0, 0, 0); PG8_LDB(B1, 0, 1); PG8_SCHED; PG8_LDA(At, 0, 0); PG8_STAGEA(PG8_SA(1, 1), a1 + hstepA, voffA);
            PG8_WAIT_V(8); PG8_WAIT_L(0); PG8_BAR; PG8_MMA(0, 0, At, B0); PG8_MMA(0, 1, At, B1); PG8_BAR; PG8_SCHED;
            PG8_LDA(At, 0, 1); PG8_STAGE(PG8_SB(0, 0), b2, voffB); PG8_STAGE(PG8_SB(0, 1), b2 + hstepB, voffB); PG8_STAGEA(PG8_SA(0, 0), a2, voffA);
            PG8_WAIT_V(8); PG8_WAIT_L(0); PG8_BAR; PG8_MMA(1, 0, At, B0); PG8_MMA(1, 1, At, B1); PG8_BAR; PG8_SCHED;
            PG8_LDB(B0, 1, 0); PG8_LDB(B1, 1, 1); PG8_SCHED; PG8_LDA(At, 1, 0); PG8_STAGEA(PG8_SA(0, 1), a2 + hstepA, voffA);
            PG8_WAIT_V(8); PG8_WAIT_L(0); PG8_BAR; PG8_MMA(0, 0, At, B0); PG8_MMA(0, 1, At, B1); PG8_BAR; PG8_SCHED;
            PG8_LDA(At, 1, 1); PG8_STAGE(PG8_SB(1, 0), b3, voffB); PG8_STAGE(PG8_SB(1, 1), b3 + hstepB, voffB); PG8_STAGEA(PG8_SA(1, 0), a3, voffA);
            PG8_WAIT_V(8); PG8_WAIT_L(0); PG8_BAR; PG8_MMA(1, 0, At, B0); PG8_MMA(1, 1, At, B1); PG8_BAR; PG8_SCHED;
        }
        if constexpr (ALIGN_EPI) { if (wr == 0) PG8_BAR; }
        E(acc, cur, wr, wc, fr, fq, lds, wid, ui & 1);
        if constexpr (CHAIN) chain_publish(cur, wid);
        if (!has_next) break;
        if constexpr (Epi::MIDK) { if (E.midk_on(nxt)) E.prep(nxt, lds, wid, (ui + 1) & 1); }
#pragma unroll
        for (int a = 0; a < 2; ++a)
#pragma unroll
            for (int b = 0; b < 2; ++b)
#pragma unroll
                for (int m = 0; m < 4; ++m)
#pragma unroll
                    for (int n = 0; n < 2; ++n) acc[a][b][m][n] = (f32x4){0.f, 0.f, 0.f, 0.f};
        cur = nxt; cA = nA; cB = nB; ++ui;
        if constexpr (ALIGN_EPI) { if (wr == 1) PG8_BAR; }
    }
    PG8_WAIT_V(0);
    if constexpr (!ALIGN_EPI) { if (wr == 0) PG8_BAR; }
    PG8_BAR;
#undef PG8_SA
#undef PG8_SB
#undef PG8_STAGE
#undef PG8_STAGE_
#undef PG8_STAGEA
#undef PG8_LDA
#undef PG8_LDB
#undef PG8_MMA
#undef PG8_WAIT_V
#undef PG8_WAIT_L
#undef PG8_BAR
#undef PG8_SCHED
}
template <class Epi, class Sched>
__device__ __forceinline__ void gemm_phase_v(LAS unsigned char* lds, const Sched& S, const Epi& E, const int wv) {
    constexpr bool ALIGN_EPI = true, SP2 = true, CHAIN = false;
    int lane = lane_id(); asm volatile("" : "+v"(lane));
    const int wid = wv, tid = wv * 64 + lane, wr = wid >> 2, wc = wid & 3, fr = lane & 15, fq = lane >> 4;
    unsigned RA2[2], RB2[2], C2[2];
#pragma unroll
    for (int i = 0; i < 2; ++i) { int R, C; stage_rc(tid * 16 + i * 8192, R, C); const int Rb = Epi::PERM ? ((R & ~31) + perm32(R & 31)) : R;
        RA2[i] = (unsigned)R * 2u; RB2[i] = (unsigned)Rb * 2u; C2[i] = (unsigned)C * 2u; }
    const size_t kstep = (size_t)(BK * 2);
    const unsigned ldsw = (unsigned)wid * 1024u;
    const int aoff = lds_byte(wr * 64 + fr, fq * 8), boff = lds_byte(wc * 32 + fr, fq * 8);
#define PG8_SA(b, h) (((b) * 2 + (h)) * HTB)
#define PG8_SB(b, h) ((4 + (b) * 2 + (h)) * HTB)
#define PG8_STAGE_(bufoff, gbase, voff, AUX) do { _Pragma("unroll") for (int _i = 0; _i < 2; ++_i) \
        __builtin_amdgcn_global_load_lds((const unsigned*)((const char*)(gbase) + (voff)[_i]), (LAS unsigned*)(lds + (bufoff) + ldsw + _i * 8192), 16, 0, AUX); } while (0)
#define PG8_STAGEV(bufoff, gbase, R2, ld) do { _Pragma("unroll") for (int _i = 0; _i < 2; ++_i) \
        __builtin_amdgcn_global_load_lds((const unsigned*)((const char*)(gbase) + ((R2)[_i] * (unsigned)(ld) + C2[_i])), (LAS unsigned*)(lds + (bufoff) + ldsw + _i * 8192), 16, 0, 0); } while (0)
#define PG8_LDA(dst, b, h) do { _Pragma("unroll") for (int m = 0; m < 4; ++m) _Pragma("unroll") for (int k = 0; k < 2; ++k) dst[m][k] = *(const LAS bf16x8*)(lds + PG8_SA(b, h) + aoff + m * 2048 + k * 1024); } while (0)
#define PG8_LDB(dst, b, h) do { _Pragma("unroll") for (int n = 0; n < 2; ++n) _Pragma("unroll") for (int k = 0; k < 2; ++k) dst[n][k] = *(const LAS bf16x8*)(lds + PG8_SB(b, h) + boff + n * 2048 + k * 1024); } while (0)
#define PG8_MMA(ai, bj, At, Bt) do { __builtin_amdgcn_s_setprio(1); _Pragma("unroll") for (int m = 0; m < 4; ++m) _Pragma("unroll") for (int n = 0; n < 2; ++n) _Pragma("unroll") for (int k = 0; k < 2; ++k) \
        acc[ai][bj][m][n] = __builtin_amdgcn_mfma_f32_16x16x32_bf16(Bt[n][k], At[m][k], acc[ai][bj][m][n], 0, 0, 0); __builtin_amdgcn_s_setprio(0); } while (0)
#define PG8_WAIT_V(n) asm volatile("s_waitcnt vmcnt(" #n ")" ::: "memory")
#define PG8_WAIT_L(n) asm volatile("s_waitcnt lgkmcnt(" #n ")" ::: "memory")
#define PG8_BAR __builtin_amdgcn_s_barrier()
#define PG8_SCHED __builtin_amdgcn_sched_barrier(0)
    Unit cur, nxt; int ui = 0;
    if (!S.next(0, cur)) return;
    if constexpr (Epi::MIDK) { if (E.midk_on(cur)) E.prep(cur, lds, wid, 0); }
    if constexpr (CHAIN) chain_wait(cur);
    f32x4 acc[2][2][4][2];
#pragma unroll
    for (int a = 0; a < 2; ++a)
#pragma unroll
        for (int b = 0; b < 2; ++b)
#pragma unroll
            for (int m = 0; m < 4; ++m)
#pragma unroll
                for (int n = 0; n < 2; ++n) acc[a][b][m][n] = (f32x4){0.f, 0.f, 0.f, 0.f};
    bf16x8 At[4][2], B0[2][2], B1[2][2];
    const char* cA = cur.A; const char* cB = cur.B; int clda = cur.lda, cldb = cur.ldb, nt = cur.nt;
    size_t hstepA = (size_t)HALF * clda * 2, hstepB = (size_t)HALF * cldb * 2;
    static_assert(SP2, "only the SP2 loop is kept");
    PG8_STAGEV(PG8_SB(0, 0), cB, RB2, cldb); PG8_STAGEV(PG8_SB(0, 1), cB + hstepB, RB2, cldb); PG8_STAGEV(PG8_SA(0, 0), cA, RA2, clda); PG8_STAGEV(PG8_SA(0, 1), cA + hstepA, RA2, clda);
    if (wr == 1) PG8_BAR;
    PG8_WAIT_V(2); PG8_BAR;
    PG8_STAGEV(PG8_SB(1, 0), cB + kstep, RB2, cldb); PG8_STAGEV(PG8_SA(1, 0), cA + kstep, RA2, clda); PG8_STAGEV(PG8_SB(1, 1), cB + hstepB + kstep, RB2, cldb);
    PG8_WAIT_V(6); PG8_BAR;
    for (;;) {
        const bool has_next = S.next(ui + 1, nxt);
        const char* nA = has_next ? nxt.A : cA; const char* nB = has_next ? nxt.B : cB; const int nlda = has_next ? nxt.lda : clda, nldb = has_next ? nxt.ldb : cldb;
        const size_t nhA = (size_t)HALF * nlda * 2, nhB = (size_t)HALF * nldb * 2;
        for (int t = 0; t < nt; t += 2) {
            if constexpr (Epi::MIDK) { if (t == Epi::TSPLIT && E.midk_on(cur)) E.midk(acc, lds, ui & 1, wr); }
            const bool last = (t == nt - 2);
            if constexpr (CHAIN) { if (last && has_next) chain_wait(nxt); }
            const char* a1 = cA + (size_t)(t + 1) * kstep;
            const char* a2 = last ? nA : cA + (size_t)(t + 2) * kstep; const char* b2 = last ? nB : cB + (size_t)(t + 2) * kstep;
            const char* a3 = a2 + kstep; const char* b3 = b2 + kstep;
            const int l2a = last ? nlda : clda, l2b = last ? nldb : cldb; const size_t h2A = last ? nhA : hstepA, h2B = last ? nhB : hstepB;
            PG8_LDB(B0, 0, 0); PG8_LDB(B1, 0, 1); PG8_SCHED; PG8_LDA(At, 0, 0); PG8_STAGEV(PG8_SA(1, 1), a1 + hstepA, RA2, clda);
            PG8_WAIT_V(8); PG8_WAIT_L(0); PG8_BAR; PG8_MMA(0, 0, At, B0); PG8_MMA(0, 1, At, B1); PG8_BAR; PG8_SCHED;
            PG8_LDA(At, 0, 1); PG8_STAGEV(PG8_SB(0, 0), b2, RB2, l2b); PG8_STAGEV(PG8_SB(0, 1), b2 + h2B, RB2, l2b); PG8_STAGEV(PG8_SA(0, 0), a2, RA2, l2a);
            PG8_WAIT_V(8); PG8_WAIT_L(0); PG8_BAR; PG8_MMA(1, 0, At, B0); PG8_MMA(1, 1, At, B1); PG8_BAR; PG8_SCHED;
            PG8_LDB(B0, 1, 0); PG8_LDB(B1, 1, 1); PG8_SCHED; PG8_LDA(At, 1, 0); PG8_STAGEV(PG8_SA(0, 1), a2 + h2A, RA2, l2a);
            PG8_WAIT_V(8); PG8_WAIT_L(0); PG8_BAR; PG8_MMA(0, 0, At, B0); PG8_MMA(0, 1, At, B1); PG8_BAR; PG8_SCHED;
            PG8_LDA(At, 1, 1); PG8_STAGEV(PG8_SB(1, 0), b3, RB2, l2b); PG8_STAGEV(PG8_SB(1, 1), b3 + h2B, RB2, l2b); PG8_STAGEV(PG8_SA(1, 0), a3, RA2, l2a);
            PG8_WAIT_V(8); PG8_WAIT_L(0); PG8_BAR; PG8_MMA(1, 0, At, B0); PG8_MMA(1, 1, At, B1); PG8_BAR; PG8_SCHED;
        }
        if constexpr (ALIGN_EPI) { if (wr == 0) PG8_BAR; }
        E(acc, cur, wr, wc, fr, fq, lds, wid, ui & 1);
        if constexpr (CHAIN) chain_publish(cur, wid);
        if (!has_next) break;
        if constexpr (Epi::MIDK) { if (E.midk_on(nxt)) E.prep(nxt, lds, wid, (ui + 1) & 1); }
#pragma unroll
        for (int a = 0; a < 2; ++a)
#pragma unroll
            for (int b = 0; b < 2; ++b)
#pragma unroll
                for (int m = 0; m < 4; ++m)
#pragma unroll
                    for (int n = 0; n < 2; ++n) acc[a][b][m][n] = (f32x4){0.f, 0.f, 0.f, 0.f};
        cur = nxt; cA = nA; cB = nB; ++ui; clda = nlda; cldb = nldb; hstepA = nhA; hstepB = nhB; nt = cur.nt;
        if constexpr (ALIGN_EPI) { if (wr == 1) PG8_BAR; }
    }
    PG8_WAIT_V(0);
    if constexpr (!ALIGN_EPI) { if (wr == 0) PG8_BAR; }
    PG8_BAR;
#undef PG8_SA
#undef PG8_SB
#undef PG8_STAGE_
#undef PG8_STAGEV
#undef PG8_LDA
#undef PG8_LDB
#undef PG8_MMA
#undef PG8_WAIT_V
#undef PG8_WAIT_L
#undef PG8_BAR
#undef PG8_SCHED
}
}

typedef f32x4 Acc[2][2][4][2];
__device__ __forceinline__ void store16(void* p, u32x4 v, bool wt) {
    if (wt) asm volatile("global_store_dwordx4 %0, %1, off sc1\n\ts_nop 1" :: "v"(p), "v"(v) : "memory"); else *(u32x4*)p = v;
}
__device__ __forceinline__ void ssq_rows_atomic(const Acc& acc, float* ssq, int row_base  , int bjmask, int fq, int lane) {
#pragma unroll
    for (int ai = 0; ai < 2; ++ai) {
        float s[4];
#pragma unroll
        for (int m = 0; m < 4; ++m) { float q = 0.f;
#pragma unroll
            for (int bj = 0; bj < 2; ++bj) if (bjmask & (1 << bj))
#pragma unroll
                for (int n = 0; n < 2; ++n) { const f32x4 x = acc[ai][bj][m][n]; q += (x[0] * x[0] + x[1] * x[1]) + (x[2] * x[2] + x[3] * x[3]); }
            q += __shfl_xor(q, 16); q += __shfl_xor(q, 32); s[m] = q; }
        const float v = fq == 0 ? s[0] : fq == 1 ? s[1] : fq == 2 ? s[2] : s[3];
        atomicAdd(ssq + row_base + ai * 128 + lane, v);
    }
}
struct EpiBf16 {
    static constexpr bool PERM = true, MIDK = false;
    bf16_t* O; int ldc; float scale; const float* ssq; float rdim_inv;
    __device__ __forceinline__ void operator()(const Acc& acc, const pg8::Unit& u, int wr, int wc, int fr, int fq, LAS unsigned char*, int, int) const {
        { const int ln_ = lane_id(); fr = ln_ & 15; fq = ln_ >> 4; }
        const int row0 = u.pm * 256 + wr * 64 + fr, col0 = u.pn * 256 + wc * 32 + 8 * fq;
#pragma unroll
        for (int ai = 0; ai < 2; ++ai)
#pragma unroll
            for (int m = 0; m < 4; ++m) { const int row = row0 + ai * 128 + m * 16; float sc = scale;
                if (ssq) sc *= __builtin_amdgcn_rsqf(ssq[row] * rdim_inv + EPS);
                bf16_t* rowp = O + u.cofs + (size_t)row * ldc + col0;
#pragma unroll
                for (int bj = 0; bj < 2; ++bj) { const f32x4 v0 = acc[ai][bj][m][0] * sc, v1 = acc[ai][bj][m][1] * sc;
                    u32x4 w; w.x = cvt_pk_bf16(v0[0], v0[1]); w.y = cvt_pk_bf16(v0[2], v0[3]); w.z = cvt_pk_bf16(v1[0], v1[1]); w.w = cvt_pk_bf16(v1[2], v1[3]);
                    *(u32x4*)(rowp + bj * 128) = w; } }
    }
};
__device__ __forceinline__ void rope8(f32x4& v0, f32x4& v1, const float* cosT, const float* sinT, int row, int i0) {
    const f32x4 c = *(const f32x4*)(cosT + (size_t)row * 32 + i0), s = *(const f32x4*)(sinT + (size_t)row * 32 + i0);
    const f32x4 a = v0, b = v1;
    v0[0] = a[0] * c[0] - a[1] * s[0]; v0[1] = a[1] * c[0] + a[0] * s[0]; v0[2] = a[2] * c[1] - a[3] * s[1]; v0[3] = a[3] * c[1] + a[2] * s[1];
    v1[0] = b[0] * c[2] - b[1] * s[2]; v1[1] = b[1] * c[2] + b[0] * s[2]; v1[2] = b[2] * c[3] - b[3] * s[3]; v1[3] = b[3] * c[3] + b[2] * s[3];
}
struct EpiZ {
    static constexpr bool PERM = true, MIDK = false;
    bf16_t* Z; bf16_t* KPE; float* ssq_cq; float* ssq_ckv; const float* cosT; const float* sinT; const float* ssq_x;
    __device__ __forceinline__ void operator()(Acc& acc, const pg8::Unit& u, int wr, int wc, int fr, int fq, LAS unsigned char*, int, int lane) const {
        { const int ln_ = lane_id(); fr = ln_ & 15; fq = ln_ >> 4; }
        const int row0 = u.pm * 256 + wr * 64 + fr, col0 = u.pn * 256 + wc * 32 + 8 * fq;
        const bool kpe_tile = (u.pn == 6);
#pragma unroll
        for (int ai = 0; ai < 2; ++ai)
#pragma unroll
            for (int m = 0; m < 4; ++m) { const float rsx = __builtin_amdgcn_rsqf(ssq_x[row0 + ai * 128 + m * 16] * (1.f / DM) + EPS);
#pragma unroll
                for (int bj = 0; bj < 2; ++bj)
#pragma unroll
                    for (int n = 0; n < 2; ++n) acc[ai][bj][m][n] = acc[ai][bj][m][n] * rsx; }
#pragma unroll
        for (int ai = 0; ai < 2; ++ai)
#pragma unroll
            for (int m = 0; m < 4; ++m) { const int row = row0 + ai * 128 + m * 16; bf16_t* rowp = Z + (size_t)row * DINP + col0;
#pragma unroll
                for (int bj = 0; bj < 2; ++bj) { f32x4 v0 = acc[ai][bj][m][0], v1 = acc[ai][bj][m][1];
                    if (kpe_tile && bj == 1) {
                        if (wc < 2) { rope8(v0, v1, cosT, sinT, row, 16 * (wc & 1) + 4 * fq);
                            u32x4 w; w.x = cvt_pk_bf16(v0[0], v0[1]); w.y = cvt_pk_bf16(v0[2], v0[3]); w.z = cvt_pk_bf16(v1[0], v1[1]); w.w = cvt_pk_bf16(v1[2], v1[3]);
                            *(u32x4*)(KPE + (size_t)row * 64 + wc * 32 + 8 * fq) = w; }
                    } else {
                        u32x4 w; w.x = cvt_pk_bf16(v0[0], v0[1]); w.y = cvt_pk_bf16(v0[2], v0[3]); w.z = cvt_pk_bf16(v1[0], v1[1]); w.w = cvt_pk_bf16(v1[2], v1[3]);
                        *(u32x4*)(rowp + bj * 128) = w; } } }
        const int rb = u.pm * 256 + wr * 64; lane = fq * 16 + fr;
        if (u.pn == 4) ssq_rows_atomic(acc, ssq_cq, rb, 3, fq, lane);
        else if (u.pn == 5) { ssq_rows_atomic(acc, ssq_cq, rb, 1, fq, lane); ssq_rows_atomic(acc, ssq_ckv, rb, 2, fq, lane); }
        else if (u.pn == 6) ssq_rows_atomic(acc, ssq_ckv, rb, 1, fq, lane);
    }
};
struct EpiQ {
    static constexpr bool PERM = true, MIDK = false;
    bf16_t* Q; const float* ssq; const float* cosT; const float* sinT;
    __device__ __forceinline__ void operator()(const Acc& acc, const pg8::Unit& u, int wr, int wc, int fr, int fq, LAS unsigned char*, int, int) const {
        { const int ln_ = lane_id(); fr = ln_ & 15; fq = ln_ >> 4; }
        const int row0 = u.pm * 256 + wr * 64 + fr, col0 = u.pn * 256 + wc * 32 + 8 * fq;
        const bool pe = (u.pn == 2);
#pragma unroll
        for (int ai = 0; ai < 2; ++ai)
#pragma unroll
            for (int m = 0; m < 4; ++m) { const int row = row0 + ai * 128 + m * 16;
                const float sc = QSCALE * __builtin_amdgcn_rsqf(ssq[row] * (1.f / QLR) + EPS);
                bf16_t* rowp = Q + (size_t)row * 768 + col0;
#pragma unroll
                for (int bj = 0; bj < 2; ++bj) { f32x4 v0 = acc[ai][bj][m][0] * sc, v1 = acc[ai][bj][m][1] * sc;
                    if (pe) rope8(v0, v1, cosT, sinT, row, 16 * (wc & 1) + 4 * fq);
                    u32x4 w; w.x = cvt_pk_bf16(v0[0], v0[1]); w.y = cvt_pk_bf16(v0[2], v0[3]); w.z = cvt_pk_bf16(v1[0], v1[1]); w.w = cvt_pk_bf16(v1[2], v1[3]);
                    *(u32x4*)(rowp + bj * 128) = w; } }
    }
};
struct EpiF32 {
    static constexpr bool PERM = false, MIDK = false;
    float* O; int ldc;
    __device__ __forceinline__ void operator()(const Acc& acc, const pg8::Unit& u, int wr, int wc, int fr, int fq, LAS unsigned char*, int, int) const {
        { const int ln_ = lane_id(); fr = ln_ & 15; fq = ln_ >> 4; }
        const int row0 = u.pm * 256 + wr * 64 + fr, col0 = u.pn * 256 + wc * 32 + 4 * fq;
#pragma unroll
        for (int ai = 0; ai < 2; ++ai)
#pragma unroll
            for (int m = 0; m < 4; ++m) { float* rowp = O + (size_t)(row0 + ai * 128 + m * 16) * ldc + col0;
#pragma unroll
                for (int bj = 0; bj < 2; ++bj)
#pragma unroll
                    for (int n = 0; n < 2; ++n) *(f32x4*)(rowp + bj * 128 + n * 16) = acc[ai][bj][m][n]; }
    }
};
struct EpiSwiGLU {
    static constexpr bool PERM = true, MIDK = false;
    bf16_t* F; const float* ssq;
    __device__ __forceinline__ void operator()(const Acc& acc, const pg8::Unit& u, int wr, int wc, int fr, int fq, LAS unsigned char*, int, int) const {
        { const int ln_ = lane_id(); fr = ln_ & 15; fq = ln_ >> 4; }
        const int row0 = u.pm * 256 + wr * 64 + fr, col0 = u.pn * 128 + wc * 32 + 8 * fq;
        float sq[2][4];
#pragma unroll
        for (int ai = 0; ai < 2; ++ai)
#pragma unroll
            for (int m = 0; m < 4; ++m) sq[ai][m] = ssq[row0 + ai * 128 + m * 16];
#pragma unroll
        for (int ai = 0; ai < 2; ++ai)
#pragma unroll
            for (int m = 0; m < 4; ++m) { bf16_t* rowp = F + (size_t)(row0 + ai * 128 + m * 16) * DFF + col0; float f[8];
                const float rsc = __builtin_amdgcn_rsqf(sq[ai][m] * (1.f / DM) + EPS);
#pragma unroll
                for (int n = 0; n < 2; ++n)
#pragma unroll
                    for (int e = 0; e < 4; ++e) { const float g = acc[ai][0][m][n][e] * rsc, up = acc[ai][1][m][n][e] * rsc;
                        f[n * 4 + e] = g * __builtin_amdgcn_rcpf(1.f + __builtin_amdgcn_exp2f(-g * LOG2E)) * up; }
                u32x4 w; w.x = cvt_pk_bf16(f[0], f[1]); w.y = cvt_pk_bf16(f[2], f[3]); w.z = cvt_pk_bf16(f[4], f[5]); w.w = cvt_pk_bf16(f[6], f[7]);
                *(u32x4*)rowp = w; }
    }
};
struct EpiSoftmax {
    static constexpr bool PERM = true, MIDK = false;
    bf16_t* P; const float* ssq; bool wt;
    __device__ __forceinline__ void operator()(Acc& acc, const pg8::Unit& u, int wr, int wc, int fr, int fq, LAS unsigned char* lds, int, int) const {
        { const int ln_ = lane_id(); fr = ln_ & 15; fq = ln_ >> 4; }
        LAS float* PM = (LAS float*)(lds + EPI_OFF);
        LAS float* PS = (LAS float*)(lds + EPI_OFF + 4096);
        float sq[2][4];
#pragma unroll
        for (int ai = 0; ai < 2; ++ai)
#pragma unroll
            for (int m = 0; m < 4; ++m) sq[ai][m] = ssq[u.pm * 256 + ai * 128 + wr * 64 + m * 16 + fr];
        float mxr[2][4];
#pragma unroll
        for (int ai = 0; ai < 2; ++ai)
#pragma unroll
            for (int m = 0; m < 4; ++m) { float q = -3.0e38f;
#pragma unroll
                for (int bj = 0; bj < 2; ++bj)
#pragma unroll
                    for (int n = 0; n < 2; ++n) { const f32x4 x = acc[ai][bj][m][n]; q = fmaxf(q, fmaxf(fmaxf(x[0], x[1]), fmaxf(x[2], x[3]))); }
                q = fmaxf(q, __shfl_xor(q, 16)); q = fmaxf(q, __shfl_xor(q, 32)); mxr[ai][m] = q; }
#pragma unroll
        for (int ai = 0; ai < 2; ++ai)
#pragma unroll
            for (int m = 0; m < 4; ++m) { sq[ai][m] = __builtin_amdgcn_rsqf(sq[ai][m] * (1.f / DM) + EPS);
                if (fq == 0) PM[(ai * 128 + wr * 64 + m * 16 + fr) * 4 + wc] = mxr[ai][m] * sq[ai][m]; }
        LDS_WAIT(); __builtin_amdgcn_s_barrier(); asm volatile("" ::: "memory");
#pragma unroll
        for (int ai = 0; ai < 2; ++ai)
#pragma unroll
            for (int m = 0; m < 4; ++m) { const f32x4 t = *(const LAS f32x4*)(PM + (ai * 128 + wr * 64 + m * 16 + fr) * 4);
                const float rm = fmaxf(fmaxf(t[0], t[1]), fmaxf(t[2], t[3])), rsc = sq[ai][m]; float s = 0.f;
#pragma unroll
                for (int bj = 0; bj < 2; ++bj)
#pragma unroll
                    for (int n = 0; n < 2; ++n) { f32x4 x = acc[ai][bj][m][n];
#pragma unroll
                        for (int e = 0; e < 4; ++e) { x[e] = __builtin_amdgcn_exp2f(fmaf(x[e], rsc, -rm)); s += x[e]; }
                        acc[ai][bj][m][n] = x; }
                s += __shfl_xor(s, 16); s += __shfl_xor(s, 32);
                if (fq == 0) PS[(ai * 128 + wr * 64 + m * 16 + fr) * 4 + wc] = s; }
        LDS_WAIT(); __builtin_amdgcn_s_barrier(); asm volatile("" ::: "memory");
        const int row0 = u.pm * 256 + wr * 64 + fr, col0 = u.pn * 256 + wc * 32 + 8 * fq;
#pragma unroll
        for (int ai = 0; ai < 2; ++ai)
#pragma unroll
            for (int m = 0; m < 4; ++m) { const f32x4 t = *(const LAS f32x4*)(PS + (ai * 128 + wr * 64 + m * 16 + fr) * 4);
                const float inv = __builtin_amdgcn_rcpf((t[0] + t[1]) + (t[2] + t[3]));
                bf16_t* rowp = P + (size_t)(row0 + ai * 128 + m * 16) * DM + col0;
#pragma unroll
                for (int bj = 0; bj < 2; ++bj) { const f32x4 v0 = acc[ai][bj][m][0] * inv, v1 = acc[ai][bj][m][1] * inv;
                    u32x4 w; w.x = cvt_pk_bf16(v0[0], v0[1]); w.y = cvt_pk_bf16(v0[2], v0[3]); w.z = cvt_pk_bf16(v1[0], v1[1]); w.w = cvt_pk_bf16(v1[2], v1[3]);
                    store16(rowp + bj * 128, w, wt); } }
    }
};

__device__ __forceinline__ unsigned ag_ld(const unsigned* p) { return __hip_atomic_load(p, __ATOMIC_RELAXED, __HIP_MEMORY_SCOPE_AGENT); }
template <bool MIDK_>
struct EpiNormResT {
    static constexpr bool PERM = true, MIDK = MIDK_; static constexpr int TSPLIT = 8;
    const float* hold_f; const bf16_t* hold_b; float* hout; const float* gpost; bf16_t* xn; float* ssq_next; float* slots; unsigned* cnt;
    bool wt;
    __device__ __forceinline__ bool midk_on(const pg8::Unit&) const { return MIDK_; }
    const float* ssq_a; const float* ssq_b;
    __device__ __forceinline__ void prep(const pg8::Unit& u, LAS unsigned char* lds, int wid, int par) const {
        if (wid < 4) { const int ln = lane_id(), row = wid * 64 + ln; const float sa = ssq_a[u.pm * 256 + row], sb = ssq_b[u.pm * 256 + row];
            const float ra = __builtin_amdgcn_rsqf(sa * (1.f / 512) + EPS), rb = __builtin_amdgcn_rsqf(sb * (1.f / 512) + EPS);
            ((LAS f32x2*)(lds + EPI_OFF + 5120))[par * 256 + row] = (f32x2){ra * __builtin_amdgcn_rcpf(rb), rb}; }
    }
    __device__ __forceinline__ void midk(Acc& acc, LAS unsigned char* lds, int par, int wr) const {
        const int ln = lane_id(), fr = ln & 15; const LAS f32x2* RT = (const LAS f32x2*)(lds + EPI_OFF + 5120) + par * 256;
#pragma unroll
        for (int ai = 0; ai < 2; ++ai)
#pragma unroll
            for (int m = 0; m < 4; ++m) { const float r = RT[ai * 128 + wr * 64 + m * 16 + fr].x;
#pragma unroll
                for (int bj = 0; bj < 2; ++bj)
#pragma unroll
                    for (int n = 0; n < 2; ++n) acc[ai][bj][m][n] = acc[ai][bj][m][n] * r; }
    }
    __device__ __forceinline__ void operator()(Acc& acc, const pg8::Unit& u, int wr, int wc, int fr, int fq, LAS unsigned char* lds, int wid, int par) const {
        const int ln = lane_id(); fr = ln & 15; fq = ln >> 4;
        if constexpr (MIDK_) { const LAS f32x2* RT = (const LAS f32x2*)(lds + EPI_OFF + 5120) + par * 256;
#pragma unroll
            for (int ai = 0; ai < 2; ++ai)
#pragma unroll
                for (int m = 0; m < 4; ++m) { const float r = RT[ai * 128 + wr * 64 + m * 16 + fr].y;
#pragma unroll
                    for (int bj = 0; bj < 2; ++bj)
#pragma unroll
                        for (int n = 0; n < 2; ++n) acc[ai][bj][m][n] = acc[ai][bj][m][n] * r; } }
        LAS float* PT = (LAS float*)(lds + EPI_OFF);
        LAS float* SR = (LAS float*)(lds + EPI_OFF + 4096);
        const int col0 = u.pn * 256 + wc * 32 + 8 * fq;
        f32x4 gv[2][2];
#pragma unroll
        for (int bj = 0; bj < 2; ++bj)
#pragma unroll
            for (int n = 0; n < 2; ++n) gv[bj][n] = *(const f32x4*)(gpost + col0 + bj * 128 + n * 4);
        u32x4 hb[2][4][2];
#pragma unroll
        for (int ai = 0; ai < 2; ++ai)
#pragma unroll
            for (int m = 0; m < 4; ++m) { float q = 0.f;
#pragma unroll
                for (int bj = 0; bj < 2; ++bj)
#pragma unroll
                    for (int n = 0; n < 2; ++n) { const f32x4 x = acc[ai][bj][m][n]; q += (x[0] * x[0] + x[1] * x[1]) + (x[2] * x[2] + x[3] * x[3]); }
                q += __shfl_xor(q, 16); q += __shfl_xor(q, 32);
                if (fq == 0) PT[(ai * 128 + wr * 64 + m * 16 + fr) * 4 + wc] = q; }
        LDS_WAIT(); __builtin_amdgcn_s_barrier(); asm volatile("" ::: "memory");
        unsigned* c = cnt + 64 * u.pm;
        if (wid < 4) { const int row = wid * 64 + ln; const f32x4 t = *(const LAS f32x4*)(PT + row * 4); const float sq = (t[0] + t[1]) + (t[2] + t[3]);
            __hip_atomic_store((unsigned*)slots + ((size_t)(u.pm * 256 + row) * 4 + u.pn), __float_as_uint(sq), __ATOMIC_RELAXED, __HIP_MEMORY_SCOPE_AGENT);
            asm volatile("s_waitcnt vmcnt(0)" ::: "memory");
            if (ln == 0) __hip_atomic_fetch_add(c, 1u, __ATOMIC_RELAXED, __HIP_MEMORY_SCOPE_AGENT); }
        if (!hold_f) {
#pragma unroll
            for (int ai = 0; ai < 2; ++ai)
#pragma unroll
                for (int m = 0; m < 4; ++m)
#pragma unroll
                    for (int bj = 0; bj < 2; ++bj) hb[ai][m][bj] = __builtin_nontemporal_load((const u32x4*)(hold_b + (size_t)(u.pm * 256 + ai * 128 + wr * 64 + m * 16 + fr) * DM + col0 + bj * 128)); }
        if (wid == 0) { unsigned sp = 0;
            while ((unsigned)__builtin_amdgcn_readfirstlane(ag_ld(c)) < 16u) { __builtin_amdgcn_s_sleep(2); if (++sp > (1u << 21)) break; } }
        asm volatile("s_waitcnt lgkmcnt(0)" ::: "memory"); __builtin_amdgcn_s_barrier(); asm volatile("" ::: "memory");
        if (wid < 4) { const int row = wid * 64 + ln; const unsigned* sl = (const unsigned*)slots + (size_t)(u.pm * 256 + row) * 4;
            const float tot = (__uint_as_float(ag_ld(sl)) + __uint_as_float(ag_ld(sl + 1))) + (__uint_as_float(ag_ld(sl + 2)) + __uint_as_float(ag_ld(sl + 3)));
            SR[row] = __builtin_amdgcn_rsqf(tot * (1.f / DM) + EPS); }
        LDS_WAIT(); __builtin_amdgcn_s_barrier(); asm volatile("" ::: "memory");
#pragma unroll
        for (int ai = 0; ai < 2; ++ai) { float s[4];
#pragma unroll
            for (int m = 0; m < 4; ++m) { const int rl = ai * 128 + wr * 64 + m * 16 + fr; const float rs = SR[rl]; const size_t off = (size_t)(u.pm * 256 + rl) * DM + col0; float q = 0.f;
#pragma unroll
                for (int bj = 0; bj < 2; ++bj) { f32x4 h0, h1;
                    if (hold_f) { h0 = *(const f32x4*)(hold_f + off + bj * 128); h1 = *(const f32x4*)(hold_f + off + bj * 128 + 4); }
                    else { const u32x4 hv = hb[ai][m][bj]; h0 = (f32x4){bflo(hv.x), bfhi(hv.x), bflo(hv.y), bfhi(hv.y)}; h1 = (f32x4){bflo(hv.z), bfhi(hv.z), bflo(hv.w), bfhi(hv.w)}; }
                    const f32x4 v0 = h0 + acc[ai][bj][m][0] * rs * gv[bj][0], v1 = h1 + acc[ai][bj][m][1] * rs * gv[bj][1];
                    q += ((v0[0] * v0[0] + v0[1] * v0[1]) + (v0[2] * v0[2] + v0[3] * v0[3])) + ((v1[0] * v1[0] + v1[1] * v1[1]) + (v1[2] * v1[2] + v1[3] * v1[3]));
                    if (hout) { __builtin_nontemporal_store(v0, (f32x4*)(hout + off + bj * 128)); __builtin_nontemporal_store(v1, (f32x4*)(hout + off + bj * 128 + 4)); }
                    if (xn) { u32x4 w; w.x = cvt_pk_bf16(v0[0], v0[1]); w.y = cvt_pk_bf16(v0[2], v0[3]); w.z = cvt_pk_bf16(v1[0], v1[1]); w.w = cvt_pk_bf16(v1[2], v1[3]); store16(xn + off + bj * 128, w, wt); } }
                q += __shfl_xor(q, 16); q += __shfl_xor(q, 32); s[m] = q; }
            if (ssq_next) { const float v = fq == 0 ? s[0] : fq == 1 ? s[1] : fq == 2 ? s[2] : s[3]; atomicAdd(ssq_next + u.pm * 256 + wr * 64 + ai * 128 + ln, v); } }
    }
};
typedef EpiNormResT<false> EpiNormRes;
typedef EpiNormResT<true> EpiNormResMid;
struct ChainOrder {
    pg8::TileOrder o; unsigned* wt_base; unsigned* dn_base;
    __device__ bool next(int i, pg8::Unit& u) const { if (!o.next(i, u)) return false; u.wait = wt_base ? wt_base + 64 * u.pm : nullptr; u.done = dn_base ? dn_base + 64 * u.pm : nullptr; return true; }
};

struct EpiP2 { static constexpr bool PERM = true, MIDK = false; EpiQ eq; EpiBf16 ekv, eqk, evo;
    __device__ __forceinline__ void operator()(Acc& acc, const pg8::Unit& u, int wr, int wc, int fr, int fq, LAS unsigned char* l, int wid, int par) const {
        if (u.job == 0) eq(acc, u, wr, wc, fr, fq, l, wid, par); else if (u.job == 1) ekv(acc, u, wr, wc, fr, fq, l, wid, par);
        else if (u.job == 2) eqk(acc, u, wr, wc, fr, fq, l, wid, par); else evo(acc, u, wr, wc, fr, fq, l, wid, par); } };

struct EpiP1 { static constexpr bool PERM = true, MIDK = false; EpiZ ez; EpiBf16 eb;
    __device__ __forceinline__ void operator()(Acc& acc, const pg8::Unit& u, int wr, int wc, int fr, int fq, LAS unsigned char* l, int wid, int par) const {
        if (u.job == 0) ez(acc, u, wr, wc, fr, fq, l, wid, par); else eb(acc, u, wr, wc, fr, fq, l, wid, par); } };

#define XB_TMO      128
#define XB_XCNT(j)  (256  + 64 * (j))
#define XB_XSUB(j)  (1280 + 64 * (j))
#define XB_XGEN(j)  (2304 + 64 * (j))
#define XB_TOP      3328
#define XB_TOPGEN   3392
#define XCD_BAR_WORDS 3456
#define XB_SPIN_CAP (1u << 20)
__device__ __forceinline__ unsigned xb_ld(unsigned* p)              { return __hip_atomic_load(p, __ATOMIC_RELAXED, __HIP_MEMORY_SCOPE_AGENT); }
__device__ __forceinline__ unsigned xb_add(unsigned* p, unsigned v) { return __hip_atomic_fetch_add(p, v, __ATOMIC_RELAXED, __HIP_MEMORY_SCOPE_AGENT); }
__device__ __forceinline__ unsigned xb_xcc_id() { return (unsigned)__builtin_amdgcn_s_getreg((3 << 11) | 20) & 0xFu; }
#define XB_SPIN(cond, bar) do { unsigned _sp = 0; while (cond) { __builtin_amdgcn_s_sleep(1); \
    if ((++_sp & 255u) == 0u) { if (xb_ld(&(bar)[XB_TMO])) break; if (_sp > XB_SPIN_CAP) { atomicAdd(&(bar)[XB_TMO], 1u); break; } } } } while (0)
struct XcdBarrier { unsigned* bar; unsigned x; volatile LAS unsigned* st; unsigned G; };
__device__ __forceinline__ XcdBarrier xcd_barrier_post(unsigned* bar, volatile LAS unsigned* st, unsigned G) {
    XcdBarrier b; b.bar = bar; b.x = xb_xcc_id(); b.st = st; b.G = G;
    if (threadIdx.x == 0) (void)xb_add(&bar[XB_XCNT(b.x)], 1u);
    return b;
}
__device__ __forceinline__ void xcd_barrier_complete(unsigned* bar, unsigned x, unsigned& nloc, unsigned& nx, const unsigned G) {
    unsigned sum, cnt, mine, sp = 0u;
    for (;;) {
        sum = 0u; cnt = 0u; mine = 0u;
#pragma unroll
        for (unsigned j = 0; j < 16; ++j) { const unsigned c = xb_ld(&bar[XB_XCNT(j)]); sum += c; cnt += (c > 0u) ? 1u : 0u; mine = (j == x) ? c : mine; }
        if (sum == G) break;
        __builtin_amdgcn_s_sleep(1);
        if ((++sp & 255u) == 0u) { if (xb_ld(&bar[XB_TMO])) break; if (sp > XB_SPIN_CAP) { atomicAdd(&bar[XB_TMO], 1u); break; } }
    }
    nloc = mine > 0u ? mine : 1u; nx = cnt > 0u ? cnt : 1u;
}
__device__ __forceinline__ void xcd_barrier(const XcdBarrier& b, const int wv) {
    asm volatile("s_waitcnt vmcnt(0)" ::: "memory");
    __syncthreads();
    if (wv == 0 && lane_id() == 0) {
        unsigned* bar = b.bar;
        __builtin_amdgcn_s_waitcnt(0);
        unsigned nloc = b.st[0], nx = b.st[1];
        if (nloc == 0u) { xcd_barrier_complete(bar, b.x, nloc, nx, b.G); b.st[0] = nloc; b.st[1] = nx; }
        const unsigned old = xb_add(&bar[XB_XSUB(b.x)], 1u);
        const unsigned gen = old / nloc;
        if (old + 1u == (gen + 1u) * nloc) {
            __builtin_amdgcn_fence(__ATOMIC_RELEASE, "agent");
            asm volatile("s_waitcnt vmcnt(0)" ::: "memory");
            const unsigned og = xb_add(&bar[XB_TOP], 1u);
            const unsigned tg = og / nx;
            if (og + 1u == (tg + 1u) * nx) xb_add(&bar[XB_TOPGEN], 1u);
            else XB_SPIN(xb_ld(&bar[XB_TOPGEN]) == tg, bar);
            __builtin_amdgcn_fence(__ATOMIC_ACQUIRE, "agent");
            xb_add(&bar[XB_XGEN(b.x)], 1u);
            asm volatile("s_waitcnt vmcnt(0)" ::: "memory");
        } else {
            XB_SPIN(xb_ld(&bar[XB_XGEN(b.x)]) == gen, bar);
            __builtin_amdgcn_fence(__ATOMIC_ACQUIRE, "agent");
            asm volatile("s_waitcnt vmcnt(0)" ::: "memory");
        }
    }
    __syncthreads();
}

enum { MAP_ID = 0, MAP_WIN = 1, MAP_WUQ = 2, MAP_WUKV = 3, MAP_GATE = 4, MAP_UP = 5 };
__device__ __forceinline__ int map_n(int mode, int n) {
    switch (mode) {
    case MAP_WIN: { if (n < OFF_KPE) return n; const int j = n - OFF_KPE; return OFF_KPE + (j < 32 ? 2 * j : 2 * (j - 32) + 1); }
    case MAP_WUQ: { const int h = n / 192, d = n % 192; if (d < 128) return h * 128 + d; const int j = d - 128; return 512 + h * 64 + (j < 32 ? 2 * j : 2 * (j - 32) + 1); }
    case MAP_WUKV: { const int h = n / 256, d = n % 256; return d < 128 ? h * 128 + d : 512 + h * 128 + (d - 128); }
    case MAP_GATE: return (n >> 7) * 256 + (n & 127);
    case MAP_UP: return (n >> 7) * 256 + 128 + (n & 127);
    default: return n;
    }
}
__device__ __forceinline__ void p0_transpose_item(const float* W, int K, int N, bf16_t* WT, int row_off, int mode, const float* kscale, const float* kscale2, LAS float* scr, int item, int lane) {
    const int nblk = N / 64, kb = item / nblk, nb = item % nblk, k0 = 64 * kb, n0 = 64 * nb;
    float v[64];
#pragma unroll
    for (int i = 0; i < 64; ++i) v[i] = __builtin_nontemporal_load(W + (size_t)(k0 + i) * N + n0 + lane);
    if (kscale) { const float* ks = (kscale2 && k0 >= 512) ? kscale2 - 512 : kscale;
#pragma unroll
        for (int i = 0; i < 64; ++i) v[i] *= ks[k0 + i]; }
#pragma unroll
    for (int i = 0; i < 64; ++i) scr[i * 65 + lane] = v[i];
    LDS_WAIT(); asm volatile("" ::: "memory");
    const int c = lane & 7;
#pragma unroll
    for (int j = 0; j < 8; ++j) { const int n = (lane >> 3) + 8 * j; const LAS float* sp = scr + (8 * c) * 65 + n;
        u32x4 o; o.x = cvt_pk_bf16(sp[0 * 65], sp[1 * 65]); o.y = cvt_pk_bf16(sp[2 * 65], sp[3 * 65]); o.z = cvt_pk_bf16(sp[4 * 65], sp[5 * 65]); o.w = cvt_pk_bf16(sp[6 * 65], sp[7 * 65]);
        *(u32x4*)(WT + (size_t)(row_off + map_n(mode, n0 + n)) * K + k0 + 8 * c) = o; }
    LDS_WAIT(); asm volatile("" ::: "memory");
}
template <int R, bool NORM>
__device__ __forceinline__ void rms_rows_to_bf16(const float* xrow, const float* g, bf16_t* orow, float* ssq_out, int lane) {
    f32x4 v[R][4]; float s[R];
#pragma unroll
    for (int r = 0; r < R; ++r)
#pragma unroll
        for (int j = 0; j < 4; ++j) v[r][j] = __builtin_nontemporal_load((const f32x4*)(xrow + (size_t)r * DM) + lane + 64 * j);
    f32x4 gg[4];
#pragma unroll
    for (int j = 0; j < 4; ++j) gg[j] = ((const f32x4*)g + lane)[64 * j];
#pragma unroll
    for (int r = 0; r < R; ++r) { float q = 0.f;
#pragma unroll
        for (int j = 0; j < 4; ++j) q += (v[r][j].x * v[r][j].x + v[r][j].y * v[r][j].y) + (v[r][j].z * v[r][j].z + v[r][j].w * v[r][j].w);
        s[r] = q; }
#pragma unroll
    for (int o = 1; o < 64; o <<= 1)
#pragma unroll
        for (int r = 0; r < R; ++r) s[r] += __shfl_xor(s[r], o);
#pragma unroll
    for (int r = 0; r < R; ++r) { const float rs = NORM ? __builtin_amdgcn_rsqf(s[r] * (1.f / DM) + EPS) : 1.f; u32x2* o8 = (u32x2*)(orow + (size_t)r * DM) + lane;
        if (!NORM) { if (lane == 0) ssq_out[r] = s[r];
#pragma unroll
            for (int j = 0; j < 4; ++j) gg[j] = (f32x4){1.f, 1.f, 1.f, 1.f}; }
#pragma unroll
        for (int j = 0; j < 4; ++j) { u32x2 w; w.x = cvt_pk_bf16(v[r][j].x * rs * gg[j].x, v[r][j].y * rs * gg[j].y); w.y = cvt_pk_bf16(v[r][j].z * rs * gg[j].z, v[r][j].w * rs * gg[j].w); o8[64 * j] = w; } }
}
__device__ __forceinline__ void resid_row(const float* pre, const float* hold, const float* gpost, float* hout, const float* gnext, bf16_t* xn, int lane) {
    const f32x4* pr = (const f32x4*)pre + lane; const f32x4* hr = (const f32x4*)hold + lane; const f32x4* gp = (const f32x4*)gpost + lane;
    f32x4 v[4]; float s = 0.f;
#pragma unroll
    for (int j = 0; j < 4; ++j) { v[j] = pr[64 * j]; s += (v[j].x * v[j].x + v[j].y * v[j].y) + (v[j].z * v[j].z + v[j].w * v[j].w); }
    const float rs = __builtin_amdgcn_rsqf(wave_sum(s) * (1.f / DM) + EPS);
    float s2 = 0.f;
#pragma unroll
    for (int j = 0; j < 4; ++j) { const f32x4 h = hr[64 * j], g = gp[64 * j]; v[j] = h + v[j] * rs * g; s2 += (v[j].x * v[j].x + v[j].y * v[j].y) + (v[j].z * v[j].z + v[j].w * v[j].w); }
    f32x4* ho = (f32x4*)hout + lane;
#pragma unroll
    for (int j = 0; j < 4; ++j) ho[64 * j] = v[j];
    if (xn) { const float rs2 = __builtin_amdgcn_rsqf(wave_sum(s2) * (1.f / DM) + EPS); const f32x4* gn = (const f32x4*)gnext + lane; u32x2* o8 = (u32x2*)xn + lane;
#pragma unroll
        for (int j = 0; j < 4; ++j) { const f32x4 gg = gn[64 * j]; u32x2 w; w.x = cvt_pk_bf16(v[j].x * rs2 * gg.x, v[j].y * rs2 * gg.y); w.y = cvt_pk_bf16(v[j].z * rs2 * gg.z, v[j].w * rs2 * gg.w); o8[64 * j] = w; } }
}


__device__ __forceinline__ float row16_sum(float v) {
    v += __builtin_bit_cast(float, __builtin_amdgcn_update_dpp(0, __builtin_bit_cast(int, v), 0xB1, 0xF, 0xF, true));
    v += __builtin_bit_cast(float, __builtin_amdgcn_update_dpp(0, __builtin_bit_cast(int, v), 0x4E, 0xF, 0xF, true));
    v += __builtin_bit_cast(float, __builtin_amdgcn_update_dpp(0, __builtin_bit_cast(int, v), 0x141, 0xF, 0xF, true));
    v += __builtin_bit_cast(float, __builtin_amdgcn_update_dpp(0, __builtin_bit_cast(int, v), 0x140, 0xF, 0xF, true));
    return v;
}
__device__ __forceinline__ void row_swap16(float x, float& from_other) { auto r = __builtin_amdgcn_permlane16_swap(__float_as_uint(x), __float_as_uint(x), false, false); const int row = (lane_id() >> 4) & 1; from_other = __uint_as_float(row ? r[0] : r[1]); }
namespace lru {
constexpr int TT = 128, NTILE = SEQ / TT, UP = 72;
constexpr int L_U = 0, L_UF = L_U + TT * UP * 2, L_WSEG = L_UF + TT * 33 * 4, L_CARRY = L_WSEG + 2 * 8 * 32 * 8, L_TSS = L_CARRY + 2 * 32 * 4, L_END = L_TSS + 2 * TT * 4;
static_assert(L_END <= RING_BYTES, "lru lds");
__device__ __forceinline__ float sigmoidf_(float x) { return __builtin_amdgcn_rcpf(1.f + __builtin_amdgcn_exp2f(-x * LOG2E)); }
__device__ __forceinline__ void unit(int b, int cb, const bf16_t* Z, bf16_t* Y, float* ssq_lru, const float* conv_w, const float* conv_b, const float* wa, const float* ba, const float* wx, const float* bx,
                                     const float* lam, LAS unsigned char* lds, const int wv) {
    const int lane = lane_id(), wid = wv, tid = wv * 64 + lane;
    const int hblk = cb >> 1, half = cb & 1, ib = hblk * 64, c0 = cb * 32;
    LAS bf16_t* U = (LAS bf16_t*)(lds + L_U); LAS float* UF = (LAS float*)(lds + L_UF); LAS f32x2* WSEG = (LAS f32x2*)(lds + L_WSEG);
    LAS float* CARRY = (LAS float*)(lds + L_CARRY); LAS float* TSS = (LAS float*)(lds + L_TSS);
    const int col = lane & 15, kq = lane >> 4;
    bf16x8 Bf[4][2];
#pragma unroll
    for (int nb = 0; nb < 4; ++nb)
#pragma unroll
        for (int ks = 0; ks < 2; ++ks) { const float* Wg = (nb < 2) ? wa : wx; const int oc = half * 32 + (nb & 1) * 16 + col; float w[8];
#pragma unroll
            for (int j = 0; j < 8; ++j) w[j] = Wg[((size_t)hblk * 64 + ks * 32 + 8 * kq + j) * 64 + oc];
            u32x4 p; p.x = cvt_pk_bf16(w[0], w[1]); p.y = cvt_pk_bf16(w[2], w[3]); p.z = cvt_pk_bf16(w[4], w[5]); p.w = cvt_pk_bf16(w[6], w[7]); Bf[nb][ks] = __builtin_bit_cast(bf16x8, p); }
    float cba[2], cbx[2], csp[2];
#pragma unroll
    for (int e = 0; e < 2; ++e) { const int ch = c0 + e * 16 + col; cba[e] = ba[ch]; cbx[e] = bx[ch]; const float l = lam[ch];
        csp[e] = 8.f * LOG2E * (fmaxf(-l, 0.f) + log1pf(expf(-fabsf(l)))); }
    const int cch = lane;
    const float cw0 = conv_w[0 * DLRU + ib + cch], cw1 = conv_w[1 * DLRU + ib + cch], cw2 = conv_w[2 * DLRU + ib + cch], cw3 = conv_w[3 * DLRU + ib + cch], cbb = conv_b[ib + cch];
    if (tid < 64) CARRY[tid] = 0.f;
    if (tid < 2 * TT) TSS[tid] = 0.f;
    const size_t rowb = (size_t)b * SEQ;
    const bf16_t* zx = Z + (rowb + wid * 16) * DINP + ib + cch;
    const bf16_t* zg = Z + (rowb + wid * 16 + kq * 4) * DINP + OFF_GATE + c0 + col;
    bf16_t* yp = Y + (rowb + wid * 16 + kq * 4) * DM + c0 + col;
    unsigned short xr[19], gr[8];
#define LRU_LOADX(t0_) do { _Pragma("unroll") for (int k = 0; k < 19; ++k) { const int tk = (t0_) + wid * 16 + k - 3; xr[k] = (tk >= 0) ? __builtin_nontemporal_load(zx + (ptrdiff_t)((t0_) + k - 3) * DINP) : (unsigned short)0; } } while (0)
    LRU_LOADX(0);
    __syncthreads();
    for (int tile = 0; tile < NTILE; ++tile) {
        const int t0 = tile * TT, par = tile & 1;
        { float xm3 = bf2f(xr[0]), xm2 = bf2f(xr[1]), xm1 = bf2f(xr[2]);
#pragma unroll
          for (int k = 0; k < 16; ++k) { const float x0 = bf2f(xr[3 + k]); const float u = cbb + cw0 * xm3 + cw1 * xm2 + cw2 * xm1 + cw3 * x0; xm3 = xm2; xm2 = xm1; xm1 = x0;
              const int tl = wid * 16 + k; U[tl * UP + cch] = (bf16_t)(cvt_pk_bf16(u, 0.f) & 0xffffu);
              if ((cch >> 5) == half) UF[tl * 33 + (cch & 31)] = u; } }
#pragma unroll
        for (int e = 0; e < 2; ++e)
#pragma unroll
            for (int r = 0; r < 4; ++r) gr[e * 4 + r] = __builtin_nontemporal_load(zg + (size_t)(t0 + r) * DINP + e * 16);
        if (tile + 1 < NTILE) LRU_LOADX(t0 + TT);
        LDS_WAIT();
        float av[2][4], uv[2][4], Ainc[2], Hinc[2];
        { f32x4 C[4];
#pragma unroll
          for (int nb = 0; nb < 4; ++nb) C[nb] = (f32x4){0.f, 0.f, 0.f, 0.f};
          const LAS bf16_t* ua = U + (wid * 16 + col) * UP + 8 * kq;
          const bf16x8 a0 = *(const LAS bf16x8*)ua, a1 = *(const LAS bf16x8*)(ua + 32);
#pragma unroll
          for (int nb = 0; nb < 4; ++nb) { C[nb] = __builtin_amdgcn_mfma_f32_16x16x32_bf16(a0, Bf[nb][0], C[nb], 0, 0, 0); C[nb] = __builtin_amdgcn_mfma_f32_16x16x32_bf16(a1, Bf[nb][1], C[nb], 0, 0, 0); }
#pragma unroll
          for (int e = 0; e < 2; ++e) { float Ap = 1.f, H = 0.f;
#pragma unroll
              for (int r = 0; r < 4; ++r) { const int tl = wid * 16 + kq * 4 + r, ch = e * 16 + col;
                  const float rg = sigmoidf_(C[e][r] + cba[e]), ig = sigmoidf_(C[e + 2][r] + cbx[e]);
                  const float a = __builtin_amdgcn_exp2f(-rg * csp[e]); const float mult = __builtin_amdgcn_sqrtf(fmaxf(1.f - a * a, 0.f));
                  const float uu = mult * ig * UF[tl * 33 + ch];
                  av[e][r] = a; uv[e][r] = uu; H = a * H + uu; Ap *= a; }
              { const float Ap1 = __shfl_up(Ap, 16), H1 = __shfl_up(H, 16); if (kq >= 1) { H = Ap * H1 + H; Ap = Ap * Ap1; } }
              { const float Ap2 = __shfl_up(Ap, 32), H2 = __shfl_up(H, 32); if (kq >= 2) { H = Ap * H2 + H; Ap = Ap * Ap2; } }
              Ainc[e] = Ap; Hinc[e] = H;
              if (kq == 3) WSEG[(par * 8 + wid) * 32 + e * 16 + col] = (f32x2){Ap, H}; } }
        __syncthreads();
        if (tid < TT) { const float v = TSS[(par ^ 1) * TT + tid]; if (tile > 0) atomicAdd(ssq_lru + rowb + t0 - TT + tid, v); }
        float qs[4] = {0.f, 0.f, 0.f, 0.f};
#pragma unroll
        for (int e = 0; e < 2; ++e) { const int ch = e * 16 + col;
            float h = CARRY[par * 32 + ch]; f32x2 sg[8];
#pragma unroll
            for (int w2 = 0; w2 < 8; ++w2) sg[w2] = WSEG[(par * 8 + w2) * 32 + ch];
#pragma unroll
            for (int w2 = 0; w2 < 7; ++w2) if (w2 < wid) h = sg[w2].x * h + sg[w2].y;
            if (wid == 7 && kq == 0) CARRY[(par ^ 1) * 32 + ch] = sg[7].x * h + sg[7].y;
            const float Ae = __shfl_up(Ainc[e], 16), He = __shfl_up(Hinc[e], 16);
            if (kq >= 1) h = Ae * h + He;
#pragma unroll
            for (int r = 0; r < 4; ++r) { h = av[e][r] * h + uv[e][r]; const float g = bf2f(gr[e * 4 + r]);
                const float ge = g * __builtin_amdgcn_rcpf(1.f + __builtin_amdgcn_exp2f(-1.5957691216057308f * LOG2E * (g + 0.044715f * g * g * g)));
                const float y = h * ge; yp[(size_t)(t0 + r) * DM + e * 16] = (bf16_t)(cvt_pk_bf16(y, 0.f) & 0xffffu); qs[r] += y * y; } }
#pragma unroll
        for (int r = 0; r < 4; ++r) { const float q = row16_sum(qs[r]);
            if (col == 0) TSS[par * TT + wid * 16 + kq * 4 + r] = q; }
    }
    __syncthreads();
    if (tid < TT) atomicAdd(ssq_lru + rowb + (NTILE - 1) * TT + tid, TSS[((NTILE - 1) & 1) * TT + tid]);
    __syncthreads();
#undef LRU_LOADX
}
}

namespace mla {
constexpr int NW = 8, QBLK = 32, KVBLK = 64, QB = 256, KROW = 384, SHM_K = KVBLK * KROW, SHM_V = KVBLK * 128 * 2;
constexpr int L_V = 0, L_K = 2 * SHM_V, L_WS = L_K + 2 * SHM_K, L_END = L_WS + NW * 64 * 4;
static_assert(L_END <= RING_BYTES && NW * 8192 <= L_WS, "mla lds");
#define KSWZ(row, colB) ((row) * KROW + ((colB) ^ ((((row) >> 1) & 7) << 4)))
#define SBAR() __builtin_amdgcn_sched_barrier(0)
__device__ __forceinline__ int v_st(int k, int c) { const int kk = (k & ~0xC) | ((k & 4) << 1) | ((k & 8) >> 1); return ((kk >> 3) * 4 + (c >> 5)) * 512 + ((kk & 7) * 32 + (c & 31)) * 2; }
__device__ __forceinline__ int v_rd_base(int lane) { return ((lane & 3) << 3) | (((lane >> 2) & 3) << 6) | (((lane >> 4) & 1) << 5) | (((lane >> 5) & 1) << 8); }
constexpr int v_rd_off(int d0, int ks, int half) { return d0 * 512 + ks * 4096 + half * 2048; }
__device__ __forceinline__ int crow(int r, int hi) { return (r & 3) + 8 * (r >> 2) + 4 * hi; }
__device__ __forceinline__ void mask_tile(f32x16& p0, f32x16& p1, int dq) {
    const float NEG = -__builtin_inff();
#pragma unroll
    for (int r = 0; r < 16; ++r) { const int c = (r & 3) + 8 * (r >> 2); if (dq - c < 0) p0[r] = NEG; if (dq - c - 32 < 0) p1[r] = NEG; }
}
constexpr float THR2 = 8.f * LOG2E;
__device__ __forceinline__ void partialSM(f32x16& p0, f32x16& p1, float& m_reg, float& alpha) {
    float pmax = p0[0];
#pragma unroll
    for (int r = 1; r < 16; ++r) pmax = fmaxf(pmax, p0[r]);
#pragma unroll
    for (int r = 0; r < 16; ++r) pmax = fmaxf(pmax, p1[r]);
    { auto rr = __builtin_amdgcn_permlane32_swap(__float_as_uint(pmax), __float_as_uint(pmax), false, false); pmax = fmaxf(__uint_as_float(rr[0]), __uint_as_float(rr[1])); }
    float mn;
    if (__builtin_expect(__all((pmax - m_reg) <= THR2), 1)) { mn = m_reg; alpha = 1.f; }
    else { mn = fmaxf(m_reg, pmax); alpha = __builtin_amdgcn_exp2f(m_reg - mn); m_reg = mn; }
#pragma unroll
    for (int r = 0; r < 16; ++r) p0[r] = p0[r] - mn;
#pragma unroll
    for (int r = 0; r < 16; ++r) p1[r] = p1[r] - mn;
#pragma unroll
    for (int r = 0; r < 16; ++r) p0[r] = __builtin_amdgcn_exp2f(p0[r]);
}
__device__ __forceinline__ void finishSM(f32x16& p0, f32x16& p1, float alpha, float& l_reg, bf16x8& pa0, bf16x8& pa1, bf16x8& pa2, bf16x8& pa3) {
#pragma unroll
    for (int r = 0; r < 16; ++r) p1[r] = __builtin_amdgcn_exp2f(p1[r]);
    float ps = 0;
#pragma unroll
    for (int r = 0; r < 16; ++r) ps += p0[r];
#pragma unroll
    for (int r = 0; r < 16; ++r) ps += p1[r];
    { auto rr = __builtin_amdgcn_permlane32_swap(__float_as_uint(ps), __float_as_uint(ps), false, false); ps = __uint_as_float(rr[0]) + __uint_as_float(rr[1]); }
    l_reg = l_reg * alpha + ps;
#define PK4(P, B_, OUT) do { unsigned a0 = cvt_pk_bf16(P[B_+0], P[B_+1]), a1 = cvt_pk_bf16(P[B_+2], P[B_+3]);                          \
        unsigned b0 = cvt_pk_bf16(P[B_+4], P[B_+5]), b1 = cvt_pk_bf16(P[B_+6], P[B_+7]);                                             \
        auto r0 = __builtin_amdgcn_permlane32_swap(a0, b0, false, false); auto r1 = __builtin_amdgcn_permlane32_swap(a1, b1, false, false); \
        u32x4 w = {r0[0], r1[0], r0[1], r1[1]}; OUT = __builtin_bit_cast(bf16x8, w); } while (0)
    PK4(p0, 0, pa0); PK4(p0, 8, pa1); PK4(p1, 0, pa2); PK4(p1, 8, pa3);
#undef PK4
}
template <int KB>
__device__ __forceinline__ void qkt(f32x16& p0, f32x16& p1, const char* K_lds, int r32, int hi, const bf16x8* qr) {
    p0 = f32x16{}; p1 = f32x16{};
    unsigned kb[4];
#pragma unroll
    for (int dd = 0; dd < 4; ++dd) kb[dd] = (unsigned)(uintptr_t)(K_lds + KB * SHM_K + KSWZ(r32, (dd * 16 + hi * 8) * 2));
    bf16x8 fa[4], fb[4];
#define KRD(slot, d0) do { asm volatile("ds_read_b128 %0, %1 offset:%2" : "=v"(fa[slot]) : "v"(kb[(d0) & 3]), "i"(((d0) >> 2) * 128)); \
                           asm volatile("ds_read_b128 %0, %1 offset:%2" : "=v"(fb[slot]) : "v"(kb[(d0) & 3]), "i"(((d0) >> 2) * 128 + 32 * KROW)); } while (0)
#define KMM(slot, d0, N) do { asm volatile("s_waitcnt lgkmcnt(%0)" :: "i"(N) : "memory"); SBAR(); \
        p0 = __builtin_amdgcn_mfma_f32_32x32x16_bf16(fa[slot], qr[d0], p0, 0, 0, 0); p1 = __builtin_amdgcn_mfma_f32_32x32x16_bf16(fb[slot], qr[d0], p1, 0, 0, 0); SBAR(); } while (0)
    KRD(0, 0); KRD(1, 1); KRD(2, 2); KRD(3, 3);
    KMM(0, 0, 6); KRD(0, 4); KMM(1, 1, 6); KRD(1, 5); KMM(2, 2, 6); KRD(2, 6); KMM(3, 3, 6); KRD(3, 7);
    KMM(0, 4, 6); KRD(0, 8); KMM(1, 5, 6); KRD(1, 9); KMM(2, 6, 6); KRD(2, 10); KMM(3, 7, 6); KRD(3, 11);
    KMM(0, 8, 6); KMM(1, 9, 4); KMM(2, 10, 2); KMM(3, 11, 0);
#undef KRD
#undef KMM
}
template <int VB>
__device__ __forceinline__ void pv_tile(f32x16* o, int vb0, bf16x8 pa0, bf16x8 pa1, bf16x8 pa2, bf16x8 pa3) {
    s16x4 lo[2][4], hh[2][4];
#define TRRD(dst, off) asm volatile("ds_read_b64_tr_b16 %0, %1 offset:%2" : "=v"(dst) : "v"(vb0), "i"(off))
#define VRD(set, d0) do { constexpr int b_ = VB * SHM_V + v_rd_off(d0, 0, 0); \
        TRRD(lo[set][0], b_); TRRD(hh[set][0], b_ + 2048); TRRD(lo[set][1], b_ + 4096); TRRD(hh[set][1], b_ + 6144); \
        TRRD(lo[set][2], b_ + 8192); TRRD(hh[set][2], b_ + 10240); TRRD(lo[set][3], b_ + 12288); TRRD(hh[set][3], b_ + 14336); } while (0)
#define VFR(set, k) (bf16x8){lo[set][k][0], lo[set][k][1], lo[set][k][2], lo[set][k][3], hh[set][k][0], hh[set][k][1], hh[set][k][2], hh[set][k][3]}
#define VMM(set, d0, N) do { asm volatile("s_waitcnt lgkmcnt(%0)" :: "i"(N) : "memory"); SBAR(); \
        o[d0] = __builtin_amdgcn_mfma_f32_32x32x16_bf16(pa0, VFR(set, 0), o[d0], 0, 0, 0); o[d0] = __builtin_amdgcn_mfma_f32_32x32x16_bf16(pa1, VFR(set, 1), o[d0], 0, 0, 0); \
        o[d0] = __builtin_amdgcn_mfma_f32_32x32x16_bf16(pa2, VFR(set, 2), o[d0], 0, 0, 0); o[d0] = __builtin_amdgcn_mfma_f32_32x32x16_bf16(pa3, VFR(set, 3), o[d0], 0, 0, 0); SBAR(); } while (0)
    VRD(0, 0); VRD(1, 1);
    VMM(0, 0, 8); VRD(0, 2); VMM(1, 1, 8); VRD(1, 3); VMM(0, 2, 8); VMM(1, 3, 0);
#undef TRRD
#undef VRD
#undef VFR
#undef VMM
}
__device__ __forceinline__ void block(int b, int h, int qb, const bf16_t* Qb, const bf16_t* KVb, const bf16_t* KPE, bf16_t* Y, float* ssq_mla, char* lds, const int wv) {
    const int lane = lane_id(), wid = wv, tid = wv * 64 + lane, r32 = lane & 31, hi = lane >> 5;
    const size_t rowbase = (size_t)b * SEQ; const int q0 = qb * QB; const int NT = (q0 + QB) / KVBLK;
    const int qlo = q0 + wid * QBLK, qm = qlo + r32 - 4 * hi;
    char* V_lds = lds + L_V; char* K_lds = lds + L_K;
    float* ws = (float*)(lds + L_WS) + wid * 64; float* li_l = ws, * al_l = ws + 32;
    float m_reg = -1e30f, l_reg = 0; f32x16 o[4] = {};
    const int sr = tid >> 4, scc = (tid & 15) * 8, vst0 = v_st(sr, scc), vst1 = v_st(32 + sr, scc), kws = KSWZ(sr, (tid & 15) * 16);
    const int pr = tid >> 3, kws2 = KSWZ(pr, 256 + (tid & 7) * 16);
    const int vb0 = (int)(uintptr_t)V_lds + v_rd_base(lane);
    const bf16_t* Kn = KVb + rowbase * 1024 + h * 128 + scc;
    const bf16_t* Vn = KVb + rowbase * 1024 + 512 + h * 128 + scc;
    const bf16_t* Kp = KPE + rowbase * 64 + (tid & 7) * 8;
    bf16x8 qr[12];
    { const bf16_t* qp = Qb + (rowbase + q0 + wid * QBLK + r32) * 768;
#pragma unroll
      for (int d0 = 0; d0 < 8; ++d0) qr[d0] = *(const bf16x8*)(qp + h * 128 + d0 * 16 + hi * 8);
#pragma unroll
      for (int d0 = 0; d0 < 4; ++d0) qr[8 + d0] = *(const bf16x8*)(qp + 512 + h * 64 + d0 * 16 + hi * 8); }
    const int grp = wid >> 2;
    bf16x8 st_v0, st_v1, st_k0, st_k1, st_k2;
#define SLOADK(t) do { const size_t k0_ = (size_t)(t) * KVBLK; st_k0 = *(const bf16x8*)(Kn + (k0_ + sr) * 1024); st_k1 = *(const bf16x8*)(Kn + (k0_ + 32 + sr) * 1024); st_k2 = *(const bf16x8*)(Kp + (k0_ + pr) * 64); } while (0)
#define SLOADV(t) do { const size_t k0_ = (size_t)(t) * KVBLK; st_v0 = *(const bf16x8*)(Vn + (k0_ + sr) * 1024); st_v1 = *(const bf16x8*)(Vn + (k0_ + 32 + sr) * 1024); } while (0)
#define SWRITEK(off) do { *(bf16x8*)(K_lds + (off) + kws) = st_k0; *(bf16x8*)(K_lds + (off) + kws + 32 * KROW) = st_k1; *(bf16x8*)(K_lds + (off) + kws2) = st_k2; } while (0)
#define SWRITEV(off) do { *(bf16x8*)(V_lds + (off) + vst0) = st_v0; *(bf16x8*)(V_lds + (off) + vst1) = st_v1; } while (0)
#define BAR() asm volatile("s_waitcnt lgkmcnt(0)\n\ts_barrier" ::: "memory")
#define RESC(a) do { if (__any((a) < 1.f)) { if (hi == 0) al_l[r32] = (a); asm volatile("s_waitcnt lgkmcnt(0)" ::: "memory");              \
                     for (int d_ = 0; d_ < 4; ++d_) for (int r = 0; r < 16; ++r) o[d_][r] *= al_l[crow(r, hi)]; } } while (0)
#define MASKT(P0_, P1_, t) do { const int kb_ = (t) * KVBLK; if (kb_ + KVBLK - 1 > qlo) mask_tile(P0_, P1_, qm - kb_); } while (0)
#define ACT(t) ((t) * KVBLK <= qlo + QBLK - 1)
#define NEGALL() do { const float NEG_ = -__builtin_inff(); _Pragma("unroll") for (int r = 0; r < 16; ++r) { p0[r] = NEG_; p1[r] = NEG_; } } while (0)
    f32x16 p0, p1; float al; bf16x8 pa0, pa1, pa2, pa3;
    SLOADK(0); VM_WAIT(); SWRITEK(0);
    if (grp) { SLOADK(1); SLOADV(0); }
    BAR();
    if (grp) { VM_WAIT(); SWRITEK(SHM_K); SWRITEV(0); BAR(); }
#define SMSLOT(t, tk, tv) do { if ((tk) < NT || (tv) < NT) { VM_WAIT(); if ((tk) < NT) SWRITEK(((tk) & 1) * SHM_K); if ((tv) < NT) SWRITEV(((tv) & 1) * SHM_V); } \
        MASKT(p0, p1, (t)); partialSM(p0, p1, m_reg, al); RESC(al); finishSM(p0, p1, al, l_reg, pa0, pa1, pa2, pa3); SBAR(); } while (0)
    { const int tk = 1 + grp, tv = grp;
      SLOADK(tk); SLOADV(tv); SBAR(); qkt<0>(p0, p1, K_lds, r32, hi, qr); SBAR();
      BAR(); SMSLOT(0, tk, tv); BAR(); }
    for (int i = 0; i < NT; i += 2) {
        { const int tk = i + 2 + grp, tv = i + 1 + grp;
          if (tk < NT) SLOADK(tk); if (tv < NT) SLOADV(tv); SBAR();
          if (ACT(i + 1)) qkt<1>(p0, p1, K_lds, r32, hi, qr); else NEGALL(); SBAR(); if (ACT(i)) pv_tile<0>(o, vb0, pa0, pa1, pa2, pa3); SBAR();
          BAR(); SMSLOT(i + 1, tk, tv); BAR(); }
        { const int tk = i + 3 + grp, tv = i + 2 + grp;
          if (tk < NT) SLOADK(tk); if (tv < NT) SLOADV(tv); SBAR();
          if (i + 2 < NT) { if (ACT(i + 2)) qkt<0>(p0, p1, K_lds, r32, hi, qr); else NEGALL(); SBAR(); }
          if (ACT(i + 1)) pv_tile<1>(o, vb0, pa0, pa1, pa2, pa3); SBAR();
          BAR(); if (i + 2 < NT) SMSLOT(i + 2, tk, tv); BAR(); }
    }
    if (!grp) BAR();
#undef SMSLOT
#undef SLOADK
#undef SLOADV
#undef SWRITEK
#undef SWRITEV
#undef BAR
    if (hi == 0) li_l[r32] = l_reg; asm volatile("s_waitcnt lgkmcnt(0)" ::: "memory");
    float rli[16];
#pragma unroll
    for (int r = 0; r < 16; ++r) rli[r] = __builtin_amdgcn_rcpf(li_l[crow(r, hi)]);
    { bf16_t* stg = (bf16_t*)lds + wid * 4096;
#pragma unroll
      for (int r = 0; r < 16; ++r) { const int orow = crow(r, hi);
#pragma unroll
          for (int d0 = 0; d0 < 4; ++d0) stg[orow * 128 + d0 * 32 + r32] = (bf16_t)(cvt_pk_bf16(o[d0][r] * rli[r], 0.f) & 0xffffu); }
      asm volatile("s_waitcnt lgkmcnt(0)" ::: "memory");
      const int row = lane >> 1, hf = lane & 1; float q = 0.f;
      bf16_t* yp = Y + (rowbase + q0 + wid * QBLK + row) * DM + 512 + h * 128 + hf * 64;
#pragma unroll
      for (int j = 0; j < 8; ++j) { const u32x4 v = *(const u32x4*)(stg + row * 128 + hf * 64 + j * 8);
          q += bflo(v.x) * bflo(v.x) + bfhi(v.x) * bfhi(v.x) + bflo(v.y) * bflo(v.y) + bfhi(v.y) * bfhi(v.y) + bflo(v.z) * bflo(v.z) + bfhi(v.z) * bfhi(v.z) + bflo(v.w) * bflo(v.w) + bfhi(v.w) * bfhi(v.w);
          *(u32x4*)(yp + j * 8) = v; }
      q += __shfl_xor(q, 1);
      if (hf == 0) atomicAdd(ssq_mla + rowbase + q0 + wid * QBLK + row, q); }
    __syncthreads();
#undef RESC
#undef MASKT
#undef ACT
#undef NEGALL
}
#undef KSWZ
#undef SBAR
}

constexpr int NWAVES = 8, NPHASE = 13;
struct Args { const void* in[32]; float* out; unsigned char* ws; int ph_lo, ph_hi; };

__global__ void __launch_bounds__(NWAVES * 64, 2) hymba_fwd(Args args) {
    extern __shared__ __attribute__((aligned(16))) unsigned char lds_raw[];
#ifdef PAD_NOPS
    for (int pn_ = 0; pn_ < 0; ++pn_) {}
    asm volatile(PAD_NOPS);
#endif
    LAS unsigned char* lds = (LAS unsigned char*)lds_raw;
    volatile LAS unsigned* MISC = (volatile LAS unsigned*)(lds + MISC_OFF);
    const int G = gridDim.x, bx = blockIdx.x, vcu = (G % 8 == 0) ? (bx % 8) * (G / 8) + bx / 8 : bx;
    const int wave_s = __builtin_amdgcn_readfirstlane((int)threadIdx.x >> 6);
#define lane (lane_id())
#define tid (wave_s * 64 + lane)
#define wave (wave_s)
#define gw (vcu * NWAVES + wave)
#define NGW (G * NWAVES)
    unsigned char* ws = args.ws;
#define x_in ((const float*)args.in[0])
#define mem ((const float*)args.in[1])
#define positions ((const int*)args.in[2])
#define g_pre_mix ((const float*)args.in[3])
#define w_in ((const float*)args.in[4])
#define conv_w ((const float*)args.in[5])
#define conv_b ((const float*)args.in[6])
#define lru_wa ((const float*)args.in[7])
#define lru_ba ((const float*)args.in[8])
#define lru_wx ((const float*)args.in[9])
#define lru_bx ((const float*)args.in[10])
#define lru_lambda ((const float*)args.in[11])
#define g_q_lat ((const float*)args.in[12])
#define w_uq ((const float*)args.in[13])
#define g_kv_lat ((const float*)args.in[14])
#define w_ukv ((const float*)args.in[15])
#define g_lru_out ((const float*)args.in[16])
#define g_mla_out ((const float*)args.in[17])
#define w_out ((const float*)args.in[18])
#define g_post_mix ((const float*)args.in[19])
#define g_pre_mem ((const float*)args.in[20])
#define g_mem_kv ((const float*)args.in[21])
#define w_mq ((const float*)args.in[22])
#define w_mk ((const float*)args.in[23])
#define w_mv ((const float*)args.in[24])
#define w_mo ((const float*)args.in[25])
#define g_post_mem ((const float*)args.in[26])
#define g_pre_ffn ((const float*)args.in[27])
#define w_gate ((const float*)args.in[28])
#define w_up ((const float*)args.in[29])
#define w_down ((const float*)args.in[30])
#define g_post_ffn ((const float*)args.in[31])
#define out_p (args.out)
#define ctl ((unsigned*)(ws + WS_CTL))
#define ssq_cq ((float*)(ws + WS_SSQ))
#define ssq_ckv (ssq_cq + T)
#define ssq_lru (ssq_cq + 2 * T)
#define ssq_mla (ssq_cq + 3 * T)
#define ssq_h1 (ssq_cq + 4 * T)
#define ssq_h2 (ssq_cq + 5 * T)
#define ssq_x (ssq_cq + 6 * T)
#define ssq_dummy (ssq_cq + 7 * T)
#define slots_p ((float*)(ws + WS_SLOTS))
#define cosT ((float*)(ws + WS_ROPE))
#define sinT (cosT + (size_t)T * 32)
#define Win_t ((bf16_t*)(ws + WS_WIN))
#define Wuq_t ((bf16_t*)(ws + WS_WUQ))
#define Wukv_t ((bf16_t*)(ws + WS_WUKV))
#define Wout_t ((bf16_t*)(ws + WS_WOUT))
#define Wmq_b ((bf16_t*)(ws + WS_WMQ))
#define Wmkv_t ((bf16_t*)(ws + WS_WMKV))
#define Wmo_t ((bf16_t*)(ws + WS_WMO))
#define Wgu_t ((bf16_t*)(ws + WS_WGU))
#define Wdown_t ((bf16_t*)(ws + WS_WDOWN))
#define MN ((bf16_t*)(ws + WS_MN))
#define MKV ((bf16_t*)(ws + WS_MKV))
#define WQK ((bf16_t*)(ws + WS_WQK))
#define WVO ((bf16_t*)(ws + WS_WVO))
#define XN ((bf16_t*)(ws + WS_XN))
#define KPE ((bf16_t*)(ws + WS_KPE))
#define Z ((bf16_t*)(ws + WS_Z))
#define Qb ((bf16_t*)(ws + WS_Q))
#define KVb ((bf16_t*)(ws + WS_KV))
#define Y ((bf16_t*)(ws + WS_Y))
#define PRE ((float*)(ws + WS_PRE))
#define Pb ((bf16_t*)(ws + WS_P))
#define Fb ((bf16_t*)(ws + WS_F))
    for (int u = tid; u < 256; u += NWAVES * 64) ((LAS unsigned*)(lds + MISC_OFF))[u] = 0u;
    __syncthreads();
    XcdBarrier bar = xcd_barrier_post(ctl + CW_BAR, MISC + 8, (unsigned)G);
    const bool grouped = (G == 256);
    XcdBarrier gbar = grouped ? xcd_barrier_post(ctl + CW_BAR + XCD_BAR_WORDS * (1 + (bx & 7)), MISC + 10, (unsigned)(G >> 3)) : bar;
    const int lo = args.ph_lo, hi = args.ph_hi;
    unsigned long long ts0 = 0, ts1 = 0, tc0 = 0, tc1 = 0;
#define TS(k) do { if ((k) == (SPIN_LO)) { ts0 = __builtin_amdgcn_s_memrealtime(); tc0 = __builtin_amdgcn_s_memtime(); } } while (0)
#define TE(k) do { if ((k) == (SPIN_HI)) { ts1 = __builtin_amdgcn_s_memrealtime(); tc1 = __builtin_amdgcn_s_memtime(); } } while (0)
#ifndef REP_PHASE
#define REP_PHASE -1
#endif
#define REPS(k) for (int rep = 0; rep < ((REP_PHASE) == (k) ? 2 : 1); ++rep)
#define RSQ(p) (rep ? ssq_dummy : (p))
#ifndef PHASE_MASK
#define PHASE_MASK 0x1fff
#endif
#define IN(k) (((PHASE_MASK >> (k)) & 1) && lo <= (k) && (k) < hi)
#ifndef SPIN_LO
#define SPIN_LO -1
#define SPIN_HI -1
#endif
#ifndef ALIGN_P10
#define ALIGN_P10 true
#endif
#ifndef EXTRA_BAR
#define EXTRA_BAR 0
#endif
#define SEAM(k) do { if (IN(k) && IN((k) + 1)) { if ((k) == 0 || !grouped) xcd_barrier(bar, wave_s); else xcd_barrier(gbar, wave_s); } } while (0)

    TS(0); if (IN(0)) REPS(0) {
        LAS float* scr = (LAS float*)(lds + wave * 16640);
        constexpr int I_IN = 16 * 27, I_UQ = 6 * 12, I_UKV = 4 * 16, I_SQ = 16 * 16, I_GU = 16 * 44, I_DN = 44 * 16;
        int cum = 0;
#define P0_JOB(W, K_, N_, WT, ROFF, MODE, KS, KS2, CNT) do { for (int it = (gw + NGW - (cum % NGW)) % NGW; it < (CNT); it += NGW) p0_transpose_item(W, K_, N_, WT, ROFF, MODE, KS, KS2, scr, it, lane); cum += (CNT); } while (0)
        P0_JOB(w_in, DM, 1728, Win_t, 0, MAP_WIN, g_pre_mix, nullptr, I_IN);
        P0_JOB(w_uq, QLR, 768, Wuq_t, 0, MAP_WUQ, g_q_lat, nullptr, I_UQ);
        P0_JOB(w_ukv, KVLR, 1024, Wukv_t, 0, MAP_WUKV, g_kv_lat, nullptr, I_UKV);
        P0_JOB(w_out, DM, DM, Wout_t, 0, MAP_ID, g_lru_out, g_mla_out, I_SQ);
        P0_JOB(w_mk, DM, DM, Wmkv_t, 0, MAP_ID, nullptr, nullptr, I_SQ);
        P0_JOB(w_mv, DM, DM, Wmkv_t, 1024, MAP_ID, nullptr, nullptr, I_SQ);
        P0_JOB(w_mo, DM, DM, Wmo_t, 0, MAP_ID, nullptr, nullptr, I_SQ);
        P0_JOB(w_gate, DM, DFF, Wgu_t, 0, MAP_GATE, g_pre_ffn, nullptr, I_GU);
        P0_JOB(w_up, DM, DFF, Wgu_t, 0, MAP_UP, g_pre_ffn, nullptr, I_GU);
        P0_JOB(w_down, DFF, DM, Wdown_t, 0, MAP_ID, nullptr, nullptr, I_DN);
#undef P0_JOB
        const int gt = vcu * (NWAVES * 64) + tid, NGT = G * NWAVES * 64;
        for (int i = gt; i < 64 * 1024 / 8; i += NGT) *(u32x4*)(Win_t + (size_t)1728 * 1024 + (size_t)i * 8) = (u32x4){0u, 0u, 0u, 0u};
        for (int i = gt; i < DM * DM / 4; i += NGT) { const f32x4 v = __builtin_nontemporal_load((const f32x4*)(w_mq + (size_t)i * 4)) * g_pre_mem[i >> 8]; u32x2 w; w.x = cvt_pk_bf16(v.x, v.y); w.y = cvt_pk_bf16(v.z, v.w); *(u32x2*)(Wmq_b + (size_t)i * 4) = w; }
        for (int i = gt; i < T * 32; i += NGT) { const int row = i >> 5, k = i & 31; const double invf = exp2(-(double)k * (13.287712379549449 / 32.0));
            const double rev = (double)positions[row] * invf * 0.15915494309189535; const float fr_ = (float)(rev - rint(rev)); cosT[i] = __builtin_amdgcn_cosf(fr_); sinT[i] = __builtin_amdgcn_sinf(fr_); }
        { const int rpw = T / (G * NWAVES);
          for (int m = gw * rpw; m < (gw + 1) * rpw; m += 4) rms_rows_to_bf16<4, false>(x_in + (size_t)m * DM, g_pre_mix, XN + (size_t)m * DM, ssq_x + m, lane); }
        { const int rpw = TM / (G * NWAVES);
          for (int m = gw * rpw; m < (gw + 1) * rpw; m += 2) rms_rows_to_bf16<2, true>(mem + (size_t)m * DM, g_mem_kv, MN + (size_t)m * DM, nullptr, lane); }
    }
    SEAM(0); TE(0);
    TS(1); if (IN(1)) REPS(1) {
        {
          struct P1Order { pg8::TileOrder o; int nz, mu; const char* A2; const char* B2;
              __device__ bool next(int i, pg8::Unit& un) const { if (o.next(i, un)) return true; if (i != nz || mu < 0) return false;
                  un.pm = mu >> 3; un.pn = mu & 7; un.A = A2 + (size_t)un.pm * 256 * DM * 2; un.B = B2 + (size_t)un.pn * 256 * DM * 2; un.cofs = 0; un.job = 1; un.wait = nullptr; un.done = nullptr; return true; } };
          const int j = bx >> 3; P1Order S; S.o.init(T, DINP, G, bx, XN, DM, Win_t, DM);
          S.nz = (896 - bx + G - 1) / G;
          S.mu = (G == 256) ? (j >= 16 ? ((bx & 7) * 2 + ((j - 16) >> 3)) * 8 + ((j - 16) & 7) : -1) : (bx < 128 ? bx : -1); S.A2 = (const char*)MN; S.B2 = (const char*)Wmkv_t;
          EpiP1 E{EpiZ{Z, KPE, RSQ(ssq_cq), RSQ(ssq_ckv), cosT, sinT, ssq_x}, EpiBf16{MKV, 2048, 1.f, nullptr, 0.f}};
          pg8::gemm_phase<EpiP1, P1Order>(lds, DM, DM, DM, S, E, wave_s); }
    }
    SEAM(1); TE(1);
    TS(2); if (IN(2)) REPS(2) {
#ifndef P2SUB
#define P2SUB 31
#endif
#ifndef REP_P2SUB
#define REP_P2SUB 0
#endif
#define R2(i) for (int r2 = 0; r2 < (((REP_P2SUB) >> (i)) & 1) + 1; ++r2)
        if (P2SUB & 1) R2(0) for (int uidx = vcu; uidx < BATCH * 16; uidx += G) lru::unit(uidx >> 4, uidx & 15, Z, Y, (rep | r2) ? ssq_dummy : ssq_lru, conv_w, conv_b, lru_wa, lru_ba, lru_wx, lru_bx, lru_lambda, lds, wave_s);
#ifndef P2_MERGED
#define P2_MERGED 1
#endif
#if P2_MERGED
        { struct P2Order { pg8::TileOrder oq, okv; int nq, c, G; const bf16_t* mkv; const bf16_t* wmq; const bf16_t* wmo;
              __device__ bool next(int i, pg8::Unit& u) const {
                  if (i < nq) { oq.next(i, u); u.job = 0; u.lda = DINP; u.ldb = QLR; u.nt = QLR / 64; return true; }
                  i -= nq; if (i < 2) { okv.next(i, u); u.job = 1; u.lda = DINP; u.ldb = KVLR; u.nt = KVLR / 64; return true; }
                  i -= 2; if (i >= 2 || c >= 256) return false;
                  const int bh = c >> 2, q = c & 3, b = bh >> 2, h = bh & 3; u.wait = nullptr; u.done = nullptr; u.nt = 4;
                  if (i == 0) { u.pm = 0; u.pn = q; u.A = (const char*)(mkv + (size_t)(b * 256) * 2048 + h * 256); u.B = (const char*)(wmq + (size_t)(q * 256) * 1024 + h * 256); u.cofs = ((long)b * 1024 + h * 256) * 1024; u.job = 2; u.lda = 2048; u.ldb = 1024; }
                  else { u.pm = q; u.pn = 0; u.A = (const char*)(wmo + (size_t)(q * 256) * 1024 + h * 256); u.B = (const char*)(mkv + (size_t)(b * 256) * 2048 + 1024 + h * 256); u.cofs = (long)b * 1024 * 1024 + h * 256; u.job = 3; u.lda = 1024; u.ldb = 2048; }
                  return true; } };
          P2Order S; S.oq.init(T, 768, G, bx, Z + OFF_CQ, DINP, Wuq_t, QLR); S.okv.init(T, 1024, G, (bx + 128) % G, Z + OFF_CKV, DINP, Wukv_t, KVLR);
          S.nq = (384 - bx + G - 1) / G; S.c = vcu; S.G = G; S.mkv = MKV; S.wmq = Wmq_b; S.wmo = Wmo_t;
          EpiP2 E{EpiQ{Qb, ssq_cq, cosT, sinT}, EpiBf16{KVb, 1024, 1.f, ssq_ckv, 1.f / KVLR}, EpiBf16{WQK, 1024, MSCALE, nullptr, 0.f}, EpiBf16{WVO, 1024, 1.f, nullptr, 0.f}};
          pg8::gemm_phase_v<EpiP2, P2Order>(lds, S, E, wave_s); }
#else
        if (P2SUB & 2) R2(1) { pg8::TileOrder S; S.init(T, 768, G, bx, Z + OFF_CQ, DINP, Wuq_t, QLR); EpiQ E{Qb, ssq_cq, cosT, sinT};
          pg8::gemm_phase<EpiQ, pg8::TileOrder>(lds, DINP, QLR, QLR, S, E, wave_s); }
        if (P2SUB & 4) R2(2) { pg8::TileOrder S; S.init(T, 1024, G, (bx + 128) % G, Z + OFF_CKV, DINP, Wukv_t, KVLR); EpiBf16 E{KVb, 1024, 1.f, ssq_ckv, 1.f / KVLR};
          pg8::gemm_phase<EpiBf16, pg8::TileOrder>(lds, DINP, KVLR, KVLR, S, E, wave_s); }
        struct FormQK { int G, c; const bf16_t* mkv; const bf16_t* W;
            __device__ bool next(int i, pg8::Unit& u) const { const int L = i * G + c; if (L >= 256) return false; const int bh = L >> 2, q = L & 3, b = bh >> 2, h = bh & 3;
                u.pm = 0; u.pn = q; u.A = (const char*)(mkv + (size_t)(b * 256) * 2048 + h * 256); u.B = (const char*)(W + (size_t)(q * 256) * 1024 + h * 256); u.cofs = ((long)b * 1024 + h * 256) * 1024; u.job = 0; u.wait = nullptr; u.done = nullptr; return true; } };
        struct FormVO { int G, c; const bf16_t* mkv; const bf16_t* W;
            __device__ bool next(int i, pg8::Unit& u) const { const int L = i * G + c; if (L >= 256) return false; const int bh = L >> 2, q = L & 3, b = bh >> 2, h = bh & 3;
                u.pm = q; u.pn = 0; u.A = (const char*)(W + (size_t)(q * 256) * 1024 + h * 256); u.B = (const char*)(mkv + (size_t)(b * 256) * 2048 + 1024 + h * 256); u.cofs = (long)b * 1024 * 1024 + h * 256; u.job = 0; u.wait = nullptr; u.done = nullptr; return true; } };
        if (P2SUB & 8) R2(3) { FormQK S{G, vcu, MKV, Wmq_b}; EpiBf16 E{WQK, 1024, MSCALE, nullptr, 0.f}; pg8::gemm_phase<EpiBf16, FormQK>(lds, 2048, 1024, 256, S, E, wave_s); }
        if (P2SUB & 16) R2(3) { FormVO S{G, vcu, MKV, Wmo_t}; EpiBf16 E{WVO, 1024, 1.f, nullptr, 0.f}; pg8::gemm_phase<EpiBf16, FormVO>(lds, 1024, 2048, 256, S, E, wave_s); }
#endif
    }
    SEAM(2); TE(2);
    TS(3); if (IN(3)) REPS(3) {
        for (int it = vcu; it < BATCH * 4 * 4; it += G) { const int bh = it >> 2, xq = it & 3, b = bh >> 2, h = bh & 3;
            mla::block(b, h, xq, Qb, KVb, KPE, Y, RSQ(ssq_mla), (char*)lds_raw, wave_s);
            mla::block(b, h, 7 - xq, Qb, KVb, KPE, Y, RSQ(ssq_mla), (char*)lds_raw, wave_s); }
    }
    SEAM(3); TE(3);
#ifndef CHAIN_TAIL
#define CHAIN_TAIL 0
#endif
#if CHAIN_TAIL
    TS(5); if (IN(5)) {
        unsigned* dn = ctl + CW_DONE;
        { pg8::TileOrder S; S.init(T, DM, G, bx, Y, DM, Wout_t, DM);
          EpiNormResMid E{nullptr, XN, nullptr, g_post_mix, XN, ssq_h1, slots_p, ctl + CW_SEAM, false, ssq_lru, ssq_mla};
          pg8::gemm_phase<EpiNormResMid, pg8::TileOrder>(lds, DM, DM, DM, S, E, wave_s); }
        if (!grouped) xcd_barrier(bar, wave_s); else xcd_barrier(gbar, wave_s);
        { ChainOrder S; S.o.init(T, DM, G, bx, XN, DM, WQK, DM, (size_t)DM * DM * 2); S.wt_base = nullptr; S.dn_base = dn + SEAM_BANK;
          EpiSoftmax E{Pb, ssq_h1, true};
          pg8::gemm_phase<EpiSoftmax, ChainOrder, true, true, true>(lds, DM, DM, DM, S, E, wave_s); }
        { ChainOrder S; S.o.init(T, DM, G, bx, Pb, DM, WVO, DM, (size_t)DM * DM * 2); S.wt_base = dn + SEAM_BANK; S.dn_base = dn + 2 * SEAM_BANK;
          EpiNormRes E{nullptr, XN, nullptr, g_post_mem, XN, ssq_h2, slots_p + (size_t)4 * T, ctl + CW_SEAM + SEAM_BANK, true, nullptr, nullptr};
          pg8::gemm_phase<EpiNormRes, ChainOrder, true, true, true>(lds, DM, DM, DM, S, E, wave_s); }
        { ChainOrder S; S.o.init(T, 2 * DFF, G, bx, XN, DM, Wgu_t, DM); S.wt_base = dn + 2 * SEAM_BANK; S.dn_base = nullptr;
          EpiSwiGLU E{Fb, ssq_h2};
          pg8::gemm_phase<EpiSwiGLU, ChainOrder, true, true, true>(lds, DM, DM, DM, S, E, wave_s); } }
    if (IN(5) && IN(11)) { if (!grouped) xcd_barrier(bar, wave_s); else xcd_barrier(gbar, wave_s); } TE(5); TE(7); TE(8); TE(10);
#else
    TS(5); if (IN(5)) REPS(5) { pg8::TileOrder S; S.init(T, DM, G, bx, Y, DM, Wout_t, DM);
        EpiNormResMid E{nullptr, XN, nullptr, g_post_mix, rep ? (bf16_t*)PRE : XN, RSQ(ssq_h1), slots_p, ctl + CW_SEAM, false, ssq_lru, ssq_mla};
        pg8::gemm_phase<EpiNormResMid, pg8::TileOrder>(lds, DM, DM, DM, S, E, wave_s); }
    SEAM(5); TE(5);
    TS(7); if (IN(7)) REPS(7) { pg8::TileOrder S; S.init(T, DM, G, bx, XN, DM, WQK, DM, (size_t)DM * DM * 2); EpiSoftmax E{Pb, ssq_h1, false}; pg8::gemm_phase<EpiSoftmax, pg8::TileOrder>(lds, DM, DM, DM, S, E, wave_s); }
    SEAM(7); TE(7);
    TS(8); if (IN(8)) REPS(8) { pg8::TileOrder S; S.init(T, DM, G, bx, Pb, DM, WVO, DM, (size_t)DM * DM * 2); EpiNormRes E{nullptr, XN, nullptr, g_post_mem, rep ? (bf16_t*)PRE : XN, RSQ(ssq_h2), slots_p + (size_t)4 * T, ctl + CW_SEAM + SEAM_BANK, false, nullptr, nullptr};
        pg8::gemm_phase<EpiNormRes, pg8::TileOrder>(lds, DM, DM, DM, S, E, wave_s); }
    SEAM(8); TE(8);
#ifdef COLD10
    if (IN(10)) { for (int m = gw * 4; m < T; m += NGW * 4) rms_rows_to_bf16<4, true>(x_in + (size_t)m * DM, g_pre_mix, (bf16_t*)PRE + (size_t)m * DM, nullptr, lane);
                  for (int m = gw * 4; m < T; m += NGW * 4) rms_rows_to_bf16<4, true>(x_in + (size_t)m * DM, g_pre_mix, (bf16_t*)PRE + (size_t)(T + m) * DM, nullptr, lane); xcd_barrier(gbar, wave_s); }
#endif
    TS(10); if (IN(10)) REPS(10) { pg8::TileOrder S; S.init(T, 2 * DFF, G, bx, XN, DM, Wgu_t, DM); EpiSwiGLU E{Fb, ssq_h2}; pg8::gemm_phase<EpiSwiGLU, pg8::TileOrder, ALIGN_P10>(lds, DM, DM, DM, S, E, wave_s); }
    SEAM(10); TE(10);
#endif
    TS(11); if (IN(11)) REPS(11) { pg8::TileOrder S; S.init(T, DM, G, bx, Fb, DFF, Wdown_t, DFF); EpiNormRes E{nullptr, XN, rep ? PRE : out_p, g_post_ffn, nullptr, nullptr, slots_p + (size_t)8 * T, ctl + CW_SEAM + 2 * SEAM_BANK, false, nullptr, nullptr};
        pg8::gemm_phase<EpiNormRes, pg8::TileOrder>(lds, DFF, DFF, DFF, S, E, wave_s); }
    TE(11);
#ifdef CLKPROBE
    if ((SPIN_LO) >= 0) { const unsigned long long dt = ((tc1 - tc0) * 1000ull) / (ts1 - ts0), t2 = __builtin_amdgcn_s_memrealtime();
#else
    if ((SPIN_LO) >= 0) { const unsigned long long dt = ts1 - ts0, t2 = __builtin_amdgcn_s_memrealtime();
#endif
        while (__builtin_amdgcn_s_memrealtime() - t2 < dt) __builtin_amdgcn_s_sleep(8); }
#undef IN
#undef SEAM
}

#undef tid
#undef lane
#undef wave
#undef gw
#undef NGW
#undef x_in
#undef ssq_h1
#undef ssq_h2
#undef ssq_dummy
#undef ssq_x
#undef slots_p
#undef mem
#undef positions
#undef g_pre_mix
#undef w_in
#undef conv_w
#undef conv_b
#undef lru_wa
#undef lru_ba
#undef lru_wx
#undef lru_bx
#undef lru_lambda
#undef g_q_lat
#undef w_uq
#undef g_kv_lat
#undef w_ukv
#undef g_lru_out
#undef g_mla_out
#undef w_out
#undef g_post_mix
#undef g_pre_mem
#undef g_mem_kv
#undef w_mq
#undef w_mk
#undef w_mv
#undef w_mo
#undef g_post_mem
#undef g_pre_ffn
#undef w_gate
#undef w_up
#undef w_down
#undef g_post_ffn
#undef out_p
#undef ctl
#undef ssq_cq
#undef ssq_ckv
#undef ssq_lru
#undef ssq_mla
#undef cosT
#undef sinT
#undef Win_t
#undef Wuq_t
#undef Wukv_t
#undef Wout_t
#undef Wmq_b
#undef Wmkv_t
#undef Wmo_t
#undef Wgu_t
#undef Wdown_t
#undef MN
#undef MKV
#undef WQK
#undef WVO
#undef XN
#undef KPE
#undef Z
#undef Qb
#undef KVb
#undef Y
#undef PRE
#undef Pb
#undef Fb
#ifndef N_LAUNCHES
#define N_LAUNCHES 1
#endif
extern "C" void kernel_launch(void* const* d_in, const int* in_sizes, int n_in, void* d_out, int out_size, void* d_ws, size_t ws_size, hipStream_t stream) {
    static int grid = 0;
    if (grid == 0) {
        if (n_in != 32 || in_sizes[0] != T * DM || out_size != T * DM || ws_size < WS_END) { fprintf(stderr, "kernel_launch: unexpected shapes (n_in %d, in0 %d, out %d, ws %zu)\n", n_in, n_in > 0 ? in_sizes[0] : -1, out_size, ws_size); grid = -1; return; }
        int dev = 0, cus = 0, per_cu = 0;
        (void)hipGetDevice(&dev); (void)hipDeviceGetAttribute(&cus, hipDeviceAttributeMultiprocessorCount, dev);
        if (hipFuncSetAttribute((const void*)hymba_fwd, hipFuncAttributeMaxDynamicSharedMemorySize, LDS_BYTES) != hipSuccess) { fprintf(stderr, "kernel_launch: hipFuncSetAttribute failed\n"); grid = -1; return; }
        if (hipOccupancyMaxActiveBlocksPerMultiprocessor(&per_cu, (const void*)hymba_fwd, NWAVES * 64, LDS_BYTES) != hipSuccess || per_cu < 1) { fprintf(stderr, "kernel_launch: occupancy query says %d\n", per_cu); per_cu = 1; }
        (void)hipGetLastError();
        grid = cus > 0 ? cus : 256;
    }
    if (grid < 0) return;
    (void)hipMemsetAsync((char*)d_ws + WS_CTL, 0, CTL_ZERO_BYTES, stream);
    Args a{};
    for (int i = 0; i < 32; ++i) a.in[i] = d_in[i];
    a.out = (float*)d_out; a.ws = (unsigned char*)d_ws;
#if N_LAUNCHES == 1
    a.ph_lo = 0; a.ph_hi = NPHASE;
    void* kargs[] = {&a};
#ifdef PLAIN_LAUNCH
    (void)kargs; hipLaunchKernelGGL(hymba_fwd, dim3(grid), dim3(NWAVES * 64), LDS_BYTES, stream, a); hipError_t e = hipPeekAtLastError();
#else
    hipError_t e = hipLaunchCooperativeKernel((const void*)hymba_fwd, dim3(grid), dim3(NWAVES * 64), kargs, LDS_BYTES, stream);
#endif
    if (e != hipSuccess) fprintf(stderr, "kernel_launch: cooperative launch failed: %s (grid %d)\n", hipGetErrorString(e), grid);
#else
    for (int p = 0; p < NPHASE; ++p) { a.ph_lo = p; a.ph_hi = p + 1; hipLaunchKernelGGL(hymba_fwd, dim3(grid), dim3(NWAVES * 64), LDS_BYTES, stream, a); }
#endif
}
```

```cpp
#include <hip/hip_runtime.h>
#include <hip/hip_bf16.h>
#include <cstdio>
#include <cstdint>

#define LAS __attribute__((address_space(3)))
#define GAS __attribute__((address_space(1)))
typedef unsigned short bf16_t;
typedef short bf16x8 __attribute__((ext_vector_type(8)));
typedef short s16x4 __attribute__((ext_vector_type(4)));
typedef float f32x4 __attribute__((ext_vector_type(4)));
typedef float f32x2 __attribute__((ext_vector_type(2)));
typedef float f32x16 __attribute__((ext_vector_type(16)));
typedef unsigned u32x4 __attribute__((ext_vector_type(4)));
typedef unsigned u32x2 __attribute__((ext_vector_type(2)));

constexpr int BATCH = 16, SEQ = 2048, DM = 1024, T = BATCH * SEQ;
constexpr int NMEM = 256, TM = BATCH * NMEM;
constexpr int DLRU = 512, DINP = 1792, QLR = 384, KVLR = 256, DFF = 2816;
constexpr int OFF_GATE = 512, OFF_CQ = 1024, OFF_CKV = 1408, OFF_KPE = 1664;
constexpr float EPS = 1e-6f;
constexpr float LOG2E = 1.4426950408889634f;
constexpr float QSCALE = 0.07216878364870322f * LOG2E;
constexpr float MSCALE = 0.0625f * LOG2E;

constexpr size_t MiB = 1u << 20;
constexpr size_t WS_CTL = 0, CTL_ZERO_BYTES = 2 * MiB;
constexpr size_t WS_SSQ = 1 * MiB;
constexpr size_t WS_SLOTS = 2 * MiB;
constexpr int CW_SEAM = 65536, SEAM_BANK = 8192, CW_DONE = CW_SEAM + 3 * SEAM_BANK;
constexpr size_t WS_ROPE = 4 * MiB;
constexpr size_t WS_WIN = 12 * MiB, WS_WUQ = 16 * MiB, WS_WUKV = 17 * MiB, WS_WOUT = 18 * MiB, WS_WMQ = 20 * MiB, WS_WMKV = 22 * MiB,
                 WS_WMO = 26 * MiB, WS_WGU = 28 * MiB, WS_WDOWN = 39 * MiB;
constexpr size_t WS_MN = 46 * MiB, WS_MKV = 54 * MiB, WS_WQK = 70 * MiB, WS_WVO = 102 * MiB, WS_XN = 134 * MiB, WS_KPE = 198 * MiB;
constexpr size_t WS_Z = 202 * MiB, WS_Q = 314 * MiB, WS_KV = 362 * MiB, WS_Y = 426 * MiB;
constexpr size_t WS_PRE = 202 * MiB, WS_P = 330 * MiB, WS_F = 330 * MiB, WS_END = 506 * MiB;
constexpr int CW_BAR = 4096;

constexpr int RING_BYTES = 131072, EPI_OFF = RING_BYTES, EPI_BYTES = 16384, MISC_OFF = EPI_OFF + EPI_BYTES, LDS_BYTES = MISC_OFF + 1024;

__device__ __forceinline__ unsigned cvt_pk_bf16(float lo, float hi) { unsigned r; asm volatile("v_cvt_pk_bf16_f32 %0, %1, %2" : "=v"(r) : "v"(lo), "v"(hi)); return r; }
__device__ __forceinline__ float bf2f(unsigned short v) { return __uint_as_float((unsigned)v << 16); }
__device__ __forceinline__ float bflo(unsigned w) { return __uint_as_float(w << 16); }
__device__ __forceinline__ float bfhi(unsigned w) { return __uint_as_float(w & 0xffff0000u); }
__device__ __forceinline__ float wave_sum(float v) {
#pragma unroll
    for (int o = 1; o < 64; o <<= 1) v += __shfl_xor(v, o);
    return v;
}
__device__ __forceinline__ int lane_id() { int l; asm volatile("v_mbcnt_lo_u32_b32 %0, -1, 0\n\tv_mbcnt_hi_u32_b32 %0, -1, %0" : "=v"(l)); return l; }
#define LDS_WAIT() asm volatile("s_waitcnt lgkmcnt(0)" ::: "memory")
#define VM_WAIT() asm volatile("s_waitcnt vmcnt(0)" ::: "memory")

namespace pg8 {
constexpr int BM = 256, BK = 64, HALF = 128, HTB = HALF * BK * 2, STAGE_BYTES = 8 * HTB, NXCD = 8, WGM = 8;
__host__ __device__ __forceinline__ int lds_byte(int r, int c) { const int st = (r >> 4) * 2 + (c >> 5), rr = r & 15, cc = c & 31, ob = rr * 64 + cc * 2; return st * 1024 + (ob ^ (((ob >> 9) & 1) << 5)); }
__host__ __device__ __forceinline__ void stage_rc(int b, int& R, int& C) { const int st = b / 1024, sb = b % 1024, swz = sb ^ (((sb >> 9) & 1) << 5); R = (st >> 1) * 16 + swz / 64; C = (st & 1) * 32 + (swz % 64) / 2; }
__host__ __device__ __forceinline__ int perm32(int rho) { const int n = rho >> 4, i = rho & 15; return 8 * (i >> 2) + 4 * n + (i & 3); }

struct Unit { int pm, pn; const char* A; const char* B; long cofs; int job; unsigned* wait; unsigned* done; int lda, ldb, nt; };

struct TileOrder {
    int nM, nN, nwg, G, c; const char* A; const char* B; size_t tA, tB, bB;
    __device__ void init(int M, int N, int G_, int c_, const void* A_, int lda, const void* B_, int ldb, size_t batchB_bytes = 0) {
        nM = M / BM; nN = N / BM; nwg = nM * nN; G = G_; c = c_; A = (const char*)A_; B = (const char*)B_; tA = (size_t)BM * lda * 2; tB = (size_t)BM * ldb * 2; bB = batchB_bytes; }
    __device__ bool next(int i, Unit& u) const {
        const long L = (long)i * G + c; if (L >= nwg) return false;
        int wgid = (int)L; { const int q = nwg / NXCD, r = nwg % NXCD, xcd = wgid % NXCD, off = wgid / NXCD; wgid = (xcd < r ? xcd * (q + 1) : r * (q + 1) + (xcd - r) * q) + off; }
        const int nig = WGM * nN, gid = wgid / nig, fm = gid * WGM, gsz = (nM - fm) < WGM ? (nM - fm) : WGM;
        u.pm = fm + ((wgid % nig) % gsz); u.pn = (wgid % nig) / gsz; u.A = A + (size_t)u.pm * tA; u.B = B + (size_t)u.pn * tB + (size_t)(u.pm >> 3) * bB; u.cofs = 0; u.job = 0; u.wait = nullptr; u.done = nullptr; return true;
    }
};

__device__ __forceinline__ void chain_wait(const Unit& u) {
    if (u.wait) { unsigned sp = 0; while ((unsigned)__builtin_amdgcn_readfirstlane(__hip_atomic_load(u.wait, __ATOMIC_RELAXED, __HIP_MEMORY_SCOPE_AGENT)) < 4u) { __builtin_amdgcn_s_sleep(1); if (++sp > (1u << 22)) break; }
    }
}
__device__ __forceinline__ void chain_publish(const Unit& u, int wid) {
    if (u.done) { asm volatile("s_waitcnt vmcnt(0)\n\ts_barrier" ::: "memory");
        if (wid == 0 && lane_id() == 0) __hip_atomic_fetch_add(u.done, 1u, __ATOMIC_RELAXED, __HIP_MEMORY_SCOPE_AGENT); }
}
template <class Epi, class Sched, bool ALIGN_EPI = true, bool SP2 = true, bool CHAIN = false>
__device__ __forceinline__ void gemm_phase(LAS unsigned char* lds, const int lda, const int ldb, const int K, const Sched& S, const Epi& E, const int wv) {
    int lane = lane_id(); asm volatile("" : "+v"(lane));
    const int wid = wv, tid = wv * 64 + lane, wr = wid >> 2, wc = wid & 3, fr = lane & 15, fq = lane >> 4;
    const int nt = K / BK;
    unsigned voffA[2], voffB[2];
#pragma unroll
    for (int i = 0; i < 2; ++i) { int R, C; stage_rc(tid * 16 + i * 8192, R, C); const int Rb = Epi::PERM ? ((R & ~31) + perm32(R & 31)) : R;
        voffA[i] = (unsigned)(R * lda + C) * 2u; voffB[i] = (unsigned)(Rb * ldb + C) * 2u; }
    const size_t kstep = (size_t)(BK * 2);
    const size_t hstepA = (size_t)HALF * lda * 2, hstepB = (size_t)HALF * ldb * 2;
    const unsigned ldsw = (unsigned)wid * 1024u;
    const int aoff = lds_byte(wr * 64 + fr, fq * 8), boff = lds_byte(wc * 32 + fr, fq * 8);
#define PG8_SA(b, h) (((b) * 2 + (h)) * HTB)
#define PG8_SB(b, h) ((4 + (b) * 2 + (h)) * HTB)
#define PG8_STAGE_(bufoff, gbase, voff, AUX) do { _Pragma("unroll") for (int _i = 0; _i < 2; ++_i) \
        __builtin_amdgcn_global_load_lds((const unsigned*)((const char*)(gbase) + (voff)[_i]), (LAS unsigned*)(lds + (bufoff) + ldsw + _i * 8192), 16, 0, AUX); } while (0)
#define PG8_STAGE(bufoff, gbase, voff) PG8_STAGE_(bufoff, gbase, voff, 0)
#define PG8_STAGEA(bufoff, gbase, voff) do { if constexpr (CHAIN) PG8_STAGE_(bufoff, gbase, voff, 16); else PG8_STAGE_(bufoff, gbase, voff, 0); } while (0)
#define PG8_LDA(dst, b, h) do { _Pragma("unroll") for (int m = 0; m < 4; ++m) _Pragma("unroll") for (int k = 0; k < 2; ++k) dst[m][k] = *(const LAS bf16x8*)(lds + PG8_SA(b, h) + aoff + m * 2048 + k * 1024); } while (0)
#define PG8_LDB(dst, b, h) do { _Pragma("unroll") for (int n = 0; n < 2; ++n) _Pragma("unroll") for (int k = 0; k < 2; ++k) dst[n][k] = *(const LAS bf16x8*)(lds + PG8_SB(b, h) + boff + n * 2048 + k * 1024); } while (0)
#define PG8_MMA(ai, bj, At, Bt) do { __builtin_amdgcn_s_setprio(1); _Pragma("unroll") for (int m = 0; m < 4; ++m) _Pragma("unroll") for (int n = 0; n < 2; ++n) _Pragma("unroll") for (int k = 0; k < 2; ++k) \
        acc[ai][bj][m][n] = __builtin_amdgcn_mfma_f32_16x16x32_bf16(Bt[n][k], At[m][k], acc[ai][bj][m][n], 0, 0, 0); __builtin_amdgcn_s_setprio(0); } while (0)
#define PG8_WAIT_V(n) asm volatile("s_waitcnt vmcnt(" #n ")" ::: "memory")
#define PG8_WAIT_L(n) asm volatile("s_waitcnt lgkmcnt(" #n ")" ::: "memory")
#define PG8_BAR __builtin_amdgcn_s_barrier()
#define PG8_SCHED __builtin_amdgcn_sched_barrier(0)
    Unit cur, nxt; int ui = 0;
    if (!S.next(0, cur)) return;
    if constexpr (Epi::MIDK) { if (E.midk_on(cur)) E.prep(cur, lds, wid, 0); }
    if constexpr (CHAIN) chain_wait(cur);
    f32x4 acc[2][2][4][2];
#pragma unroll
    for (int a = 0; a < 2; ++a)
#pragma unroll
        for (int b = 0; b < 2; ++b)
#pragma unroll
            for (int m = 0; m < 4; ++m)
#pragma unroll
                for (int n = 0; n < 2; ++n) acc[a][b][m][n] = (f32x4){0.f, 0.f, 0.f, 0.f};
    bf16x8 At[4][2], B0[2][2], B1[2][2];
    const char* cA = cur.A; const char* cB = cur.B;
    static_assert(SP2, "only the SP2 loop is kept");
    PG8_STAGE(PG8_SB(0, 0), cB, voffB); PG8_STAGE(PG8_SB(0, 1), cB + hstepB, voffB); PG8_STAGEA(PG8_SA(0, 0), cA, voffA); PG8_STAGEA(PG8_SA(0, 1), cA + hstepA, voffA);
    if (wr == 1) PG8_BAR;
    PG8_WAIT_V(2); PG8_BAR;
    PG8_STAGE(PG8_SB(1, 0), cB + kstep, voffB); PG8_STAGEA(PG8_SA(1, 0), cA + kstep, voffA); PG8_STAGE(PG8_SB(1, 1), cB + hstepB + kstep, voffB);
    PG8_WAIT_V(6); PG8_BAR;
    for (;;) {
        const bool has_next = S.next(ui + 1, nxt);
        const char* nA = has_next ? nxt.A : cA; const char* nB = has_next ? nxt.B : cB;
        for (int t = 0; t < nt; t += 2) {
            if constexpr (Epi::MIDK) { if (t == Epi::TSPLIT && E.midk_on(cur)) E.midk(acc, lds, ui & 1, wr); }
            const bool last = (t == nt - 2);
            if constexpr (CHAIN) { if (last && has_next) chain_wait(nxt); }
            const char* a1 = cA + (size_t)(t + 1) * kstep;
            const char* a2 = last ? nA : cA + (size_t)(t + 2) * kstep; const char* b2 = last ? nB : cB + (size_t)(t + 2) * kstep;
            const char* a3 = a2 + kstep; const char* b3 = b2 + kstep;
            PG8_LDB(B0, 0, 0); PG8_LDB(B1, 0, 1); PG8_SCHED; PG8_LDA(At, 0, 0); PG8_STAGEA(PG8_SA(1, 1), a1 + hstepA, voffA);
            PG8_WAIT_V(8); PG8_WAIT_L(0); PG8_BAR; PG8_MMA(0, 0, At, B0); PG8_MMA(0, 1, At, B1); PG8_BAR; PG8_SCHED;
            PG8_LDA(At, 0, 1); PG8_STAGE(PG8_SB(0, 0), b2, voffB); PG8_STAGE(PG8_SB(0, 1), b2 + hstepB, voffB); PG8_STAGEA(PG8_SA(0, 0), a2, voffA);
            PG8_WAIT_V(8); PG8_WAIT_L(0); PG8_BAR; PG8_MMA(1, 0, At, B0); PG8_MMA(1, 1, At, B1); PG8_BAR; PG8_SCHED;
            PG8_LDB(B0, 1, 0); PG8_LDB(B1, 1, 1); PG8_SCHED; PG8_LDA(At, 1, 0); PG8_STAGEA(PG8_SA(0, 1), a2 + hstepA, voffA);
            PG8_WAIT_V(8); PG8_WAIT_L(0); PG8_BAR; PG8_MMA(0, 0, At, B0); PG8_MMA(0, 1, At, B1); PG8_BAR; PG8_SCHED;
            PG8_LDA(At, 1, 1); PG8_STAGE(PG8_SB(1, 0), b3, voffB); PG8_STAGE(PG8_SB(1, 1), b3 + hstepB, voffB); PG8_STAGEA(PG8_SA(1, 0), a3, voffA);
            PG8_WAIT_V(8); PG8_WAIT_L(0); PG8_BAR; PG8_MMA(1, 0, At, B0); PG8_MMA(1, 1, At, B1); PG8_BAR; PG8_SCHED;
        }
        if constexpr (ALIGN_EPI) { if (wr == 0) PG8_BAR; }
        E(acc, cur, wr, wc, fr, fq, lds, wid, ui & 1);
        if constexpr (CHAIN) chain_publish(cur, wid);
        if (!has_next) break;
        if constexpr (Epi::MIDK) { if (E.midk_on(nxt)) E.prep(nxt, lds, wid, (ui + 1) & 1); }
#pragma unroll
        for (int a = 0; a < 2; ++a)
#pragma unroll
            for (int b = 0; b < 2; ++b)
#pragma unroll
                for (int m = 0; m < 4; ++m)
#pragma unroll
                    for (int n = 0; n < 2; ++n) acc[a][b][m][n] = (f32x4){0.f, 0.f, 0.f, 0.f};
        cur = nxt; cA = nA; cB = nB; ++ui;
        if constexpr (ALIGN_EPI) { if (wr == 1) PG8_BAR; }
    }
    PG8_WAIT_V(0);
    if constexpr (!ALIGN_EPI) { if (wr == 0) PG8_BAR; }
    PG8_BAR;
#undef PG8_SA
#undef PG8_SB
#undef PG8_STAGE
#undef PG8_STAGE_
#undef PG8_STAGEA
#undef PG8_LDA
#undef PG8_LDB
#undef PG8_MMA
#undef PG8_WAIT_V
#undef PG8_WAIT_L
#undef PG8_BAR
#undef PG8_SCHED
}
template <class Epi, class Sched>
__device__ __forceinline__ void gemm_phase_v(LAS unsigned char* lds, const Sched& S, const Epi& E, const int wv) {
    constexpr bool ALIGN_EPI = true, SP2 = true, CHAIN = false;
    int lane = lane_id(); asm volatile("" : "+v"(lane));
    const int wid = wv, tid = wv * 64 + lane, wr = wid >> 2, wc = wid & 3, fr = lane & 15, fq = lane >> 4;
    unsigned RA2[2], RB2[2], C2[2];
#pragma unroll
    for (int i = 0; i < 2; ++i) { int R, C; stage_rc(tid * 16 + i * 8192, R, C); const int Rb = Epi::PERM ? ((R & ~31) + perm32(R & 31)) : R;
        RA2[i] = (unsigned)R * 2u; RB2[i] = (unsigned)Rb * 2u; C2[i] = (unsigned)C * 2u; }
    const size_t kstep = (size_t)(BK * 2);
    const unsigned ldsw = (unsigned)wid * 1024u;
    const int aoff = lds_byte(wr * 64 + fr, fq * 8), boff = lds_byte(wc * 32 + fr, fq * 8);
#define PG8_SA(b, h) (((b) * 2 + (h)) * HTB)
#define PG8_SB(b, h) ((4 + (b) * 2 + (h)) * HTB)
#define PG8_STAGE_(bufoff, gbase, voff, AUX) do { _Pragma("unroll") for (int _i = 0; _i < 2; ++_i) \
        __builtin_amdgcn_global_load_lds((const unsigned*)((const char*)(gbase) + (voff)[_i]), (LAS unsigned*)(lds + (bufoff) + ldsw + _i * 8192), 16, 0, AUX); } while (0)
#define PG8_STAGEV(bufoff, gbase, R2, ld) do { _Pragma("unroll") for (int _i = 0; _i < 2; ++_i) \
        __builtin_amdgcn_global_load_lds((const unsigned*)((const char*)(gbase) + ((R2)[_i] * (unsigned)(ld) + C2[_i])), (LAS unsigned*)(lds + (bufoff) + ldsw + _i * 8192), 16, 0, 0); } while (0)
#define PG8_LDA(dst, b, h) do { _Pragma("unroll") for (int m = 0; m < 4; ++m) _Pragma("unroll") for (int k = 0; k < 2; ++k) dst[m][k] = *(const LAS bf16x8*)(lds + PG8_SA(b, h) + aoff + m * 2048 + k * 1024); } while (0)
#define PG8_LDB(dst, b, h) do { _Pragma("unroll") for (int n = 0; n < 2; ++n) _Pragma("unroll") for (int k = 0; k < 2; ++k) dst[n][k] = *(const LAS bf16x8*)(lds + PG8_SB(b, h) + boff + n * 2048 + k * 1024); } while (0)
#define PG8_MMA(ai, bj, At, Bt) do { __builtin_amdgcn_s_setprio(1); _Pragma("unroll") for (int m = 0; m < 4; ++m) _Pragma("unroll") for (int n = 0; n < 2; ++n) _Pragma("unroll") for (int k = 0; k < 2; ++k) \
        acc[ai][bj][m][n] = __builtin_amdgcn_mfma_f32_16x16x32_bf16(Bt[n][k], At[m][k], acc[ai][bj][m][n], 0, 0, 0); __builtin_amdgcn_s_setprio(0); } while (0)
#define PG8_WAIT_V(n) asm volatile("s_waitcnt vmcnt(" #n ")" ::: "memory")
#define PG8_WAIT_L(n) asm volatile("s_waitcnt lgkmcnt(" #n ")" ::: "memory")
#define PG8_BAR __builtin_amdgcn_s_barrier()
#define PG8_SCHED __builtin_amdgcn_sched_barrier(0)
    Unit cur, nxt; int ui = 0;
    if (!S.next(0, cur)) return;
    if constexpr (Epi::MIDK) { if (E.midk_on(cur)) E.prep(cur, lds, wid, 0); }
    if constexpr (CHAIN) chain_wait(cur);
    f32x4 acc[2][2][4][2];
#pragma unroll
    for (int a = 0; a < 2; ++a)
#pragma unroll
        for (int b = 0; b < 2; ++b)
#pragma unroll
            for (int m = 0; m < 4; ++m)
#pragma unroll
                for (int n = 0; n < 2; ++n) acc[a][b][m][n] = (f32x4){0.f, 0.f, 0.f, 0.f};
    bf16x8 At[4][2], B0[2][2], B1[2][2];
    const char* cA = cur.A; const char* cB = cur.B; int clda = cur.lda, cldb = cur.ldb, nt = cur.nt;
    size_t hstepA = (size_t)HALF * clda * 2, hstepB = (size_t)HALF * cldb * 2;
    static_assert(SP2, "only the SP2 loop is kept");
    PG8_STAGEV(PG8_SB(0, 0), cB, RB2, cldb); PG8_STAGEV(PG8_SB(0, 1), cB + hstepB, RB2, cldb); PG8_STAGEV(PG8_SA(0, 0), cA, RA2, clda); PG8_STAGEV(PG8_SA(0, 1), cA + hstepA, RA2, clda);
    if (wr == 1) PG8_BAR;
    PG8_WAIT_V(2); PG8_BAR;
    PG8_STAGEV(PG8_SB(1, 0), cB + kstep, RB2, cldb); PG8_STAGEV(PG8_SA(1, 0), cA + kstep, RA2, clda); PG8_STAGEV(PG8_SB(1, 1), cB + hstepB + kstep, RB2, cldb);
    PG8_WAIT_V(6); PG8_BAR;
    for (;;) {
        const bool has_next = S.next(ui + 1, nxt);
        const char* nA = has_next ? nxt.A : cA; const char* nB = has_next ? nxt.B : cB; const int nlda = has_next ? nxt.lda : clda, nldb = has_next ? nxt.ldb : cldb;
        const size_t nhA = (size_t)HALF * nlda * 2, nhB = (size_t)HALF * nldb * 2;
        for (int t = 0; t < nt; t += 2) {
            if constexpr (Epi::MIDK) { if (t == Epi::TSPLIT && E.midk_on(cur)) E.midk(acc, lds, ui & 1, wr); }
            const bool last = (t == nt - 2);
            if constexpr (CHAIN) { if (last && has_next) chain_wait(nxt); }
            const char* a1 = cA + (size_t)(t + 1) * kstep;
            const char* a2 = last ? nA : cA + (size_t)(t + 2) * kstep; const char* b2 = last ? nB : cB + (size_t)(t + 2) * kstep;
            const char* a3 = a2 + kstep; const char* b3 = b2 + kstep;
            const int l2a = last ? nlda : clda, l2b = last ? nldb : cldb; const size_t h2A = last ? nhA : hstepA, h2B = last ? nhB : hstepB;
            PG8_LDB(B0, 0, 0); PG8_LDB(B1, 0, 1); PG8_SCHED; PG8_LDA(At, 0, 0); PG8_STAGEV(PG8_SA(1, 1), a1 + hstepA, RA2, clda);
            PG8_WAIT_V(8); PG8_WAIT_L(0); PG8_BAR; PG8_MMA(0, 0, At, B0); PG8_MMA(0, 1, At, B1); PG8_BAR; PG8_SCHED;
            PG8_LDA(At, 0, 1); PG8_STAGEV(PG8_SB(0, 0), b2, RB2, l2b); PG8_STAGEV(PG8_SB(0, 1), b2 + h2B, RB2, l2b); PG8_STAGEV(PG8_SA(0, 0), a2, RA2, l2a);
            PG8_WAIT_V(8); PG8_WAIT_L(0); PG8_BAR; PG8_MMA(1, 0, At, B0); PG8_MMA(1, 1, At, B1); PG8_BAR; PG8_SCHED;
            PG8_LDB(B0, 1, 0); PG8_LDB(B1, 1, 1); PG8_SCHED; PG8_LDA(At, 1, 0); PG8_STAGEV(PG8_SA(0, 1), a2 + h2A, RA2, l2a);
            PG8_WAIT_V(8); PG8_WAIT_L(0); PG8_BAR; PG8_MMA(0, 0, At, B0); PG8_MMA(0, 1, At, B1); PG8_BAR; PG8_SCHED;
            PG8_LDA(At, 1, 1); PG8_STAGEV(PG8_SB(1, 0), b3, RB2, l2b); PG8_STAGEV(PG8_SB(1, 1), b3 + h2B, RB2, l2b); PG8_STAGEV(PG8_SA(1, 0), a3, RA2, l2a);
            PG8_WAIT_V(8); PG8_WAIT_L(0); PG8_BAR; PG8_MMA(1, 0, At, B0); PG8_MMA(1, 1, At, B1); PG8_BAR; PG8_SCHED;
        }
        if constexpr (ALIGN_EPI) { if (wr == 0) PG8_BAR; }
        E(acc, cur, wr, wc, fr, fq, lds, wid, ui & 1);
        if constexpr (CHAIN) chain_publish(cur, wid);
        if (!has_next) break;
        if constexpr (Epi::MIDK) { if (E.midk_on(nxt)) E.prep(nxt, lds, wid, (ui + 1) & 1); }
#pragma unroll
        for (int a = 0; a < 2; ++a)
#pragma unroll
            for (int b = 0; b < 2; ++b)
#pragma unroll
                for (int m = 0; m < 4; ++m)
#pragma unroll
                    for (int n = 0; n < 2; ++n) acc[a][b][m][n] = (f32x4){0.f, 0.f, 0.f, 0.f};
        cur = nxt; cA = nA; cB = nB; ++ui; clda = nlda; cldb = nldb; hstepA = nhA; hstepB = nhB; nt = cur.nt;
        if constexpr (ALIGN_EPI) { if (wr == 1) PG8_BAR; }
    }
    PG8_WAIT_V(0);
    if constexpr (!ALIGN_EPI) { if (wr == 0) PG8_BAR; }
    PG8_BAR;
#undef PG8_SA
#undef PG8_SB
#undef PG8_STAGE_
#undef PG8_STAGEV
#undef PG8_LDA
#undef PG8_LDB
#undef PG8_MMA
#undef PG8_WAIT_V
#undef PG8_WAIT_L
#undef PG8_BAR
#undef PG8_SCHED
}
}

typedef f32x4 Acc[2][2][4][2];
__device__ __forceinline__ void store16(void* p, u32x4 v, bool wt) {
    if (wt) asm volatile("global_store_dwordx4 %0, %1, off sc1\n\ts_nop 1" :: "v"(p), "v"(v) : "memory"); else *(u32x4*)p = v;
}
__device__ __forceinline__ void ssq_rows_atomic(const Acc& acc, float* ssq, int row_base  , int bjmask, int fq, int lane) {
#pragma unroll
    for (int ai = 0; ai < 2; ++ai) {
        float s[4];
#pragma unroll
        for (int m = 0; m < 4; ++m) { float q = 0.f;
#pragma unroll
            for (int bj = 0; bj < 2; ++bj) if (bjmask & (1 << bj))
#pragma unroll
                for (int n = 0; n < 2; ++n) { const f32x4 x = acc[ai][bj][m][n]; q += (x[0] * x[0] + x[1] * x[1]) + (x[2] * x[2] + x[3] * x[3]); }
            q += __shfl_xor(q, 16); q += __shfl_xor(q, 32); s[m] = q; }
        const float v = fq == 0 ? s[0] : fq == 1 ? s[1] : fq == 2 ? s[2] : s[3];
        atomicAdd(ssq + row_base + ai * 128 + lane, v);
    }
}
struct EpiBf16 {
    static constexpr bool PERM = true, MIDK = false;
    bf16_t* O; int ldc; float scale; const float* ssq; float rdim_inv;
    __device__ __forceinline__ void operator()(const Acc& acc, const pg8::Unit& u, int wr, int wc, int fr, int fq, LAS unsigned char*, int, int) const {
        { const int ln_ = lane_id(); fr = ln_ & 15; fq = ln_ >> 4; }
        const int row0 = u.pm * 256 + wr * 64 + fr, col0 = u.pn * 256 + wc * 32 + 8 * fq;
#pragma unroll
        for (int ai = 0; ai < 2; ++ai)
#pragma unroll
            for (int m = 0; m < 4; ++m) { const int row = row0 + ai * 128 + m * 16; float sc = scale;
                if (ssq) sc *= __builtin_amdgcn_rsqf(ssq[row] * rdim_inv + EPS);
                bf16_t* rowp = O + u.cofs + (size_t)row * ldc + col0;
#pragma unroll
                for (int bj = 0; bj < 2; ++bj) { const f32x4 v0 = acc[ai][bj][m][0] * sc, v1 = acc[ai][bj][m][1] * sc;
                    u32x4 w; w.x = cvt_pk_bf16(v0[0], v0[1]); w.y = cvt_pk_bf16(v0[2], v0[3]); w.z = cvt_pk_bf16(v1[0], v1[1]); w.w = cvt_pk_bf16(v1[2], v1[3]);
                    *(u32x4*)(rowp + bj * 128) = w; } }
    }
};
__device__ __forceinline__ void rope8(f32x4& v0, f32x4& v1, const float* cosT, const float* sinT, int row, int i0) {
    const f32x4 c = *(const f32x4*)(cosT + (size_t)row * 32 + i0), s = *(const f32x4*)(sinT + (size_t)row * 32 + i0);
    const f32x4 a = v0, b = v1;
    v0[0] = a[0] * c[0] - a[1] * s[0]; v0[1] = a[1] * c[0] + a[0] * s[0]; v0[2] = a[2] * c[1] - a[3] * s[1]; v0[3] = a[3] * c[1] + a[2] * s[1];
    v1[0] = b[0] * c[2] - b[1] * s[2]; v1[1] = b[1] * c[2] + b[0] * s[2]; v1[2] = b[2] * c[3] - b[3] * s[3]; v1[3] = b[3] * c[3] + b[2] * s[3];
}
struct EpiZ {
    static constexpr bool PERM = true, MIDK = false;
    bf16_t* Z; bf16_t* KPE; float* ssq_cq; float* ssq_ckv; const float* cosT; const float* sinT; const float* ssq_x;
    __device__ __forceinline__ void operator()(Acc& acc, const pg8::Unit& u, int wr, int wc, int fr, int fq, LAS unsigned char*, int, int lane) const {
        { const int ln_ = lane_id(); fr = ln_ & 15; fq = ln_ >> 4; }
        const int row0 = u.pm * 256 + wr * 64 + fr, col0 = u.pn * 256 + wc * 32 + 8 * fq;
        const bool kpe_tile = (u.pn == 6);
#pragma unroll
        for (int ai = 0; ai < 2; ++ai)
#pragma unroll
            for (int m = 0; m < 4; ++m) { const float rsx = __builtin_amdgcn_rsqf(ssq_x[row0 + ai * 128 + m * 16] * (1.f / DM) + EPS);
#pragma unroll
                for (int bj = 0; bj < 2; ++bj)
#pragma unroll
                    for (int n = 0; n < 2; ++n) acc[ai][bj][m][n] = acc[ai][bj][m][n] * rsx; }
#pragma unroll
        for (int ai = 0; ai < 2; ++ai)
#pragma unroll
            for (int m = 0; m < 4; ++m) { const int row = row0 + ai * 128 + m * 16; bf16_t* rowp = Z + (size_t)row * DINP + col0;
#pragma unroll
                for (int bj = 0; bj < 2; ++bj) { f32x4 v0 = acc[ai][bj][m][0], v1 = acc[ai][bj][m][1];
                    if (kpe_tile && bj == 1) {
                        if (wc < 2) { rope8(v0, v1, cosT, sinT, row, 16 * (wc & 1) + 4 * fq);
                            u32x4 w; w.x = cvt_pk_bf16(v0[0], v0[1]); w.y = cvt_pk_bf16(v0[2], v0[3]); w.z = cvt_pk_bf16(v1[0], v1[1]); w.w = cvt_pk_bf16(v1[2], v1[3]);
                            *(u32x4*)(KPE + (size_t)row * 64 + wc * 32 + 8 * fq) = w; }
                    } else {
                        u32x4 w; w.x = cvt_pk_bf16(v0[0], v0[1]); w.y = cvt_pk_bf16(v0[2], v0[3]); w.z = cvt_pk_bf16(v1[0], v1[1]); w.w = cvt_pk_bf16(v1[2], v1[3]);
                        *(u32x4*)(rowp + bj * 128) = w; } } }
        const int rb = u.pm * 256 + wr * 64; lane = fq * 16 + fr;
        if (u.pn == 4) ssq_rows_atomic(acc, ssq_cq, rb, 3, fq, lane);
        else if (u.pn == 5) { ssq_rows_atomic(acc, ssq_cq, rb, 1, fq, lane); ssq_rows_atomic(acc, ssq_ckv, rb, 2, fq, lane); }
        else if (u.pn == 6) ssq_rows_atomic(acc, ssq_ckv, rb, 1, fq, lane);
    }
};
struct EpiQ {
    static constexpr bool PERM = true, MIDK = false;
    bf16_t* Q; const float* ssq; const float* cosT; const float* sinT;
    __device__ __forceinline__ void operator()(const Acc& acc, const pg8::Unit& u, int wr, int wc, int fr, int fq, LAS unsigned char*, int, int) const {
        { const int ln_ = lane_id(); fr = ln_ & 15; fq = ln_ >> 4; }
        const int row0 = u.pm * 256 + wr * 64 + fr, col0 = u.pn * 256 + wc * 32 + 8 * fq;
        const bool pe = (u.pn == 2);
#pragma unroll
        for (int ai = 0; ai < 2; ++ai)
#pragma unroll
            for (int m = 0; m < 4; ++m) { const int row = row0 + ai * 128 + m * 16;
                const float sc = QSCALE * __builtin_amdgcn_rsqf(ssq[row] * (1.f / QLR) + EPS);
                bf16_t* rowp = Q + (size_t)row * 768 + col0;
#pragma unroll
                for (int bj = 0; bj < 2; ++bj) { f32x4 v0 = acc[ai][bj][m][0] * sc, v1 = acc[ai][bj][m][1] * sc;
                    if (pe) rope8(v0, v1, cosT, sinT, row, 16 * (wc & 1) + 4 * fq);
                    u32x4 w; w.x = cvt_pk_bf16(v0[0], v0[1]); w.y = cvt_pk_bf16(v0[2], v0[3]); w.z = cvt_pk_bf16(v1[0], v1[1]); w.w = cvt_pk_bf16(v1[2], v1[3]);
                    *(u32x4*)(rowp + bj * 128) = w; } }
    }
};
struct EpiF32 {
    static constexpr bool PERM = false, MIDK = false;
    float* O; int ldc;
    __device__ __forceinline__ void operator()(const Acc& acc, const pg8::Unit& u, int wr, int wc, int fr, int fq, LAS unsigned char*, int, int) const {
        { const int ln_ = lane_id(); fr = ln_ & 15; fq = ln_ >> 4; }
        const int row0 = u.pm * 256 + wr * 64 + fr, col0 = u.pn * 256 + wc * 32 + 4 * fq;
#pragma unroll
        for (int ai = 0; ai < 2; ++ai)
#pragma unroll
            for (int m = 0; m < 4; ++m) { float* rowp = O + (size_t)(row0 + ai * 128 + m * 16) * ldc + col0;
#pragma unroll
                for (int bj = 0; bj < 2; ++bj)
#pragma unroll
                    for (int n = 0; n < 2; ++n) *(f32x4*)(rowp + bj * 128 + n * 16) = acc[ai][bj][m][n]; }
    }
};
struct EpiSwiGLU {
    static constexpr bool PERM = true, MIDK = false;
    bf16_t* F; const float* ssq;
    __device__ __forceinline__ void operator()(const Acc& acc, const pg8::Unit& u, int wr, int wc, int fr, int fq, LAS unsigned char*, int, int) const {
        { const int ln_ = lane_id(); fr = ln_ & 15; fq = ln_ >> 4; }
        const int row0 = u.pm * 256 + wr * 64 + fr, col0 = u.pn * 128 + wc * 32 + 8 * fq;
        float sq[2][4];
#pragma unroll
        for (int ai = 0; ai < 2; ++ai)
#pragma unroll
            for (int m = 0; m < 4; ++m) sq[ai][m] = ssq[row0 + ai * 128 + m * 16];
#pragma unroll
        for (int ai = 0; ai < 2; ++ai)
#pragma unroll
            for (int m = 0; m < 4; ++m) { bf16_t* rowp = F + (size_t)(row0 + ai * 128 + m * 16) * DFF + col0; float f[8];
                const float rsc = __builtin_amdgcn_rsqf(sq[ai][m] * (1.f / DM) + EPS);
#pragma unroll
                for (int n = 0; n < 2; ++n)
#pragma unroll
                    for (int e = 0; e < 4; ++e) { const float g = acc[ai][0][m][n][e] * rsc, up = acc[ai][1][m][n][e] * rsc;
                        f[n * 4 + e] = g * __builtin_amdgcn_rcpf(1.f + __builtin_amdgcn_exp2f(-g * LOG2E)) * up; }
                u32x4 w; w.x = cvt_pk_bf16(f[0], f[1]); w.y = cvt_pk_bf16(f[2], f[3]); w.z = cvt_pk_bf16(f[4], f[5]); w.w = cvt_pk_bf16(f[6], f[7]);
                *(u32x4*)rowp = w; }
    }
};
struct EpiSoftmax {
    static constexpr bool PERM = true, MIDK = false;
    bf16_t* P; const float* ssq; bool wt;
    __device__ __forceinline__ void operator()(Acc& acc, const pg8::Unit& u, int wr, int wc, int fr, int fq, LAS unsigned char* lds, int, int) const {
        { const int ln_ = lane_id(); fr = ln_ & 15; fq = ln_ >> 4; }
        LAS float* PM = (LAS float*)(lds + EPI_OFF);
        LAS float* PS = (LAS float*)(lds + EPI_OFF + 4096);
        float sq[2][4];
#pragma unroll
        for (int ai = 0; ai < 2; ++ai)
#pragma unroll
            for (int m = 0; m < 4; ++m) sq[ai][m] = ssq[u.pm * 256 + ai * 128 + wr * 64 + m * 16 + fr];
        float mxr[2][4];
#pragma unroll
        for (int ai = 0; ai < 2; ++ai)
#pragma unroll
            for (int m = 0; m < 4; ++m) { float q = -3.0e38f;
#pragma unroll
                for (int bj = 0; bj < 2; ++bj)
#pragma unroll
                    for (int n = 0; n < 2; ++n) { const f32x4 x = acc[ai][bj][m][n]; q = fmaxf(q, fmaxf(fmaxf(x[0], x[1]), fmaxf(x[2], x[3]))); }
                q = fmaxf(q, __shfl_xor(q, 16)); q = fmaxf(q, __shfl_xor(q, 32)); mxr[ai][m] = q; }
#pragma unroll
        for (int ai = 0; ai < 2; ++ai)
#pragma unroll
            for (int m = 0; m < 4; ++m) { sq[ai][m] = __builtin_amdgcn_rsqf(sq[ai][m] * (1.f / DM) + EPS);
                if (fq == 0) PM[(ai * 128 + wr * 64 + m * 16 + fr) * 4 + wc] = mxr[ai][m] * sq[ai][m]; }
        LDS_WAIT(); __builtin_amdgcn_s_barrier(); asm volatile("" ::: "memory");
#pragma unroll
        for (int ai = 0; ai < 2; ++ai)
#pragma unroll
            for (int m = 0; m < 4; ++m) { const f32x4 t = *(const LAS f32x4*)(PM + (ai * 128 + wr * 64 + m * 16 + fr) * 4);
                const float rm = fmaxf(fmaxf(t[0], t[1]), fmaxf(t[2], t[3])), rsc = sq[ai][m]; float s = 0.f;
#pragma unroll
                for (int bj = 0; bj < 2; ++bj)
#pragma unroll
                    for (int n = 0; n < 2; ++n) { f32x4 x = acc[ai][bj][m][n];
#pragma unroll
                        for (int e = 0; e < 4; ++e) { x[e] = __builtin_amdgcn_exp2f(fmaf(x[e], rsc, -rm)); s += x[e]; }
                        acc[ai][bj][m][n] = x; }
                s += __shfl_xor(s, 16); s += __shfl_xor(s, 32);
                if (fq == 0) PS[(ai * 128 + wr * 64 + m * 16 + fr) * 4 + wc] = s; }
        LDS_WAIT(); __builtin_amdgcn_s_barrier(); asm volatile("" ::: "memory");
        const int row0 = u.pm * 256 + wr * 64 + fr, col0 = u.pn * 256 + wc * 32 + 8 * fq;
#pragma unroll
        for (int ai = 0; ai < 2; ++ai)
#pragma unroll
            for (int m = 0; m < 4; ++m) { const f32x4 t = *(const LAS f32x4*)(PS + (ai * 128 + wr * 64 + m * 16 + fr) * 4);
                const float inv = __builtin_amdgcn_rcpf((t[0] + t[1]) + (t[2] + t[3]));
                bf16_t* rowp = P + (size_t)(row0 + ai * 128 + m * 16) * DM + col0;
#pragma unroll
                for (int bj = 0; bj < 2; ++bj) { const f32x4 v0 = acc[ai][bj][m][0] * inv, v1 = acc[ai][bj][m][1] * inv;
                    u32x4 w; w.x = cvt_pk_bf16(v0[0], v0[1]); w.y = cvt_pk_bf16(v0[2], v0[3]); w.z = cvt_pk_bf16(v1[0], v1[1]); w.w = cvt_pk_bf16(v1[2], v1[3]);
                    store16(rowp + bj * 128, w, wt); } }
    }
};

__device__ __forceinline__ unsigned ag_ld(const unsigned* p) { return __hip_atomic_load(p, __ATOMIC_RELAXED, __HIP_MEMORY_SCOPE_AGENT); }
template <bool MIDK_>
struct EpiNormResT {
    static constexpr bool PERM = true, MIDK = MIDK_; static constexpr int TSPLIT = 8;
    const float* hold_f; const bf16_t* hold_b; float* hout; const float* gpost; bf16_t* xn; float* ssq_next; float* slots; unsigned* cnt;
    bool wt;
    __device__ __forceinline__ bool midk_on(const pg8::Unit&) const { return MIDK_; }
    const float* ssq_a; const float* ssq_b;
    __device__ __forceinline__ void prep(const pg8::Unit& u, LAS unsigned char* lds, int wid, int par) const {
        if (wid < 4) { const int ln = lane_id(), row = wid * 64 + ln; const float sa = ssq_a[u.pm * 256 + row], sb = ssq_b[u.pm * 256 + row];
            const float ra = __builtin_amdgcn_rsqf(sa * (1.f / 512) + EPS), rb = __builtin_amdgcn_rsqf(sb * (1.f / 512) + EPS);
            ((LAS f32x2*)(lds + EPI_OFF + 5120))[par * 256 + row] = (f32x2){ra * __builtin_amdgcn_rcpf(rb), rb}; }
    }
    __device__ __forceinline__ void midk(Acc& acc, LAS unsigned char* lds, int par, int wr) const {
        const int ln = lane_id(), fr = ln & 15; const LAS f32x2* RT = (const LAS f32x2*)(lds + EPI_OFF + 5120) + par * 256;
#pragma unroll
        for (int ai = 0; ai < 2; ++ai)
#pragma unroll
            for (int m = 0; m < 4; ++m) { const float r = RT[ai * 128 + wr * 64 + m * 16 + fr].x;
#pragma unroll
                for (int bj = 0; bj < 2; ++bj)
#pragma unroll
                    for (int n = 0; n < 2; ++n) acc[ai][bj][m][n] = acc[ai][bj][m][n] * r; }
    }
    __device__ __forceinline__ void operator()(Acc& acc, const pg8::Unit& u, int wr, int wc, int fr, int fq, LAS unsigned char* lds, int wid, int par) const {
        const int ln = lane_id(); fr = ln & 15; fq = ln >> 4;
        if constexpr (MIDK_) { const LAS f32x2* RT = (const LAS f32x2*)(lds + EPI_OFF + 5120) + par * 256;
#pragma unroll
            for (int ai = 0; ai < 2; ++ai)
#pragma unroll
                for (int m = 0; m < 4; ++m) { const float r = RT[ai * 128 + wr * 64 + m * 16 + fr].y;
#pragma unroll
                    for (int bj = 0; bj < 2; ++bj)
#pragma unroll
                        for (int n = 0; n < 2; ++n) acc[ai][bj][m][n] = acc[ai][bj][m][n] * r; } }
        LAS float* PT = (LAS float*)(lds + EPI_OFF);
        LAS float* SR = (LAS float*)(lds + EPI_OFF + 4096);
        const int col0 = u.pn * 256 + wc * 32 + 8 * fq;
        f32x4 gv[2][2];
#pragma unroll
        for (int bj = 0; bj < 2; ++bj)
#pragma unroll
            for (int n = 0; n < 2; ++n) gv[bj][n] = *(const f32x4*)(gpost + col0 + bj * 128 + n * 4);
        u32x4 hb[2][4][2];
#pragma unroll
        for (int ai = 0; ai < 2; ++ai)
#pragma unroll
            for (int m = 0; m < 4; ++m) { float q = 0.f;
#pragma unroll
                for (int bj = 0; bj < 2; ++bj)
#pragma unroll
                    for (int n = 0; n < 2; ++n) { const f32x4 x = acc[ai][bj][m][n]; q += (x[0] * x[0] + x[1] * x[1]) + (x[2] * x[2] + x[3] * x[3]); }
                q += __shfl_xor(q, 16); q += __shfl_xor(q, 32);
                if (fq == 0) PT[(ai * 128 + wr * 64 + m * 16 + fr) * 4 + wc] = q; }
        LDS_WAIT(); __builtin_amdgcn_s_barrier(); asm volatile("" ::: "memory");
        unsigned* c = cnt + 64 * u.pm;
        if (wid < 4) { const int row = wid * 64 + ln; const f32x4 t = *(const LAS f32x4*)(PT + row * 4); const float sq = (t[0] + t[1]) + (t[2] + t[3]);
            __hip_atomic_store((unsigned*)slots + ((size_t)(u.pm * 256 + row) * 4 + u.pn), __float_as_uint(sq), __ATOMIC_RELAXED, __HIP_MEMORY_SCOPE_AGENT);
            asm volatile("s_waitcnt vmcnt(0)" ::: "memory");
            if (ln == 0) __hip_atomic_fetch_add(c, 1u, __ATOMIC_RELAXED, __HIP_MEMORY_SCOPE_AGENT); }
        if (!hold_f) {
#pragma unroll
            for (int ai = 0; ai < 2; ++ai)
#pragma unroll
                for (int m = 0; m < 4; ++m)
#pragma unroll
                    for (int bj = 0; bj < 2; ++bj) hb[ai][m][bj] = __builtin_nontemporal_load((const u32x4*)(hold_b + (size_t)(u.pm * 256 + ai * 128 + wr * 64 + m * 16 + fr) * DM + col0 + bj * 128)); }
        if (wid == 0) { unsigned sp = 0;
            while ((unsigned)__builtin_amdgcn_readfirstlane(ag_ld(c)) < 16u) { __builtin_amdgcn_s_sleep(2); if (++sp > (1u << 21)) break; } }
        asm volatile("s_waitcnt lgkmcnt(0)" ::: "memory"); __builtin_amdgcn_s_barrier(); asm volatile("" ::: "memory");
        if (wid < 4) { const int row = wid * 64 + ln; const unsigned* sl = (const unsigned*)slots + (size_t)(u.pm * 256 + row) * 4;
            const float tot = (__uint_as_float(ag_ld(sl)) + __uint_as_float(ag_ld(sl + 1))) + (__uint_as_float(ag_ld(sl + 2)) + __uint_as_float(ag_ld(sl + 3)));
            SR[row] = __builtin_amdgcn_rsqf(tot * (1.f / DM) + EPS); }
        LDS_WAIT(); __builtin_amdgcn_s_barrier(); asm volatile("" ::: "memory");
#pragma unroll
        for (int ai = 0; ai < 2; ++ai) { float s[4];
#pragma unroll
            for (int m = 0; m < 4; ++m) { const int rl = ai * 128 + wr * 64 + m * 16 + fr; const float rs = SR[rl]; const size_t off = (size_t)(u.pm * 256 + rl) * DM + col0; float q = 0.f;
#pragma unroll
                for (int bj = 0; bj < 2; ++bj) { f32x4 h0, h1;
                    if (hold_f) { h0 = *(const f32x4*)(hold_f + off + bj * 128); h1 = *(const f32x4*)(hold_f + off + bj * 128 + 4); }
                    else { const u32x4 hv = hb[ai][m][bj]; h0 = (f32x4){bflo(hv.x), bfhi(hv.x), bflo(hv.y), bfhi(hv.y)}; h1 = (f32x4){bflo(hv.z), bfhi(hv.z), bflo(hv.w), bfhi(hv.w)}; }
                    const f32x4 v0 = h0 + acc[ai][bj][m][0] * rs * gv[bj][0], v1 = h1 + acc[ai][bj][m][1] * rs * gv[bj][1];
                    q += ((v0[0] * v0[0] + v0[1] * v0[1]) + (v0[2] * v0[2] + v0[3] * v0[3])) + ((v1[0] * v1[0] + v1[1] * v1[1]) + (v1[2] * v1[2] + v1[3] * v1[3]));
                    if (hout) { __builtin_nontemporal_store(v0, (f32x4*)(hout + off + bj * 128)); __builtin_nontemporal_store(v1, (f32x4*)(hout + off + bj * 128 + 4)); }
                    if (xn) { u32x4 w; w.x = cvt_pk_bf16(v0[0], v0[1]); w.y = cvt_pk_bf16(v0[2], v0[3]); w.z = cvt_pk_bf16(v1[0], v1[1]); w.w = cvt_pk_bf16(v1[2], v1[3]); store16(xn + off + bj * 128, w, wt); } }
                q += __shfl_xor(q, 16); q += __shfl_xor(q, 32); s[m] = q; }
            if (ssq_next) { const float v = fq == 0 ? s[0] : fq == 1 ? s[1] : fq == 2 ? s[2] : s[3]; atomicAdd(ssq_next + u.pm * 256 + wr * 64 + ai * 128 + ln, v); } }
    }
};
typedef EpiNormResT<false> EpiNormRes;
typedef EpiNormResT<true> EpiNormResMid;
struct ChainOrder {
    pg8::TileOrder o; unsigned* wt_base; unsigned* dn_base;
    __device__ bool next(int i, pg8::Unit& u) const { if (!o.next(i, u)) return false; u.wait = wt_base ? wt_base + 64 * u.pm : nullptr; u.done = dn_base ? dn_base + 64 * u.pm : nullptr; return true; }
};

struct EpiP2 { static constexpr bool PERM = true, MIDK = false; EpiQ eq; EpiBf16 ekv, eqk, evo;
    __device__ __forceinline__ void operator()(Acc& acc, const pg8::Unit& u, int wr, int wc, int fr, int fq, LAS unsigned char* l, int wid, int par) const {
        if (u.job == 0) eq(acc, u, wr, wc, fr, fq, l, wid, par); else if (u.job == 1) ekv(acc, u, wr, wc, fr, fq, l, wid, par);
        else if (u.job == 2) eqk(acc, u, wr, wc, fr, fq, l, wid, par); else evo(acc, u, wr, wc, fr, fq, l, wid, par); } };

struct EpiP1 { static constexpr bool PERM = true, MIDK = false; EpiZ ez; EpiBf16 eb;
    __device__ __forceinline__ void operator()(Acc& acc, const pg8::Unit& u, int wr, int wc, int fr, int fq, LAS unsigned char* l, int wid, int par) const {
        if (u.job == 0) ez(acc, u, wr, wc, fr, fq, l, wid, par); else eb(acc, u, wr, wc, fr, fq, l, wid, par); } };

#define XB_TMO      128
#define XB_XCNT(j)  (256  + 64 * (j))
#define XB_XSUB(j)  (1280 + 64 * (j))
#define XB_XGEN(j)  (2304 + 64 * (j))
#define XB_TOP      3328
#define XB_TOPGEN   3392
#define XCD_BAR_WORDS 3456
#define XB_SPIN_CAP (1u << 20)
__device__ __forceinline__ unsigned xb_ld(unsigned* p)              { return __hip_atomic_load(p, __ATOMIC_RELAXED, __HIP_MEMORY_SCOPE_AGENT); }
__device__ __forceinline__ unsigned xb_add(unsigned* p, unsigned v) { return __hip_atomic_fetch_add(p, v, __ATOMIC_RELAXED, __HIP_MEMORY_SCOPE_AGENT); }
__device__ __forceinline__ unsigned xb_xcc_id() { return (unsigned)__builtin_amdgcn_s_getreg((3 << 11) | 20) & 0xFu; }
#define XB_SPIN(cond, bar) do { unsigned _sp = 0; while (cond) { __builtin_amdgcn_s_sleep(1); \
    if ((++_sp & 255u) == 0u) { if (xb_ld(&(bar)[XB_TMO])) break; if (_sp > XB_SPIN_CAP) { atomicAdd(&(bar)[XB_TMO], 1u); break; } } } } while (0)
struct XcdBarrier { unsigned* bar; unsigned x; volatile LAS unsigned* st; unsigned G; };
__device__ __forceinline__ XcdBarrier xcd_barrier_post(unsigned* bar, volatile LAS unsigned* st, unsigned G) {
    XcdBarrier b; b.bar = bar; b.x = xb_xcc_id(); b.st = st; b.G = G;
    if (threadIdx.x == 0) (void)xb_add(&bar[XB_XCNT(b.x)], 1u);
    return b;
}
__device__ __forceinline__ void xcd_barrier_complete(unsigned* bar, unsigned x, unsigned& nloc, unsigned& nx, const unsigned G) {
    unsigned sum, cnt, mine, sp = 0u;
    for (;;) {
        sum = 0u; cnt = 0u; mine = 0u;
#pragma unroll
        for (unsigned j = 0; j < 16; ++j) { const unsigned c = xb_ld(&bar[XB_XCNT(j)]); sum += c; cnt += (c > 0u) ? 1u : 0u; mine = (j == x) ? c : mine; }
        if (sum == G) break;
        __builtin_amdgcn_s_sleep(1);
        if ((++sp & 255u) == 0u) { if (xb_ld(&bar[XB_TMO])) break; if (sp > XB_SPIN_CAP) { atomicAdd(&bar[XB_TMO], 1u); break; } }
    }
    nloc = mine > 0u ? mine : 1u; nx = cnt > 0u ? cnt : 1u;
}
__device__ __forceinline__ void xcd_barrier(const XcdBarrier& b, const int wv) {
    asm volatile("s_waitcnt vmcnt(0)" ::: "memory");
    __syncthreads();
    if (wv == 0 && lane_id() == 0) {
        unsigned* bar = b.bar;
        __builtin_amdgcn_s_waitcnt(0);
        asm volatile("buffer_inv sc1" ::: "memory");
        unsigned nloc = b.st[0], nx = b.st[1];
        if (nloc == 0u) { xcd_barrier_complete(bar, b.x, nloc, nx, b.G); b.st[0] = nloc; b.st[1] = nx; }
        const unsigned old = xb_add(&bar[XB_XSUB(b.x)], 1u);
        const unsigned gen = old / nloc;
        if (old + 1u == (gen + 1u) * nloc) {
            __builtin_amdgcn_fence(__ATOMIC_RELEASE, "agent");
            asm volatile("s_waitcnt vmcnt(0)" ::: "memory");
            const unsigned og = xb_add(&bar[XB_TOP], 1u);
            const unsigned tg = og / nx;
            if (og + 1u == (tg + 1u) * nx) xb_add(&bar[XB_TOPGEN], 1u);
            else XB_SPIN(xb_ld(&bar[XB_TOPGEN]) == tg, bar);
            xb_add(&bar[XB_XGEN(b.x)], 1u);
            asm volatile("s_waitcnt vmcnt(0)" ::: "memory");
        } else {
            XB_SPIN(xb_ld(&bar[XB_XGEN(b.x)]) == gen, bar);
            asm volatile("s_waitcnt vmcnt(0)" ::: "memory");
        }
    }
    __syncthreads();
}

enum { MAP_ID = 0, MAP_WIN = 1, MAP_WUQ = 2, MAP_WUKV = 3, MAP_GATE = 4, MAP_UP = 5 };
__device__ __forceinline__ int map_n(int mode, int n) {
    switch (mode) {
    case MAP_WIN: { if (n < OFF_KPE) return n; const int j = n - OFF_KPE; return OFF_KPE + (j < 32 ? 2 * j : 2 * (j - 32) + 1); }
    case MAP_WUQ: { const int h = n / 192, d = n % 192; if (d < 128) return h * 128 + d; const int j = d - 128; return 512 + h * 64 + (j < 32 ? 2 * j : 2 * (j - 32) + 1); }
    case MAP_WUKV: { const int h = n / 256, d = n % 256; return d < 128 ? h * 128 + d : 512 + h * 128 + (d - 128); }
    case MAP_GATE: return (n >> 7) * 256 + (n & 127);
    case MAP_UP: return (n >> 7) * 256 + 128 + (n & 127);
    default: return n;
    }
}
__device__ __forceinline__ void p0_transpose_item(const float* W, int K, int N, bf16_t* WT, int row_off, int mode, const float* kscale, const float* kscale2, LAS float* scr, int item, int lane) {
    const int nblk = N / 64, kb = item / nblk, nb = item % nblk, k0 = 64 * kb, n0 = 64 * nb;
    float v[64];
#pragma unroll
    for (int i = 0; i < 64; ++i) v[i] = __builtin_nontemporal_load(W + (size_t)(k0 + i) * N + n0 + lane);
    if (kscale) { const float* ks = (kscale2 && k0 >= 512) ? kscale2 - 512 : kscale;
#pragma unroll
        for (int i = 0; i < 64; ++i) v[i] *= ks[k0 + i]; }
#pragma unroll
    for (int i = 0; i < 64; ++i) scr[i * 65 + lane] = v[i];
    LDS_WAIT(); asm volatile("" ::: "memory");
    const int c = lane & 7;
#pragma unroll
    for (int j = 0; j < 8; ++j) { const int n = (lane >> 3) + 8 * j; const LAS float* sp = scr + (8 * c) * 65 + n;
        u32x4 o; o.x = cvt_pk_bf16(sp[0 * 65], sp[1 * 65]); o.y = cvt_pk_bf16(sp[2 * 65], sp[3 * 65]); o.z = cvt_pk_bf16(sp[4 * 65], sp[5 * 65]); o.w = cvt_pk_bf16(sp[6 * 65], sp[7 * 65]);
        *(u32x4*)(WT + (size_t)(row_off + map_n(mode, n0 + n)) * K + k0 + 8 * c) = o; }
    LDS_WAIT(); asm volatile("" ::: "memory");
}
template <int R, bool NORM>
__device__ __forceinline__ void rms_rows_to_bf16(const float* xrow, const float* g, bf16_t* orow, float* ssq_out, int lane) {
    f32x4 v[R][4]; float s[R];
#pragma unroll
    for (int r = 0; r < R; ++r)
#pragma unroll
        for (int j = 0; j < 4; ++j) v[r][j] = __builtin_nontemporal_load((const f32x4*)(xrow + (size_t)r * DM) + lane + 64 * j);
    f32x4 gg[4];
#pragma unroll
    for (int j = 0; j < 4; ++j) gg[j] = ((const f32x4*)g + lane)[64 * j];
#pragma unroll
    for (int r = 0; r < R; ++r) { float q = 0.f;
#pragma unroll
        for (int j = 0; j < 4; ++j) q += (v[r][j].x * v[r][j].x + v[r][j].y * v[r][j].y) + (v[r][j].z * v[r][j].z + v[r][j].w * v[r][j].w);
        s[r] = q; }
#pragma unroll
    for (int o = 1; o < 64; o <<= 1)
#pragma unroll
        for (int r = 0; r < R; ++r) s[r] += __shfl_xor(s[r], o);
#pragma unroll
    for (int r = 0; r < R; ++r) { const float rs = NORM ? __builtin_amdgcn_rsqf(s[r] * (1.f / DM) + EPS) : 1.f; u32x2* o8 = (u32x2*)(orow + (size_t)r * DM) + lane;
        if (!NORM) { if (lane == 0) ssq_out[r] = s[r];
#pragma unroll
            for (int j = 0; j < 4; ++j) gg[j] = (f32x4){1.f, 1.f, 1.f, 1.f}; }
#pragma unroll
        for (int j = 0; j < 4; ++j) { u32x2 w; w.x = cvt_pk_bf16(v[r][j].x * rs * gg[j].x, v[r][j].y * rs * gg[j].y); w.y = cvt_pk_bf16(v[r][j].z * rs * gg[j].z, v[r][j].w * rs * gg[j].w); o8[64 * j] = w; } }
}
__device__ __forceinline__ void resid_row(const float* pre, const float* hold, const float* gpost, float* hout, const float* gnext, bf16_t* xn, int lane) {
    const f32x4* pr = (const f32x4*)pre + lane; const f32x4* hr = (const f32x4*)hold + lane; const f32x4* gp = (const f32x4*)gpost + lane;
    f32x4 v[4]; float s = 0.f;
#pragma unroll
    for (int j = 0; j < 4; ++j) { v[j] = pr[64 * j]; s += (v[j].x * v[j].x + v[j].y * v[j].y) + (v[j].z * v[j].z + v[j].w * v[j].w); }
    const float rs = __builtin_amdgcn_rsqf(wave_sum(s) * (1.f / DM) + EPS);
    float s2 = 0.f;
#pragma unroll
    for (int j = 0; j < 4; ++j) { const f32x4 h = hr[64 * j], g = gp[64 * j]; v[j] = h + v[j] * rs * g; s2 += (v[j].x * v[j].x + v[j].y * v[j].y) + (v[j].z * v[j].z + v[j].w * v[j].w); }
    f32x4* ho = (f32x4*)hout + lane;
#pragma unroll
    for (int j = 0; j < 4; ++j) ho[64 * j] = v[j];
    if (xn) { const float rs2 = __builtin_amdgcn_rsqf(wave_sum(s2) * (1.f / DM) + EPS); const f32x4* gn = (const f32x4*)gnext + lane; u32x2* o8 = (u32x2*)xn + lane;
#pragma unroll
        for (int j = 0; j < 4; ++j) { const f32x4 gg = gn[64 * j]; u32x2 w; w.x = cvt_pk_bf16(v[j].x * rs2 * gg.x, v[j].y * rs2 * gg.y); w.y = cvt_pk_bf16(v[j].z * rs2 * gg.z, v[j].w * rs2 * gg.w); o8[64 * j] = w; } }
}


__device__ __forceinline__ float row16_sum(float v) {
    v += __builtin_bit_cast(float, __builtin_amdgcn_update_dpp(0, __builtin_bit_cast(int, v), 0xB1, 0xF, 0xF, true));
    v += __builtin_bit_cast(float, __builtin_amdgcn_update_dpp(0, __builtin_bit_cast(int, v), 0x4E, 0xF, 0xF, true));
    v += __builtin_bit_cast(float, __builtin_amdgcn_update_dpp(0, __builtin_bit_cast(int, v), 0x141, 0xF, 0xF, true));
    v += __builtin_bit_cast(float, __builtin_amdgcn_update_dpp(0, __builtin_bit_cast(int, v), 0x140, 0xF, 0xF, true));
    return v;
}
__device__ __forceinline__ void row_swap16(float x, float& from_other) { auto r = __builtin_amdgcn_permlane16_swap(__float_as_uint(x), __float_as_uint(x), false, false); const int row = (lane_id() >> 4) & 1; from_other = __uint_as_float(row ? r[0] : r[1]); }
namespace lru {
constexpr int TT = 128, NTILE = SEQ / TT, UP = 72;
constexpr int L_U = 0, L_UF = L_U + TT * UP * 2, L_WSEG = L_UF + TT * 33 * 4, L_CARRY = L_WSEG + 2 * 8 * 32 * 8, L_TSS = L_CARRY + 2 * 32 * 4, L_END = L_TSS + 2 * TT * 4;
static_assert(L_END <= RING_BYTES, "lru lds");
__device__ __forceinline__ float sigmoidf_(float x) { return __builtin_amdgcn_rcpf(1.f + __builtin_amdgcn_exp2f(-x * LOG2E)); }
__device__ __forceinline__ void unit(int b, int cb, const bf16_t* Z, bf16_t* Y, float* ssq_lru, const float* conv_w, const float* conv_b, const float* wa, const float* ba, const float* wx, const float* bx,
                                     const float* lam, LAS unsigned char* lds, const int wv) {
    const int lane = lane_id(), wid = wv, tid = wv * 64 + lane;
    const int hblk = cb >> 1, half = cb & 1, ib = hblk * 64, c0 = cb * 32;
    LAS bf16_t* U = (LAS bf16_t*)(lds + L_U); LAS float* UF = (LAS float*)(lds + L_UF); LAS f32x2* WSEG = (LAS f32x2*)(lds + L_WSEG);
    LAS float* CARRY = (LAS float*)(lds + L_CARRY); LAS float* TSS = (LAS float*)(lds + L_TSS);
    const int col = lane & 15, kq = lane >> 4;
    bf16x8 Bf[4][2];
#pragma unroll
    for (int nb = 0; nb < 4; ++nb)
#pragma unroll
        for (int ks = 0; ks < 2; ++ks) { const float* Wg = (nb < 2) ? wa : wx; const int oc = half * 32 + (nb & 1) * 16 + col; float w[8];
#pragma unroll
            for (int j = 0; j < 8; ++j) w[j] = Wg[((size_t)hblk * 64 + ks * 32 + 8 * kq + j) * 64 + oc];
            u32x4 p; p.x = cvt_pk_bf16(w[0], w[1]); p.y = cvt_pk_bf16(w[2], w[3]); p.z = cvt_pk_bf16(w[4], w[5]); p.w = cvt_pk_bf16(w[6], w[7]); Bf[nb][ks] = __builtin_bit_cast(bf16x8, p); }
    float cba[2], cbx[2], csp[2];
#pragma unroll
    for (int e = 0; e < 2; ++e) { const int ch = c0 + e * 16 + col; cba[e] = ba[ch]; cbx[e] = bx[ch]; const float l = lam[ch];
        csp[e] = 8.f * LOG2E * (fmaxf(-l, 0.f) + log1pf(expf(-fabsf(l)))); }
    const int cch = lane;
    const float cw0 = conv_w[0 * DLRU + ib + cch], cw1 = conv_w[1 * DLRU + ib + cch], cw2 = conv_w[2 * DLRU + ib + cch], cw3 = conv_w[3 * DLRU + ib + cch], cbb = conv_b[ib + cch];
    if (tid < 64) CARRY[tid] = 0.f;
    if (tid < 2 * TT) TSS[tid] = 0.f;
    const size_t rowb = (size_t)b * SEQ;
    const bf16_t* zx = Z + (rowb + wid * 16) * DINP + ib + cch;
    const bf16_t* zg = Z + (rowb + wid * 16 + kq * 4) * DINP + OFF_GATE + c0 + col;
    bf16_t* yp = Y + (rowb + wid * 16 + kq * 4) * DM + c0 + col;
    unsigned short xr[19], gr[8];
#define LRU_LOADX(t0_) do { _Pragma("unroll") for (int k = 0; k < 19; ++k) { const int tk = (t0_) + wid * 16 + k - 3; xr[k] = (tk >= 0) ? __builtin_nontemporal_load(zx + (ptrdiff_t)((t0_) + k - 3) * DINP) : (unsigned short)0; } } while (0)
    LRU_LOADX(0);
    __syncthreads();
    for (int tile = 0; tile < NTILE; ++tile) {
        const int t0 = tile * TT, par = tile & 1;
        { float xm3 = bf2f(xr[0]), xm2 = bf2f(xr[1]), xm1 = bf2f(xr[2]);
#pragma unroll
          for (int k = 0; k < 16; ++k) { const float x0 = bf2f(xr[3 + k]); const float u = cbb + cw0 * xm3 + cw1 * xm2 + cw2 * xm1 + cw3 * x0; xm3 = xm2; xm2 = xm1; xm1 = x0;
              const int tl = wid * 16 + k; U[tl * UP + cch] = (bf16_t)(cvt_pk_bf16(u, 0.f) & 0xffffu);
              if ((cch >> 5) == half) UF[tl * 33 + (cch & 31)] = u; } }
#pragma unroll
        for (int e = 0; e < 2; ++e)
#pragma unroll
            for (int r = 0; r < 4; ++r) gr[e * 4 + r] = __builtin_nontemporal_load(zg + (size_t)(t0 + r) * DINP + e * 16);
        if (tile + 1 < NTILE) LRU_LOADX(t0 + TT);
        LDS_WAIT();
        float av[2][4], uv[2][4], Ainc[2], Hinc[2];
        { f32x4 C[4];
#pragma unroll
          for (int nb = 0; nb < 4; ++nb) C[nb] = (f32x4){0.f, 0.f, 0.f, 0.f};
          const LAS bf16_t* ua = U + (wid * 16 + col) * UP + 8 * kq;
          const bf16x8 a0 = *(const LAS bf16x8*)ua, a1 = *(const LAS bf16x8*)(ua + 32);
#pragma unroll
          for (int nb = 0; nb < 4; ++nb) { C[nb] = __builtin_amdgcn_mfma_f32_16x16x32_bf16(a0, Bf[nb][0], C[nb], 0, 0, 0); C[nb] = __builtin_amdgcn_mfma_f32_16x16x32_bf16(a1, Bf[nb][1], C[nb], 0, 0, 0); }
#pragma unroll
          for (int e = 0; e < 2; ++e) { float Ap = 1.f, H = 0.f;
#pragma unroll
              for (int r = 0; r < 4; ++r) { const int tl = wid * 16 + kq * 4 + r, ch = e * 16 + col;
                  const float rg = sigmoidf_(C[e][r] + cba[e]), ig = sigmoidf_(C[e + 2][r] + cbx[e]);
                  const float a = __builtin_amdgcn_exp2f(-rg * csp[e]); const float mult = __builtin_amdgcn_sqrtf(fmaxf(1.f - a * a, 0.f));
                  const float uu = mult * ig * UF[tl * 33 + ch];
                  av[e][r] = a; uv[e][r] = uu; H = a * H + uu; Ap *= a; }
              { const float Ap1 = __shfl_up(Ap, 16), H1 = __shfl_up(H, 16); if (kq >= 1) { H = Ap * H1 + H; Ap = Ap * Ap1; } }
              { const float Ap2 = __shfl_up(Ap, 32), H2 = __shfl_up(H, 32); if (kq >= 2) { H = Ap * H2 + H; Ap = Ap * Ap2; } }
              Ainc[e] = Ap; Hinc[e] = H;
              if (kq == 3) WSEG[(par * 8 + wid) * 32 + e * 16 + col] = (f32x2){Ap, H}; } }
        __syncthreads();
        if (tid < TT) { const float v = TSS[(par ^ 1) * TT + tid]; if (tile > 0) atomicAdd(ssq_lru + rowb + t0 - TT + tid, v); }
        float qs[4] = {0.f, 0.f, 0.f, 0.f};
#pragma unroll
        for (int e = 0; e < 2; ++e) { const int ch = e * 16 + col;
            float h = CARRY[par * 32 + ch]; f32x2 sg[8];
#pragma unroll
            for (int w2 = 0; w2 < 8; ++w2) sg[w2] = WSEG[(par * 8 + w2) * 32 + ch];
#pragma unroll
            for (int w2 = 0; w2 < 7; ++w2) if (w2 < wid) h = sg[w2].x * h + sg[w2].y;
            if (wid == 7 && kq == 0) CARRY[(par ^ 1) * 32 + ch] = sg[7].x * h + sg[7].y;
            const float Ae = __shfl_up(Ainc[e], 16), He = __shfl_up(Hinc[e], 16);
            if (kq >= 1) h = Ae * h + He;
#pragma unroll
            for (int r = 0; r < 4; ++r) { h = av[e][r] * h + uv[e][r]; const float g = bf2f(gr[e * 4 + r]);
                const float ge = g * __builtin_amdgcn_rcpf(1.f + __builtin_amdgcn_exp2f(-1.5957691216057308f * LOG2E * (g + 0.044715f * g * g * g)));
                const float y = h * ge; yp[(size_t)(t0 + r) * DM + e * 16] = (bf16_t)(cvt_pk_bf16(y, 0.f) & 0xffffu); qs[r] += y * y; } }
#pragma unroll
        for (int r = 0; r < 4; ++r) { const float q = row16_sum(qs[r]);
            if (col == 0) TSS[par * TT + wid * 16 + kq * 4 + r] = q; }
    }
    __syncthreads();
    if (tid < TT) atomicAdd(ssq_lru + rowb + (NTILE - 1) * TT + tid, TSS[((NTILE - 1) & 1) * TT + tid]);
    __syncthreads();
#undef LRU_LOADX
}
}

namespace mla {
constexpr int NW = 8, QBLK = 32, KVBLK = 64, QB = 256, KROW = 384, SHM_K = KVBLK * KROW, SHM_V = KVBLK * 128 * 2;
constexpr int L_V = 0, L_K = 2 * SHM_V, L_WS = L_K + 2 * SHM_K, L_END = L_WS + NW * 64 * 4;
static_assert(L_END <= RING_BYTES && NW * 8192 <= L_WS, "mla lds");
#define KSWZ(row, colB) ((row) * KROW + ((colB) ^ ((((row) >> 1) & 7) << 4)))
#define SBAR() __builtin_amdgcn_sched_barrier(0)
__device__ __forceinline__ int v_st(int k, int c) { const int kk = (k & ~0xC) | ((k & 4) << 1) | ((k & 8) >> 1); return ((kk >> 3) * 4 + (c >> 5)) * 512 + ((kk & 7) * 32 + (c & 31)) * 2; }
__device__ __forceinline__ int v_rd_base(int lane) { return ((lane & 3) << 3) | (((lane >> 2) & 3) << 6) | (((lane >> 4) & 1) << 5) | (((lane >> 5) & 1) << 8); }
constexpr int v_rd_off(int d0, int ks, int half) { return d0 * 512 + ks * 4096 + half * 2048; }
__device__ __forceinline__ int crow(int r, int hi) { return (r & 3) + 8 * (r >> 2) + 4 * hi; }
__device__ __forceinline__ void mask_tile(f32x16& p0, f32x16& p1, int dq) {
    const float NEG = -__builtin_inff();
#pragma unroll
    for (int r = 0; r < 16; ++r) { const int c = (r & 3) + 8 * (r >> 2); if (dq - c < 0) p0[r] = NEG; if (dq - c - 32 < 0) p1[r] = NEG; }
}
constexpr float THR2 = 8.f * LOG2E;
__device__ __forceinline__ void partialSM(f32x16& p0, f32x16& p1, float& m_reg, float& alpha) {
    float pmax = p0[0];
#pragma unroll
    for (int r = 1; r < 16; ++r) pmax = fmaxf(pmax, p0[r]);
#pragma unroll
    for (int r = 0; r < 16; ++r) pmax = fmaxf(pmax, p1[r]);
    { auto rr = __builtin_amdgcn_permlane32_swap(__float_as_uint(pmax), __float_as_uint(pmax), false, false); pmax = fmaxf(__uint_as_float(rr[0]), __uint_as_float(rr[1])); }
    float mn;
    if (__builtin_expect(__all((pmax - m_reg) <= THR2), 1)) { mn = m_reg; alpha = 1.f; }
    else { mn = fmaxf(m_reg, pmax); alpha = __builtin_amdgcn_exp2f(m_reg - mn); m_reg = mn; }
#pragma unroll
    for (int r = 0; r < 16; ++r) p0[r] = p0[r] - mn;
#pragma unroll
    for (int r = 0; r < 16; ++r) p1[r] = p1[r] - mn;
#pragma unroll
    for (int r = 0; r < 16; ++r) p0[r] = __builtin_amdgcn_exp2f(p0[r]);
}
__device__ __forceinline__ void finishSM(f32x16& p0, f32x16& p1, float alpha, float& l_reg, bf16x8& pa0, bf16x8& pa1, bf16x8& pa2, bf16x8& pa3) {
#pragma unroll
    for (int r = 0; r < 16; ++r) p1[r] = __builtin_amdgcn_exp2f(p1[r]);
    float ps = 0;
#pragma unroll
    for (int r = 0; r < 16; ++r) ps += p0[r];
#pragma unroll
    for (int r = 0; r < 16; ++r) ps += p1[r];
    { auto rr = __builtin_amdgcn_permlane32_swap(__float_as_uint(ps), __float_as_uint(ps), false, false); ps = __uint_as_float(rr[0]) + __uint_as_float(rr[1]); }
    l_reg = l_reg * alpha + ps;
#define PK4(P, B_, OUT) do { unsigned a0 = cvt_pk_bf16(P[B_+0], P[B_+1]), a1 = cvt_pk_bf16(P[B_+2], P[B_+3]);                          \
        unsigned b0 = cvt_pk_bf16(P[B_+4], P[B_+5]), b1 = cvt_pk_bf16(P[B_+6], P[B_+7]);                                             \
        auto r0 = __builtin_amdgcn_permlane32_swap(a0, b0, false, false); auto r1 = __builtin_amdgcn_permlane32_swap(a1, b1, false, false); \
        u32x4 w = {r0[0], r1[0], r0[1], r1[1]}; OUT = __builtin_bit_cast(bf16x8, w); } while (0)
    PK4(p0, 0, pa0); PK4(p0, 8, pa1); PK4(p1, 0, pa2); PK4(p1, 8, pa3);
#undef PK4
}
template <int KB>
__device__ __forceinline__ void qkt(f32x16& p0, f32x16& p1, const char* K_lds, int r32, int hi, const bf16x8* qr) {
    p0 = f32x16{}; p1 = f32x16{};
    unsigned kb[4];
#pragma unroll
    for (int dd = 0; dd < 4; ++dd) kb[dd] = (unsigned)(uintptr_t)(K_lds + KB * SHM_K + KSWZ(r32, (dd * 16 + hi * 8) * 2));
    bf16x8 fa[4], fb[4];
#define KRD(slot, d0) do { asm volatile("ds_read_b128 %0, %1 offset:%2" : "=v"(fa[slot]) : "v"(kb[(d0) & 3]), "i"(((d0) >> 2) * 128)); \
                           asm volatile("ds_read_b128 %0, %1 offset:%2" : "=v"(fb[slot]) : "v"(kb[(d0) & 3]), "i"(((d0) >> 2) * 128 + 32 * KROW)); } while (0)
#define KMM(slot, d0, N) do { asm volatile("s_waitcnt lgkmcnt(%0)" :: "i"(N) : "memory"); SBAR(); \
        p0 = __builtin_amdgcn_mfma_f32_32x32x16_bf16(fa[slot], qr[d0], p0, 0, 0, 0); p1 = __builtin_amdgcn_mfma_f32_32x32x16_bf16(fb[slot], qr[d0], p1, 0, 0, 0); SBAR(); } while (0)
    KRD(0, 0); KRD(1, 1); KRD(2, 2); KRD(3, 3);
    KMM(0, 0, 6); KRD(0, 4); KMM(1, 1, 6); KRD(1, 5); KMM(2, 2, 6); KRD(2, 6); KMM(3, 3, 6); KRD(3, 7);
    KMM(0, 4, 6); KRD(0, 8); KMM(1, 5, 6); KRD(1, 9); KMM(2, 6, 6); KRD(2, 10); KMM(3, 7, 6); KRD(3, 11);
    KMM(0, 8, 6); KMM(1, 9, 4); KMM(2, 10, 2); KMM(3, 11, 0);
#undef KRD
#undef KMM
}
template <int VB>
__device__ __forceinline__ void pv_tile(f32x16* o, int vb0, bf16x8 pa0, bf16x8 pa1, bf16x8 pa2, bf16x8 pa3) {
    s16x4 lo[2][4], hh[2][4];
#define TRRD(dst, off) asm volatile("ds_read_b64_tr_b16 %0, %1 offset:%2" : "=v"(dst) : "v"(vb0), "i"(off))
#define VRD(set, d0) do { constexpr int b_ = VB * SHM_V + v_rd_off(d0, 0, 0); \
        TRRD(lo[set][0], b_); TRRD(hh[set][0], b_ + 2048); TRRD(lo[set][1], b_ + 4096); TRRD(hh[set][1], b_ + 6144); \
        TRRD(lo[set][2], b_ + 8192); TRRD(hh[set][2], b_ + 10240); TRRD(lo[set][3], b_ + 12288); TRRD(hh[set][3], b_ + 14336); } while (0)
#define VFR(set, k) (bf16x8){lo[set][k][0], lo[set][k][1], lo[set][k][2], lo[set][k][3], hh[set][k][0], hh[set][k][1], hh[set][k][2], hh[set][k][3]}
#define VMM(set, d0, N) do { asm volatile("s_waitcnt lgkmcnt(%0)" :: "i"(N) : "memory"); SBAR(); \
        o[d0] = __builtin_amdgcn_mfma_f32_32x32x16_bf16(pa0, VFR(set, 0), o[d0], 0, 0, 0); o[d0] = __builtin_amdgcn_mfma_f32_32x32x16_bf16(pa1, VFR(set, 1), o[d0], 0, 0, 0); \
        o[d0] = __builtin_amdgcn_mfma_f32_32x32x16_bf16(pa2, VFR(set, 2), o[d0], 0, 0, 0); o[d0] = __builtin_amdgcn_mfma_f32_32x32x16_bf16(pa3, VFR(set, 3), o[d0], 0, 0, 0); SBAR(); } while (0)
    VRD(0, 0); VRD(1, 1);
    VMM(0, 0, 8); VRD(0, 2); VMM(1, 1, 8); VRD(1, 3); VMM(0, 2, 8); VMM(1, 3, 0);
#undef TRRD
#undef VRD
#undef VFR
#undef VMM
}
__device__ __forceinline__ void block(int b, int h, int qb, const bf16_t* Qb, const bf16_t* KVb, const bf16_t* KPE, bf16_t* Y, float* ssq_mla, char* lds, const int wv) {
    const int lane = lane_id(), wid = wv, tid = wv * 64 + lane, r32 = lane & 31, hi = lane >> 5;
    const size_t rowbase = (size_t)b * SEQ; const int q0 = qb * QB; const int NT = (q0 + QB) / KVBLK;
    const int qlo = q0 + wid * QBLK, qm = qlo + r32 - 4 * hi;
    char* V_lds = lds + L_V; char* K_lds = lds + L_K;
    float* ws = (float*)(lds + L_WS) + wid * 64; float* li_l = ws, * al_l = ws + 32;
    float m_reg = -1e30f, l_reg = 0; f32x16 o[4] = {};
    const int sr = tid >> 4, scc = (tid & 15) * 8, vst0 = v_st(sr, scc), vst1 = v_st(32 + sr, scc), kws = KSWZ(sr, (tid & 15) * 16);
    const int pr = tid >> 3, kws2 = KSWZ(pr, 256 + (tid & 7) * 16);
    const int vb0 = (int)(uintptr_t)V_lds + v_rd_base(lane);
    const bf16_t* Kn = KVb + rowbase * 1024 + h * 128 + scc;
    const bf16_t* Vn = KVb + rowbase * 1024 + 512 + h * 128 + scc;
    const bf16_t* Kp = KPE + rowbase * 64 + (tid & 7) * 8;
    bf16x8 qr[12];
    { const bf16_t* qp = Qb + (rowbase + q0 + wid * QBLK + r32) * 768;
#pragma unroll
      for (int d0 = 0; d0 < 8; ++d0) qr[d0] = *(const bf16x8*)(qp + h * 128 + d0 * 16 + hi * 8);
#pragma unroll
      for (int d0 = 0; d0 < 4; ++d0) qr[8 + d0] = *(const bf16x8*)(qp + 512 + h * 64 + d0 * 16 + hi * 8); }
    const int grp = wid >> 2;
    bf16x8 st_v0, st_v1, st_k0, st_k1, st_k2;
#define SLOADK(t) do { const size_t k0_ = (size_t)(t) * KVBLK; st_k0 = *(const bf16x8*)(Kn + (k0_ + sr) * 1024); st_k1 = *(const bf16x8*)(Kn + (k0_ + 32 + sr) * 1024); st_k2 = *(const bf16x8*)(Kp + (k0_ + pr) * 64); } while (0)
#define SLOADV(t) do { const size_t k0_ = (size_t)(t) * KVBLK; st_v0 = *(const bf16x8*)(Vn + (k0_ + sr) * 1024); st_v1 = *(const bf16x8*)(Vn + (k0_ + 32 + sr) * 1024); } while (0)
#define SWRITEK(off) do { *(bf16x8*)(K_lds + (off) + kws) = st_k0; *(bf16x8*)(K_lds + (off) + kws + 32 * KROW) = st_k1; *(bf16x8*)(K_lds + (off) + kws2) = st_k2; } while (0)
#define SWRITEV(off) do { *(bf16x8*)(V_lds + (off) + vst0) = st_v0; *(bf16x8*)(V_lds + (off) + vst1) = st_v1; } while (0)
#define BAR() asm volatile("s_waitcnt lgkmcnt(0)\n\ts_barrier" ::: "memory")
#define RESC(a) do { if (__any((a) < 1.f)) { if (hi == 0) al_l[r32] = (a); asm volatile("s_waitcnt lgkmcnt(0)" ::: "memory");              \
                     for (int d_ = 0; d_ < 4; ++d_) for (int r = 0; r < 16; ++r) o[d_][r] *= al_l[crow(r, hi)]; } } while (0)
#define MASKT(P0_, P1_, t) do { const int kb_ = (t) * KVBLK; if (kb_ + KVBLK - 1 > qlo) mask_tile(P0_, P1_, qm - kb_); } while (0)
#define ACT(t) ((t) * KVBLK <= qlo + QBLK - 1)
#define NEGALL() do { const float NEG_ = -__builtin_inff(); _Pragma("unroll") for (int r = 0; r < 16; ++r) { p0[r] = NEG_; p1[r] = NEG_; } } while (0)
    f32x16 p0, p1; float al; bf16x8 pa0, pa1, pa2, pa3;
    SLOADK(0); VM_WAIT(); SWRITEK(0);
    if (grp) { SLOADK(1); SLOADV(0); }
    BAR();
    if (grp) { VM_WAIT(); SWRITEK(SHM_K); SWRITEV(0); BAR(); }
#define SMSLOT(t, tk, tv) do { if ((tk) < NT || (tv) < NT) { VM_WAIT(); if ((tk) < NT) SWRITEK(((tk) & 1) * SHM_K); if ((tv) < NT) SWRITEV(((tv) & 1) * SHM_V); } \
        MASKT(p0, p1, (t)); partialSM(p0, p1, m_reg, al); RESC(al); finishSM(p0, p1, al, l_reg, pa0, pa1, pa2, pa3); SBAR(); } while (0)
    { const int tk = 1 + grp, tv = grp;
      SLOADK(tk); SLOADV(tv); SBAR(); qkt<0>(p0, p1, K_lds, r32, hi, qr); SBAR();
      BAR(); SMSLOT(0, tk, tv); BAR(); }
    for (int i = 0; i < NT; i += 2) {
        { const int tk = i + 2 + grp, tv = i + 1 + grp;
          if (tk < NT) SLOADK(tk); if (tv < NT) SLOADV(tv); SBAR();
          if (ACT(i + 1)) qkt<1>(p0, p1, K_lds, r32, hi, qr); else NEGALL(); SBAR(); if (ACT(i)) pv_tile<0>(o, vb0, pa0, pa1, pa2, pa3); SBAR();
          BAR(); SMSLOT(i + 1, tk, tv); BAR(); }
        { const int tk = i + 3 + grp, tv = i + 2 + grp;
          if (tk < NT) SLOADK(tk); if (tv < NT) SLOADV(tv); SBAR();
          if (i + 2 < NT) { if (ACT(i + 2)) qkt<0>(p0, p1, K_lds, r32, hi, qr); else NEGALL(); SBAR(); }
          if (ACT(i + 1)) pv_tile<1>(o, vb0, pa0, pa1, pa2, pa3); SBAR();
          BAR(); if (i + 2 < NT) SMSLOT(i + 2, tk, tv); BAR(); }
    }
    if (!grp) BAR();
#undef SMSLOT
#undef SLOADK
#undef SLOADV
#undef SWRITEK
#undef SWRITEV
#undef BAR
    if (hi == 0) li_l[r32] = l_reg; asm volatile("s_waitcnt lgkmcnt(0)" ::: "memory");
    float rli[16];
#pragma unroll
    for (int r = 0; r < 16; ++r) rli[r] = __builtin_amdgcn_rcpf(li_l[crow(r, hi)]);
    { bf16_t* stg = (bf16_t*)lds + wid * 4096;
#pragma unroll
      for (int r = 0; r < 16; ++r) { const int orow = crow(r, hi);
#pragma unroll
          for (int d0 = 0; d0 < 4; ++d0) stg[orow * 128 + d0 * 32 + r32] = (bf16_t)(cvt_pk_bf16(o[d0][r] * rli[r], 0.f) & 0xffffu); }
      asm volatile("s_waitcnt lgkmcnt(0)" ::: "memory");
      const int row = lane >> 1, hf = lane & 1; float q = 0.f;
      bf16_t* yp = Y + (rowbase + q0 + wid * QBLK + row) * DM + 512 + h * 128 + hf * 64;
#pragma unroll
      for (int j = 0; j < 8; ++j) { const u32x4 v = *(const u32x4*)(stg + row * 128 + hf * 64 + j * 8);
          q += bflo(v.x) * bflo(v.x) + bfhi(v.x) * bfhi(v.x) + bflo(v.y) * bflo(v.y) + bfhi(v.y) * bfhi(v.y) + bflo(v.z) * bflo(v.z) + bfhi(v.z) * bfhi(v.z) + bflo(v.w) * bflo(v.w) + bfhi(v.w) * bfhi(v.w);
          *(u32x4*)(yp + j * 8) = v; }
      q += __shfl_xor(q, 1);
      if (hf == 0) atomicAdd(ssq_mla + rowbase + q0 + wid * QBLK + row, q); }
    __syncthreads();
#undef RESC
#undef MASKT
#undef ACT
#undef NEGALL
}
#undef KSWZ
#undef SBAR
}

constexpr int NWAVES = 8, NPHASE = 13;
struct Args { const void* in[32]; float* out; unsigned char* ws; int ph_lo, ph_hi; };

__global__ void __launch_bounds__(NWAVES * 64, 2) hymba_fwd(Args args) {
    extern __shared__ __attribute__((aligned(16))) unsigned char lds_raw[];
#ifdef PAD_NOPS
    for (int pn_ = 0; pn_ < 0; ++pn_) {}
    asm volatile(PAD_NOPS);
#endif
    LAS unsigned char* lds = (LAS unsigned char*)lds_raw;
    volatile LAS unsigned* MISC = (volatile LAS unsigned*)(lds + MISC_OFF);
    const int G = gridDim.x, bx = blockIdx.x, vcu = (G % 8 == 0) ? (bx % 8) * (G / 8) + bx / 8 : bx;
    const int wave_s = __builtin_amdgcn_readfirstlane((int)threadIdx.x >> 6);
#define lane (lane_id())
#define tid (wave_s * 64 + lane)
#define wave (wave_s)
#define gw (vcu * NWAVES + wave)
#define NGW (G * NWAVES)
    unsigned char* ws = args.ws;
#define x_in ((const float*)args.in[0])
#define mem ((const float*)args.in[1])
#define positions ((const int*)args.in[2])
#define g_pre_mix ((const float*)args.in[3])
#define w_in ((const float*)args.in[4])
#define conv_w ((const float*)args.in[5])
#define conv_b ((const float*)args.in[6])
#define lru_wa ((const float*)args.in[7])
#define lru_ba ((const float*)args.in[8])
#define lru_wx ((const float*)args.in[9])
#define lru_bx ((const float*)args.in[10])
#define lru_lambda ((const float*)args.in[11])
#define g_q_lat ((const float*)args.in[12])
#define w_uq ((const float*)args.in[13])
#define g_kv_lat ((const float*)args.in[14])
#define w_ukv ((const float*)args.in[15])
#define g_lru_out ((const float*)args.in[16])
#define g_mla_out ((const float*)args.in[17])
#define w_out ((const float*)args.in[18])
#define g_post_mix ((const float*)args.in[19])
#define g_pre_mem ((const float*)args.in[20])
#define g_mem_kv ((const float*)args.in[21])
#define w_mq ((const float*)args.in[22])
#define w_mk ((const float*)args.in[23])
#define w_mv ((const float*)args.in[24])
#define w_mo ((const float*)args.in[25])
#define g_post_mem ((const float*)args.in[26])
#define g_pre_ffn ((const float*)args.in[27])
#define w_gate ((const float*)args.in[28])
#define w_up ((const float*)args.in[29])
#define w_down ((const float*)args.in[30])
#define g_post_ffn ((const float*)args.in[31])
#define out_p (args.out)
#define ctl ((unsigned*)(ws + WS_CTL))
#define ssq_cq ((float*)(ws + WS_SSQ))
#define ssq_ckv (ssq_cq + T)
#define ssq_lru (ssq_cq + 2 * T)
#define ssq_mla (ssq_cq + 3 * T)
#define ssq_h1 (ssq_cq + 4 * T)
#define ssq_h2 (ssq_cq + 5 * T)
#define ssq_x (ssq_cq + 6 * T)
#define ssq_dummy (ssq_cq + 7 * T)
#define slots_p ((float*)(ws + WS_SLOTS))
#define cosT ((float*)(ws + WS_ROPE))
#define sinT (cosT + (size_t)T * 32)
#define Win_t ((bf16_t*)(ws + WS_WIN))
#define Wuq_t ((bf16_t*)(ws + WS_WUQ))
#define Wukv_t ((bf16_t*)(ws + WS_WUKV))
#define Wout_t ((bf16_t*)(ws + WS_WOUT))
#define Wmq_b ((bf16_t*)(ws + WS_WMQ))
#define Wmkv_t ((bf16_t*)(ws + WS_WMKV))
#define Wmo_t ((bf16_t*)(ws + WS_WMO))
#define Wgu_t ((bf16_t*)(ws + WS_WGU))
#define Wdown_t ((bf16_t*)(ws + WS_WDOWN))
#define MN ((bf16_t*)(ws + WS_MN))
#define MKV ((bf16_t*)(ws + WS_MKV))
#define WQK ((bf16_t*)(ws + WS_WQK))
#define WVO ((bf16_t*)(ws + WS_WVO))
#define XN ((bf16_t*)(ws + WS_XN))
#define KPE ((bf16_t*)(ws + WS_KPE))
#define Z ((bf16_t*)(ws + WS_Z))
#define Qb ((bf16_t*)(ws + WS_Q))
#define KVb ((bf16_t*)(ws + WS_KV))
#define Y ((bf16_t*)(ws + WS_Y))
#define PRE ((float*)(ws + WS_PRE))
#define Pb ((bf16_t*)(ws + WS_P))
#define Fb ((bf16_t*)(ws + WS_F))
    for (int u = tid; u < 256; u += NWAVES * 64) ((LAS unsigned*)(lds + MISC_OFF))[u] = 0u;
    __syncthreads();
    XcdBarrier bar = xcd_barrier_post(ctl + CW_BAR, MISC + 8, (unsigned)G);
    const bool grouped = (G == 256);
    XcdBarrier gbar = grouped ? xcd_barrier_post(ctl + CW_BAR + XCD_BAR_WORDS * (1 + (bx & 7)), MISC + 10, (unsigned)(G >> 3)) : bar;
    const int lo = args.ph_lo, hi = args.ph_hi;
    unsigned long long ts0 = 0, ts1 = 0, tc0 = 0, tc1 = 0;
#define TS(k) do { if ((k) == (SPIN_LO)) { ts0 = __builtin_amdgcn_s_memrealtime(); tc0 = __builtin_amdgcn_s_memtime(); } } while (0)
#define TE(k) do { if ((k) == (SPIN_HI)) { ts1 = __builtin_amdgcn_s_memrealtime(); tc1 = __builtin_amdgcn_s_memtime(); } } while (0)
#ifndef REP_PHASE
#define REP_PHASE -1
#endif
#define REPS(k) for (int rep = 0; rep < ((REP_PHASE) == (k) ? 2 : 1); ++rep)
#define RSQ(p) (rep ? ssq_dummy : (p))
#ifndef PHASE_MASK
#define PHASE_MASK 0x1fff
#endif
#define IN(k) (((PHASE_MASK >> (k)) & 1) && lo <= (k) && (k) < hi)
#ifndef SPIN_LO
#define SPIN_LO -1
#define SPIN_HI -1
#endif
#ifndef ALIGN_P10
#define ALIGN_P10 true
#endif
#ifndef EXTRA_BAR
#define EXTRA_BAR 0
#endif
#define SEAM(k) do { if (IN(k) && IN((k) + 1)) { if ((k) == 0 || !grouped) xcd_barrier(bar, wave_s); else xcd_barrier(gbar, wave_s); } } while (0)

    TS(0); if (IN(0)) REPS(0) {
        LAS float* scr = (LAS float*)(lds + wave * 16640);
        constexpr int I_IN = 16 * 27, I_UQ = 6 * 12, I_UKV = 4 * 16, I_SQ = 16 * 16, I_GU = 16 * 44, I_DN = 44 * 16;
        int cum = 0;
#define P0_JOB(W, K_, N_, WT, ROFF, MODE, KS, KS2, CNT) do { for (int it = (gw + NGW - (cum % NGW)) % NGW; it < (CNT); it += NGW) p0_transpose_item(W, K_, N_, WT, ROFF, MODE, KS, KS2, scr, it, lane); cum += (CNT); } while (0)
        P0_JOB(w_in, DM, 1728, Win_t, 0, MAP_WIN, g_pre_mix, nullptr, I_IN);
        P0_JOB(w_uq, QLR, 768, Wuq_t, 0, MAP_WUQ, g_q_lat, nullptr, I_UQ);
        P0_JOB(w_ukv, KVLR, 1024, Wukv_t, 0, MAP_WUKV, g_kv_lat, nullptr, I_UKV);
        P0_JOB(w_out, DM, DM, Wout_t, 0, MAP_ID, g_lru_out, g_mla_out, I_SQ);
        P0_JOB(w_mk, DM, DM, Wmkv_t, 0, MAP_ID, nullptr, nullptr, I_SQ);
        P0_JOB(w_mv, DM, DM, Wmkv_t, 1024, MAP_ID, nullptr, nullptr, I_SQ);
        P0_JOB(w_mo, DM, DM, Wmo_t, 0, MAP_ID, nullptr, nullptr, I_SQ);
        P0_JOB(w_gate, DM, DFF, Wgu_t, 0, MAP_GATE, g_pre_ffn, nullptr, I_GU);
        P0_JOB(w_up, DM, DFF, Wgu_t, 0, MAP_UP, g_pre_ffn, nullptr, I_GU);
        P0_JOB(w_down, DFF, DM, Wdown_t, 0, MAP_ID, nullptr, nullptr, I_DN);
#undef P0_JOB
        const int gt = vcu * (NWAVES * 64) + tid, NGT = G * NWAVES * 64;
        for (int i = gt; i < 64 * 1024 / 8; i += NGT) *(u32x4*)(Win_t + (size_t)1728 * 1024 + (size_t)i * 8) = (u32x4){0u, 0u, 0u, 0u};
        for (int i = gt; i < DM * DM / 4; i += NGT) { const f32x4 v = __builtin_nontemporal_load((const f32x4*)(w_mq + (size_t)i * 4)) * g_pre_mem[i >> 8]; u32x2 w; w.x = cvt_pk_bf16(v.x, v.y); w.y = cvt_pk_bf16(v.z, v.w); *(u32x2*)(Wmq_b + (size_t)i * 4) = w; }
        for (int i = gt; i < T * 32; i += NGT) { const int row = i >> 5, k = i & 31; const double invf = exp2(-(double)k * (13.287712379549449 / 32.0));
            const double rev = (double)positions[row] * invf * 0.15915494309189535; const float fr_ = (float)(rev - rint(rev)); cosT[i] = __builtin_amdgcn_cosf(fr_); sinT[i] = __builtin_amdgcn_sinf(fr_); }
        { const int rpw = T / (G * NWAVES);
          for (int m = gw * rpw; m < (gw + 1) * rpw; m += 4) rms_rows_to_bf16<4, false>(x_in + (size_t)m * DM, g_pre_mix, XN + (size_t)m * DM, ssq_x + m, lane); }
        { const int rpw = TM / (G * NWAVES);
          for (int m = gw * rpw; m < (gw + 1) * rpw; m += 2) rms_rows_to_bf16<2, true>(mem + (size_t)m * DM, g_mem_kv, MN + (size_t)m * DM, nullptr, lane); }
    }
    SEAM(0); TE(0);
    TS(1); if (IN(1)) REPS(1) {
        {
          struct P1Order { pg8::TileOrder o; int nz, mu; const char* A2; const char* B2;
              __device__ bool next(int i, pg8::Unit& un) const { if (o.next(i, un)) return true; if (i != nz || mu < 0) return false;
                  un.pm = mu >> 3; un.pn = mu & 7; un.A = A2 + (size_t)un.pm * 256 * DM * 2; un.B = B2 + (size_t)un.pn * 256 * DM * 2; un.cofs = 0; un.job = 1; un.wait = nullptr; un.done = nullptr; return true; } };
          const int j = bx >> 3; P1Order S; S.o.init(T, DINP, G, bx, XN, DM, Win_t, DM);
          S.nz = (896 - bx + G - 1) / G;
          S.mu = (G == 256) ? (j >= 16 ? ((bx & 7) * 2 + ((j - 16) >> 3)) * 8 + ((j - 16) & 7) : -1) : (bx < 128 ? bx : -1); S.A2 = (const char*)MN; S.B2 = (const char*)Wmkv_t;
          EpiP1 E{EpiZ{Z, KPE, RSQ(ssq_cq), RSQ(ssq_ckv), cosT, sinT, ssq_x}, EpiBf16{MKV, 2048, 1.f, nullptr, 0.f}};
          pg8::gemm_phase<EpiP1, P1Order>(lds, DM, DM, DM, S, E, wave_s); }
    }
    SEAM(1); TE(1);
    TS(2); if (IN(2)) REPS(2) {
#ifndef P2SUB
#define P2SUB 31
#endif
#ifndef REP_P2SUB
#define REP_P2SUB 0
#endif
#define R2(i) for (int r2 = 0; r2 < (((REP_P2SUB) >> (i)) & 1) + 1; ++r2)
        if (P2SUB & 1) R2(0) for (int uidx = vcu; uidx < BATCH * 16; uidx += G) lru::unit(uidx >> 4, uidx & 15, Z, Y, (rep | r2) ? ssq_dummy : ssq_lru, conv_w, conv_b, lru_wa, lru_ba, lru_wx, lru_bx, lru_lambda, lds, wave_s);
#ifndef P2_MERGED
#define P2_MERGED 1
#endif
#if P2_MERGED
        { struct P2Order { pg8::TileOrder oq, okv; int nq, c, G; const bf16_t* mkv; const bf16_t* wmq; const bf16_t* wmo;
              __device__ bool next(int i, pg8::Unit& u) const {
                  if (i < nq) { oq.next(i, u); u.job = 0; u.lda = DINP; u.ldb = QLR; u.nt = QLR / 64; return true; }
                  i -= nq; if (i < 2) { okv.next(i, u); u.job = 1; u.lda = DINP; u.ldb = KVLR; u.nt = KVLR / 64; return true; }
                  i -= 2; if (i >= 2 || c >= 256) return false;
                  const int bh = c >> 2, q = c & 3, b = bh >> 2, h = bh & 3; u.wait = nullptr; u.done = nullptr; u.nt = 4;
                  if (i == 0) { u.pm = 0; u.pn = q; u.A = (const char*)(mkv + (size_t)(b * 256) * 2048 + h * 256); u.B = (const char*)(wmq + (size_t)(q * 256) * 1024 + h * 256); u.cofs = ((long)b * 1024 + h * 256) * 1024; u.job = 2; u.lda = 2048; u.ldb = 1024; }
                  else { u.pm = q; u.pn = 0; u.A = (const char*)(wmo + (size_t)(q * 256) * 1024 + h * 256); u.B = (const char*)(mkv + (size_t)(b * 256) * 2048 + 1024 + h * 256); u.cofs = (long)b * 1024 * 1024 + h * 256; u.job = 3; u.lda = 1024; u.ldb = 2048; }
                  return true; } };
          P2Order S; S.oq.init(T, 768, G, bx, Z + OFF_CQ, DINP, Wuq_t, QLR); S.okv.init(T, 1024, G, (bx + 128) % G, Z + OFF_CKV, DINP, Wukv_t, KVLR);
          S.nq = (384 - bx + G - 1) / G; S.c = vcu; S.G = G; S.mkv = MKV; S.wmq = Wmq_b; S.wmo = Wmo_t;
          EpiP2 E{EpiQ{Qb, ssq_cq, cosT, sinT}, EpiBf16{KVb, 1024, 1.f, ssq_ckv, 1.f / KVLR}, EpiBf16{WQK, 1024, MSCALE, nullptr, 0.f}, EpiBf16{WVO, 1024, 1.f, nullptr, 0.f}};
          pg8::gemm_phase_v<EpiP2, P2Order>(lds, S, E, wave_s); }
#else
        if (P2SUB & 2) R2(1) { pg8::TileOrder S; S.init(T, 768, G, bx, Z + OFF_CQ, DINP, Wuq_t, QLR); EpiQ E{Qb, ssq_cq, cosT, sinT};
          pg8::gemm_phase<EpiQ, pg8::TileOrder>(lds, DINP, QLR, QLR, S, E, wave_s); }
        if (P2SUB & 4) R2(2) { pg8::TileOrder S; S.init(T, 1024, G, (bx + 128) % G, Z + OFF_CKV, DINP, Wukv_t, KVLR); EpiBf16 E{KVb, 1024, 1.f, ssq_ckv, 1.f / KVLR};
          pg8::gemm_phase<EpiBf16, pg8::TileOrder>(lds, DINP, KVLR, KVLR, S, E, wave_s); }
        struct FormQK { int G, c; const bf16_t* mkv; const bf16_t* W;
            __device__ bool next(int i, pg8::Unit& u) const { const int L = i * G + c; if (L >= 256) return false; const int bh = L >> 2, q = L & 3, b = bh >> 2, h = bh & 3;
                u.pm = 0; u.pn = q; u.A = (const char*)(mkv + (size_t)(b * 256) * 2048 + h * 256); u.B = (const char*)(W + (size_t)(q * 256) * 1024 + h * 256); u.cofs = ((long)b * 1024 + h * 256) * 1024; u.job = 0; u.wait = nullptr; u.done = nullptr; return true; } };
        struct FormVO { int G, c; const bf16_t* mkv; const bf16_t* W;
            __device__ bool next(int i, pg8::Unit& u) const { const int L = i * G + c; if (L >= 256) return false; const int bh = L >> 2, q = L & 3, b = bh >> 2, h = bh & 3;
                u.pm = q; u.pn = 0; u.A = (const char*)(W + (size_t)(q * 256) * 1024 + h * 256); u.B = (const char*)(mkv + (size_t)(b * 256) * 2048 + 1024 + h * 256); u.cofs = (long)b * 1024 * 1024 + h * 256; u.job = 0; u.wait = nullptr; u.done = nullptr; return true; } };
        if (P2SUB & 8) R2(3) { FormQK S{G, vcu, MKV, Wmq_b}; EpiBf16 E{WQK, 1024, MSCALE, nullptr, 0.f}; pg8::gemm_phase<EpiBf16, FormQK>(lds, 2048, 1024, 256, S, E, wave_s); }
        if (P2SUB & 16) R2(3) { FormVO S{G, vcu, MKV, Wmo_t}; EpiBf16 E{WVO, 1024, 1.f, nullptr, 0.f}; pg8::gemm_phase<EpiBf16, FormVO>(lds, 1024, 2048, 256, S, E, wave_s); }
#endif
    }
    SEAM(2); TE(2);
    TS(3); if (IN(3)) REPS(3) {
        for (int it = vcu; it < BATCH * 4 * 4; it += G) { const int bh = it >> 2, xq = it & 3, b = bh >> 2, h = bh & 3;
            mla::block(b, h, xq, Qb, KVb, KPE, Y, RSQ(ssq_mla), (char*)lds_raw, wave_s);
            mla::block(b, h, 7 - xq, Qb, KVb, KPE, Y, RSQ(ssq_mla), (char*)lds_raw, wave_s); }
    }
    SEAM(3); TE(3);
#ifndef CHAIN_TAIL
#define CHAIN_TAIL 0
#endif
#if CHAIN_TAIL
    TS(5); if (IN(5)) {
        unsigned* dn = ctl + CW_DONE;
        { pg8::TileOrder S; S.init(T, DM, G, bx, Y, DM, Wout_t, DM);
          EpiNormResMid E{nullptr, XN, nullptr, g_post_mix, XN, ssq_h1, slots_p, ctl + CW_SEAM, false, ssq_lru, ssq_mla};
          pg8::gemm_phase<EpiNormResMid, pg8::TileOrder>(lds, DM, DM, DM, S, E, wave_s); }
        if (!grouped) xcd_barrier(bar, wave_s); else xcd_barrier(gbar, wave_s);
        { ChainOrder S; S.o.init(T, DM, G, bx, XN, DM, WQK, DM, (size_t)DM * DM * 2); S.wt_base = nullptr; S.dn_base = dn + SEAM_BANK;
          EpiSoftmax E{Pb, ssq_h1, true};
          pg8::gemm_phase<EpiSoftmax, ChainOrder, true, true, true>(lds, DM, DM, DM, S, E, wave_s); }
        { ChainOrder S; S.o.init(T, DM, G, bx, Pb, DM, WVO, DM, (size_t)DM * DM * 2); S.wt_base = dn + SEAM_BANK; S.dn_base = dn + 2 * SEAM_BANK;
          EpiNormRes E{nullptr, XN, nullptr, g_post_mem, XN, ssq_h2, slots_p + (size_t)4 * T, ctl + CW_SEAM + SEAM_BANK, true, nullptr, nullptr};
          pg8::gemm_phase<EpiNormRes, ChainOrder, true, true, true>(lds, DM, DM, DM, S, E, wave_s); }
        { ChainOrder S; S.o.init(T, 2 * DFF, G, bx, XN, DM, Wgu_t, DM); S.wt_base = dn + 2 * SEAM_BANK; S.dn_base = nullptr;
          EpiSwiGLU E{Fb, ssq_h2};
          pg8::gemm_phase<EpiSwiGLU, ChainOrder, true, true, true>(lds, DM, DM, DM, S, E, wave_s); } }
    if (IN(5) && IN(11)) { if (!grouped) xcd_barrier(bar, wave_s); else xcd_barrier(gbar, wave_s); } TE(5); TE(7); TE(8); TE(10);
#else
    TS(5); if (IN(5)) REPS(5) { pg8::TileOrder S; S.init(T, DM, G, bx, Y, DM, Wout_t, DM);
        EpiNormResMid E{nullptr, XN, nullptr, g_post_mix, rep ? (bf16_t*)PRE : XN, RSQ(ssq_h1), slots_p, ctl + CW_SEAM, false, ssq_lru, ssq_mla};
        pg8::gemm_phase<EpiNormResMid, pg8::TileOrder>(lds, DM, DM, DM, S, E, wave_s); }
    SEAM(5); TE(5);
    TS(7); if (IN(7)) REPS(7) { pg8::TileOrder S; S.init(T, DM, G, bx, XN, DM, WQK, DM, (size_t)DM * DM * 2); EpiSoftmax E{Pb, ssq_h1, false}; pg8::gemm_phase<EpiSoftmax, pg8::TileOrder>(lds, DM, DM, DM, S, E, wave_s); }
    SEAM(7); TE(7);
    TS(8); if (IN(8)) REPS(8) { pg8::TileOrder S; S.init(T, DM, G, bx, Pb, DM, WVO, DM, (size_t)DM * DM * 2); EpiNormRes E{nullptr, XN, nullptr, g_post_mem, rep ? (bf16_t*)PRE : XN, RSQ(ssq_h2), slots_p + (size_t)4 * T, ctl + CW_SEAM + SEAM_BANK, false, nullptr, nullptr};
        pg8::gemm_phase<EpiNormRes, pg8::TileOrder>(lds, DM, DM, DM, S, E, wave_s); }
    SEAM(8); TE(8);
#ifdef COLD10
    if (IN(10)) { for (int m = gw * 4; m < T; m += NGW * 4) rms_rows_to_bf16<4, true>(x_in + (size_t)m * DM, g_pre_mix, (bf16_t*)PRE + (size_t)m * DM, nullptr, lane);
                  for (int m = gw * 4; m < T; m += NGW * 4) rms_rows_to_bf16<4, true>(x_in + (size_t)m * DM, g_pre_mix, (bf16_t*)PRE + (size_t)(T + m) * DM, nullptr, lane); xcd_barrier(gbar, wave_s); }
#endif
    TS(10); if (IN(10)) REPS(10) { pg8::TileOrder S; S.init(T, 2 * DFF, G, bx, XN, DM, Wgu_t, DM); EpiSwiGLU E{Fb, ssq_h2}; pg8::gemm_phase<EpiSwiGLU, pg8::TileOrder, ALIGN_P10>(lds, DM, DM, DM, S, E, wave_s); }
    SEAM(10); TE(10);
#endif
    TS(11); if (IN(11)) REPS(11) { pg8::TileOrder S; S.init(T, DM, G, bx, Fb, DFF, Wdown_t, DFF); EpiNormRes E{nullptr, XN, rep ? PRE : out_p, g_post_ffn, nullptr, nullptr, slots_p + (size_t)8 * T, ctl + CW_SEAM + 2 * SEAM_BANK, false, nullptr, nullptr};
        pg8::gemm_phase<EpiNormRes, pg8::TileOrder>(lds, DFF, DFF, DFF, S, E, wave_s); }
    TE(11);
#ifdef CLKPROBE
    if ((SPIN_LO) >= 0) { const unsigned long long dt = ((tc1 - tc0) * 1000ull) / (ts1 - ts0), t2 = __builtin_amdgcn_s_memrealtime();
#else
    if ((SPIN_LO) >= 0) { const unsigned long long dt = ts1 - ts0, t2 = __builtin_amdgcn_s_memrealtime();
#endif
        while (__builtin_amdgcn_s_memrealtime() - t2 < dt) __builtin_amdgcn_s_sleep(8); }
#undef IN
#undef SEAM
}

#undef tid
#undef lane
#undef wave
#undef gw
#undef NGW
#undef x_in
#undef ssq_h1
#undef ssq_h2
#undef ssq_dummy
#undef ssq_x
#undef slots_p
#undef mem
#undef positions
#undef g_pre_mix
#undef w_in
#undef conv_w
#undef conv_b
#undef lru_wa
#undef lru_ba
#undef lru_wx
#undef lru_bx
#undef lru_lambda
#undef g_q_lat
#undef w_uq
#undef g_kv_lat
#undef w_ukv
#undef g_lru_out
#undef g_mla_out
#undef w_out
#undef g_post_mix
#undef g_pre_mem
#undef g_mem_kv
#undef w_mq
#undef w_mk
#undef w_mv
#undef w_mo
#undef g_post_mem
#undef g_pre_ffn
#undef w_gate
#undef w_up
#undef w_down
#undef g_post_ffn
#undef out_p
#undef ctl
#undef ssq_cq
#undef ssq_ckv
#undef ssq_lru
#undef ssq_mla
#undef cosT
#undef sinT
#undef Win_t
#undef Wuq_t
#undef Wukv_t
#undef Wout_t
#undef Wmq_b
#undef Wmkv_t
#undef Wmo_t
#undef Wgu_t
#undef Wdown_t
#undef MN
#undef MKV
#undef WQK
#undef WVO
#undef XN
#undef KPE
#undef Z
#undef Qb
#undef KVb
#undef Y
#undef PRE
#undef Pb
#undef Fb
#ifndef N_LAUNCHES
#define N_LAUNCHES 1
#endif
extern "C" void kernel_launch(void* const* d_in, const int* in_sizes, int n_in, void* d_out, int out_size, void* d_ws, size_t ws_size, hipStream_t stream) {
    static int grid = 0;
    if (grid == 0) {
        if (n_in != 32 || in_sizes[0] != T * DM || out_size != T * DM || ws_size < WS_END) { fprintf(stderr, "kernel_launch: unexpected shapes (n_in %d, in0 %d, out %d, ws %zu)\n", n_in, n_in > 0 ? in_sizes[0] : -1, out_size, ws_size); grid = -1; return; }
        int dev = 0, cus = 0, per_cu = 0;
        (void)hipGetDevice(&dev); (void)hipDeviceGetAttribute(&cus, hipDeviceAttributeMultiprocessorCount, dev);
        if (hipFuncSetAttribute((const void*)hymba_fwd, hipFuncAttributeMaxDynamicSharedMemorySize, LDS_BYTES) != hipSuccess) { fprintf(stderr, "kernel_launch: hipFuncSetAttribute failed\n"); grid = -1; return; }
        if (hipOccupancyMaxActiveBlocksPerMultiprocessor(&per_cu, (const void*)hymba_fwd, NWAVES * 64, LDS_BYTES) != hipSuccess || per_cu < 1) { fprintf(stderr, "kernel_launch: occupancy query says %d\n", per_cu); per_cu = 1; }
        (void)hipGetLastError();
        grid = cus > 0 ? cus : 256;
    }
    if (grid < 0) return;
    (void)hipMemsetAsync((char*)d_ws + WS_CTL, 0, CTL_ZERO_BYTES, stream);
    Args a{};
    for (int i = 0; i < 32; ++i) a.in[i] = d_in[i];
    a.out = (float*)d_out; a.ws = (unsigned char*)d_ws;
#if N_LAUNCHES == 1
    a.ph_lo = 0; a.ph_hi = NPHASE;
    void* kargs[] = {&a};
#ifdef PLAIN_LAUNCH
    (void)kargs; hipLaunchKernelGGL(hymba_fwd, dim3(grid), dim3(NWAVES * 64), LDS_BYTES, stream, a); hipError_t e = hipPeekAtLastError();
#else
    hipError_t e = hipLaunchCooperativeKernel((const void*)hymba_fwd, dim3(grid), dim3(NWAVES * 64), kargs, LDS_BYTES, stream);
#endif
    if (e != hipSuccess) fprintf(stderr, "kernel_launch: cooperative launch failed: %s (grid %d)\n", hipGetErrorString(e), grid);
#else
    for (int p = 0; p < NPHASE; ++p) { a.ph_lo = p; a.ph_hi = p + 1; hipLaunchKernelGGL(hymba_fwd, dim3(grid), dim3(NWAVES * 64), LDS_BYTES, stream, a); }
#endif
}
```
